# Optimizing an MI355X kernel written in HIP

```python
import math
import jax
import jax.numpy as jnp
from jax import lax
import numpy as np

D_MODEL = 2048
BATCH = 1
SEQ = 16384
DEPTH = 1

MIX_WIDTH = D_MODEL
ML_HEADS = 4
ML_V_W = MIX_WIDTH // 2
ML_DV = ML_V_W // ML_HEADS
ML_DQK = ML_DV // 2
ML_QK_W = ML_HEADS * ML_DQK
ML_CHUNK = 64
CONV_K = 4
MB_W = MIX_WIDTH - ML_V_W
MB_HEADS = 8
MB_DH = MB_W // MB_HEADS
MB_BLOCK = 256
MB_TOPK = 3
MB_QCHUNK = 64
ROPE_THETA = 500000.0
ROPE_DIM = MB_DH // 4
D_FF = ((8 * D_MODEL + 3 * 256 - 1) // (3 * 256)) * 256
LN_EPS = 1e-5
DN_ALPHA = (2 * DEPTH) ** 0.25
DN_BETA = (8 * DEPTH) ** -0.25
IN_SIZES = (MB_W, MB_W, MB_W, ML_QK_W, ML_QK_W, ML_V_W, ML_V_W, ML_HEADS, ML_HEADS)
IN_OFFSETS = tuple(int(o) for o in np.cumsum(IN_SIZES)[:-1])
IN_WIDTH = int(sum(IN_SIZES))

kernel_name = "hymba_mlstm_moba_deepnorm_adaln"


def layer_norm(x, w, b):
    xf = x.astype(jnp.float32)
    mu = jnp.mean(xf, axis=-1, keepdims=True)
    var = jnp.mean(jnp.square(xf - mu), axis=-1, keepdims=True)
    return ((xf - mu) * lax.rsqrt(var + LN_EPS) * w + b).astype(x.dtype)


def rope_partial(x, pos):
    half = ROPE_DIM // 2
    inv = ROPE_THETA ** (-jnp.arange(half, dtype=jnp.float32) * 2.0 / ROPE_DIM)
    ang = pos.astype(jnp.float32)[:, None] * inv[None, :]
    cos = jnp.cos(ang)[None, :, None, :]
    sin = jnp.sin(ang)[None, :, None, :]
    xf = x[..., :ROPE_DIM].astype(jnp.float32)
    x1, x2 = xf[..., :half], xf[..., half:]
    rot = jnp.concatenate([x1 * cos - x2 * sin, x2 * cos + x1 * sin], axis=-1)
    return jnp.concatenate([rot.astype(x.dtype), x[..., ROPE_DIM:]], axis=-1)


def causal_conv(x, w, b):
    ch = x.shape[-1]
    y = lax.conv_general_dilated(x, w[:, None, :].astype(x.dtype), (1,), [(CONV_K - 1, 0)],
                                 dimension_numbers=('NWC', 'WIO', 'NWC'), feature_group_count=ch)
    return y + b.astype(x.dtype)


def moba_attention(q, k, v):
    B, S, H, Dh = q.shape
    nb = -(-S // MB_BLOCK)
    pad = nb * MB_BLOCK - S
    kp = jnp.pad(k, ((0, 0), (0, pad), (0, 0), (0, 0)))
    vp = jnp.pad(v, ((0, 0), (0, pad), (0, 0), (0, 0)))
    kblk = kp.reshape(B, nb, MB_BLOCK, H, Dh).transpose(0, 3, 1, 2, 4)
    vblk = vp.reshape(B, nb, MB_BLOCK, H, Dh).transpose(0, 3, 1, 2, 4)
    kmean = jnp.mean(kblk.astype(jnp.float32), axis=3)
    topk = min(MB_TOPK, nb)
    nq = S // MB_QCHUNK
    q_chunks = q.reshape(B, nq, MB_QCHUNK, H, Dh).transpose(1, 0, 2, 3, 4)
    scale = Dh ** -0.5
    b_ix = jnp.arange(B)[:, None, None, None]
    h_ix = jnp.arange(H)[None, None, :, None]

    def one_chunk(args):
        qc, ci = args
        q0 = ci * MB_QCHUNK
        blk = q0 // MB_BLOCK
        qpos = q0 + jnp.arange(MB_QCHUNK)
        gate = jnp.einsum('bqhd,bhnd->bqhn', qc.astype(jnp.float32), kmean)
        gate = jnp.where(jnp.arange(nb) < blk, gate, -jnp.inf)
        _, idx = lax.top_k(gate, topk)
        valid = jnp.arange(topk) < blk
        ksel = kblk[b_ix, h_ix, idx]
        vsel = vblk[b_ix, h_ix, idx]
        s_sel = jnp.einsum('bqhd,bqhjkd->bqhjk', qc, ksel).astype(jnp.float32) * scale
        s_sel = jnp.where(valid[:, None], s_sel, -jnp.inf)
        kown = lax.dynamic_index_in_dim(kblk, blk, axis=2, keepdims=False)
        vown = lax.dynamic_index_in_dim(vblk, blk, axis=2, keepdims=False)
        s_own = jnp.einsum('bqhd,bhkd->bqhk', qc, kown).astype(jnp.float32) * scale
        kpos = blk * MB_BLOCK + jnp.arange(MB_BLOCK)
        causal = (kpos[None, :] <= qpos[:, None])[None, :, None, :]
        s_own = jnp.where(causal, s_own, -jnp.inf)
        logits = jnp.concatenate([s_sel.reshape(B, MB_QCHUNK, H, topk * MB_BLOCK), s_own], axis=-1)
        p = jax.nn.softmax(logits, axis=-1)
        p_sel = p[..., :topk * MB_BLOCK].reshape(B, MB_QCHUNK, H, topk, MB_BLOCK).astype(v.dtype)
        p_own = p[..., topk * MB_BLOCK:].astype(v.dtype)
        return (jnp.einsum('bqhjk,bqhjkd->bqhd', p_sel, vsel)
                + jnp.einsum('bqhk,bhkd->bqhd', p_own, vown))

    out = lax.map(one_chunk, (q_chunks, jnp.arange(nq)))
    return out.transpose(1, 0, 2, 3, 4).reshape(B, S, H * Dh)


def _mlstm_chunk_step(carry, inp):
    c_st, n_st, m_st = carry
    q, k, v, ig, lf = inp
    L = q.shape[-2]
    causal = jnp.tril(jnp.ones((L, L), dtype=bool))
    b = jnp.cumsum(lf, axis=-1)
    a = b + m_st[..., None]
    d = jnp.where(causal, b[..., :, None] - b[..., None, :] + ig[..., None, :], -jnp.inf)
    m_t = jnp.maximum(a, jnp.max(d, axis=-1))
    s = jnp.einsum('bhtd,bhsd->bhts', q, k) * jnp.exp(d - m_t[..., None])
    w_inter = jnp.exp(a - m_t)
    num = w_inter[..., None] * jnp.einsum('bhtd,bhdv->bhtv', q, c_st) + jnp.einsum('bhts,bhsv->bhtv', s, v)
    den = w_inter * jnp.einsum('bhtd,bhd->bht', q, n_st) + jnp.sum(s, axis=-1)
    h = num / jnp.maximum(jnp.abs(den), jnp.exp(-m_t))[..., None]
    b_last = b[..., -1]
    g = b_last[..., None] - b + ig
    m_new = jnp.maximum(b_last + m_st, jnp.max(g, axis=-1))
    w_k = jnp.exp(g - m_new[..., None])
    decay = jnp.exp(b_last + m_st - m_new)
    c_new = decay[..., None, None] * c_st + jnp.einsum('bhs,bhsd,bhsv->bhdv', w_k, k, v)
    n_new = decay[..., None] * n_st + jnp.einsum('bhs,bhsd->bhd', w_k, k)
    return (c_new, n_new, m_new), h


def mlstm(q, k, v, ig, fg):
    B, S, H, _ = q.shape
    nc = S // ML_CHUNK

    def to_chunks(t):
        t = t.astype(jnp.float32).reshape((B, nc, ML_CHUNK, H) + t.shape[3:])
        return jnp.moveaxis(t, (1, 3), (0, 2))

    lf = jax.nn.log_sigmoid(fg.astype(jnp.float32))
    init = (jnp.zeros((B, H, ML_DQK, ML_DV), jnp.float32),
            jnp.zeros((B, H, ML_DQK), jnp.float32),
            jnp.zeros((B, H), jnp.float32))
    _, h = lax.scan(_mlstm_chunk_step, init,
                    (to_chunks(q), to_chunks(k), to_chunks(v), to_chunks(ig), to_chunks(lf)))
    h = jnp.moveaxis(h, (0, 2), (1, 3))
    return h.reshape(B, S, H, ML_DV)


def setup_inputs(seed: int = 0) -> dict:
    key = jax.random.key(seed)
    ks = jax.random.split(key, 20)
    f32 = jnp.float32
    nrm = lambda k, shape, s: jax.random.normal(k, shape, f32) * s
    col_scale = np.ones((IN_WIDTH,), np.float32)
    col_scale[2 * MB_W:3 * MB_W] = DN_BETA
    v0 = 3 * MB_W + 2 * ML_QK_W
    col_scale[v0:v0 + ML_V_W] = DN_BETA
    return {
        "x": nrm(ks[0], (BATCH, SEQ, D_MODEL), 1.0),
        "c": nrm(ks[1], (BATCH, D_MODEL), 1.0),
        "w_ada": nrm(ks[2], (DEPTH, D_MODEL, 6 * D_MODEL), 0.5 * D_MODEL ** -0.5),
        "b_ada": nrm(ks[3], (DEPTH, 6 * D_MODEL), 0.02),
        "w_in": nrm(ks[4], (DEPTH, D_MODEL, IN_WIDTH), D_MODEL ** -0.5) * jnp.asarray(col_scale),
        "conv_w": nrm(ks[5], (DEPTH, CONV_K, 2 * ML_QK_W), CONV_K ** -0.5),
        "conv_b": nrm(ks[6], (DEPTH, 2 * ML_QK_W), 0.02),
        "ml_igate_b": nrm(ks[7], (DEPTH, ML_HEADS), 0.1),
        "ml_fgate_b": jnp.linspace(3.0, 6.0, ML_HEADS, dtype=f32)[None, :] + nrm(ks[8], (DEPTH, ML_HEADS), 0.01),
        "ml_norm_w": 1.0 + nrm(ks[9], (DEPTH, ML_V_W), 0.02),
        "w_out": nrm(ks[10], (DEPTH, MIX_WIDTH, D_MODEL), DN_BETA * MIX_WIDTH ** -0.5),
        "ln1_w": 1.0 + nrm(ks[11], (DEPTH, D_MODEL), 0.02),
        "ln1_b": nrm(ks[12], (DEPTH, D_MODEL), 0.02),
        "w_gu": nrm(ks[13], (DEPTH, D_MODEL, 2 * D_FF), DN_BETA * D_MODEL ** -0.5),
        "w_down": nrm(ks[14], (DEPTH, D_FF, D_MODEL), DN_BETA * D_FF ** -0.5),
        "ln2_w": 1.0 + nrm(ks[15], (DEPTH, D_MODEL), 0.02),
        "ln2_b": nrm(ks[16], (DEPTH, D_MODEL), 0.02),
    }


def reference(x, c, w_ada, b_ada, w_in, conv_w, conv_b, ml_igate_b, ml_fgate_b, ml_norm_w,
              w_out, ln1_w, ln1_b, w_gu, w_down, ln2_w, ln2_b):
    B, S, D = x.shape
    pos = jnp.arange(S)
    for l in range(DEPTH):
        ada = jax.nn.silu(c) @ w_ada[l] + b_ada[l]
        shift1, scale1, gate1, shift2, scale2, gate2 = [a[:, None, :] for a in jnp.split(ada, 6, axis=-1)]

        u = x * (1.0 + scale1) + shift1
        proj = u @ w_in[l]
        aq, ak, av, mq, mk, mv, mo, mi, mf = jnp.split(proj, IN_OFFSETS, axis=-1)

        aq = rope_partial(aq.reshape(B, S, MB_HEADS, MB_DH), pos)
        ak = rope_partial(ak.reshape(B, S, MB_HEADS, MB_DH), pos)
        a_out = moba_attention(aq, ak, av.reshape(B, S, MB_HEADS, MB_DH))

        qk = jax.nn.silu(causal_conv(jnp.concatenate([mq, mk], axis=-1), conv_w[l], conv_b[l]))
        mq, mk = jnp.split(qk, 2, axis=-1)
        h = mlstm(mq.reshape(B, S, ML_HEADS, ML_DQK),
                  mk.reshape(B, S, ML_HEADS, ML_DQK) * (ML_DQK ** -0.5),
                  mv.reshape(B, S, ML_HEADS, ML_DV),
                  mi + ml_igate_b[l], mf + ml_fgate_b[l])
        mu = jnp.mean(h, axis=-1, keepdims=True)
        var = jnp.mean(jnp.square(h - mu), axis=-1, keepdims=True)
        h = ((h - mu) * lax.rsqrt(var + LN_EPS)).reshape(B, S, ML_V_W) * ml_norm_w[l]
        m_out = (h * jax.nn.sigmoid(mo.astype(jnp.float32))).astype(x.dtype)

        mix = jnp.concatenate([m_out, a_out.astype(x.dtype)], axis=-1) @ w_out[l]
        x = layer_norm(DN_ALPHA * x + (1.0 + gate1) * mix, ln1_w[l], ln1_b[l])

        u = x * (1.0 + scale2) + shift2
        g, up = jnp.split(u @ w_gu[l], 2, axis=-1)
        f = (jax.nn.silu(g) * up) @ w_down[l]
        x = layer_norm(DN_ALPHA * x + (1.0 + gate2) * f, ln2_w[l], ln2_b[l])
    return x
```

```cpp
#include <hip/hip_runtime.h>
#include <cstdio>
#include <cstdint>
#include <cmath>
namespace pg8 {
#define PG8_LAS __attribute__((address_space(3)))
typedef unsigned short bf16_t;
typedef short bf16x8 __attribute__((ext_vector_type(8)));
typedef float f32x4 __attribute__((ext_vector_type(4)));
typedef unsigned u32x4 __attribute__((ext_vector_type(4)));
constexpr int BM = 256, BK = 64, HALF = 128, HTB = HALF * BK * 2  , STAGE_BYTES = 8 * HTB, NXCD = 8, WGM = 8;

__host__ __device__ __forceinline__ int lds_byte(int r, int c) { const int st = (r >> 4) * 2 + (c >> 5), rr = r & 15, cc = c & 31, ob = rr * 64 + cc * 2; return st * 1024 + (ob ^ (((ob >> 9) & 1) << 5)); }
__host__ __device__ __forceinline__ void stage_rc(int b, int& R, int& C) { const int st = b / 1024, sb = b % 1024, swz = sb ^ (((sb >> 9) & 1) << 5); R = (st >> 1) * 16 + swz / 64; C = (st & 1) * 32 + (swz % 64) / 2; }
__host__ __device__ __forceinline__ int perm32(int rho) { const int n = rho >> 4, i = rho & 15; return 8 * (i >> 2) + 4 * n + (i & 3); }

struct Unit { int pm, pn; };
struct Gemm { const bf16_t* A; const bf16_t* Bt; int M, N, K; };

struct StaticOrder {
    int nM, nN, nwg, G, c;
    __host__ __device__ void init(int M, int N, int G_, int c_) { nM = M / BM; nN = N / BM; nwg = nM * nN; G = G_; c = c_; }
    __host__ __device__ bool next(int i, Unit& u) const {
        const long L = (long)i * G + c; if (L >= nwg) return false;
        int wgid = (int)L; { const int q = nwg / NXCD, r = nwg % NXCD, xcd = wgid % NXCD, off = wgid / NXCD; wgid = (xcd < r ? xcd * (q + 1) : r * (q + 1) + (xcd - r) * q) + off; }
        const int nig = WGM * nN, gid = wgid / nig, fm = gid * WGM, gsz = (nM - fm) < WGM ? (nM - fm) : WGM;
        u.pm = fm + ((wgid % nig) % gsz); u.pn = (wgid % nig) / gsz; return true;
    }
    __device__ __forceinline__ void a_ready(const Unit&) const {}
    __device__ __forceinline__ void done(const Unit&) const {}
};

__device__ __forceinline__ unsigned cvt_pk_bf16(float lo, float hi) { unsigned r; asm volatile("v_cvt_pk_bf16_f32 %0, %1, %2" : "=v"(r) : "v"(lo), "v"(hi)); return r; }
typedef float f32x2 __attribute__((ext_vector_type(2)));
__device__ __forceinline__ f32x2 gelu_pk(f32x2 v) {
    const f32x2 av = __builtin_elementwise_abs(v), d = av * 0.2316418882f + 1.0f;
    f32x2 t; t.x = __builtin_amdgcn_rcpf(d.x); t.y = __builtin_amdgcn_rcpf(d.y);
    f32x2 q = t * 0.5307027145f + (-0.7265760135f); q = q * t + 0.7107068705f; q = q * t + (-0.142248368f); q = q * t + 0.127414796f; q = q * t;
    const f32x2 s = (v * v) * (-0.72134752044f);
    f32x2 e; e.x = __builtin_amdgcn_exp2f(s.x); e.y = __builtin_amdgcn_exp2f(s.y);
    const f32x2 m = v * (q * e), r = v - m;
    f32x2 o; o.x = v.x < 0.f ? m.x : r.x; o.y = v.y < 0.f ? m.y : r.y; return o;
}

template <int ACT  > struct EpiBf16 {
    static constexpr bool PERM = true, AFTER_DRAIN = false; static_assert(ACT == 0 || ACT == 1, "EpiBf16: ACT is 0 (none) or 1 (gelu_pk)");
    bf16_t* O; int ldc; const float* bias; int split_cols; size_t split_stride; float scale0;
    __device__ __forceinline__ void operator()(const f32x4 (&acc)[2][2][4][2], const Unit& u, int wr, int wc, int fr, int fq) const {
        const int row0 = u.pm * BM + wr * 64 + fr; int colt = u.pn * BM; bf16_t* base = O;
        float sc = 1.f; if (split_cols) { const int t = colt / split_cols; base += (size_t)t * split_stride; colt -= t * split_cols; if (t == 0) sc = scale0; }
        const int col0 = colt + wc * 32 + 8 * fq, bcol0 = u.pn * BM + wc * 32 + 8 * fq;
        f32x4 bv[2][2];
#pragma unroll
        for (int bj = 0; bj < 2; ++bj)
#pragma unroll
            for (int n = 0; n < 2; ++n) bv[bj][n] = bias ? *(const f32x4*)(bias + bcol0 + bj * HALF + 4 * n) : (f32x4){0.f, 0.f, 0.f, 0.f};
#pragma unroll
        for (int ai = 0; ai < 2; ++ai)
#pragma unroll
            for (int m = 0; m < 4; ++m) { bf16_t* rowp = base + (size_t)(row0 + ai * HALF + m * 16) * ldc + col0;
#pragma unroll
                for (int bj = 0; bj < 2; ++bj) { f32x4 v0 = acc[ai][bj][m][0] + bv[bj][0], v1 = acc[ai][bj][m][1] + bv[bj][1];
                    if (ACT == 1) { f32x2 a = gelu_pk((f32x2){v0[0], v0[1]}), b = gelu_pk((f32x2){v0[2], v0[3]}), c = gelu_pk((f32x2){v1[0], v1[1]}), d = gelu_pk((f32x2){v1[2], v1[3]});
                        v0 = (f32x4){a.x, a.y, b.x, b.y}; v1 = (f32x4){c.x, c.y, d.x, d.y}; }
                    v0 = v0 * sc; v1 = v1 * sc; u32x4 w; w.x = cvt_pk_bf16(v0[0], v0[1]); w.y = cvt_pk_bf16(v0[2], v0[3]); w.z = cvt_pk_bf16(v1[0], v1[1]); w.w = cvt_pk_bf16(v1[2], v1[3]);
                    *(u32x4*)(rowp + bj * HALF) = w; } }
    }
};

struct PanelStats {
    unsigned* xbuf;
    unsigned* cnt;
    unsigned* tmo;
    int ntn; float eps;
    unsigned code;
    __device__ __forceinline__ bool run(const f32x4 (&v)[2][2][4][2], const Unit& u, int wr, int wc, int fr, int fq, PG8_LAS unsigned char* lds, int wid, int lane) const {
        typedef float f32x2v __attribute__((ext_vector_type(2)));
        PG8_LAS f32x2v* P = (PG8_LAS f32x2v*)lds;
        PG8_LAS f32x2v* S = (PG8_LAS f32x2v*)(lds + 8192);
        PG8_LAS unsigned* flag = (PG8_LAS unsigned*)(lds + 8192 + 2048);
#pragma unroll
        for (int ai = 0; ai < 2; ++ai)
#pragma unroll
            for (int m = 0; m < 4; ++m) {
                float s = 0.f;
#pragma unroll
                for (int bj = 0; bj < 2; ++bj)
#pragma unroll
                    for (int n = 0; n < 2; ++n) { const f32x4 x = v[ai][bj][m][n]; s += (x[0] + x[1]) + (x[2] + x[3]); }
                s += __shfl_xor(s, 16); s += __shfl_xor(s, 32);
                const float mw = s * (1.0f / 64.0f); float q = 0.f;
#pragma unroll
                for (int bj = 0; bj < 2; ++bj)
#pragma unroll
                    for (int n = 0; n < 2; ++n) { const f32x4 d = v[ai][bj][m][n] - mw; q += (d[0] * d[0] + d[1] * d[1]) + (d[2] * d[2] + d[3] * d[3]); }
                q += __shfl_xor(q, 16); q += __shfl_xor(q, 32);
                if (fq == 0) P[(ai * HALF + wr * 64 + m * 16 + fr) * 4 + wc] = (f32x2v){mw, q};
            }
        asm volatile("s_waitcnt lgkmcnt(0)" ::: "memory"); __builtin_amdgcn_s_barrier(); asm volatile("" ::: "memory");
#if defined(BROKEN_EXCHANGE_NO_WAIT)
#warning BROKEN CONTROL BUILD: the row-statistics exchange does not wait; results are wrong by design
        if (blockIdx.x >= 64) { const long long t0_ = clock64(); while (clock64() - t0_ < 60000) __builtin_amdgcn_s_sleep(8); }
#endif
        const int row = wid * 32 + (lane & 31);
        if (lane < 32) {
            const f32x2v a = P[row * 4 + 0], b = P[row * 4 + 1], c = P[row * 4 + 2], d = P[row * 4 + 3];
            const float mt = (a.x + b.x + c.x + d.x) * 0.25f;
            const float da = a.x - mt, db = b.x - mt, dc = c.x - mt, dd = d.x - mt;
            const float m2 = (a.y + b.y) + (c.y + d.y) + 64.0f * ((da * da + db * db) + (dc * dc + dd * dd));
            unsigned long long* slot = (unsigned long long*)xbuf + ((size_t)(u.pm * BM + row) * 4 + u.pn);
            __hip_atomic_store(slot, ((unsigned long long)__float_as_uint(m2) << 32) | __float_as_uint(mt), __ATOMIC_RELAXED, __HIP_MEMORY_SCOPE_AGENT);
        }
        asm volatile("s_waitcnt vmcnt(0)" ::: "memory");
        if (lane == 0) __hip_atomic_fetch_add(cnt + 64 * u.pm, 1u, __ATOMIC_RELAXED, __HIP_MEMORY_SCOPE_AGENT);
        if (wid == 0) {
            bool dead = false; const unsigned long long t0 = __builtin_amdgcn_s_memrealtime(); const unsigned want = 8u * (unsigned)ntn;
            for (;;) {
#if defined(BROKEN_EXCHANGE_NO_WAIT)
                break;
#endif
                if ((unsigned)__builtin_amdgcn_readfirstlane(__hip_atomic_load(cnt + 64 * u.pm, __ATOMIC_RELAXED, __HIP_MEMORY_SCOPE_AGENT)) >= want) break;
                if (__builtin_amdgcn_s_memrealtime() - t0 > 2000000ull) {
                    if (lane == 0) { unsigned expect = 0u; __hip_atomic_compare_exchange_strong(tmo + 1, &expect, code | (unsigned)(u.pm & 0xff), __ATOMIC_RELAXED, __ATOMIC_RELAXED, __HIP_MEMORY_SCOPE_AGENT);
                                     __hip_atomic_store(tmo, 1u, __ATOMIC_RELAXED, __HIP_MEMORY_SCOPE_AGENT); }
                    dead = true; break; }
                __builtin_amdgcn_s_sleep(2);
            }
            __builtin_amdgcn_fence(__ATOMIC_ACQUIRE, "agent");
            if (lane == 0) flag[0] = dead ? 1u : 0u;
        }
        asm volatile("s_waitcnt vmcnt(0) lgkmcnt(0)" ::: "memory"); __builtin_amdgcn_s_barrier(); asm volatile("" ::: "memory");
        const bool bad = flag[0] != 0u;
        if (lane < 32) {
            const unsigned long long* slot = (const unsigned long long*)xbuf + (size_t)(u.pm * BM + row) * 4; float mt[4], m2[4]; float ms = 0.f;
#pragma unroll
            for (int t = 0; t < 4; ++t) { if (t < ntn) { const unsigned long long w = __hip_atomic_load(slot + t, __ATOMIC_RELAXED, __HIP_MEMORY_SCOPE_AGENT); mt[t] = __uint_as_float((unsigned)w); m2[t] = __uint_as_float((unsigned)(w >> 32)); } else { mt[t] = 0.f; m2[t] = 0.f; } ms += mt[t]; }
            const float mean = ms / (float)ntn; float q = 0.f;
#pragma unroll
            for (int t = 0; t < 4; ++t) if (t < ntn) { const float dm = mt[t] - mean; q += m2[t] + 256.0f * dm * dm; }
            S[row] = (f32x2v){mean, 1.0f / sqrtf(q / (256.0f * (float)ntn) + eps)};
        }
        asm volatile("s_waitcnt lgkmcnt(0)" ::: "memory"); __builtin_amdgcn_s_barrier(); asm volatile("" ::: "memory");
        return bad;
    }
};
struct EpiLnRes {
    static constexpr bool PERM = false, AFTER_DRAIN = true;
    const float* base; float* out; int ldc; const float* bias; PanelStats st; unsigned poison;
    __device__ __forceinline__ void fused(f32x4 (&acc)[2][2][4][2], const Unit& u, int wr, int wc, int fr, int fq, PG8_LAS unsigned char* lds, int wid, int lane) const {
        typedef float f32x2v __attribute__((ext_vector_type(2)));
        const PG8_LAS f32x2v* S = (const PG8_LAS f32x2v*)(lds + 8192);
        const int col0 = u.pn * BM + wc * 32 + 4 * fq;
#pragma unroll
        for (int bj = 0; bj < 2; ++bj)
#pragma unroll
            for (int n = 0; n < 2; ++n) { const f32x4 bv = bias ? *(const f32x4*)(bias + col0 + bj * HALF + n * 16) : (f32x4){0.f, 0.f, 0.f, 0.f};
#pragma unroll
                for (int ai = 0; ai < 2; ++ai)
#pragma unroll
                    for (int m = 0; m < 4; ++m) acc[ai][bj][m][n] += bv; }
        f32x4 pre[4][2][2];
#pragma unroll
        for (int m = 0; m < 4; ++m) { const size_t off = (size_t)(u.pm * BM + wr * 64 + m * 16 + fr) * ldc + col0;
#pragma unroll
            for (int bj = 0; bj < 2; ++bj)
#pragma unroll
                for (int n = 0; n < 2; ++n) pre[m][bj][n] = *(const f32x4*)(base + off + bj * HALF + n * 16); }
        const bool bad = st.run(acc, u, wr, wc, fr, fq, lds, wid, lane) || poison != 0u;
        const float qnan = __builtin_nanf("");
#pragma unroll
        for (int ai = 0; ai < 2; ++ai)
#pragma unroll
            for (int m = 0; m < 4; ++m) { const int r = ai * HALF + wr * 64 + m * 16 + fr; const f32x2v sr = S[r]; const size_t off = (size_t)(u.pm * BM + r) * ldc + col0;
#pragma unroll
                for (int bj = 0; bj < 2; ++bj)
#pragma unroll
                    for (int n = 0; n < 2; ++n) { const f32x4 bs = ai == 0 ? pre[m][bj][n] : *(const f32x4*)(base + off + bj * HALF + n * 16); f32x4 o = bs + (acc[ai][bj][m][n] - sr.x) * sr.y;
                        if (bad) o = (f32x4){qnan, qnan, qnan, qnan}; *(f32x4*)(out + off + bj * HALF + n * 16) = o; }
                if (m & 1) asm volatile("" ::: "memory"); }
    }
};
struct EpiLnResLn {
    static constexpr bool PERM = false, AFTER_DRAIN = true;
    const float* base; float* out; bf16_t* xn; int ldc; const float* bias; PanelStats st1, st2; unsigned poison;
    __device__ __forceinline__ void fused(f32x4 (&acc)[2][2][4][2], const Unit& u, int wr, int wc, int fr, int fq, PG8_LAS unsigned char* lds, int wid, int lane) const {
        typedef float f32x2v __attribute__((ext_vector_type(2))); typedef unsigned u32x2v __attribute__((ext_vector_type(2)));
        const PG8_LAS f32x2v* S = (const PG8_LAS f32x2v*)(lds + 8192);
        const int col0 = u.pn * BM + wc * 32 + 4 * fq;
#pragma unroll
        for (int bj = 0; bj < 2; ++bj)
#pragma unroll
            for (int n = 0; n < 2; ++n) { const f32x4 bv = bias ? *(const f32x4*)(bias + col0 + bj * HALF + n * 16) : (f32x4){0.f, 0.f, 0.f, 0.f};
#pragma unroll
                for (int ai = 0; ai < 2; ++ai)
#pragma unroll
                    for (int m = 0; m < 4; ++m) acc[ai][bj][m][n] += bv; }
        bool bad = st1.run(acc, u, wr, wc, fr, fq, lds, wid, lane) || poison != 0u;
        const float qnan = __builtin_nanf("");
#pragma unroll
        for (int ai = 0; ai < 2; ++ai)
#pragma unroll
            for (int m = 0; m < 4; ++m) { const int r = ai * HALF + wr * 64 + m * 16 + fr; const f32x2v sr = S[r]; const size_t off = (size_t)(u.pm * BM + r) * ldc + col0;
#pragma unroll
                for (int bj = 0; bj < 2; ++bj)
#pragma unroll
                    for (int n = 0; n < 2; ++n) { const f32x4 bs = *(const f32x4*)(base + off + bj * HALF + n * 16); acc[ai][bj][m][n] = bs + (acc[ai][bj][m][n] - sr.x) * sr.y; }
                asm volatile("" : "+v"(acc[ai][0][m][0]), "+v"(acc[ai][0][m][1]), "+v"(acc[ai][1][m][0]), "+v"(acc[ai][1][m][1]));
                if (m & 1) asm volatile("" ::: "memory"); }
        const bool bad1 = bad;
        bad = st2.run(acc, u, wr, wc, fr, fq, lds, wid, lane) || bad;
#pragma unroll
        for (int ai = 0; ai < 2; ++ai)
#pragma unroll
            for (int m = 0; m < 4; ++m) { const int r = ai * HALF + wr * 64 + m * 16 + fr; const f32x2v sr = S[r]; const size_t off = (size_t)(u.pm * BM + r) * ldc + col0;
#pragma unroll
                for (int bj = 0; bj < 2; ++bj)
#pragma unroll
                    for (int n = 0; n < 2; ++n) { const f32x4 x1 = acc[ai][bj][m][n]; *(f32x4*)(out + off + bj * HALF + n * 16) = bad1 ? (f32x4){qnan, qnan, qnan, qnan} : x1;
                        const f32x4 o = (x1 - sr.x) * sr.y; u32x2v w; w.x = cvt_pk_bf16(o[0], o[1]); w.y = cvt_pk_bf16(o[2], o[3]);
                        if (bad) { w.x = 0x7fc07fc0u; w.y = 0x7fc07fc0u; } *(u32x2v*)(xn + off + bj * HALF + n * 16) = w; }
                asm volatile("" ::: "memory"); }
    }
};

template <class Epi, class Sched, bool ALIGN_EPI = false, bool SP2 = false>
__device__ __forceinline__ void gemm_phase(PG8_LAS unsigned char* lds, const Gemm g, const Sched& S, const Epi& E) {
    const int tid = threadIdx.x, wid = __builtin_amdgcn_readfirstlane(tid >> 6), lane = tid & 63, wr = wid >> 2, wc = wid & 3, fr = lane & 15, fq = lane >> 4;
    const int K = g.K, nt = K / BK;
    unsigned voffA[2], voffB[2];
#pragma unroll
    for (int i = 0; i < 2; ++i) { int R, C; stage_rc(tid * 16 + i * 8192, R, C); const int Rb = Epi::PERM ? ((R & ~31) + perm32(R & 31)) : R;
        voffA[i] = (unsigned)(R * K + C) * 2u; voffB[i] = (unsigned)(Rb * K + C) * 2u; }
    const size_t kstep = (size_t)(BK * 2);
    const size_t hstep = (size_t)HALF * K * 2;
    const size_t tstep = 2 * hstep;
    const unsigned ldsw = (unsigned)wid * 1024u;
    const int aoff = lds_byte(wr * 64 + fr, fq * 8), boff = lds_byte(wc * 32 + fr, fq * 8);
#define PG8_SA(b, h) (((b) * 2 + (h)) * HTB)
#define PG8_SB(b, h) ((4 + (b) * 2 + (h)) * HTB)
#define PG8_STAGE(bufoff, gbase, voff) do { _Pragma("unroll") for (int _i = 0; _i < 2; ++_i) \
        __builtin_amdgcn_global_load_lds((const unsigned*)((const char*)(gbase) + (voff)[_i]), (PG8_LAS unsigned*)(lds + (bufoff) + ldsw + _i * 8192), 16, 0, 0); } while (0)
#define PG8_LDA(dst, b, h) do { _Pragma("unroll") for (int m = 0; m < 4; ++m) _Pragma("unroll") for (int k = 0; k < 2; ++k) dst[m][k] = *(const PG8_LAS bf16x8*)(lds + PG8_SA(b, h) + aoff + m * 2048 + k * 1024); } while (0)
#define PG8_LDB(dst, b, h) do { _Pragma("unroll") for (int n = 0; n < 2; ++n) _Pragma("unroll") for (int k = 0; k < 2; ++k) dst[n][k] = *(const PG8_LAS bf16x8*)(lds + PG8_SB(b, h) + boff + n * 2048 + k * 1024); } while (0)
#define PG8_MMA(ai, bj, At, Bt) do { __builtin_amdgcn_s_setprio(1); _Pragma("unroll") for (int m = 0; m < 4; ++m) _Pragma("unroll") for (int n = 0; n < 2; ++n) _Pragma("unroll") for (int k = 0; k < 2; ++k) \
        acc[ai][bj][m][n] = __builtin_amdgcn_mfma_f32_16x16x32_bf16(Bt[n][k], At[m][k], acc[ai][bj][m][n], 0, 0, 0); __builtin_amdgcn_s_setprio(0); } while (0)
#define PG8_WAIT_V(n) asm volatile("s_waitcnt vmcnt(" #n ")" ::: "memory")
#define PG8_WAIT_L(n) asm volatile("s_waitcnt lgkmcnt(" #n ")" ::: "memory")
#define PG8_BAR __builtin_amdgcn_s_barrier()
#define PG8_SCHED __builtin_amdgcn_sched_barrier(0)
    Unit cur, nxt; int ui = 0;
    if (!S.next(0, cur)) return;
    f32x4 acc[2][2][4][2];
#pragma unroll
    for (int a = 0; a < 2; ++a)
#pragma unroll
        for (int b = 0; b < 2; ++b)
#pragma unroll
            for (int m = 0; m < 4; ++m)
#pragma unroll
                for (int n = 0; n < 2; ++n) acc[a][b][m][n] = (f32x4){0.f, 0.f, 0.f, 0.f};
    bf16x8 At[4][2], B0[2][2], B1[2][2];
    const char* cA = (const char*)g.A + (size_t)cur.pm * tstep; const char* cB = (const char*)g.Bt + (size_t)cur.pn * tstep;
    S.a_ready(cur);
    if constexpr (SP2) {
        PG8_STAGE(PG8_SB(0, 0), cB, voffB); PG8_STAGE(PG8_SB(0, 1), cB + hstep, voffB); PG8_STAGE(PG8_SA(0, 0), cA, voffA); PG8_STAGE(PG8_SA(0, 1), cA + hstep, voffA);
        if (wr == 1) PG8_BAR;
        PG8_WAIT_V(2); PG8_BAR;
        PG8_STAGE(PG8_SB(1, 0), cB + kstep, voffB); PG8_STAGE(PG8_SA(1, 0), cA + kstep, voffA); PG8_STAGE(PG8_SB(1, 1), cB + hstep + kstep, voffB);
        PG8_WAIT_V(6); PG8_BAR;
    } else {
        PG8_STAGE(PG8_SB(0, 0), cB, voffB); PG8_STAGE(PG8_SA(0, 0), cA, voffA); PG8_STAGE(PG8_SB(0, 1), cB + hstep, voffB); PG8_STAGE(PG8_SA(0, 1), cA + hstep, voffA);
        if (wr == 1) PG8_BAR;
        PG8_WAIT_V(4); PG8_BAR;
        PG8_STAGE(PG8_SB(1, 0), cB + kstep, voffB); PG8_STAGE(PG8_SA(1, 0), cA + kstep, voffA); PG8_STAGE(PG8_SB(1, 1), cB + hstep + kstep, voffB);
        PG8_WAIT_V(6); PG8_BAR;
    }
    for (;;) {
        const bool has_next = S.next(ui + 1, nxt);
        const char* nA = has_next ? (const char*)g.A + (size_t)nxt.pm * tstep : cA; const char* nB = has_next ? (const char*)g.Bt + (size_t)nxt.pn * tstep : cB;
        for (int t = 0; t < nt; t += 2) {
            const bool last = (t == nt - 2);
            const char* a1 = cA + (size_t)(t + 1) * kstep;
            const char* a2 = last ? nA : cA + (size_t)(t + 2) * kstep; const char* b2 = last ? nB : cB + (size_t)(t + 2) * kstep;
            const char* a3 = a2 + kstep; const char* b3 = b2 + kstep;
            if (last && has_next) S.a_ready(nxt);
            if constexpr (SP2) {
            PG8_LDB(B0, 0, 0); PG8_LDB(B1, 0, 1); PG8_SCHED; PG8_LDA(At, 0, 0); PG8_STAGE(PG8_SA(1, 1), a1 + hstep, voffA);
            PG8_WAIT_V(8); PG8_WAIT_L(0); PG8_BAR; PG8_MMA(0, 0, At, B0); PG8_MMA(0, 1, At, B1); PG8_BAR; PG8_SCHED;
            PG8_LDA(At, 0, 1); PG8_STAGE(PG8_SB(0, 0), b2, voffB); PG8_STAGE(PG8_SB(0, 1), b2 + hstep, voffB); PG8_STAGE(PG8_SA(0, 0), a2, voffA);
            PG8_WAIT_V(8); PG8_WAIT_L(0); PG8_BAR; PG8_MMA(1, 0, At, B0); PG8_MMA(1, 1, At, B1); PG8_BAR; PG8_SCHED;
            PG8_LDB(B0, 1, 0); PG8_LDB(B1, 1, 1); PG8_SCHED; PG8_LDA(At, 1, 0); PG8_STAGE(PG8_SA(0, 1), a2 + hstep, voffA);
            PG8_WAIT_V(8); PG8_WAIT_L(0); PG8_BAR; PG8_MMA(0, 0, At, B0); PG8_MMA(0, 1, At, B1); PG8_BAR; PG8_SCHED;
            PG8_LDA(At, 1, 1); PG8_STAGE(PG8_SB(1, 0), b3, voffB); PG8_STAGE(PG8_SB(1, 1), b3 + hstep, voffB); PG8_STAGE(PG8_SA(1, 0), a3, voffA);
            PG8_WAIT_V(8); PG8_WAIT_L(0); PG8_BAR; PG8_MMA(1, 0, At, B0); PG8_MMA(1, 1, At, B1); PG8_BAR; PG8_SCHED;
            } else {
            PG8_LDB(B0, 0, 0); PG8_SCHED; PG8_LDA(At, 0, 0); PG8_STAGE(PG8_SA(1, 1), a1 + hstep, voffA);
            PG8_WAIT_L(8); PG8_BAR; PG8_WAIT_L(0); PG8_MMA(0, 0, At, B0); PG8_BAR; PG8_SCHED;
            PG8_LDB(B1, 0, 1); PG8_STAGE(PG8_SB(0, 0), b2, voffB);
            PG8_BAR; PG8_WAIT_L(0); PG8_MMA(0, 1, At, B1); PG8_BAR;
            PG8_LDA(At, 0, 1); PG8_STAGE(PG8_SA(0, 0), a2, voffA);
            PG8_BAR; PG8_WAIT_L(0); PG8_MMA(1, 0, At, B0); PG8_BAR; PG8_SCHED;
            PG8_STAGE(PG8_SB(0, 1), b2 + hstep, voffB);
            PG8_WAIT_V(6); PG8_BAR; PG8_MMA(1, 1, At, B1); PG8_BAR;
            PG8_LDB(B0, 1, 0); PG8_SCHED; PG8_LDA(At, 1, 0); PG8_STAGE(PG8_SA(0, 1), a2 + hstep, voffA);
            PG8_WAIT_L(8); PG8_BAR; PG8_WAIT_L(0); PG8_MMA(0, 0, At, B0); PG8_BAR; PG8_SCHED;
            PG8_LDB(B1, 1, 1); PG8_STAGE(PG8_SB(1, 0), b3, voffB);
            PG8_BAR; PG8_WAIT_L(0); PG8_MMA(0, 1, At, B1); PG8_BAR;
            PG8_LDA(At, 1, 1); PG8_STAGE(PG8_SA(1, 0), a3, voffA);
            PG8_BAR; PG8_WAIT_L(0); PG8_MMA(1, 0, At, B0); PG8_BAR; PG8_SCHED;
            PG8_STAGE(PG8_SB(1, 1), b3 + hstep, voffB);
            PG8_WAIT_V(6); PG8_BAR; PG8_MMA(1, 1, At, B1); PG8_BAR;
            }
        }
        if constexpr (ALIGN_EPI) { if (wr == 0) PG8_BAR; }
        if constexpr (!Epi::AFTER_DRAIN) { E(acc, cur, wr, wc, fr, fq); S.done(cur); }
        if (!has_next) break;
#pragma unroll
        for (int a = 0; a < 2; ++a)
#pragma unroll
            for (int b = 0; b < 2; ++b)
#pragma unroll
                for (int m = 0; m < 4; ++m)
#pragma unroll
                    for (int n = 0; n < 2; ++n) acc[a][b][m][n] = (f32x4){0.f, 0.f, 0.f, 0.f};
        cur = nxt; cA = nA; cB = nB; ++ui;
        if constexpr (ALIGN_EPI) { if (wr == 1) PG8_BAR; }
    }
    PG8_WAIT_V(0);
    if constexpr (!ALIGN_EPI) { if (wr == 0) PG8_BAR; }
    PG8_BAR;
    if constexpr (Epi::AFTER_DRAIN) { E.fused(acc, cur, wr, wc, fr, fq, lds, wid, lane); S.done(cur); }
#undef PG8_SA
#undef PG8_SB
#undef PG8_STAGE
#undef PG8_LDA
#undef PG8_LDB
#undef PG8_MMA
#undef PG8_WAIT_V
#undef PG8_WAIT_L
#undef PG8_BAR
#undef PG8_SCHED
}
}
#define GAS __attribute__((address_space(1)))
#define LAS __attribute__((address_space(3)))
typedef unsigned short bf16;
typedef unsigned v4u __attribute__((ext_vector_type(4)));
typedef float f32x4 __attribute__((ext_vector_type(4)));
typedef short bf16x8 __attribute__((ext_vector_type(8)));
typedef GAS unsigned gu32;
typedef GAS unsigned long long gu64;
#define RLX_AGENT __ATOMIC_RELAXED, __HIP_MEMORY_SCOPE_AGENT
#define LDS_WAIT() asm volatile("s_waitcnt lgkmcnt(0)" ::: "memory")
#define VM_WAIT() asm volatile("s_waitcnt vmcnt(0)" ::: "memory")
__device__ __forceinline__ unsigned long long rt() { return __builtin_amdgcn_s_memrealtime(); }
__device__ __forceinline__ unsigned f2bf(float f) { unsigned u = __builtin_bit_cast(unsigned, f); return (u + 0x7fffu + ((u >> 16) & 1u)) >> 16; }
__device__ __forceinline__ unsigned pk2(float lo, float hi) { return f2bf(lo) | (f2bf(hi) << 16); }
#define XB_TMO      128
#define XB_XCNT(j)  (256  + 64 * (j))
#define XB_XSUB(j)  (1280 + 64 * (j))
#define XB_XGEN(j)  (2304 + 64 * (j))
#define XB_TOP      3328
#define XB_TOPGEN   3392
#define XCD_BAR_WORDS 3456
#define XB_SPIN_CAP (1u << 18)

__device__ __forceinline__ unsigned xb_ld(unsigned* p)              { return __hip_atomic_load(p, __ATOMIC_RELAXED, __HIP_MEMORY_SCOPE_AGENT); }
__device__ __forceinline__ unsigned xb_add(unsigned* p, unsigned v) { return __hip_atomic_fetch_add(p, v, __ATOMIC_RELAXED, __HIP_MEMORY_SCOPE_AGENT); }
__device__ __forceinline__ unsigned xb_xcc_id() { return (unsigned)__builtin_amdgcn_s_getreg((3 << 11) | 20) & 0xFu; }
#define XB_SPIN(cond, bar) do { unsigned _sp = 0; while (cond) { __builtin_amdgcn_s_sleep(1); \
    if ((++_sp & 255u) == 0u) { if (xb_ld(&(bar)[XB_TMO])) break; if (_sp > XB_SPIN_CAP) { atomicAdd(&(bar)[XB_TMO], 1u); break; } } } } while (0)

struct XcdBarrier {
    unsigned* bar; unsigned x;
    volatile LAS unsigned* st;
};

__device__ __forceinline__ XcdBarrier xcd_barrier_post(unsigned* bar, volatile LAS unsigned* st) {
    XcdBarrier b; b.bar = bar; b.x = xb_xcc_id(); b.st = st;
    if (threadIdx.x == 0) (void)xb_add(&bar[XB_XCNT(b.x)], 1u);
    return b;
}
__device__ __forceinline__ void xcd_barrier_complete(unsigned* bar, unsigned x, unsigned& nloc, unsigned& nx) {
    const unsigned G = gridDim.x * gridDim.y * gridDim.z;
    unsigned sum, cnt, mine, sp = 0u;
    for (;;) {
        sum = 0u; cnt = 0u; mine = 0u;
#pragma unroll
        for (unsigned j = 0; j < 16; ++j) { const unsigned c = xb_ld(&bar[XB_XCNT(j)]); sum += c; cnt += (c > 0u) ? 1u : 0u; mine = (j == x) ? c : mine; }
        if (sum == G) break;
        __builtin_amdgcn_s_sleep(1);
        if ((++sp & 255u) == 0u) { if (xb_ld(&bar[XB_TMO])) break; if (sp > XB_SPIN_CAP) { atomicAdd(&bar[XB_TMO], 1u); break; } }
    }
    nloc = mine > 0u ? mine : 1u; nx = cnt > 0u ? cnt : 1u;
}

__device__ __forceinline__ void xcd_barrier(const XcdBarrier& b) {
    asm volatile("s_waitcnt vmcnt(0)" ::: "memory");
    __syncthreads();
    if (threadIdx.x == 0) {
        unsigned* bar = b.bar;
        __builtin_amdgcn_s_waitcnt(0);
        unsigned nloc = b.st[0], nx = b.st[1];
        if (nloc == 0u) { xcd_barrier_complete(bar, b.x, nloc, nx); b.st[0] = nloc; b.st[1] = nx; }
        const unsigned old = xb_add(&bar[XB_XSUB(b.x)], 1u);
        const unsigned gen = old / nloc;
        if (old + 1u == (gen + 1u) * nloc) {
            __builtin_amdgcn_fence(__ATOMIC_RELEASE, "agent");
            asm volatile("s_waitcnt vmcnt(0)" ::: "memory");
            const unsigned og = xb_add(&bar[XB_TOP], 1u);
            const unsigned tg = og / nx;
            if (og + 1u == (tg + 1u) * nx) xb_add(&bar[XB_TOPGEN], 1u);
            else XB_SPIN(xb_ld(&bar[XB_TOPGEN]) == tg, bar);
            __builtin_amdgcn_fence(__ATOMIC_ACQUIRE, "agent");
            xb_add(&bar[XB_XGEN(b.x)], 1u);
            asm volatile("s_waitcnt vmcnt(0)" ::: "memory");
        } else {
            XB_SPIN(xb_ld(&bar[XB_XGEN(b.x)]) == gen, bar);
            __builtin_amdgcn_fence(__ATOMIC_ACQUIRE, "agent");
            asm volatile("s_waitcnt vmcnt(0)" ::: "memory");
        }
    }
    __syncthreads();
}
constexpr int NWAVES = 8;
constexpr int M_TOK = 16384, DM = 2048, NPROJ = 6144, WIN_LD = 6152, DFF = 5632, NGU = 11264, NADA = 12288;
constexpr int MB_H = 8, MB_DH = 128, MB_BLK = 256, MB_NB = 64;
constexpr int ML_H = 4, ML_DQK = 128, ML_DV = 256, ML_L = 64, ML_NC = 256;
constexpr float DN_ALPHA = 1.189207115002721f;
constexpr float LN_EPS = 1e-5f;
constexpr float K_SCALE = 0.08838834764831845f;

constexpr size_t MiB = 1u << 20;
constexpr size_t WS_CTL = 0, CTL_ZERO_BYTES = 1 * MiB;
constexpr size_t WS_SMALL = 1 * MiB;
constexpr size_t SM_ADA = 0, SM_C1 = 64 * 1024, SM_C2 = 128 * 1024, SM_KMEAN = 256 * 1024, SM_GATES = 512 * 1024, SM_TOKSC = 1 * MiB,
                 SM_CHSUM = 2 * MiB, SM_DECAY = 2 * MiB + 16 * 1024, SM_NLOC = 2 * MiB + 64 * 1024, SM_MUR = 3 * MiB;
constexpr size_t WS_WIN = 6 * MiB, WS_LISTS = 6 * MiB, WS_STATP = 6 * MiB;
constexpr size_t WS_WOUT = 30 * MiB, WS_WGU = 38 * MiB, WS_WDOWN = 82 * MiB;
constexpr size_t WS_U = 104 * MiB, WS_LOCAL = 104 * MiB, WS_Y1B = 104 * MiB;
constexpr size_t WS_MIX = 168 * MiB, WS_H = 168 * MiB;
constexpr size_t WS_KB = 232 * MiB, WS_VB = 264 * MiB, WS_MQK = 296 * MiB, WS_MV = 328 * MiB;
constexpr size_t WS_PART0 = 296 * MiB, WS_PART1 = 328 * MiB, WS_PART2 = 440 * MiB, WS_PART3 = 472 * MiB, WS_LSE = 504 * MiB;
constexpr size_t WS_QC = 360 * MiB, WS_KC = 376 * MiB, WS_KWT = 392 * MiB, WS_VT = 408 * MiB;
constexpr size_t WS_ROPE = 506 * MiB, WS_C12P = 508 * MiB;
constexpr size_t WS_Y1F = 384 * MiB, WS_END = 512 * MiB;
constexpr int CW_TMO = 0, CW_BAR = 4096, CW_CNT = 16384;

constexpr int RING_BYTES = 131072, LDSCTL_OFF = RING_BYTES, MISC_OFF = LDSCTL_OFF + 320, LDS_BYTES = 147456;

typedef float f32x2 __attribute__((ext_vector_type(2)));
typedef unsigned u32x2 __attribute__((ext_vector_type(2)));

__device__ __forceinline__ float bf2f(unsigned short b) { return __builtin_bit_cast(float, (unsigned)b << 16); }
__device__ __forceinline__ float bflo(unsigned w) { return __builtin_bit_cast(float, w << 16); }
__device__ __forceinline__ float bfhi(unsigned w) { return __builtin_bit_cast(float, w & 0xffff0000u); }
__device__ __forceinline__ float sigmoid_f(float v) { return 1.f / (1.f + __expf(-v)); }
__device__ __forceinline__ float silu_f(float v) { return v / (1.f + __expf(-v)); }
__device__ __forceinline__ float logsigmoid_f(float v) { return fminf(v, 0.f) - log1pf(expf(-fabsf(v))); }

struct Frame {
    LAS unsigned char* lds;
    volatile LAS unsigned* MISC;
    gu32* ctl;
    int tid, lane, wave, G, bid;
    const float *x, *c, *w_ada, *b_ada, *w_in, *conv_w, *conv_b, *igb, *fgb, *normw, *w_out, *ln1_w, *ln1_b, *w_gu, *w_down, *ln2_w, *ln2_b;
    float* out; unsigned char* ws;
};
#define SMALLF(off) ((float*)(F.ws + WS_SMALL + (off)))

__device__ __forceinline__ float wave_sum(float v) {
#pragma unroll
    for (int o = 1; o < 64; o <<= 1) v += __shfl_xor(v, o);
    return v;
}

__device__ __forceinline__ void p0_transpose_item(const float* W, int K, int N, int ld, bf16* WT, LAS float* scr, int item, int lane) {
    const int nblk = N / 32, kb = item / nblk, nb = item % nblk, k0 = 64 * kb, n0 = 32 * nb;
#pragma unroll 8
    for (int i = 0; i < 32; ++i) { const int kk = 2 * i + (lane >> 5); scr[kk * 33 + (lane & 31)] = W[(size_t)(k0 + kk) * ld + n0 + (lane & 31)]; }
    LDS_WAIT(); asm volatile("" ::: "memory");
    const int c = lane & 7;
#pragma unroll
    for (int j = 0; j < 4; ++j) { const int n = (lane >> 3) + 8 * j; const LAS float* s = scr + (8 * c) * 33 + n;
        v4u o; o.x = pk2(s[0 * 33], s[1 * 33]); o.y = pk2(s[2 * 33], s[3 * 33]); o.z = pk2(s[4 * 33], s[5 * 33]); o.w = pk2(s[6 * 33], s[7 * 33]);
        *(GAS v4u*)(WT + (size_t)(n0 + n) * K + k0 + 8 * c) = o; }
    LDS_WAIT(); asm volatile("" ::: "memory");
}

__device__ __forceinline__ void p0_phase(Frame& F) {
    {
        LAS float* sc = (LAS float*)(F.lds); LAS float* red = sc + 2048;
        for (int k = F.tid; k < DM; k += 512) sc[k] = silu_f(F.c[k]);
        __syncthreads();
        float* ada = SMALLF(SM_ADA);
        for (int slab = F.bid; slab < NADA / 48; slab += F.G) {
            const int kg = F.tid / 12, cq = F.tid % 12;
            f32x4 acc = {0.f, 0.f, 0.f, 0.f};
            if (F.tid < 504) {
                const float* wp = F.w_ada + slab * 48 + cq * 4;
#pragma unroll 7
                for (int k = kg; k < DM; k += 42) { const f32x4 w = *(const f32x4*)(wp + (size_t)k * NADA); acc += w * sc[k]; }
                red[kg * 48 + cq * 4 + 0] = acc.x; red[kg * 48 + cq * 4 + 1] = acc.y; red[kg * 48 + cq * 4 + 2] = acc.z; red[kg * 48 + cq * 4 + 3] = acc.w;
            }
            __syncthreads();
            if (F.tid < 48) { float s = F.b_ada[slab * 48 + F.tid]; for (int g = 0; g < 42; ++g) s += red[g * 48 + F.tid]; ada[slab * 48 + F.tid] = s; }
            __syncthreads();
        }
    }
    {
        LAS float* scr = (LAS float*)(F.lds + F.wave * 16384);
        const int gw = F.bid * NWAVES + F.wave, NGW = F.G * NWAVES;
        constexpr int I_IN = (DM / 64) * (NPROJ / 32), I_OUT = (DM / 64) * (DM / 32), I_DN = (DFF / 64) * (DM / 32);
        for (int it = gw; it < I_IN + I_OUT + I_DN; it += NGW) {
            int r = it;
            if (r < I_IN) { p0_transpose_item(F.w_in, DM, NPROJ, WIN_LD, (bf16*)(F.ws + WS_WIN), scr, r, F.lane); continue; } r -= I_IN;
            if (r < I_OUT) { p0_transpose_item(F.w_out, DM, DM, DM, (bf16*)(F.ws + WS_WOUT), scr, r, F.lane); continue; } r -= I_OUT;
            p0_transpose_item(F.w_down, DFF, DM, DM, (bf16*)(F.ws + WS_WDOWN), scr, r, F.lane);
        }
    }
    {
        const double INV[16] = {1.0, 0.44036660267178046, 0.19392274474868576, 0.08539710028576561, 0.03760603093086393, 0.016560440080994446, 0.007292664737217109, 0.003211445994752591,
                                0.001414213562373095, 0.000622772421914596, 0.0002742481756762073, 0.00012076973741146504, 5.318295896944988e-05, 2.341999896140934e-05, 1.031338537721246e-05, 4.5416704806078695e-06};
        float* rope = (float*)(F.ws + WS_ROPE);
        for (int idx = F.bid * 512 + F.tid; idx < M_TOK * 16; idx += F.G * 512) {
            const int pos = idx >> 4, i = idx & 15;
            double inv = INV[0];
#pragma unroll
            for (int j = 1; j < 16; ++j) inv = (i == j) ? INV[j] : inv;
            const double ang = (double)pos * inv;
            const double q = __builtin_floor(ang * 0.6366197723675814 + 0.5);
            double r = __builtin_fma(-q, 1.5707963267948966, ang); r = __builtin_fma(-q, 6.123233995736766e-17, r);
            const int qi = ((int)q) & 3; const double r2 = r * r;
            double cs = 1.0 + r2 * (-0.5 + r2 * (1.0 / 24 + r2 * (-1.0 / 720 + r2 * (1.0 / 40320 + r2 * (-1.0 / 3628800 + r2 * (1.0 / 479001600 + r2 * (-1.0 / 87178291200.0)))))));
            double sn = r * (1.0 + r2 * (-1.0 / 6 + r2 * (1.0 / 120 + r2 * (-1.0 / 5040 + r2 * (1.0 / 362880 + r2 * (-1.0 / 39916800 + r2 * (1.0 / 6227020800.0 + r2 * (-1.0 / 1307674368000.0))))))));
            double co, si;
            if (qi == 0) { co = cs; si = sn; } else if (qi == 1) { co = -sn; si = cs; } else if (qi == 2) { co = -cs; si = -sn; } else { co = sn; si = -cs; }
            rope[pos * 32 + i] = (float)co; rope[pos * 32 + 16 + i] = (float)si;
        }
    }
}

__device__ __forceinline__ void p1_wgu_item(Frame& F, LAS float* scr, int item) {
    const int lane = F.lane;
    constexpr int nblk = NGU / 32; const int kb = item / nblk, nb = item % nblk, k0 = 64 * kb, n0 = 32 * nb;
    const int pn = n0 >> 8, bj = (n0 >> 7) & 1, idx0 = n0 & 127;
    const int src0 = (bj ? DFF : 0) + pn * 128 + idx0;
    LAS float* wv = scr + 64 * 33; LAS float* bv = wv + 64;
    {   const float* ada = SMALLF(SM_ADA); const int k = k0 + lane;
        const float s2 = 1.f + ada[4 * DM + k]; wv[lane] = F.ln1_w[k] * s2; bv[lane] = F.ln1_b[k] * s2 + ada[3 * DM + k]; }
#pragma unroll 8
    for (int i = 0; i < 32; ++i) { const int kk = 2 * i + (lane >> 5); scr[kk * 33 + (lane & 31)] = F.w_gu[(size_t)(k0 + kk) * NGU + src0 + (lane & 31)]; }
    LDS_WAIT(); asm volatile("" ::: "memory");
    const int c = lane & 7; bf16* WT = (bf16*)(F.ws + WS_WGU);
    float* c1p = (float*)(F.ws + WS_C12P) + (size_t)kb * NGU; float* c2p = (float*)(F.ws + WS_C12P) + (size_t)(32 + kb) * NGU;
#pragma unroll
    for (int j = 0; j < 4; ++j) { const int n = (lane >> 3) + 8 * j; const LAS float* s = scr + (8 * c) * 33 + n;
        float v[8], s1 = 0.f, s2 = 0.f; unsigned short b[8];
#pragma unroll
        for (int e = 0; e < 8; ++e) { const float raw = s[e * 33]; v[e] = raw * wv[8 * c + e]; b[e] = (unsigned short)f2bf(v[e]); s1 += bf2f(b[e]); s2 += raw * bv[8 * c + e]; }
        v4u o; o.x = b[0] | ((unsigned)b[1] << 16); o.y = b[2] | ((unsigned)b[3] << 16); o.z = b[4] | ((unsigned)b[5] << 16); o.w = b[6] | ((unsigned)b[7] << 16);
        *(GAS v4u*)(WT + (size_t)(n0 + n) * DM + k0 + 8 * c) = o;
        s1 += __shfl_xor(s1, 1); s1 += __shfl_xor(s1, 2); s1 += __shfl_xor(s1, 4);
        s2 += __shfl_xor(s2, 1); s2 += __shfl_xor(s2, 2); s2 += __shfl_xor(s2, 4);
        if (c == 0) { c1p[n0 + n] = s1; c2p[n0 + n] = s2; } }
    LDS_WAIT(); asm volatile("" ::: "memory");
}

__device__ __forceinline__ void p1_phase(Frame& F) {
    const float* ada = SMALLF(SM_ADA);
    {
        LAS float* sc1 = (LAS float*)(F.lds);
        LAS float* sh1 = sc1 + 2048;
        LAS float* wg = sh1 + 2048;
        for (int k = F.tid; k < DM; k += 512) { sc1[k] = 1.f + ada[DM + k]; sh1[k] = ada[k]; }
        for (int i = F.tid; i < DM * 2; i += 512) { const int k = i >> 1, hf = i & 1; *(LAS f32x4*)(wg + k * 8 + hf * 4) = *(const f32x4*)(F.w_in + (size_t)k * WIN_LD + NPROJ + hf * 4); }
        __syncthreads();
        bf16* U = (bf16*)(F.ws + WS_U); float* gates = SMALLF(SM_GATES);
        for (int row = F.bid * NWAVES + F.wave; row < M_TOK; row += F.G * NWAVES) {
            const GAS f32x4* xr = (const GAS f32x4*)(F.x + (size_t)row * DM) + F.lane;
            float g[8];
#pragma unroll
            for (int e = 0; e < 8; ++e) g[e] = 0.f;
            GAS unsigned long long* o8 = (GAS unsigned long long*)(U + (size_t)row * DM) + F.lane;
#pragma unroll 2
            for (int j = 0; j < 8; ++j) {
                const f32x4 xv = xr[64 * j]; const int k = F.lane * 4 + 256 * j;
                const f32x4 s = *(LAS f32x4*)(sc1 + k), h = *(LAS f32x4*)(sh1 + k);
                const f32x4 u = xv * s + h;
                o8[64 * j] = (unsigned long long)pk2(u.x, u.y) | ((unsigned long long)pk2(u.z, u.w) << 32);
#pragma unroll
                for (int e = 0; e < 4; ++e) { const f32x4 w0 = *(LAS f32x4*)(wg + (k + e) * 8), w1 = *(LAS f32x4*)(wg + (k + e) * 8 + 4);
                    g[0] += u[e] * w0.x; g[1] += u[e] * w0.y; g[2] += u[e] * w0.z; g[3] += u[e] * w0.w; g[4] += u[e] * w1.x; g[5] += u[e] * w1.y; g[6] += u[e] * w1.z; g[7] += u[e] * w1.w; }
            }
#pragma unroll
            for (int e = 0; e < 8; ++e) g[e] = wave_sum(g[e]);
            if (F.lane == 0) { *(f32x4*)(gates + row * 8) = (f32x4){g[0], g[1], g[2], g[3]}; *(f32x4*)(gates + row * 8 + 4) = (f32x4){g[4], g[5], g[6], g[7]}; }
        }
        __syncthreads();
    }
    {
        LAS float* scr = (LAS float*)(F.lds + F.wave * 16384);
        const int gw = F.bid * NWAVES + F.wave, NGW = F.G * NWAVES;
        constexpr int I_GU = (DM / 64) * (NGU / 32);
        for (int it = gw; it < I_GU; it += NGW) p1_wgu_item(F, scr, it);
    }
}

namespace pg8 {
struct EpiProj {
    static constexpr bool PERM = true, AFTER_DRAIN = false;
    bf16_t *mix, *kb, *vb, *mqk, *mv; const float* rope;
    __device__ __forceinline__ void operator()(const f32x4 (&acc)[2][2][4][2], const Unit& u, int wr, int wc, int fr, int fq) const {
        const int row0 = u.pm * BM + wr * 64 + fr; const int colt = u.pn * BM; const int t = colt >> 10, cl = colt & 1023;
        bf16_t* base; int ldc;
        if (t == 0) { base = mix + 1024; ldc = 2048; } else if (t == 1) { base = kb; ldc = 1024; } else if (t == 2) { base = vb; ldc = 1024; }
        else if (t == 3) { base = mqk; ldc = 1024; } else if (t == 4) { base = mv; ldc = 1024; } else { base = mix; ldc = 2048; }
        const int col0 = cl + wc * 32 + 8 * fq;
        const bool dorope = (t < 2) && (wc == 0);
        const float sgn = (fq < 2) ? -1.f : 1.f;
#pragma unroll
        for (int ai = 0; ai < 2; ++ai)
#pragma unroll
            for (int m = 0; m < 4; ++m) {
                const int row = row0 + ai * HALF + m * 16;
                f32x4 cs0 = {1.f, 1.f, 1.f, 1.f}, cs1 = cs0, sn0 = {0.f, 0.f, 0.f, 0.f}, sn1 = sn0;
                if (dorope) { const float* rp = rope + (size_t)row * 32 + 8 * (fq & 1); cs0 = *(const f32x4*)(rp); cs1 = *(const f32x4*)(rp + 4); sn0 = *(const f32x4*)(rp + 16); sn1 = *(const f32x4*)(rp + 20); }
                bf16_t* rowp = base + (size_t)row * ldc + col0;
#pragma unroll
                for (int bj = 0; bj < 2; ++bj) {
                    f32x4 v0 = acc[ai][bj][m][0], v1 = acc[ai][bj][m][1];
                    if (dorope) {
                        f32x4 p0, p1;
#pragma unroll
                        for (int i = 0; i < 4; ++i) { p0[i] = __shfl_xor(v0[i], 32); p1[i] = __shfl_xor(v1[i], 32); }
                        v0 = v0 * cs0 + p0 * sn0 * sgn; v1 = v1 * cs1 + p1 * sn1 * sgn;
                    }
                    u32x4 w; w.x = cvt_pk_bf16(v0[0], v0[1]); w.y = cvt_pk_bf16(v0[2], v0[3]); w.z = cvt_pk_bf16(v1[0], v1[1]); w.w = cvt_pk_bf16(v1[2], v1[3]);
                    *(u32x4*)(rowp + bj * HALF) = w;
                }
            }
    }
};
struct EpiY1 {
    static constexpr bool PERM = false, AFTER_DRAIN = false;
    const float* x; const float* gate1; float* y1f; bf16_t* y1b; float* statp;
    __device__ __forceinline__ void operator()(const f32x4 (&acc)[2][2][4][2], const Unit& u, int wr, int wc, int fr, int fq) const {
        const int row0 = u.pm * BM + wr * 64 + fr, col0 = u.pn * BM + wc * 32 + 4 * fq;
        f32x4 g1[2][2];
#pragma unroll
        for (int bj = 0; bj < 2; ++bj)
#pragma unroll
            for (int n = 0; n < 2; ++n) g1[bj][n] = *(const f32x4*)(gate1 + col0 + bj * HALF + n * 16) + 1.0f;
#pragma unroll
        for (int ai = 0; ai < 2; ++ai)
#pragma unroll
            for (int m = 0; m < 4; ++m) {
                const int row = row0 + ai * HALF + m * 16; const size_t off = (size_t)row * 2048 + col0;
                float s = 0.f, ss = 0.f;
#pragma unroll
                for (int bj = 0; bj < 2; ++bj)
#pragma unroll
                    for (int n = 0; n < 2; ++n) {
                        const f32x4 xv = *(const f32x4*)(x + off + bj * HALF + n * 16);
                        const f32x4 y = xv * 1.189207115002721f + g1[bj][n] * acc[ai][bj][m][n];
                        *(f32x4*)(y1f + off + bj * HALF + n * 16) = y;
                        typedef unsigned u32x2v __attribute__((ext_vector_type(2)));
                        u32x2v w; w.x = cvt_pk_bf16(y[0], y[1]); w.y = cvt_pk_bf16(y[2], y[3]);
                        *(u32x2v*)(y1b + off + bj * HALF + n * 16) = w;
                        s += (y[0] + y[1]) + (y[2] + y[3]); ss += (y[0] * y[0] + y[1] * y[1]) + (y[2] * y[2] + y[3] * y[3]);
                    }
                s += __shfl_xor(s, 16); s += __shfl_xor(s, 32); ss += __shfl_xor(ss, 16); ss += __shfl_xor(ss, 32);
                if (fq == 0) { typedef float f32x2v __attribute__((ext_vector_type(2))); *(f32x2v*)(statp + ((size_t)row * 32 + u.pn * 4 + wc) * 2) = (f32x2v){s, ss}; }
            }
    }
};
struct EpiSwiGLU {
    static constexpr bool PERM = true, AFTER_DRAIN = false;
    const float* mur; const float* c1; const float* c2; bf16_t* H;
    __device__ __forceinline__ void operator()(const f32x4 (&acc)[2][2][4][2], const Unit& u, int wr, int wc, int fr, int fq) const {
        const int row0 = u.pm * BM + wr * 64 + fr; const int cl = wc * 32 + 8 * fq; const int cg = u.pn * BM + cl;
        f32x4 c1g[2], c2g[2], c1u[2], c2u[2];
#pragma unroll
        for (int n = 0; n < 2; ++n) { c1g[n] = *(const f32x4*)(c1 + cg + 4 * n); c2g[n] = *(const f32x4*)(c2 + cg + 4 * n); c1u[n] = *(const f32x4*)(c1 + cg + HALF + 4 * n); c2u[n] = *(const f32x4*)(c2 + cg + HALF + 4 * n); }
#pragma unroll
        for (int ai = 0; ai < 2; ++ai)
#pragma unroll
            for (int m = 0; m < 4; ++m) {
                const int row = row0 + ai * HALF + m * 16;
                typedef float f32x2v __attribute__((ext_vector_type(2)));
                const f32x2v mr = *(const f32x2v*)(mur + (size_t)row * 2);
                f32x4 hv[2];
#pragma unroll
                for (int n = 0; n < 2; ++n) {
                    const f32x4 g = (acc[ai][0][m][n] - c1g[n] * mr.x) * mr.y + c2g[n];
                    const f32x4 up = (acc[ai][1][m][n] - c1u[n] * mr.x) * mr.y + c2u[n];
#pragma unroll
                    for (int i = 0; i < 4; ++i) { const float e = __builtin_amdgcn_exp2f(g[i] * -1.4426950408889634f); hv[n][i] = g[i] * __builtin_amdgcn_rcpf(1.f + e) * up[i]; }
                }
                u32x4 w; w.x = cvt_pk_bf16(hv[0][0], hv[0][1]); w.y = cvt_pk_bf16(hv[0][2], hv[0][3]); w.z = cvt_pk_bf16(hv[1][0], hv[1][1]); w.w = cvt_pk_bf16(hv[1][2], hv[1][3]);
                *(u32x4*)(H + (size_t)row * 5632 + u.pn * HALF + cl) = w;
            }
    }
};
struct EpiY2 {
    static constexpr bool PERM = false, AFTER_DRAIN = false;
    const float* y1f; const float* mur; const float* gate2; const float* lw; const float* lb; float* out;
    __device__ __forceinline__ void operator()(const f32x4 (&acc)[2][2][4][2], const Unit& u, int wr, int wc, int fr, int fq) const {
        const int row0 = u.pm * BM + wr * 64 + fr, col0 = u.pn * BM + wc * 32 + 4 * fq;
#pragma unroll
        for (int ai = 0; ai < 2; ++ai)
#pragma unroll
            for (int m = 0; m < 4; ++m) {
                const int row = row0 + ai * HALF + m * 16; const size_t off = (size_t)row * 2048 + col0;
                typedef float f32x2v __attribute__((ext_vector_type(2)));
                const f32x2v mr = *(const f32x2v*)(mur + (size_t)row * 2);
#pragma unroll
                for (int bj = 0; bj < 2; ++bj)
#pragma unroll
                    for (int n = 0; n < 2; ++n) {
                        const int c = col0 + bj * HALF + n * 16;
                        const f32x4 g2 = *(const f32x4*)(gate2 + c) + 1.0f, w = *(const f32x4*)(lw + c), b = *(const f32x4*)(lb + c);
                        const f32x4 y1 = *(const f32x4*)(y1f + off + bj * HALF + n * 16);
                        const f32x4 x1 = (y1 - mr.x) * mr.y * w + b;
                        *(f32x4*)(out + off + bj * HALF + n * 16) = x1 * 1.189207115002721f + g2 * acc[ai][bj][m][n];
                    }
                asm volatile("" ::: "memory");
            }
    }
};
}

__device__ __forceinline__ float wave_incl_scan_add(float v, int lane) {
#pragma unroll
    for (int o = 1; o < 64; o <<= 1) { const float t = __shfl_up(v, o); if (lane >= o) v += t; }
    return v;
}
__device__ __forceinline__ float wave_incl_scan_max(float v, int lane) {
#pragma unroll
    for (int o = 1; o < 64; o <<= 1) { const float t = __shfl_up(v, o); if (lane >= o) v = fmaxf(v, t); }
    return v;
}
__device__ __forceinline__ void p3_chunk_item(Frame& F, int c) {
    const int t0 = c * ML_L, tid = F.tid, lane = F.lane;
    LAS float* wgt = (LAS float*)F.lds;
    LAS unsigned short* tile = (LAS unsigned short*)(F.lds + 1024);
    const float* gates = SMALLF(SM_GATES);
    if (F.wave < 4) {
        const int h = F.wave, t = t0 + lane;
        const float ig = gates[t * 8 + h] + F.igb[h], fg = gates[t * 8 + 4 + h] + F.fgb[h];
        const float lf = logsigmoid_f(fg);
        const float b = wave_incl_scan_add(lf, lane), u = ig - b, m1 = wave_incl_scan_max(u, lane);
        const float m1l = __shfl(m1, 63), bl = __shfl(b, 63);
        *(f32x4*)(SMALLF(SM_TOKSC) + (size_t)(t * 4 + h) * 4) = (f32x4){b, u, m1, 0.f};
        if (lane == 63) { SMALLF(SM_CHSUM)[(c * 4 + h) * 2] = bl; SMALLF(SM_CHSUM)[(c * 4 + h) * 2 + 1] = m1l; }
        wgt[h * 64 + lane] = expf(u - m1l);
    }
    __syncthreads();
    {
        const int ch = tid * 2;
        const unsigned* MQK = (const unsigned*)(F.ws + WS_MQK);
        float w[4][2], bs[2];
#pragma unroll
        for (int j = 0; j < 4; ++j) { w[j][0] = F.conv_w[j * 1024 + ch]; w[j][1] = F.conv_w[j * 1024 + ch + 1]; }
        bs[0] = F.conv_b[ch]; bs[1] = F.conv_b[ch + 1];
        float xa[3][2];
#pragma unroll
        for (int j = 0; j < 3; ++j) { const int t = t0 - 3 + j; unsigned v = 0u; if (t >= 0) v = MQK[(size_t)t * 512 + tid]; xa[j][0] = bflo(v); xa[j][1] = bfhi(v); }
        unsigned* QC = (unsigned*)(F.ws + WS_QC); unsigned* KC = (unsigned*)(F.ws + WS_KC);
        const bool isq = ch < 512; const int hh = (ch - 512) >> 7;
#pragma unroll 4
        for (int s = 0; s < ML_L; ++s) {
            const unsigned v = MQK[(size_t)(t0 + s) * 512 + tid]; const float x0 = bflo(v), x1 = bfhi(v);
            float y0 = bs[0] + w[0][0] * xa[0][0] + w[1][0] * xa[1][0] + w[2][0] * xa[2][0] + w[3][0] * x0;
            float y1 = bs[1] + w[0][1] * xa[0][1] + w[1][1] * xa[1][1] + w[2][1] * xa[2][1] + w[3][1] * x1;
            y0 = silu_f(y0); y1 = silu_f(y1);
            xa[0][0] = xa[1][0]; xa[0][1] = xa[1][1]; xa[1][0] = xa[2][0]; xa[1][1] = xa[2][1]; xa[2][0] = x0; xa[2][1] = x1;
            if (isq) { QC[(size_t)(t0 + s) * 256 + tid] = pk2(y0, y1); }
            else { y0 *= K_SCALE; y1 *= K_SCALE; KC[(size_t)(t0 + s) * 256 + (tid - 256)] = pk2(y0, y1);
                   const float wg_ = wgt[hh * 64 + s]; tile[(ch - 512) * 72 + s] = (unsigned short)f2bf(y0 * wg_); tile[(ch - 511) * 72 + s] = (unsigned short)f2bf(y1 * wg_); }
        }
    }
    __syncthreads();
    {
        bf16* KWT = (bf16*)(F.ws + WS_KWT);
#pragma unroll
        for (int p = 0; p < 8; ++p) { const int row = p * 64 + (tid >> 3), chn = tid & 7;
            const v4u v = *(LAS v4u*)(tile + row * 72 + chn * 8); *(GAS v4u*)(KWT + ((size_t)c * 512 + row) * 64 + chn * 8) = v; }
    }
    __syncthreads();
    {
        const unsigned* MV = (const unsigned*)(F.ws + WS_MV); bf16* VT = (bf16*)(F.ws + WS_VT);
        for (int half = 0; half < 2; ++half) {
            const int cp = tid & 255, sg = tid >> 8;
#pragma unroll 8
            for (int s = sg; s < ML_L; s += 2) { const unsigned v = MV[(size_t)(t0 + s) * 512 + half * 256 + cp]; tile[(cp * 2) * 72 + s] = (unsigned short)(v & 0xffffu); tile[(cp * 2 + 1) * 72 + s] = (unsigned short)(v >> 16); }
            __syncthreads();
#pragma unroll
            for (int p = 0; p < 8; ++p) { const int row = p * 64 + (tid >> 3), chn = tid & 7;
                const v4u v = *(LAS v4u*)(tile + row * 72 + chn * 8); *(GAS v4u*)(VT + ((size_t)c * 1024 + half * 512 + row) * 64 + chn * 8) = v; }
            __syncthreads();
        }
    }
}
__device__ __forceinline__ void p3_kmean_item(Frame& F, int j) {
    const unsigned* KB = (const unsigned*)(F.ws + WS_KB);
    float s0 = 0.f, s1 = 0.f;
#pragma unroll 8
    for (int r = 0; r < MB_BLK; ++r) { const unsigned v = KB[(size_t)(j * MB_BLK + r) * 512 + F.tid]; s0 += bflo(v); s1 += bfhi(v); }
    const int col = F.tid * 2, h = col >> 7, d = col & 127;
    float* km = SMALLF(SM_KMEAN) + (size_t)(h * 64 + j) * 128 + d;
    km[0] = s0 * (1.f / 256.f); km[1] = s1 * (1.f / 256.f);
}
__device__ __forceinline__ void p3_c12_item(Frame& F, int it) {
    const int n = it * 512 + F.tid; if (n >= NGU) return;
    const float* p = (const float*)(F.ws + WS_C12P);
    float a = 0.f, b = 0.f;
    for (int k = 0; k < 32; ++k) { a += p[(size_t)k * NGU + n]; b += p[(size_t)(32 + k) * NGU + n]; }
    SMALLF(SM_C1)[n] = a; SMALLF(SM_C2)[n] = b;
}
__device__ __forceinline__ void p3_phase(Frame& F) {
    constexpr int N_CH = ML_NC, N_KM = MB_NB, N_C12 = NGU / 512;
    for (int it = F.bid; it < N_CH + N_KM + N_C12; it += F.G) {
        if (it < N_CH) p3_chunk_item(F, it);
        else if (it < N_CH + N_KM) p3_kmean_item(F, it - N_CH);
        else p3_c12_item(F, it - N_CH - N_KM);
    }
}

__device__ __forceinline__ void stat_phase(Frame& F) {
    const float* sp = (const float*)(F.ws + WS_STATP); float* mur = SMALLF(SM_MUR);
    for (int row = F.bid * 512 + F.tid; row < M_TOK; row += F.G * 512) {
        float s = 0.f, ss = 0.f;
#pragma unroll
        for (int i = 0; i < 16; ++i) { const f32x4 v = *(const f32x4*)(sp + (size_t)row * 64 + i * 4); s += v.x + v.z; ss += v.y + v.w; }
        const float mean = s * (1.f / DM); const float var = fmaxf(ss * (1.f / DM) - mean * mean, 0.f);
        mur[row * 2] = mean; mur[row * 2 + 1] = rsqrtf(var + LN_EPS);
    }
}
__device__ __forceinline__ void ln2_phase(Frame& F) {
    for (int row = F.bid * NWAVES + F.wave; row < M_TOK; row += F.G * NWAVES) {
        GAS f32x4* xr = (GAS f32x4*)(F.out + (size_t)row * DM) + F.lane;
        f32x4 v[8]; float s = 0.f;
#pragma unroll
        for (int j = 0; j < 8; ++j) { v[j] = xr[64 * j]; s += (v[j].x + v[j].y) + (v[j].z + v[j].w); }
        const float mean = wave_sum(s) * (1.f / DM); float s2 = 0.f;
#pragma unroll
        for (int j = 0; j < 8; ++j) { v[j] = v[j] - mean; s2 += (v[j].x * v[j].x + v[j].y * v[j].y) + (v[j].z * v[j].z + v[j].w * v[j].w); }
        const float rstd = rsqrtf(wave_sum(s2) * (1.f / DM) + LN_EPS);
#pragma unroll
        for (int j = 0; j < 8; ++j) { const int k = F.lane * 4 + 256 * j; const f32x4 w = *(const f32x4*)(F.ln2_w + k), b = *(const f32x4*)(F.ln2_b + k); xr[64 * j] = v[j] * rstd * w + b; }
    }
}
__global__ void __launch_bounds__(512) naive_moba(unsigned char* ws) {
    __shared__ float qf_s[8][128];
    __shared__ float pb_s[8][1024];
    const int wave = threadIdx.x >> 6, lane = threadIdx.x & 63;
    const int gw = blockIdx.x * 8 + wave; const int p = gw >> 3, h = gw & 7;
    unsigned short* MIX = (unsigned short*)(ws + WS_MIX);
    const unsigned short* KB = (const unsigned short*)(ws + WS_KB); const unsigned short* VB = (const unsigned short*)(ws + WS_VB);
    const float* kmean = (const float*)(ws + WS_SMALL + SM_KMEAN);
    float* qf = qf_s[wave]; float* pb = pb_s[wave];
    unsigned short* qp = MIX + (size_t)p * 2048 + 1024 + h * 128;
    qf[lane * 2] = bf2f(qp[lane * 2]); qf[lane * 2 + 1] = bf2f(qp[lane * 2 + 1]);
    __syncthreads();
    const int b = p >> 8;
    float sc = -INFINITY;
    if (lane < b) { const float* km = kmean + (size_t)(h * 64 + lane) * 128; float s = 0.f; for (int d = 0; d < 128; ++d) s += qf[d] * km[d]; sc = s; }
    int sel[3]; const int nsel = b < 3 ? b : 3;
#pragma unroll
    for (int k = 0; k < 3; ++k) {
        float bv = sc; int bi = lane;
        for (int o = 1; o < 64; o <<= 1) { const float ov = __shfl_xor(bv, o); const int oi = __shfl_xor(bi, o); if (ov > bv || (ov == bv && oi < bi)) { bv = ov; bi = oi; } }
        sel[k] = bi; if (lane == bi) sc = -INFINITY;
    }
    float s[16]; float mx = -INFINITY;
#pragma unroll
    for (int bi = 0; bi < 4; ++bi) {
        const bool valid = (bi < nsel) || (bi == 3); const int blk = (bi == 3) ? b : sel[bi < 3 ? bi : 0];
#pragma unroll
        for (int kk = 0; kk < 4; ++kk) {
            float v = -INFINITY;
            if (valid) { const int key = blk * 256 + kk * 64 + lane; const unsigned short* kr = KB + (size_t)key * 1024 + h * 128; float a = 0.f; for (int d = 0; d < 128; ++d) a += qf[d] * bf2f(kr[d]); a *= K_SCALE; if (bi == 3 && key > p) a = -INFINITY; v = a; }
            s[bi * 4 + kk] = v; mx = fmaxf(mx, v);
        }
    }
    for (int o = 1; o < 64; o <<= 1) mx = fmaxf(mx, __shfl_xor(mx, o));
    float sum = 0.f;
#pragma unroll
    for (int i = 0; i < 16; ++i) { const float e = (s[i] == -INFINITY) ? 0.f : expf(s[i] - mx); pb[i * 64 + lane] = e; sum += e; }
    sum = wave_sum(sum);
    __syncthreads();
    float o0 = 0.f, o1 = 0.f;
#pragma unroll
    for (int bi = 0; bi < 4; ++bi) {
        const bool valid = (bi < nsel) || (bi == 3); if (!valid) continue; const int blk = (bi == 3) ? b : sel[bi];
        for (int kk = 0; kk < 256; ++kk) { const float pv = pb[bi * 256 + kk]; const unsigned v = *(const unsigned*)(VB + (size_t)(blk * 256 + kk) * 1024 + h * 128 + lane * 2); o0 += pv * bflo(v); o1 += pv * bfhi(v); }
    }
    const float inv = 1.f / sum;
    *(unsigned*)(qp + lane * 2) = pk2(o0 * inv, o1 * inv);
}
__global__ void __launch_bounds__(256) naive_mlstm(unsigned char* ws, const float* igb, const float* fgb, const float* normw) {
    __shared__ float q[128], k[128], nn[128], red[4], red2[4];
    const int h = blockIdx.x, v = threadIdx.x, lane = v & 63, wv = v >> 6;
    const unsigned short* QC = (const unsigned short*)(ws + WS_QC); const unsigned short* KC = (const unsigned short*)(ws + WS_KC); const unsigned short* MV = (const unsigned short*)(ws + WS_MV);
    const float* gates = (const float*)(ws + WS_SMALL + SM_GATES); unsigned short* MIX = (unsigned short*)(ws + WS_MIX);
    float C[128];
#pragma unroll
    for (int d = 0; d < 128; ++d) C[d] = 0.f;
    float m = 0.f; if (v < 128) nn[v] = 0.f;
    const float ib = igb[h], fb = fgb[h], nw = normw[h * 256 + v];
    for (int t = 0; t < M_TOK; ++t) {
        if (v < 128) q[v] = bf2f(QC[(size_t)t * 512 + h * 128 + v]); else k[v - 128] = bf2f(KC[(size_t)t * 512 + h * 128 + v - 128]);
        const float ig = gates[t * 8 + h] + ib, lf = logsigmoid_f(gates[t * 8 + 4 + h] + fb);
        const float mn = fmaxf(lf + m, ig), fd = expf(lf + m - mn), iw = expf(ig - mn); m = mn;
        const float vv = bf2f(MV[(size_t)t * 1024 + h * 256 + v]);
        __syncthreads();
        if (v < 128) nn[v] = fd * nn[v] + iw * k[v];
        float num = 0.f;
#pragma unroll
        for (int d = 0; d < 128; ++d) { C[d] = fd * C[d] + iw * k[d] * vv; num += q[d] * C[d]; }
        __syncthreads();
        float den = 0.f;
#pragma unroll 16
        for (int d = 0; d < 128; ++d) den += q[d] * nn[d];
        const float hv = num / fmaxf(fabsf(den), expf(-m));
        float s = wave_sum(hv); if (lane == 0) red[wv] = s;
        __syncthreads();
        const float mu = (red[0] + red[1] + red[2] + red[3]) * (1.f / 256.f);
        const float dv = hv - mu; float s2 = wave_sum(dv * dv); if (lane == 0) red2[wv] = s2;
        __syncthreads();
        const float var = (red2[0] + red2[1] + red2[2] + red2[3]) * (1.f / 256.f);
        unsigned short* op = MIX + (size_t)t * 2048 + h * 256 + v;
        const float mo = bf2f(*op);
        *op = (unsigned short)f2bf(dv * rsqrtf(var + LN_EPS) * nw * sigmoid_f(mo));
    }
}
#ifndef PG8_SP2
#define PG8_SP2 true
#endif
#ifndef PG8_ALIGN
#define PG8_ALIGN true
#endif
constexpr int N_PHASES = 12;
struct Args { const float* in[17]; float* out; unsigned char* ws; int ph_lo, ph_hi, li, pad; };
__global__ void __launch_bounds__(NWAVES * 64, 2) mk_fwd(Args args) {
    extern __shared__ __attribute__((aligned(16))) unsigned char lds[];
    Frame F;
    F.lds = (LAS unsigned char*)lds;
    F.MISC = (volatile LAS unsigned*)(F.lds + MISC_OFF);
    F.tid = threadIdx.x; F.lane = F.tid & 63; F.wave = __builtin_amdgcn_readfirstlane(F.tid >> 6);
    F.G = gridDim.x; F.bid = blockIdx.x;
    F.ws = args.ws; F.ctl = (gu32*)(args.ws + WS_CTL); F.out = args.out;
    F.x = args.in[0]; F.c = args.in[1]; F.w_ada = args.in[2]; F.b_ada = args.in[3]; F.w_in = args.in[4]; F.conv_w = args.in[5]; F.conv_b = args.in[6];
    F.igb = args.in[7]; F.fgb = args.in[8]; F.normw = args.in[9]; F.w_out = args.in[10]; F.ln1_w = args.in[11]; F.ln1_b = args.in[12];
    F.w_gu = args.in[13]; F.w_down = args.in[14]; F.ln2_w = args.in[15]; F.ln2_b = args.in[16];
    for (int u = F.tid; u < (LDS_BYTES - LDSCTL_OFF) / 4; u += NWAVES * 64) ((LAS unsigned*)(F.lds + LDSCTL_OFF))[u] = 0u;
    __syncthreads();
    const int lo = args.ph_lo, hi = args.ph_hi;
    XcdBarrier bar; bar.bar = (unsigned*)(F.ctl + CW_BAR) + args.li * XCD_BAR_WORDS; bar.x = 0; bar.st = nullptr;
    if (hi - lo > 1) bar = xcd_barrier_post((unsigned*)(F.ctl + CW_BAR) + args.li * XCD_BAR_WORDS, F.MISC + 8);
#ifndef PHMASK
#define PHMASK 0xFFF
#endif
#define IN(k) (((PHMASK >> (k)) & 1) && lo <= (k) && (k) < hi)
#define SEAM(k) do { if (IN(k) && IN((k) + 1)) xcd_barrier(bar); } while (0)
    float* ada = SMALLF(SM_ADA);
    if (IN(0)) { p0_phase(F); } SEAM(0);
    if (IN(1)) { p1_phase(F); } SEAM(1);
    if (IN(2)) {
        pg8::Gemm g{(const pg8::bf16_t*)(F.ws + WS_U), (const pg8::bf16_t*)(F.ws + WS_WIN), M_TOK, NPROJ, DM}; pg8::StaticOrder S; S.init(M_TOK, NPROJ, F.G, F.bid);
        pg8::EpiProj E{(pg8::bf16_t*)(F.ws + WS_MIX), (pg8::bf16_t*)(F.ws + WS_KB), (pg8::bf16_t*)(F.ws + WS_VB), (pg8::bf16_t*)(F.ws + WS_MQK), (pg8::bf16_t*)(F.ws + WS_MV), (const float*)(F.ws + WS_ROPE)};
        pg8::gemm_phase<pg8::EpiProj, pg8::StaticOrder, PG8_ALIGN, PG8_SP2>(F.lds, g, S, E);
    } SEAM(2);
    if (IN(3)) { p3_phase(F); } SEAM(3);
    if (IN(4)) { } SEAM(4);
    if (IN(5)) { } SEAM(5);
    if (IN(6)) { } SEAM(6);
    if (IN(7)) {
        pg8::Gemm g{(const pg8::bf16_t*)(F.ws + WS_MIX), (const pg8::bf16_t*)(F.ws + WS_WOUT), M_TOK, DM, DM}; pg8::StaticOrder S; S.init(M_TOK, DM, F.G, F.bid);
        pg8::EpiY1 E{F.x, ada + 2 * DM, (float*)(F.ws + WS_Y1F), (pg8::bf16_t*)(F.ws + WS_Y1B), (float*)(F.ws + WS_STATP)};
        pg8::gemm_phase<pg8::EpiY1, pg8::StaticOrder, PG8_ALIGN, PG8_SP2>(F.lds, g, S, E);
    } SEAM(7);
    if (IN(8)) { stat_phase(F); } SEAM(8);
    if (IN(9)) {
        pg8::Gemm g{(const pg8::bf16_t*)(F.ws + WS_Y1B), (const pg8::bf16_t*)(F.ws + WS_WGU), M_TOK, NGU, DM}; pg8::StaticOrder S; S.init(M_TOK, NGU, F.G, F.bid);
        pg8::EpiSwiGLU E{SMALLF(SM_MUR), SMALLF(SM_C1), SMALLF(SM_C2), (pg8::bf16_t*)(F.ws + WS_H)};
        pg8::gemm_phase<pg8::EpiSwiGLU, pg8::StaticOrder, PG8_ALIGN, PG8_SP2>(F.lds, g, S, E);
    } SEAM(9);
    if (IN(10)) {
        pg8::Gemm g{(const pg8::bf16_t*)(F.ws + WS_H), (const pg8::bf16_t*)(F.ws + WS_WDOWN), M_TOK, DM, DFF}; pg8::StaticOrder S; S.init(M_TOK, DM, F.G, F.bid);
        pg8::EpiY2 E{(const float*)(F.ws + WS_Y1F), SMALLF(SM_MUR), ada + 5 * DM, F.ln1_w, F.ln1_b, F.out};
        pg8::gemm_phase<pg8::EpiY2, pg8::StaticOrder, PG8_ALIGN, PG8_SP2>(F.lds, g, S, E);
    } SEAM(10);
    if (IN(11)) { ln2_phase(F); }
#undef IN
#undef SEAM
}

#ifndef MK_MODE
#define MK_MODE 0
#endif
extern "C" void kernel_launch(void* const* d_in, const int* in_sizes, int n_in, void* d_out, int out_size, void* d_ws, size_t ws_size, hipStream_t stream) {
    static int grid = 0;
    if (grid == 0) {
        if (n_in != 17 || in_sizes[0] != M_TOK * DM || out_size != M_TOK * DM || ws_size < WS_END) {
            fprintf(stderr, "kernel_launch: shape mismatch: n_in %d in0 %d out %d ws %zu (need %zu)\n", n_in, n_in > 0 ? in_sizes[0] : -1, out_size, ws_size, (size_t)WS_END); grid = -1; return; }
        int dev = 0, cus = 0, per_cu = 0;
        if (hipGetDevice(&dev) != hipSuccess || hipDeviceGetAttribute(&cus, hipDeviceAttributeMultiprocessorCount, dev) != hipSuccess) { fprintf(stderr, "kernel_launch: device query failed\n"); grid = -1; return; }
        if (hipFuncSetAttribute((const void*)mk_fwd, hipFuncAttributeMaxDynamicSharedMemorySize, LDS_BYTES) != hipSuccess) { fprintf(stderr, "kernel_launch: hipFuncSetAttribute failed\n"); grid = -1; return; }
        if (hipOccupancyMaxActiveBlocksPerMultiprocessor(&per_cu, (const void*)mk_fwd, NWAVES * 64, LDS_BYTES) != hipSuccess || per_cu < 1) { fprintf(stderr, "kernel_launch: occupancy query says %d blocks per CU\n", per_cu); (void)hipGetLastError(); grid = -1; return; }
        grid = cus;
    }
    if (grid < 0) return;
    (void)hipMemsetAsync((char*)d_ws + WS_CTL, 0, CTL_ZERO_BYTES, stream);
    Args a{};
    for (int i = 0; i < 17; ++i) a.in[i] = (const float*)d_in[i];
    a.out = (float*)d_out; a.ws = (unsigned char*)d_ws;
#if MK_MODE == 0
    for (int ph = 0; ph < N_PHASES; ++ph) {
        if (ph == 4) {
            hipLaunchKernelGGL(naive_moba, dim3(M_TOK), dim3(512), 0, stream, (unsigned char*)d_ws);
            hipLaunchKernelGGL(naive_mlstm, dim3(ML_H), dim3(256), 0, stream, (unsigned char*)d_ws, (const float*)d_in[7], (const float*)d_in[8], (const float*)d_in[9]);
        }
        if (ph >= 4 && ph <= 6) continue;
        a.ph_lo = ph; a.ph_hi = ph + 1; a.li = 0;
        hipLaunchKernelGGL(mk_fwd, dim3(grid), dim3(NWAVES * 64), LDS_BYTES, stream, a);
    }
#else
    a.ph_lo = 0; a.ph_hi = N_PHASES; a.li = 0;
    hipLaunchKernelGGL(mk_fwd, dim3(grid), dim3(NWAVES * 64), LDS_BYTES, stream, a);
#endif
    const hipError_t le = hipPeekAtLastError();
    if (le != hipSuccess) fprintf(stderr, "kernel_launch: launch failed: %s\n", hipGetErrorName(le));
}
```

```cpp
#include <hip/hip_runtime.h>
#include <cstdio>
#include <cstdint>
#include <cmath>
namespace pg8 {
#define PG8_LAS __attribute__((address_space(3)))
typedef unsigned short bf16_t;
typedef short bf16x8 __attribute__((ext_vector_type(8)));
typedef float f32x4 __attribute__((ext_vector_type(4)));
typedef unsigned u32x4 __attribute__((ext_vector_type(4)));
constexpr int BM = 256, BK = 64, HALF = 128, HTB = HALF * BK * 2  , STAGE_BYTES = 8 * HTB, NXCD = 8, WGM = 4;

__host__ __device__ __forceinline__ int lds_byte(int r, int c) { const int st = (r >> 4) * 2 + (c >> 5), rr = r & 15, cc = c & 31, ob = rr * 64 + cc * 2; return st * 1024 + (ob ^ (((ob >> 9) & 1) << 5)); }
__host__ __device__ __forceinline__ void stage_rc(int b, int& R, int& C) { const int st = b / 1024, sb = b % 1024, swz = sb ^ (((sb >> 9) & 1) << 5); R = (st >> 1) * 16 + swz / 64; C = (st & 1) * 32 + (swz % 64) / 2; }
__host__ __device__ __forceinline__ int perm32(int rho) { const int n = rho >> 4, i = rho & 15; return 8 * (i >> 2) + 4 * n + (i & 3); }

struct Unit { int pm, pn; };
struct Gemm { const bf16_t* A; const bf16_t* Bt; int M, N, K; };

struct StaticOrder {
    int nM, nN, nwg, G, c, wgm;
    __host__ __device__ void init(int M, int N, int G_, int c_, int wgm_ = WGM) { nM = M / BM; nN = N / BM; nwg = nM * nN; G = G_; c = c_; wgm = wgm_; }
    __host__ __device__ bool next(int i, Unit& u) const {
        const long L = (long)i * G + c; if (L >= nwg) return false;
        int wgid = (int)L; { const int q = nwg / NXCD, r = nwg % NXCD, xcd = wgid % NXCD, off = wgid / NXCD; wgid = (xcd < r ? xcd * (q + 1) : r * (q + 1) + (xcd - r) * q) + off; }
        const int nig = wgm * nN, gid = wgid / nig, fm = gid * wgm, gsz = (nM - fm) < wgm ? (nM - fm) : wgm;
        u.pm = fm + ((wgid % nig) % gsz); u.pn = (wgid % nig) / gsz; return true;
    }
    __device__ __forceinline__ void a_ready(const Unit&) const {}
    __device__ __forceinline__ void done(const Unit&) const {}
};

typedef float cvp_f32x2_t __attribute__((ext_vector_type(2))); typedef __bf16 cvp_bf16x2_t __attribute__((ext_vector_type(2)));
__device__ __forceinline__ unsigned cvt_pk_bf16(float lo, float hi) { cvp_f32x2_t v = {lo, hi}; cvp_bf16x2_t b = __builtin_convertvector(v, cvp_bf16x2_t); return __builtin_bit_cast(unsigned, b); }
typedef float f32x2 __attribute__((ext_vector_type(2)));
__device__ __forceinline__ f32x2 gelu_pk(f32x2 v) {
    const f32x2 av = __builtin_elementwise_abs(v), d = av * 0.2316418882f + 1.0f;
    f32x2 t; t.x = __builtin_amdgcn_rcpf(d.x); t.y = __builtin_amdgcn_rcpf(d.y);
    f32x2 q = t * 0.5307027145f + (-0.7265760135f); q = q * t + 0.7107068705f; q = q * t + (-0.142248368f); q = q * t + 0.127414796f; q = q * t;
    const f32x2 s = (v * v) * (-0.72134752044f);
    f32x2 e; e.x = __builtin_amdgcn_exp2f(s.x); e.y = __builtin_amdgcn_exp2f(s.y);
    const f32x2 m = v * (q * e), r = v - m;
    f32x2 o; o.x = v.x < 0.f ? m.x : r.x; o.y = v.y < 0.f ? m.y : r.y; return o;
}

template <int ACT  > struct EpiBf16 {
    static constexpr bool PERM = true, AFTER_DRAIN = false; static_assert(ACT == 0 || ACT == 1, "EpiBf16: ACT is 0 (none) or 1 (gelu_pk)");
    bf16_t* O; int ldc; const float* bias; int split_cols; size_t split_stride; float scale0;
    __device__ __forceinline__ void operator()(const f32x4 (&acc)[2][2][4][2], const Unit& u, int wr, int wc, int fr, int fq) const {
        const int row0 = u.pm * BM + wr * 64 + fr; int colt = u.pn * BM; bf16_t* base = O;
        float sc = 1.f; if (split_cols) { const int t = colt / split_cols; base += (size_t)t * split_stride; colt -= t * split_cols; if (t == 0) sc = scale0; }
        const int col0 = colt + wc * 32 + 8 * fq, bcol0 = u.pn * BM + wc * 32 + 8 * fq;
        f32x4 bv[2][2];
#pragma unroll
        for (int bj = 0; bj < 2; ++bj)
#pragma unroll
            for (int n = 0; n < 2; ++n) bv[bj][n] = bias ? *(const f32x4*)(bias + bcol0 + bj * HALF + 4 * n) : (f32x4){0.f, 0.f, 0.f, 0.f};
#pragma unroll
        for (int ai = 0; ai < 2; ++ai)
#pragma unroll
            for (int m = 0; m < 4; ++m) { bf16_t* rowp = base + (size_t)(row0 + ai * HALF + m * 16) * ldc + col0;
#pragma unroll
                for (int bj = 0; bj < 2; ++bj) { f32x4 v0 = acc[ai][bj][m][0] + bv[bj][0], v1 = acc[ai][bj][m][1] + bv[bj][1];
                    if (ACT == 1) { f32x2 a = gelu_pk((f32x2){v0[0], v0[1]}), b = gelu_pk((f32x2){v0[2], v0[3]}), c = gelu_pk((f32x2){v1[0], v1[1]}), d = gelu_pk((f32x2){v1[2], v1[3]});
                        v0 = (f32x4){a.x, a.y, b.x, b.y}; v1 = (f32x4){c.x, c.y, d.x, d.y}; }
                    v0 = v0 * sc; v1 = v1 * sc; u32x4 w; w.x = cvt_pk_bf16(v0[0], v0[1]); w.y = cvt_pk_bf16(v0[2], v0[3]); w.z = cvt_pk_bf16(v1[0], v1[1]); w.w = cvt_pk_bf16(v1[2], v1[3]);
                    *(u32x4*)(rowp + bj * HALF) = w; } }
    }
};

struct PanelStats {
    unsigned* xbuf;
    unsigned* cnt;
    unsigned* tmo;
    int ntn; float eps;
    unsigned code;
    __device__ __forceinline__ bool run(const f32x4 (&v)[2][2][4][2], const Unit& u, int wr, int wc, int fr, int fq, PG8_LAS unsigned char* lds, int wid, int lane) const {
        typedef float f32x2v __attribute__((ext_vector_type(2)));
        PG8_LAS f32x2v* P = (PG8_LAS f32x2v*)lds;
        PG8_LAS f32x2v* S = (PG8_LAS f32x2v*)(lds + 8192);
        PG8_LAS unsigned* flag = (PG8_LAS unsigned*)(lds + 8192 + 2048);
#pragma unroll
        for (int ai = 0; ai < 2; ++ai)
#pragma unroll
            for (int m = 0; m < 4; ++m) {
                float s = 0.f;
#pragma unroll
                for (int bj = 0; bj < 2; ++bj)
#pragma unroll
                    for (int n = 0; n < 2; ++n) { const f32x4 x = v[ai][bj][m][n]; s += (x[0] + x[1]) + (x[2] + x[3]); }
                s += __shfl_xor(s, 16); s += __shfl_xor(s, 32);
                const float mw = s * (1.0f / 64.0f); float q = 0.f;
#pragma unroll
                for (int bj = 0; bj < 2; ++bj)
#pragma unroll
                    for (int n = 0; n < 2; ++n) { const f32x4 d = v[ai][bj][m][n] - mw; q += (d[0] * d[0] + d[1] * d[1]) + (d[2] * d[2] + d[3] * d[3]); }
                q += __shfl_xor(q, 16); q += __shfl_xor(q, 32);
                if (fq == 0) P[(ai * HALF + wr * 64 + m * 16 + fr) * 4 + wc] = (f32x2v){mw, q};
            }
        asm volatile("s_waitcnt lgkmcnt(0)" ::: "memory"); __builtin_amdgcn_s_barrier(); asm volatile("" ::: "memory");
#if defined(BROKEN_EXCHANGE_NO_WAIT)
#warning BROKEN CONTROL BUILD: the row-statistics exchange does not wait; results are wrong by design
        if (blockIdx.x >= 64) { const long long t0_ = clock64(); while (clock64() - t0_ < 60000) __builtin_amdgcn_s_sleep(8); }
#endif
        const int row = wid * 32 + (lane & 31);
        if (lane < 32) {
            const f32x2v a = P[row * 4 + 0], b = P[row * 4 + 1], c = P[row * 4 + 2], d = P[row * 4 + 3];
            const float mt = (a.x + b.x + c.x + d.x) * 0.25f;
            const float da = a.x - mt, db = b.x - mt, dc = c.x - mt, dd = d.x - mt;
            const float m2 = (a.y + b.y) + (c.y + d.y) + 64.0f * ((da * da + db * db) + (dc * dc + dd * dd));
            unsigned long long* slot = (unsigned long long*)xbuf + ((size_t)(u.pm * BM + row) * 4 + u.pn);
            __hip_atomic_store(slot, ((unsigned long long)__float_as_uint(m2) << 32) | __float_as_uint(mt), __ATOMIC_RELAXED, __HIP_MEMORY_SCOPE_AGENT);
        }
        asm volatile("s_waitcnt vmcnt(0)" ::: "memory");
        if (lane == 0) __hip_atomic_fetch_add(cnt + 64 * u.pm, 1u, __ATOMIC_RELAXED, __HIP_MEMORY_SCOPE_AGENT);
        if (wid == 0) {
            bool dead = false; const unsigned long long t0 = __builtin_amdgcn_s_memrealtime(); const unsigned want = 8u * (unsigned)ntn;
            for (;;) {
#if defined(BROKEN_EXCHANGE_NO_WAIT)
                break;
#endif
                if ((unsigned)__builtin_amdgcn_readfirstlane(__hip_atomic_load(cnt + 64 * u.pm, __ATOMIC_RELAXED, __HIP_MEMORY_SCOPE_AGENT)) >= want) break;
                if (__builtin_amdgcn_s_memrealtime() - t0 > 2000000ull) {
                    if (lane == 0) { unsigned expect = 0u; __hip_atomic_compare_exchange_strong(tmo + 1, &expect, code | (unsigned)(u.pm & 0xff), __ATOMIC_RELAXED, __ATOMIC_RELAXED, __HIP_MEMORY_SCOPE_AGENT);
                                     __hip_atomic_store(tmo, 1u, __ATOMIC_RELAXED, __HIP_MEMORY_SCOPE_AGENT); }
                    dead = true; break; }
                __builtin_amdgcn_s_sleep(2);
            }
            __builtin_amdgcn_fence(__ATOMIC_ACQUIRE, "agent");
            if (lane == 0) flag[0] = dead ? 1u : 0u;
        }
        asm volatile("s_waitcnt vmcnt(0) lgkmcnt(0)" ::: "memory"); __builtin_amdgcn_s_barrier(); asm volatile("" ::: "memory");
        const bool bad = flag[0] != 0u;
        if (lane < 32) {
            const unsigned long long* slot = (const unsigned long long*)xbuf + (size_t)(u.pm * BM + row) * 4; float mt[4], m2[4]; float ms = 0.f;
#pragma unroll
            for (int t = 0; t < 4; ++t) { if (t < ntn) { const unsigned long long w = __hip_atomic_load(slot + t, __ATOMIC_RELAXED, __HIP_MEMORY_SCOPE_AGENT); mt[t] = __uint_as_float((unsigned)w); m2[t] = __uint_as_float((unsigned)(w >> 32)); } else { mt[t] = 0.f; m2[t] = 0.f; } ms += mt[t]; }
            const float mean = ms / (float)ntn; float q = 0.f;
#pragma unroll
            for (int t = 0; t < 4; ++t) if (t < ntn) { const float dm = mt[t] - mean; q += m2[t] + 256.0f * dm * dm; }
            S[row] = (f32x2v){mean, 1.0f / sqrtf(q / (256.0f * (float)ntn) + eps)};
        }
        asm volatile("s_waitcnt lgkmcnt(0)" ::: "memory"); __builtin_amdgcn_s_barrier(); asm volatile("" ::: "memory");
        return bad;
    }
};
struct EpiLnRes {
    static constexpr bool PERM = false, AFTER_DRAIN = true;
    const float* base; float* out; int ldc; const float* bias; PanelStats st; unsigned poison;
    __device__ __forceinline__ void fused(f32x4 (&acc)[2][2][4][2], const Unit& u, int wr, int wc, int fr, int fq, PG8_LAS unsigned char* lds, int wid, int lane) const {
        typedef float f32x2v __attribute__((ext_vector_type(2)));
        const PG8_LAS f32x2v* S = (const PG8_LAS f32x2v*)(lds + 8192);
        const int col0 = u.pn * BM + wc * 32 + 4 * fq;
#pragma unroll
        for (int bj = 0; bj < 2; ++bj)
#pragma unroll
            for (int n = 0; n < 2; ++n) { const f32x4 bv = bias ? *(const f32x4*)(bias + col0 + bj * HALF + n * 16) : (f32x4){0.f, 0.f, 0.f, 0.f};
#pragma unroll
                for (int ai = 0; ai < 2; ++ai)
#pragma unroll
                    for (int m = 0; m < 4; ++m) acc[ai][bj][m][n] += bv; }
        f32x4 pre[4][2][2];
#pragma unroll
        for (int m = 0; m < 4; ++m) { const size_t off = (size_t)(u.pm * BM + wr * 64 + m * 16 + fr) * ldc + col0;
#pragma unroll
            for (int bj = 0; bj < 2; ++bj)
#pragma unroll
                for (int n = 0; n < 2; ++n) pre[m][bj][n] = *(const f32x4*)(base + off + bj * HALF + n * 16); }
        const bool bad = st.run(acc, u, wr, wc, fr, fq, lds, wid, lane) || poison != 0u;
        const float qnan = __builtin_nanf("");
#pragma unroll
        for (int ai = 0; ai < 2; ++ai)
#pragma unroll
            for (int m = 0; m < 4; ++m) { const int r = ai * HALF + wr * 64 + m * 16 + fr; const f32x2v sr = S[r]; const size_t off = (size_t)(u.pm * BM + r) * ldc + col0;
#pragma unroll
                for (int bj = 0; bj < 2; ++bj)
#pragma unroll
                    for (int n = 0; n < 2; ++n) { const f32x4 bs = ai == 0 ? pre[m][bj][n] : *(const f32x4*)(base + off + bj * HALF + n * 16); f32x4 o = bs + (acc[ai][bj][m][n] - sr.x) * sr.y;
                        if (bad) o = (f32x4){qnan, qnan, qnan, qnan}; *(f32x4*)(out + off + bj * HALF + n * 16) = o; }
                if (m & 1) asm volatile("" ::: "memory"); }
    }
};
struct EpiLnResLn {
    static constexpr bool PERM = false, AFTER_DRAIN = true;
    const float* base; float* out; bf16_t* xn; int ldc; const float* bias; PanelStats st1, st2; unsigned poison;
    __device__ __forceinline__ void fused(f32x4 (&acc)[2][2][4][2], const Unit& u, int wr, int wc, int fr, int fq, PG8_LAS unsigned char* lds, int wid, int lane) const {
        typedef float f32x2v __attribute__((ext_vector_type(2))); typedef unsigned u32x2v __attribute__((ext_vector_type(2)));
        const PG8_LAS f32x2v* S = (const PG8_LAS f32x2v*)(lds + 8192);
        const int col0 = u.pn * BM + wc * 32 + 4 * fq;
#pragma unroll
        for (int bj = 0; bj < 2; ++bj)
#pragma unroll
            for (int n = 0; n < 2; ++n) { const f32x4 bv = bias ? *(const f32x4*)(bias + col0 + bj * HALF + n * 16) : (f32x4){0.f, 0.f, 0.f, 0.f};
#pragma unroll
                for (int ai = 0; ai < 2; ++ai)
#pragma unroll
                    for (int m = 0; m < 4; ++m) acc[ai][bj][m][n] += bv; }
        bool bad = st1.run(acc, u, wr, wc, fr, fq, lds, wid, lane) || poison != 0u;
        const float qnan = __builtin_nanf("");
#pragma unroll
        for (int ai = 0; ai < 2; ++ai)
#pragma unroll
            for (int m = 0; m < 4; ++m) { const int r = ai * HALF + wr * 64 + m * 16 + fr; const f32x2v sr = S[r]; const size_t off = (size_t)(u.pm * BM + r) * ldc + col0;
#pragma unroll
                for (int bj = 0; bj < 2; ++bj)
#pragma unroll
                    for (int n = 0; n < 2; ++n) { const f32x4 bs = *(const f32x4*)(base + off + bj * HALF + n * 16); acc[ai][bj][m][n] = bs + (acc[ai][bj][m][n] - sr.x) * sr.y; }
                asm volatile("" : "+v"(acc[ai][0][m][0]), "+v"(acc[ai][0][m][1]), "+v"(acc[ai][1][m][0]), "+v"(acc[ai][1][m][1]));
                if (m & 1) asm volatile("" ::: "memory"); }
        const bool bad1 = bad;
        bad = st2.run(acc, u, wr, wc, fr, fq, lds, wid, lane) || bad;
#pragma unroll
        for (int ai = 0; ai < 2; ++ai)
#pragma unroll
            for (int m = 0; m < 4; ++m) { const int r = ai * HALF + wr * 64 + m * 16 + fr; const f32x2v sr = S[r]; const size_t off = (size_t)(u.pm * BM + r) * ldc + col0;
#pragma unroll
                for (int bj = 0; bj < 2; ++bj)
#pragma unroll
                    for (int n = 0; n < 2; ++n) { const f32x4 x1 = acc[ai][bj][m][n]; *(f32x4*)(out + off + bj * HALF + n * 16) = bad1 ? (f32x4){qnan, qnan, qnan, qnan} : x1;
                        const f32x4 o = (x1 - sr.x) * sr.y; u32x2v w; w.x = cvt_pk_bf16(o[0], o[1]); w.y = cvt_pk_bf16(o[2], o[3]);
                        if (bad) { w.x = 0x7fc07fc0u; w.y = 0x7fc07fc0u; } *(u32x2v*)(xn + off + bj * HALF + n * 16) = w; }
                asm volatile("" ::: "memory"); }
    }
};

template <class Epi, class Sched, bool ALIGN_EPI = false, bool SP2 = false>
__device__ __forceinline__ void gemm_phase(PG8_LAS unsigned char* lds, const Gemm g, const Sched& S, const Epi& E) {
    const int tid = threadIdx.x, wid = __builtin_amdgcn_readfirstlane(tid >> 6), lane = tid & 63, wr = wid >> 2, wc = wid & 3, fr = lane & 15, fq = lane >> 4;
    const int K = g.K, nt = K / BK;
    unsigned voffA[2], voffB[2];
#pragma unroll
    for (int i = 0; i < 2; ++i) { int R, C; stage_rc(tid * 16 + i * 8192, R, C); const int Rb = Epi::PERM ? ((R & ~31) + perm32(R & 31)) : R;
        voffA[i] = (unsigned)(R * K + C) * 2u; voffB[i] = (unsigned)(Rb * K + C) * 2u; }
    const size_t kstep = (size_t)(BK * 2);
    const size_t hstep = (size_t)HALF * K * 2;
    const size_t tstep = 2 * hstep;
    const unsigned ldsw = (unsigned)wid * 1024u;
    const int aoff = lds_byte(wr * 64 + fr, fq * 8), boff = lds_byte(wc * 32 + fr, fq * 8);
#define PG8_SA(b, h) (((b) * 2 + (h)) * HTB)
#define PG8_SB(b, h) ((4 + (b) * 2 + (h)) * HTB)
#define PG8_STAGE(bufoff, gbase, voff) do { _Pragma("unroll") for (int _i = 0; _i < 2; ++_i) \
        __builtin_amdgcn_global_load_lds((const unsigned*)((const char*)(gbase) + (voff)[_i]), (PG8_LAS unsigned*)(lds + (bufoff) + ldsw + _i * 8192), 16, 0, 0); } while (0)
#define PG8_LDA(dst, b, h) do { _Pragma("unroll") for (int m = 0; m < 4; ++m) _Pragma("unroll") for (int k = 0; k < 2; ++k) dst[m][k] = *(const PG8_LAS bf16x8*)(lds + PG8_SA(b, h) + aoff + m * 2048 + k * 1024); } while (0)
#define PG8_LDB(dst, b, h) do { _Pragma("unroll") for (int n = 0; n < 2; ++n) _Pragma("unroll") for (int k = 0; k < 2; ++k) dst[n][k] = *(const PG8_LAS bf16x8*)(lds + PG8_SB(b, h) + boff + n * 2048 + k * 1024); } while (0)
#define PG8_MMA(ai, bj, At, Bt) do { __builtin_amdgcn_s_setprio(1); _Pragma("unroll") for (int m = 0; m < 4; ++m) _Pragma("unroll") for (int n = 0; n < 2; ++n) _Pragma("unroll") for (int k = 0; k < 2; ++k) \
        acc[ai][bj][m][n] = __builtin_amdgcn_mfma_f32_16x16x32_bf16(Bt[n][k], At[m][k], acc[ai][bj][m][n], 0, 0, 0); __builtin_amdgcn_s_setprio(0); } while (0)
#define PG8_WAIT_V(n) asm volatile("s_waitcnt vmcnt(" #n ")" ::: "memory")
#define PG8_WAIT_L(n) asm volatile("s_waitcnt lgkmcnt(" #n ")" ::: "memory")
#define PG8_BAR __builtin_amdgcn_s_barrier()
#define PG8_SCHED __builtin_amdgcn_sched_barrier(0)
    Unit cur, nxt; int ui = 0;
    if (!S.next(0, cur)) return;
    f32x4 acc[2][2][4][2];
#pragma unroll
    for (int a = 0; a < 2; ++a)
#pragma unroll
        for (int b = 0; b < 2; ++b)
#pragma unroll
            for (int m = 0; m < 4; ++m)
#pragma unroll
                for (int n = 0; n < 2; ++n) acc[a][b][m][n] = (f32x4){0.f, 0.f, 0.f, 0.f};
    bf16x8 At[4][2], B0[2][2], B1[2][2];
    const char* cA = (const char*)g.A + (size_t)cur.pm * tstep; const char* cB = (const char*)g.Bt + (size_t)cur.pn * tstep;
    S.a_ready(cur);
    if constexpr (SP2) {
        PG8_STAGE(PG8_SB(0, 0), cB, voffB); PG8_STAGE(PG8_SB(0, 1), cB + hstep, voffB); PG8_STAGE(PG8_SA(0, 0), cA, voffA); PG8_STAGE(PG8_SA(0, 1), cA + hstep, voffA);
        if (wr == 1) PG8_BAR;
        PG8_WAIT_V(2); PG8_BAR;
        PG8_STAGE(PG8_SB(1, 0), cB + kstep, voffB); PG8_STAGE(PG8_SA(1, 0), cA + kstep, voffA); PG8_STAGE(PG8_SB(1, 1), cB + hstep + kstep, voffB);
        PG8_WAIT_V(6); PG8_BAR;
    } else {
        PG8_STAGE(PG8_SB(0, 0), cB, voffB); PG8_STAGE(PG8_SA(0, 0), cA, voffA); PG8_STAGE(PG8_SB(0, 1), cB + hstep, voffB); PG8_STAGE(PG8_SA(0, 1), cA + hstep, voffA);
        if (wr == 1) PG8_BAR;
        PG8_WAIT_V(4); PG8_BAR;
        PG8_STAGE(PG8_SB(1, 0), cB + kstep, voffB); PG8_STAGE(PG8_SA(1, 0), cA + kstep, voffA); PG8_STAGE(PG8_SB(1, 1), cB + hstep + kstep, voffB);
        PG8_WAIT_V(6); PG8_BAR;
    }
    for (;;) {
        const bool has_next = S.next(ui + 1, nxt);
        const char* nA = has_next ? (const char*)g.A + (size_t)nxt.pm * tstep : cA; const char* nB = has_next ? (const char*)g.Bt + (size_t)nxt.pn * tstep : cB;
        for (int t = 0; t < nt; t += 2) {
            const bool last = (t == nt - 2);
            const char* a1 = cA + (size_t)(t + 1) * kstep;
            const char* a2 = last ? nA : cA + (size_t)(t + 2) * kstep; const char* b2 = last ? nB : cB + (size_t)(t + 2) * kstep;
            const char* a3 = a2 + kstep; const char* b3 = b2 + kstep;
            if (last && has_next) S.a_ready(nxt);
            if constexpr (SP2) {
            PG8_LDB(B0, 0, 0); PG8_LDB(B1, 0, 1); PG8_SCHED; PG8_LDA(At, 0, 0); PG8_STAGE(PG8_SA(1, 1), a1 + hstep, voffA);
            PG8_WAIT_V(8); PG8_WAIT_L(0); PG8_BAR; PG8_MMA(0, 0, At, B0); PG8_MMA(0, 1, At, B1); PG8_BAR; PG8_SCHED;
            PG8_LDA(At, 0, 1); PG8_STAGE(PG8_SB(0, 0), b2, voffB); PG8_STAGE(PG8_SB(0, 1), b2 + hstep, voffB); PG8_STAGE(PG8_SA(0, 0), a2, voffA);
            PG8_WAIT_V(8); PG8_WAIT_L(0); PG8_BAR; PG8_MMA(1, 0, At, B0); PG8_MMA(1, 1, At, B1); PG8_BAR; PG8_SCHED;
            PG8_LDB(B0, 1, 0); PG8_LDB(B1, 1, 1); PG8_SCHED; PG8_LDA(At, 1, 0); PG8_STAGE(PG8_SA(0, 1), a2 + hstep, voffA);
            PG8_WAIT_V(8); PG8_WAIT_L(0); PG8_BAR; PG8_MMA(0, 0, At, B0); PG8_MMA(0, 1, At, B1); PG8_BAR; PG8_SCHED;
            PG8_LDA(At, 1, 1); PG8_STAGE(PG8_SB(1, 0), b3, voffB); PG8_STAGE(PG8_SB(1, 1), b3 + hstep, voffB); PG8_STAGE(PG8_SA(1, 0), a3, voffA);
            PG8_WAIT_V(8); PG8_WAIT_L(0); PG8_BAR; PG8_MMA(1, 0, At, B0); PG8_MMA(1, 1, At, B1); PG8_BAR; PG8_SCHED;
            } else {
            PG8_LDB(B0, 0, 0); PG8_SCHED; PG8_LDA(At, 0, 0); PG8_STAGE(PG8_SA(1, 1), a1 + hstep, voffA);
            PG8_WAIT_L(8); PG8_BAR; PG8_WAIT_L(0); PG8_MMA(0, 0, At, B0); PG8_BAR; PG8_SCHED;
            PG8_LDB(B1, 0, 1); PG8_STAGE(PG8_SB(0, 0), b2, voffB);
            PG8_BAR; PG8_WAIT_L(0); PG8_MMA(0, 1, At, B1); PG8_BAR;
            PG8_LDA(At, 0, 1); PG8_STAGE(PG8_SA(0, 0), a2, voffA);
            PG8_BAR; PG8_WAIT_L(0); PG8_MMA(1, 0, At, B0); PG8_BAR; PG8_SCHED;
            PG8_STAGE(PG8_SB(0, 1), b2 + hstep, voffB);
            PG8_WAIT_V(6); PG8_BAR; PG8_MMA(1, 1, At, B1); PG8_BAR;
            PG8_LDB(B0, 1, 0); PG8_SCHED; PG8_LDA(At, 1, 0); PG8_STAGE(PG8_SA(0, 1), a2 + hstep, voffA);
            PG8_WAIT_L(8); PG8_BAR; PG8_WAIT_L(0); PG8_MMA(0, 0, At, B0); PG8_BAR; PG8_SCHED;
            PG8_LDB(B1, 1, 1); PG8_STAGE(PG8_SB(1, 0), b3, voffB);
            PG8_BAR; PG8_WAIT_L(0); PG8_MMA(0, 1, At, B1); PG8_BAR;
            PG8_LDA(At, 1, 1); PG8_STAGE(PG8_SA(1, 0), a3, voffA);
            PG8_BAR; PG8_WAIT_L(0); PG8_MMA(1, 0, At, B0); PG8_BAR; PG8_SCHED;
            PG8_STAGE(PG8_SB(1, 1), b3 + hstep, voffB);
            PG8_WAIT_V(6); PG8_BAR; PG8_MMA(1, 1, At, B1); PG8_BAR;
            }
        }
        if constexpr (ALIGN_EPI) { if (wr == 0) PG8_BAR; }
        if constexpr (!Epi::AFTER_DRAIN) { E(acc, cur, wr, wc, fr, fq); S.done(cur); }
        if (!has_next) break;
#pragma unroll
        for (int a = 0; a < 2; ++a)
#pragma unroll
            for (int b = 0; b < 2; ++b)
#pragma unroll
                for (int m = 0; m < 4; ++m)
#pragma unroll
                    for (int n = 0; n < 2; ++n) acc[a][b][m][n] = (f32x4){0.f, 0.f, 0.f, 0.f};
        cur = nxt; cA = nA; cB = nB; ++ui;
        if constexpr (ALIGN_EPI) { if (wr == 1) PG8_BAR; }
    }
    PG8_WAIT_V(0);
    if constexpr (!ALIGN_EPI) { if (wr == 0) PG8_BAR; }
    PG8_BAR;
    if constexpr (Epi::AFTER_DRAIN) { E.fused(acc, cur, wr, wc, fr, fq, lds, wid, lane); S.done(cur); }
#undef PG8_SA
#undef PG8_SB
#undef PG8_STAGE
#undef PG8_LDA
#undef PG8_LDB
#undef PG8_MMA
#undef PG8_WAIT_V
#undef PG8_WAIT_L
#undef PG8_BAR
#undef PG8_SCHED
}
}
#define GAS __attribute__((address_space(1)))
#define LAS __attribute__((address_space(3)))
typedef unsigned short bf16;
typedef unsigned v4u __attribute__((ext_vector_type(4)));
typedef float f32x4 __attribute__((ext_vector_type(4)));
typedef short bf16x8 __attribute__((ext_vector_type(8)));
typedef GAS unsigned gu32;
typedef GAS unsigned long long gu64;
#define RLX_AGENT __ATOMIC_RELAXED, __HIP_MEMORY_SCOPE_AGENT
#define LDS_WAIT() asm volatile("s_waitcnt lgkmcnt(0)" ::: "memory")
#define VM_WAIT() asm volatile("s_waitcnt vmcnt(0)" ::: "memory")
__device__ __forceinline__ unsigned long long rt() { return __builtin_amdgcn_s_memrealtime(); }
__device__ __forceinline__ unsigned f2bf(float f) { unsigned u = __builtin_bit_cast(unsigned, f); return (u + 0x7fffu + ((u >> 16) & 1u)) >> 16; }
__device__ __forceinline__ unsigned pk2(float lo, float hi) { return f2bf(lo) | (f2bf(hi) << 16); }
#define XB_TMO      128
#define XB_XCNT(j)  (256  + 64 * (j))
#define XB_XSUB(j)  (1280 + 64 * (j))
#define XB_XGEN(j)  (2304 + 64 * (j))
#define XB_TOP      3328
#define XB_TOPGEN   3392
#define XCD_BAR_WORDS 3456
#define XB_SPIN_CAP (1u << 18)

__device__ __forceinline__ unsigned xb_ld(unsigned* p)              { return __hip_atomic_load(p, __ATOMIC_RELAXED, __HIP_MEMORY_SCOPE_AGENT); }
__device__ __forceinline__ unsigned xb_add(unsigned* p, unsigned v) { return __hip_atomic_fetch_add(p, v, __ATOMIC_RELAXED, __HIP_MEMORY_SCOPE_AGENT); }
__device__ __forceinline__ unsigned xb_xcc_id() { return (unsigned)__builtin_amdgcn_s_getreg((3 << 11) | 20) & 0xFu; }
#define XB_SPIN(cond, bar) do { unsigned _sp = 0; while (cond) { __builtin_amdgcn_s_sleep(1); \
    if ((++_sp & 255u) == 0u) { if (xb_ld(&(bar)[XB_TMO])) break; if (_sp > XB_SPIN_CAP) { atomicAdd(&(bar)[XB_TMO], 1u); break; } } } } while (0)

struct XcdBarrier {
    unsigned* bar; unsigned x;
    volatile LAS unsigned* st;
};

__device__ __forceinline__ XcdBarrier xcd_barrier_post(unsigned* bar, volatile LAS unsigned* st) {
    XcdBarrier b; b.bar = bar; b.x = xb_xcc_id(); b.st = st;
    if (threadIdx.x == 0) (void)xb_add(&bar[XB_XCNT(b.x)], 1u);
    return b;
}
__device__ __forceinline__ void xcd_barrier_complete(unsigned* bar, unsigned x, unsigned& nloc, unsigned& nx) {
    const unsigned G = gridDim.x * gridDim.y * gridDim.z;
    unsigned sum, cnt, mine, sp = 0u;
    for (;;) {
        sum = 0u; cnt = 0u; mine = 0u;
#pragma unroll
        for (unsigned j = 0; j < 16; ++j) { const unsigned c = xb_ld(&bar[XB_XCNT(j)]); sum += c; cnt += (c > 0u) ? 1u : 0u; mine = (j == x) ? c : mine; }
        if (sum == G) break;
        __builtin_amdgcn_s_sleep(1);
        if ((++sp & 255u) == 0u) { if (xb_ld(&bar[XB_TMO])) break; if (sp > XB_SPIN_CAP) { atomicAdd(&bar[XB_TMO], 1u); break; } }
    }
    nloc = mine > 0u ? mine : 1u; nx = cnt > 0u ? cnt : 1u;
}

__device__ __forceinline__ void xcd_barrier(const XcdBarrier& b) {
    asm volatile("s_waitcnt vmcnt(0)" ::: "memory");
    __syncthreads();
    if (threadIdx.x == 0) {
        unsigned* bar = b.bar;
        __builtin_amdgcn_s_waitcnt(0);
        unsigned nloc = b.st[0], nx = b.st[1];
        if (nloc == 0u) { xcd_barrier_complete(bar, b.x, nloc, nx); b.st[0] = nloc; b.st[1] = nx; }
        const unsigned old = xb_add(&bar[XB_XSUB(b.x)], 1u);
        const unsigned gen = old / nloc;
        if (old + 1u == (gen + 1u) * nloc) {
            __builtin_amdgcn_fence(__ATOMIC_RELEASE, "agent");
            asm volatile("s_waitcnt vmcnt(0)" ::: "memory");
            const unsigned og = xb_add(&bar[XB_TOP], 1u);
            const unsigned tg = og / nx;
            if (og + 1u == (tg + 1u) * nx) xb_add(&bar[XB_TOPGEN], 1u);
            else XB_SPIN(xb_ld(&bar[XB_TOPGEN]) == tg, bar);
            __builtin_amdgcn_fence(__ATOMIC_ACQUIRE, "agent");
            xb_add(&bar[XB_XGEN(b.x)], 1u);
            asm volatile("s_waitcnt vmcnt(0)" ::: "memory");
        } else {
            XB_SPIN(xb_ld(&bar[XB_XGEN(b.x)]) == gen, bar);
            __builtin_amdgcn_fence(__ATOMIC_ACQUIRE, "agent");
            asm volatile("s_waitcnt vmcnt(0)" ::: "memory");
        }
    }
    __syncthreads();
}
constexpr int NWAVES = 8;
#ifndef WGM_P2
#define WGM_P2 2
#endif
#ifndef WGM_P5
#define WGM_P5 4
#endif
#ifndef WGM_P6
#define WGM_P6 8
#endif
#ifndef WGM_P7
#define WGM_P7 1
#endif
constexpr int M_TOK = 16384, DM = 2048, NPROJ = 6144, WIN_LD = 6152, DFF = 5632, NGU = 11264, NADA = 12288;
constexpr int MB_H = 8, MB_DH = 128, MB_BLK = 256, MB_NB = 64;
constexpr int ML_H = 4, ML_DQK = 128, ML_DV = 256, ML_L = 64, ML_NC = 256;
constexpr float DN_ALPHA = 1.189207115002721f;
constexpr float LN_EPS = 1e-5f;
constexpr float K_SCALE = 0.08838834764831845f;

constexpr size_t MiB = 1u << 20;
constexpr size_t WS_CTL = 0, CTL_ZERO_BYTES = 128 * 1024;
constexpr size_t WS_SMALL = 1 * MiB;
constexpr size_t SM_ADA = 0, SM_C1 = 64 * 1024, SM_C2 = 128 * 1024, SM_KMEAN = 256 * 1024, SM_GATES = 512 * 1024, SM_TOKSC = 1 * MiB,
                 SM_CHSUM = 2 * MiB, SM_DECAY = 2 * MiB + 16 * 1024, SM_NLOC = 2 * MiB + 64 * 1024, SM_MUR = 3 * MiB;
constexpr size_t WS_WIN = 6 * MiB, WS_LISTS = 6 * MiB, WS_STATP = 6 * MiB;
constexpr size_t WS_WOUT = 30 * MiB, WS_WGU = 38 * MiB, WS_WDOWN = 82 * MiB;
constexpr size_t WS_U = 104 * MiB, WS_LOCAL = 104 * MiB, WS_Y1B = 104 * MiB;
constexpr size_t WS_MIX = 168 * MiB, WS_H = 168 * MiB;
constexpr size_t WS_KB = 232 * MiB, WS_VB = 264 * MiB, WS_MQK = 296 * MiB, WS_MV = 328 * MiB;
constexpr size_t WS_PART0 = 296 * MiB, WS_PART1 = 328 * MiB, WS_PART2 = 440 * MiB, WS_PART3 = 472 * MiB, WS_LSE = 504 * MiB;
constexpr size_t WS_QC = 360 * MiB, WS_KC = 376 * MiB, WS_KWT = 392 * MiB, WS_VT = 408 * MiB;
constexpr size_t WS_ROPE = 506 * MiB, WS_C12P = 508 * MiB, WS_ADAP = 511 * MiB;
constexpr size_t WS_Y1F = 384 * MiB, WS_END = 512 * MiB;
constexpr int CW_TMO = 0, CW_BAR = 4096, CW_CNT = 16384, CW_QUEUE = 20480, CW_PANEL = 24576;

constexpr int RING_BYTES = 131072, LDSCTL_OFF = RING_BYTES, MISC_OFF = LDSCTL_OFF + 320, LDS_BYTES = 147456;

typedef float f32x2 __attribute__((ext_vector_type(2)));
typedef unsigned u32x2 __attribute__((ext_vector_type(2)));

__device__ __forceinline__ float bf2f(unsigned short b) { return __builtin_bit_cast(float, (unsigned)b << 16); }
__device__ __forceinline__ float bflo(unsigned w) { return __builtin_bit_cast(float, w << 16); }
__device__ __forceinline__ float bfhi(unsigned w) { return __builtin_bit_cast(float, w & 0xffff0000u); }
__device__ __forceinline__ float sigmoid_f(float v) { return 1.f / (1.f + __expf(-v)); }
__device__ __forceinline__ float silu_f(float v) { return v / (1.f + __expf(-v)); }
__device__ __forceinline__ float logsigmoid_f(float v) { return fminf(v, 0.f) - log1pf(expf(-fabsf(v))); }

struct Frame {
    LAS unsigned char* lds;
    volatile LAS unsigned* MISC;
    gu32* ctl;
    int tid, lane, wave, G, bid;
    const float *x, *c, *w_ada, *b_ada, *w_in, *conv_w, *conv_b, *igb, *fgb, *normw, *w_out, *ln1_w, *ln1_b, *w_gu, *w_down, *ln2_w, *ln2_b;
    float* out; unsigned char* ws; unsigned long long tp0, tp1;
};
#if defined(TIME_PHASE)
#define TP_BEGIN(id) do { if (TIME_PHASE == (id)) F.tp0 = __builtin_amdgcn_s_memrealtime(); } while (0)
#define TP_END(id) do { if (TIME_PHASE == (id)) F.tp1 = __builtin_amdgcn_s_memrealtime(); } while (0)
#define TPA_BEGIN(id) unsigned long long tpa_t0_ = (TIME_PHASE == (id)) ? __builtin_amdgcn_s_memrealtime() : 0ull
#define TPA_END(id) do { if (TIME_PHASE == (id)) F.tp1 += __builtin_amdgcn_s_memrealtime() - tpa_t0_; } while (0)
#else
#define TPA_BEGIN(id) do { } while (0)
#define TPA_END(id) do { } while (0)
#define TP_BEGIN(id) do { } while (0)
#define TP_END(id) do { } while (0)
#endif
#define SMALLF(off) ((float*)(F.ws + WS_SMALL + (off)))

__device__ __forceinline__ float wave_sum(float v) {
#pragma unroll
    for (int o = 1; o < 64; o <<= 1) v += __shfl_xor(v, o);
    return v;
}

__device__ __forceinline__ void p0_transpose_item(const float* W, int K, int N, int ld, bf16* WT, LAS float* scr, int item, int lane) {
    const int nblk = N / 32, kb = item / nblk, nb = item % nblk, k0 = 64 * kb, n0 = 32 * nb;
    float ldv[32];
#pragma unroll
    for (int i = 0; i < 32; ++i) ldv[i] = W[(size_t)(k0 + 2 * i + (lane >> 5)) * ld + n0 + (lane & 31)];
#pragma unroll
    for (int i = 0; i < 32; ++i) scr[(2 * i + (lane >> 5)) * 33 + (lane & 31)] = ldv[i];
    LDS_WAIT(); asm volatile("" ::: "memory");
    const int c = lane & 7;
#pragma unroll
    for (int j = 0; j < 4; ++j) { const int n = (lane >> 3) + 8 * j; const LAS float* s = scr + (8 * c) * 33 + n;
        v4u o; o.x = pk2(s[0 * 33], s[1 * 33]); o.y = pk2(s[2 * 33], s[3 * 33]); o.z = pk2(s[4 * 33], s[5 * 33]); o.w = pk2(s[6 * 33], s[7 * 33]);
        *(GAS v4u*)(WT + (size_t)(n0 + n) * K + k0 + 8 * c) = o; }
    LDS_WAIT(); asm volatile("" ::: "memory");
}

__device__ __forceinline__ void p0_phase(Frame& F) {
    TP_BEGIN(120);
    {
        LAS float* sc = (LAS float*)(F.lds); LAS float* red = sc + 2048;
        for (int k = F.tid; k < DM; k += 512) sc[k] = silu_f(F.c[k]);
        __syncthreads();
        float* adap = (float*)(F.ws + WS_ADAP);
        for (int item = F.bid; item < 256; item += F.G) {
            const int kq = item >> 6, slab = item & 63;
            const int rg = F.tid / 48, cq = F.tid % 48;
            if (F.tid < 480) {
                f32x4 acc = {0.f, 0.f, 0.f, 0.f};
                const float* wp = F.w_ada + (size_t)(kq * 512) * NADA + slab * 192 + cq * 4;
#pragma unroll 13
                for (int k = rg; k < 512; k += 10) { const f32x4 w = *(const f32x4*)(wp + (size_t)k * NADA); acc += w * sc[kq * 512 + k]; }
                *(LAS f32x4*)(red + rg * 192 + cq * 4) = acc;
            }
            __syncthreads();
            if (F.tid < 192) { float s = 0.f;
#pragma unroll
                for (int g = 0; g < 10; ++g) s += red[g * 192 + F.tid];
                adap[(size_t)kq * NADA + slab * 192 + F.tid] = s; }
            __syncthreads();
        }
    }
    TP_END(120); TP_BEGIN(121);
    {
        LAS float* scr = (LAS float*)(F.lds + F.wave * 16384);
        const int gw = F.bid * NWAVES + F.wave, NGW = F.G * NWAVES;
        constexpr int I_IN = (DM / 64) * (NPROJ / 32), I_OUT = (DM / 64) * (DM / 32), I_DN = (DFF / 64) * (DM / 32);
        for (int it = gw; it < I_IN + I_OUT + I_DN; it += NGW) {
            int r = it;
            if (r < I_IN) { p0_transpose_item(F.w_in, DM, NPROJ, WIN_LD, (bf16*)(F.ws + WS_WIN), scr, r, F.lane); continue; } r -= I_IN;
            if (r < I_OUT) { p0_transpose_item(F.w_out, DM, DM, DM, (bf16*)(F.ws + WS_WOUT), scr, r, F.lane); continue; } r -= I_OUT;
            p0_transpose_item(F.w_down, DFF, DM, DM, (bf16*)(F.ws + WS_WDOWN), scr, r, F.lane);
        }
    }
    TP_END(121); TP_BEGIN(122);
    for (int i = F.bid * 512 + F.tid; i < MB_H * MB_NB * MB_DH; i += F.G * 512) SMALLF(SM_KMEAN)[i] = 0.f;
    for (int i = F.bid * 512 + F.tid; i < M_TOK * 2; i += F.G * 512) ((unsigned long long*)SMALLF(SM_MUR))[i] = 0ull;
    {
        const double INV[16] = {1.0, 0.44036660267178046, 0.19392274474868576, 0.08539710028576561, 0.03760603093086393, 0.016560440080994446, 0.007292664737217109, 0.003211445994752591,
                                0.001414213562373095, 0.000622772421914596, 0.0002742481756762073, 0.00012076973741146504, 5.318295896944988e-05, 2.341999896140934e-05, 1.031338537721246e-05, 4.5416704806078695e-06};
        float* rope = (float*)(F.ws + WS_ROPE);
        for (int idx = F.bid * 512 + F.tid; idx < M_TOK * 16; idx += F.G * 512) {
            const int pos = idx >> 4, i = idx & 15;
            double inv = INV[0];
#pragma unroll
            for (int j = 1; j < 16; ++j) inv = (i == j) ? INV[j] : inv;
            const double ang = (double)pos * inv;
            const double q = __builtin_floor(ang * 0.6366197723675814 + 0.5);
            double r = __builtin_fma(-q, 1.5707963267948966, ang); r = __builtin_fma(-q, 6.123233995736766e-17, r);
            const int qi = ((int)q) & 3; const double r2 = r * r;
            double cs = 1.0 + r2 * (-0.5 + r2 * (1.0 / 24 + r2 * (-1.0 / 720 + r2 * (1.0 / 40320 + r2 * (-1.0 / 3628800 + r2 * (1.0 / 479001600 + r2 * (-1.0 / 87178291200.0)))))));
            double sn = r * (1.0 + r2 * (-1.0 / 6 + r2 * (1.0 / 120 + r2 * (-1.0 / 5040 + r2 * (1.0 / 362880 + r2 * (-1.0 / 39916800 + r2 * (1.0 / 6227020800.0 + r2 * (-1.0 / 1307674368000.0))))))));
            double co, si;
            if (qi == 0) { co = cs; si = sn; } else if (qi == 1) { co = -sn; si = cs; } else if (qi == 2) { co = -cs; si = -sn; } else { co = sn; si = -cs; }
            rope[pos * 32 + i] = (float)co; rope[pos * 32 + 16 + i] = (float)si;
        }
    }
    TP_END(122);
}

__device__ __forceinline__ float ada_val(const Frame& F, int n) {
    const float* p = (const float*)(F.ws + WS_ADAP) + n;
    return ((p[0] + p[NADA]) + (p[2 * NADA] + p[3 * NADA])) + F.b_ada[n];
}
__device__ __forceinline__ void p1_wgu_item(Frame& F, LAS float* scr, int item) {
    const int lane = F.lane;
    constexpr int nblk = NGU / 32; const int kb = item / nblk, nb = item % nblk, k0 = 64 * kb, n0 = 32 * nb;
    const int pn = n0 >> 8, bj = (n0 >> 7) & 1, idx0 = n0 & 127;
    const int src0 = (bj ? DFF : 0) + pn * 128 + idx0;
    LAS float* wv = scr + 64 * 33; LAS float* bv = wv + 64;
    {   const int k = k0 + lane;
        const float s2 = 1.f + ada_val(F, 4 * DM + k); wv[lane] = F.ln1_w[k] * s2; bv[lane] = F.ln1_b[k] * s2 + ada_val(F, 3 * DM + k); }
    float ldv[32];
#pragma unroll
    for (int i = 0; i < 32; ++i) ldv[i] = F.w_gu[(size_t)(k0 + 2 * i + (lane >> 5)) * NGU + src0 + (lane & 31)];
#pragma unroll
    for (int i = 0; i < 32; ++i) scr[(2 * i + (lane >> 5)) * 33 + (lane & 31)] = ldv[i];
    LDS_WAIT(); asm volatile("" ::: "memory");
    const int c = lane & 7; bf16* WT = (bf16*)(F.ws + WS_WGU);
    float* c1p = (float*)(F.ws + WS_C12P) + (size_t)kb * NGU; float* c2p = (float*)(F.ws + WS_C12P) + (size_t)(32 + kb) * NGU;
#pragma unroll
    for (int j = 0; j < 4; ++j) { const int n = (lane >> 3) + 8 * j; const LAS float* s = scr + (8 * c) * 33 + n;
        float v[8], s1 = 0.f, s2 = 0.f; unsigned short b[8];
#pragma unroll
        for (int e = 0; e < 8; ++e) { const float raw = s[e * 33]; v[e] = raw * wv[8 * c + e]; b[e] = (unsigned short)f2bf(v[e]); s1 += bf2f(b[e]); s2 += raw * bv[8 * c + e]; }
        v4u o; o.x = b[0] | ((unsigned)b[1] << 16); o.y = b[2] | ((unsigned)b[3] << 16); o.z = b[4] | ((unsigned)b[5] << 16); o.w = b[6] | ((unsigned)b[7] << 16);
        *(GAS v4u*)(WT + (size_t)(n0 + n) * DM + k0 + 8 * c) = o;
        s1 += __shfl_xor(s1, 1); s1 += __shfl_xor(s1, 2); s1 += __shfl_xor(s1, 4);
        s2 += __shfl_xor(s2, 1); s2 += __shfl_xor(s2, 2); s2 += __shfl_xor(s2, 4);
        if (c == 0) { c1p[n0 + n] = s1; c2p[n0 + n] = s2; } }
    LDS_WAIT(); asm volatile("" ::: "memory");
}

__device__ __forceinline__ void p1_phase(Frame& F) {
    {   float* ada = SMALLF(SM_ADA);
        for (int n = F.bid * 512 + F.tid; n < NADA; n += F.G * 512) ada[n] = ada_val(F, n); }
    TP_BEGIN(110);
    {
        LAS float* sc1 = (LAS float*)(F.lds);
        LAS float* sh1 = sc1 + 2048;
        LAS float* wgT = sh1 + 2048;
        for (int k = F.tid; k < DM; k += 512) { sc1[k] = 1.f + ada_val(F, DM + k); sh1[k] = ada_val(F, k); }
        for (int i = F.tid; i < DM * 2; i += 512) { const int k = i >> 1, hf = i & 1; const f32x4 v = *(const f32x4*)(F.w_in + (size_t)k * WIN_LD + NPROJ + hf * 4);
            wgT[(hf * 4 + 0) * DM + k] = v.x; wgT[(hf * 4 + 1) * DM + k] = v.y; wgT[(hf * 4 + 2) * DM + k] = v.z; wgT[(hf * 4 + 3) * DM + k] = v.w; }
        __syncthreads();
        bf16* U = (bf16*)(F.ws + WS_U); float* gates = SMALLF(SM_GATES);
        const int rstep = F.G * NWAVES;
#define XROW_LOAD(X, row_) do { const GAS f32x4* xr_ = (const GAS f32x4*)(F.x + (size_t)(row_) * DM) + F.lane; _Pragma("unroll") for (int j = 0; j < 8; ++j) X[j] = xr_[64 * j]; } while (0)
#define XROW_DO(X, row_) do { float g[8]; _Pragma("unroll") for (int e = 0; e < 8; ++e) g[e] = 0.f; \
            GAS unsigned long long* o8 = (GAS unsigned long long*)(U + (size_t)(row_) * DM) + F.lane; \
            _Pragma("unroll") for (int j = 0; j < 8; ++j) { asm volatile("" ::: "memory"); const int k = F.lane * 4 + 256 * j; \
                const f32x4 s = *(LAS f32x4*)(sc1 + k), h = *(LAS f32x4*)(sh1 + k); const f32x4 u = X[j] * s + h; \
                o8[64 * j] = (unsigned long long)pk2(u.x, u.y) | ((unsigned long long)pk2(u.z, u.w) << 32); \
                _Pragma("unroll") for (int e = 0; e < 8; ++e) { const f32x4 w = *(LAS f32x4*)(wgT + e * DM + k); g[e] += (u.x * w.x + u.y * w.y) + (u.z * w.z + u.w * w.w); } } \
            _Pragma("unroll") for (int e = 0; e < 8; ++e) { float t = g[e]; \
                t += __builtin_bit_cast(float, __builtin_amdgcn_update_dpp(0, __builtin_bit_cast(int, t), 0xB1, 0xF, 0xF, true)); \
                t += __builtin_bit_cast(float, __builtin_amdgcn_update_dpp(0, __builtin_bit_cast(int, t), 0x4E, 0xF, 0xF, true)); \
                t += __builtin_bit_cast(float, __builtin_amdgcn_update_dpp(0, __builtin_bit_cast(int, t), 0x141, 0xF, 0xF, true)); \
                t += __builtin_bit_cast(float, __builtin_amdgcn_update_dpp(0, __builtin_bit_cast(int, t), 0x140, 0xF, 0xF, true)); \
                t += __shfl_xor(t, 16); t += __shfl_xor(t, 32); g[e] = t; } \
            if (F.lane == 0) { *(f32x4*)(gates + (row_) * 8) = (f32x4){g[0], g[1], g[2], g[3]}; *(f32x4*)(gates + (row_) * 8 + 4) = (f32x4){g[4], g[5], g[6], g[7]}; } } while (0)
        f32x4 xa[8], xb[8];
        int row = F.bid * NWAVES + F.wave;
        if (row < M_TOK) XROW_LOAD(xa, row);
        while (row < M_TOK) {
            if (row + rstep < M_TOK) XROW_LOAD(xb, row + rstep);
            XROW_DO(xa, row);
            row += rstep; if (row >= M_TOK) break;
            if (row + rstep < M_TOK) XROW_LOAD(xa, row + rstep);
            XROW_DO(xb, row);
            row += rstep;
        }
#undef XROW_LOAD
#undef XROW_DO
        __syncthreads();
    }
    TP_END(110); TP_BEGIN(111);
    {
        LAS float* scr = (LAS float*)(F.lds + F.wave * 16384);
        const int gw = F.bid * NWAVES + F.wave, NGW = F.G * NWAVES;
        constexpr int I_GU = (DM / 64) * (NGU / 32);
        for (int it = gw; it < I_GU; it += NGW) p1_wgu_item(F, scr, it);
    }
    TP_END(111);
}

namespace pg8 {
struct EpiProj {
    static constexpr bool PERM = true, AFTER_DRAIN = false;
    bf16_t *mix, *kb, *vb, *mqk, *mv; const float* rope; float* kmean;
    __device__ __forceinline__ void operator()(const f32x4 (&acc)[2][2][4][2], const Unit& u, int wr, int wc, int fr, int fq) const {
        const int row0 = u.pm * BM + wr * 64 + fr; const int colt = u.pn * BM; const int t = colt >> 10, cl = colt & 1023;
        bf16_t* base; int ldc;
        if (t == 0) { base = mix + 1024; ldc = 2048; } else if (t == 1) { base = kb; ldc = 1024; } else if (t == 2) { base = vb; ldc = 1024; }
        else if (t == 3) { base = mqk; ldc = 1024; } else if (t == 4) { base = mv; ldc = 1024; } else { base = mix; ldc = 2048; }
        const int col0 = cl + wc * 32 + 8 * fq;
        const bool dorope = (t < 2) && (wc == 0);
        const float sgn = (fq < 2) ? -1.f : 1.f;
        f32x4 ks0[2] = {{0.f, 0.f, 0.f, 0.f}, {0.f, 0.f, 0.f, 0.f}}, ks1[2] = {{0.f, 0.f, 0.f, 0.f}, {0.f, 0.f, 0.f, 0.f}};
#pragma unroll
        for (int ai = 0; ai < 2; ++ai) {
            f32x4 rc0[4], rc1[4], rs0[4], rs1[4];
            if (dorope) {
#pragma unroll
                for (int m = 0; m < 4; ++m) { const float* rp = rope + (size_t)(row0 + ai * HALF + m * 16) * 32 + 8 * (fq & 1);
                    rc0[m] = *(const f32x4*)(rp); rc1[m] = *(const f32x4*)(rp + 4); rs0[m] = *(const f32x4*)(rp + 16); rs1[m] = *(const f32x4*)(rp + 20); }
            }
#pragma unroll
            for (int m = 0; m < 4; ++m) {
                const int row = row0 + ai * HALF + m * 16;
                bf16_t* rowp = base + (size_t)row * ldc + col0;
#pragma unroll
                for (int bj = 0; bj < 2; ++bj) {
                    f32x4 v0 = acc[ai][bj][m][0], v1 = acc[ai][bj][m][1];
                    if (dorope) {
                        f32x4 p0, p1;
#pragma unroll
                        for (int i = 0; i < 4; ++i) { p0[i] = __shfl_xor(v0[i], 32); p1[i] = __shfl_xor(v1[i], 32); }
                        v0 = v0 * rc0[m] + p0 * rs0[m] * sgn; v1 = v1 * rc1[m] + p1 * rs1[m] * sgn;
                    }
                    u32x4 w; w.x = cvt_pk_bf16(v0[0], v0[1]); w.y = cvt_pk_bf16(v0[2], v0[3]); w.z = cvt_pk_bf16(v1[0], v1[1]); w.w = cvt_pk_bf16(v1[2], v1[3]);
                    *(u32x4*)(rowp + bj * HALF) = w;
                    if (t == 1) { ks0[bj] += v0; ks1[bj] += v1; }
                }
            }
        }
        if (t == 1) {
#pragma unroll
            for (int bj = 0; bj < 2; ++bj) {
                float s8[8] = {ks0[bj][0], ks0[bj][1], ks0[bj][2], ks0[bj][3], ks1[bj][0], ks1[bj][1], ks1[bj][2], ks1[bj][3]};
#pragma unroll
                for (int e = 0; e < 8; ++e) {
                    float x = s8[e];
                    x += __builtin_bit_cast(float, __builtin_amdgcn_update_dpp(0, __builtin_bit_cast(int, x), 0xB1, 0xF, 0xF, true));
                    x += __builtin_bit_cast(float, __builtin_amdgcn_update_dpp(0, __builtin_bit_cast(int, x), 0x4E, 0xF, 0xF, true));
                    x += __builtin_bit_cast(float, __builtin_amdgcn_update_dpp(0, __builtin_bit_cast(int, x), 0x141, 0xF, 0xF, true));
                    x += __builtin_bit_cast(float, __builtin_amdgcn_update_dpp(0, __builtin_bit_cast(int, x), 0x140, 0xF, 0xF, true));
                    s8[e] = x;
                }
                if (fr == 0) { const int col = cl + bj * HALF + wc * 32 + 8 * fq; float* kp = kmean + ((size_t)(col >> 7) * 64 + u.pm) * 128 + (col & 127);
#pragma unroll
                    for (int e = 0; e < 8; ++e) atomicAdd(kp + e, s8[e] * (1.f / 256.f)); }
            }
        }
    }
};
struct EpiY1 {
    static constexpr bool PERM = false, AFTER_DRAIN = false;
    const float* x; const float* gate1; bf16_t* y1b; unsigned long long* stat;
    __device__ __forceinline__ void operator()(const f32x4 (&acc)[2][2][4][2], const Unit& u, int wr, int wc, int fr, int fq) const {
        const int row0 = u.pm * BM + wr * 64 + fr, col0 = u.pn * BM + wc * 32 + 4 * fq;
        float s[8], ss[8];
#pragma unroll
        for (int i = 0; i < 8; ++i) { s[i] = 0.f; ss[i] = 0.f; }
#pragma unroll
        for (int bj = 0; bj < 2; ++bj)
#pragma unroll
            for (int n = 0; n < 2; ++n) {
                const int c = col0 + bj * HALF + n * 16;
                const f32x4 g1 = *(const f32x4*)(gate1 + c) + 1.0f;
                f32x4 xv[8];
#pragma unroll
                for (int i = 0; i < 8; ++i) xv[i] = *(const f32x4*)(x + (size_t)(row0 + (i >> 2) * HALF + (i & 3) * 16) * 2048 + c);
                asm volatile("" ::: "memory");
#pragma unroll
                for (int i = 0; i < 8; ++i) {
                    const size_t off = (size_t)(row0 + (i >> 2) * HALF + (i & 3) * 16) * 2048 + c;
                    const f32x4 y = xv[i] * 1.189207115002721f + g1 * acc[i >> 2][bj][i & 3][n];
                    typedef unsigned u32x2v __attribute__((ext_vector_type(2)));
                    u32x2v w; w.x = cvt_pk_bf16(y[0], y[1]); w.y = cvt_pk_bf16(y[2], y[3]);
                    *(u32x2v*)(y1b + off) = w;
                    s[i] += (y[0] + y[1]) + (y[2] + y[3]); ss[i] += (y[0] * y[0] + y[1] * y[1]) + (y[2] * y[2] + y[3] * y[3]);
                }
                asm volatile("" ::: "memory");
            }
#pragma unroll
        for (int i = 0; i < 8; ++i) {
            float a = s[i], a2 = ss[i];
            a += __shfl_xor(a, 16); a += __shfl_xor(a, 32); a2 += __shfl_xor(a2, 16); a2 += __shfl_xor(a2, 32);
            if (fq == 0) { unsigned long long* sp = stat + (size_t)(row0 + (i >> 2) * HALF + (i & 3) * 16) * 2;
                atomicAdd(sp, (unsigned long long)(long long)(a * 16777216.f)); atomicAdd(sp + 1, (unsigned long long)(long long)(a2 * 16777216.f)); }
        }
    }
};
__device__ __forceinline__ f32x2 ln_stats_from_fixed(const unsigned long long* sp) {
    typedef unsigned long long u64x2 __attribute__((ext_vector_type(2)));
    const u64x2 v = *(const u64x2*)sp;
    const float s = (float)((double)(long long)v.x * (1.0 / (16777216.0 * 2048.0))), q = (float)((double)(long long)v.y * (1.0 / (16777216.0 * 2048.0)));
    const float var = fmaxf(q - s * s, 0.f);
    return (f32x2){s, rsqrtf(var + 1e-5f)};
}
struct EpiSwiGLU {
    static constexpr bool PERM = true, AFTER_DRAIN = false;
    const unsigned long long* stat; const float* c1; const float* c2; bf16_t* H;
    __device__ __forceinline__ void operator()(const f32x4 (&acc)[2][2][4][2], const Unit& u, int wr, int wc, int fr, int fq) const {
        const int row0 = u.pm * BM + wr * 64 + fr; const int cl = wc * 32 + 8 * fq; const int cg = u.pn * BM + cl;
        f32x4 c1g[2], c2g[2], c1u[2], c2u[2];
#pragma unroll
        for (int n = 0; n < 2; ++n) { c1g[n] = *(const f32x4*)(c1 + cg + 4 * n); c2g[n] = *(const f32x4*)(c2 + cg + 4 * n); c1u[n] = *(const f32x4*)(c1 + cg + HALF + 4 * n); c2u[n] = *(const f32x4*)(c2 + cg + HALF + 4 * n); }
        typedef float f32x2v __attribute__((ext_vector_type(2)));
        f32x2v mrs[8];
#pragma unroll
        for (int i = 0; i < 8; ++i) { const f32x2 t_ = ln_stats_from_fixed(stat + (size_t)(row0 + (i >> 2) * HALF + (i & 3) * 16) * 2); mrs[i] = (f32x2v){t_.x, t_.y}; }
#pragma unroll
        for (int ai = 0; ai < 2; ++ai)
#pragma unroll
            for (int m = 0; m < 4; ++m) {
                const int row = row0 + ai * HALF + m * 16;
                const f32x2v mr = mrs[ai * 4 + m];
                f32x4 hv[2];
#pragma unroll
                for (int n = 0; n < 2; ++n) {
                    const f32x4 g = (acc[ai][0][m][n] - c1g[n] * mr.x) * mr.y + c2g[n];
                    const f32x4 up = (acc[ai][1][m][n] - c1u[n] * mr.x) * mr.y + c2u[n];
#pragma unroll
                    for (int i = 0; i < 4; ++i) { const float e = __builtin_amdgcn_exp2f(g[i] * -1.4426950408889634f); hv[n][i] = g[i] * __builtin_amdgcn_rcpf(1.f + e) * up[i]; }
                }
                u32x4 w; w.x = cvt_pk_bf16(hv[0][0], hv[0][1]); w.y = cvt_pk_bf16(hv[0][2], hv[0][3]); w.z = cvt_pk_bf16(hv[1][0], hv[1][1]); w.w = cvt_pk_bf16(hv[1][2], hv[1][3]);
                *(u32x4*)(H + (size_t)row * 5632 + u.pn * HALF + cl) = w;
            }
    }
};
struct EpiY2 {
    static constexpr bool PERM = false, AFTER_DRAIN = false;
    const bf16_t* y1b; const unsigned long long* stat; const float* gate2; const float* lw; const float* lb; float* out;
    __device__ __forceinline__ void operator()(const f32x4 (&acc)[2][2][4][2], const Unit& u, int wr, int wc, int fr, int fq) const {
        const int row0 = u.pm * BM + wr * 64 + fr, col0 = u.pn * BM + wc * 32 + 4 * fq;
        typedef float f32x2v __attribute__((ext_vector_type(2)));
        f32x2v mrs[8];
#pragma unroll
        for (int i = 0; i < 8; ++i) { const f32x2 t_ = ln_stats_from_fixed(stat + (size_t)(row0 + (i >> 2) * HALF + (i & 3) * 16) * 2); mrs[i] = (f32x2v){t_.x, t_.y}; }
#pragma unroll
        for (int bj = 0; bj < 2; ++bj)
#pragma unroll
            for (int n = 0; n < 2; ++n) {
                const int c = col0 + bj * HALF + n * 16;
                const f32x4 g2 = *(const f32x4*)(gate2 + c) + 1.0f, w = *(const f32x4*)(lw + c), b = *(const f32x4*)(lb + c);
                f32x4 yv[8];
                {   typedef unsigned u32x2v __attribute__((ext_vector_type(2))); u32x2v yr[8];
#pragma unroll
                    for (int i = 0; i < 8; ++i) yr[i] = *(const u32x2v*)(y1b + (size_t)(row0 + (i >> 2) * HALF + (i & 3) * 16) * 2048 + c);
                    asm volatile("" ::: "memory");
#pragma unroll
                    for (int i = 0; i < 8; ++i) yv[i] = (f32x4){__builtin_bit_cast(float, yr[i].x << 16), __builtin_bit_cast(float, yr[i].x & 0xffff0000u), __builtin_bit_cast(float, yr[i].y << 16), __builtin_bit_cast(float, yr[i].y & 0xffff0000u)}; }
#pragma unroll
                for (int i = 0; i < 8; ++i) {
                    const size_t off = (size_t)(row0 + (i >> 2) * HALF + (i & 3) * 16) * 2048 + c;
                    const f32x4 x1 = (yv[i] - mrs[i].x) * mrs[i].y * w + b;
                    *(f32x4*)(out + off) = x1 * 1.189207115002721f + g2 * acc[i >> 2][bj][i & 3][n];
                }
                asm volatile("" ::: "memory");
            }
    }
};
}

__device__ __forceinline__ float wave_incl_scan_add(float v, int lane) {
#pragma unroll
    for (int o = 1; o < 64; o <<= 1) { const float t = __shfl_up(v, o); if (lane >= o) v += t; }
    return v;
}
__device__ __forceinline__ float wave_incl_scan_max(float v, int lane) {
#pragma unroll
    for (int o = 1; o < 64; o <<= 1) { const float t = __shfl_up(v, o); if (lane >= o) v = fmaxf(v, t); }
    return v;
}
__device__ __forceinline__ void p3_chunk_item(Frame& F, int c) {
    const int t0 = c * ML_L, tid = F.tid, lane = F.lane;
    LAS float* wgt = (LAS float*)F.lds;
    LAS unsigned short* KT = (LAS unsigned short*)(F.lds + 1024);
    LAS unsigned short* VTh = (LAS unsigned short*)(F.lds + 1024 + 512 * 72 * 2);
    const float* gates = SMALLF(SM_GATES);
    if (F.wave < 4) {
        const int h = F.wave, t = t0 + lane;
        const float ig = gates[t * 8 + h] + F.igb[h], fg = gates[t * 8 + 4 + h] + F.fgb[h];
        const float lf = logsigmoid_f(fg);
        const float b = wave_incl_scan_add(lf, lane), u = ig - b, m1 = wave_incl_scan_max(u, lane);
        const float m1l = __shfl(m1, 63), bl = __shfl(b, 63);
        *(f32x4*)(SMALLF(SM_TOKSC) + (size_t)(t * 4 + h) * 4) = (f32x4){b, u, m1, 0.f};
        if (lane == 63) { SMALLF(SM_CHSUM)[(c * 4 + h) * 2] = bl; SMALLF(SM_CHSUM)[(c * 4 + h) * 2 + 1] = m1l; }
        wgt[h * 64 + lane] = expf(u - m1l);
    }
    {
        const int cgp = tid & 127, rq = tid >> 7, ch0 = cgp * 8, r0 = 16 * rq;
        const v4u* MQK = (const v4u*)(F.ws + WS_MQK);
        float w[4][8], bs[8];
#pragma unroll
        for (int j = 0; j < 4; ++j) { const f32x4 a = *(const f32x4*)(F.conv_w + j * 1024 + ch0), b = *(const f32x4*)(F.conv_w + j * 1024 + ch0 + 4);
            w[j][0] = a.x; w[j][1] = a.y; w[j][2] = a.z; w[j][3] = a.w; w[j][4] = b.x; w[j][5] = b.y; w[j][6] = b.z; w[j][7] = b.w; }
        { const f32x4 a = *(const f32x4*)(F.conv_b + ch0), b = *(const f32x4*)(F.conv_b + ch0 + 4); bs[0] = a.x; bs[1] = a.y; bs[2] = a.z; bs[3] = a.w; bs[4] = b.x; bs[5] = b.y; bs[6] = b.z; bs[7] = b.w; }
        __syncthreads();
        const bool isq = ch0 < 512; const int hh = (ch0 - 512) >> 7;
        v4u* QC = (v4u*)(F.ws + WS_QC); v4u* KC = (v4u*)(F.ws + WS_KC);
#pragma unroll 1
        for (int hf = 0; hf < 2; ++hf) {
        v4u xin[11];
#pragma unroll
        for (int i = 0; i < 11; ++i) { const int t = t0 + r0 + 8 * hf - 3 + i; xin[i] = (t >= 0) ? MQK[(size_t)t * 128 + cgp] : (v4u){0u, 0u, 0u, 0u}; }
#pragma unroll
        for (int r = 0; r < 8; ++r) {
            float y[8];
#pragma unroll
            for (int e = 0; e < 8; ++e) y[e] = bs[e];
#pragma unroll
            for (int j = 0; j < 4; ++j) { const v4u x = xin[r + j];
                y[0] += w[j][0] * bflo(x.x); y[1] += w[j][1] * bfhi(x.x); y[2] += w[j][2] * bflo(x.y); y[3] += w[j][3] * bfhi(x.y);
                y[4] += w[j][4] * bflo(x.z); y[5] += w[j][5] * bfhi(x.z); y[6] += w[j][6] * bflo(x.w); y[7] += w[j][7] * bfhi(x.w); }
#pragma unroll
            for (int e = 0; e < 8; ++e) y[e] = silu_f(y[e]);
            const int s = r0 + 8 * hf + r;
            if (isq) { v4u o; o.x = pk2(y[0], y[1]); o.y = pk2(y[2], y[3]); o.z = pk2(y[4], y[5]); o.w = pk2(y[6], y[7]); QC[(size_t)(t0 + s) * 64 + cgp] = o; }
            else {
#pragma unroll
                for (int e = 0; e < 8; ++e) y[e] *= K_SCALE;
                v4u o; o.x = pk2(y[0], y[1]); o.y = pk2(y[2], y[3]); o.z = pk2(y[4], y[5]); o.w = pk2(y[6], y[7]); KC[(size_t)(t0 + s) * 64 + (cgp - 64)] = o;
                const float wg_ = wgt[hh * 64 + s];
#pragma unroll
                for (int e = 0; e < 8; ++e) KT[(ch0 - 512 + e) * 72 + s] = (unsigned short)f2bf(y[e] * wg_);
            }
        }
        }
    }
    __syncthreads();
    {
        float sm = 0.f;
#pragma unroll
        for (int i = 0; i < 8; ++i) { const v4u v = *(LAS v4u*)(KT + tid * 72 + i * 8); sm += bflo(v.x) + bfhi(v.x) + bflo(v.y) + bfhi(v.y) + bflo(v.z) + bfhi(v.z) + bflo(v.w) + bfhi(v.w); }
        SMALLF(SM_NLOC)[(size_t)c * 512 + tid] = sm;
    }
    const v4u* MV = (const v4u*)(F.ws + WS_MV);
    const int r = lane & 31, hh2 = lane >> 5, w = F.wave;
    const int vg = tid & 31, sq = tid >> 5;
    v4u vin[4];
#pragma unroll
    for (int i = 0; i < 4; ++i) vin[i] = MV[(size_t)(t0 + 4 * sq + i) * 128 + vg];
#pragma unroll 1
    for (int h = 0; h < 4; ++h) {
#pragma unroll
        for (int i = 0; i < 4; ++i) { const int s = 4 * sq + i; LAS unsigned short* p = VTh + (8 * vg) * 72 + s;
            p[0] = (unsigned short)vin[i].x; p[72] = (unsigned short)(vin[i].x >> 16); p[144] = (unsigned short)vin[i].y; p[216] = (unsigned short)(vin[i].y >> 16);
            p[288] = (unsigned short)vin[i].z; p[360] = (unsigned short)(vin[i].z >> 16); p[432] = (unsigned short)vin[i].w; p[504] = (unsigned short)(vin[i].w >> 16); }
        __syncthreads();
        if (h < 3) {
#pragma unroll
            for (int i = 0; i < 4; ++i) vin[i] = MV[(size_t)(t0 + 4 * sq + i) * 128 + (h + 1) * 32 + vg];
        }
        {
            unsigned long long* VT8 = (unsigned long long*)(F.ws + WS_VT) + (size_t)(c * 4 + h) * 4096;
#pragma unroll
            for (int p = 0; p < 8; ++p) { const int idx = p * 512 + tid, sb = idx >> 8, v = idx & 255;
                VT8[idx] = *(LAS unsigned long long*)(VTh + v * 72 + sb * 4); } }
        {
            pg8::bf16x8 bfr[4];
#pragma unroll
            for (int ks = 0; ks < 4; ++ks) bfr[ks] = *(LAS pg8::bf16x8*)(VTh + (32 * w + r) * 72 + 16 * ks + 8 * hh2);
            unsigned short* LOC = (unsigned short*)(F.ws + WS_LOCAL) + (size_t)(c * 4 + h) * 256 * 128 + (size_t)(32 * w + r) * 8 + 4 * hh2;
#pragma unroll
            for (int dt = 0; dt < 4; ++dt) {
                __attribute__((ext_vector_type(16))) float acc = {};
#pragma unroll
                for (int ks = 0; ks < 4; ++ks) { const pg8::bf16x8 af = *(LAS pg8::bf16x8*)(KT + (h * 128 + 32 * dt + r) * 72 + 16 * ks + 8 * hh2);
                    acc = __builtin_amdgcn_mfma_f32_32x32x16_bf16(af, bfr[ks], acc, 0, 0, 0); }
#pragma unroll
                for (int g = 0; g < 4; ++g) { u32x2 o; o.x = pk2(acc[4 * g], acc[4 * g + 1]); o.y = pk2(acc[4 * g + 2], acc[4 * g + 3]);
                    *(u32x2*)(LOC + (size_t)(4 * dt + g) * 2048) = o; }
            }
        }
        __syncthreads();
    }
}
__device__ __forceinline__ void p3_kmean_item(Frame& F, int j) {
    const v4u* KB = (const v4u*)(F.ws + WS_KB);
    const int cg = F.tid & 127, rg = F.tid >> 7;
    float s[8];
#pragma unroll
    for (int e = 0; e < 8; ++e) s[e] = 0.f;
#pragma unroll 16
    for (int r = 0; r < 64; ++r) { const v4u v = KB[(size_t)(j * MB_BLK + rg * 64 + r) * 128 + cg];
        s[0] += bflo(v.x); s[1] += bfhi(v.x); s[2] += bflo(v.y); s[3] += bfhi(v.y); s[4] += bflo(v.z); s[5] += bfhi(v.z); s[6] += bflo(v.w); s[7] += bfhi(v.w); }
    LAS float* red = (LAS float*)F.lds;
#pragma unroll
    for (int e = 0; e < 8; ++e) red[rg * 1024 + cg * 8 + e] = s[e];
    __syncthreads();
#pragma unroll
    for (int e = 0; e < 2; ++e) { const int col = F.tid * 2 + e; const float t = (red[col] + red[1024 + col]) + (red[2048 + col] + red[3072 + col]);
        SMALLF(SM_KMEAN)[(size_t)((col >> 7) * 64 + j) * 128 + (col & 127)] = t * (1.f / 256.f); }
    __syncthreads();
}
__device__ __forceinline__ void p3_c12_item(Frame& F, int it) {
    const int n = it * 512 + F.tid; if (n >= NGU) return;
    const float* p = (const float*)(F.ws + WS_C12P);
    float a = 0.f, b = 0.f;
    for (int k = 0; k < 32; ++k) { a += p[(size_t)k * NGU + n]; b += p[(size_t)(32 + k) * NGU + n]; }
    SMALLF(SM_C1)[n] = a; SMALLF(SM_C2)[n] = b;
}
__device__ __forceinline__ void moba_select_item(Frame& F, int b, int h);
__device__ __forceinline__ void p3_phase(Frame& F) {
    constexpr int N_CH = ML_NC, N_SEL = MB_NB * MB_H, N_C12 = NGU / 512;
    for (int it = F.bid; it < N_CH + N_SEL + N_C12; it += F.G) {
        if (it < N_CH) { TP_BEGIN(160); p3_chunk_item(F, it); TP_END(160); }
        else if (it < N_CH + N_SEL) {
#if !defined(NAIVE_MOBA)
            const int i = it - N_CH, b = 63 - (i >> 3), h = i & 7; if (b > 0) moba_select_item(F, b, h);
#endif
        }
        else p3_c12_item(F, it - N_CH - N_SEL);
    }
}

__device__ __forceinline__ void stat_phase(Frame& F) {
    const float* sp = (const float*)(F.ws + WS_STATP); float* mur = SMALLF(SM_MUR);
    for (int row = F.bid * 512 + F.tid; row < M_TOK; row += F.G * 512) {
        float s = 0.f, ss = 0.f;
#pragma unroll
        for (int i = 0; i < 16; ++i) { const f32x4 v = *(const f32x4*)(sp + (size_t)row * 64 + i * 4); s += v.x + v.z; ss += v.y + v.w; }
        const float mean = s * (1.f / DM); const float var = fmaxf(ss * (1.f / DM) - mean * mean, 0.f);
        mur[row * 2] = mean; mur[row * 2 + 1] = rsqrtf(var + LN_EPS);
    }
}
__device__ __forceinline__ void ln2_rows(Frame& F, int row0, int nrows) {
#define LN2_LOAD(V, row_) do { const GAS f32x4* xr_ = (const GAS f32x4*)(F.out + (size_t)(row_) * DM) + F.lane; _Pragma("unroll") for (int j = 0; j < 8; ++j) V[j] = xr_[64 * j]; } while (0)
#define LN2_DO(V, row_) do { GAS f32x4* xw_ = (GAS f32x4*)(F.out + (size_t)(row_) * DM) + F.lane; float s = 0.f; \
        _Pragma("unroll") for (int j = 0; j < 8; ++j) s += (V[j].x + V[j].y) + (V[j].z + V[j].w); \
        const float mean = wave_sum(s) * (1.f / DM); float s2 = 0.f; \
        _Pragma("unroll") for (int j = 0; j < 8; ++j) { V[j] = V[j] - mean; s2 += (V[j].x * V[j].x + V[j].y * V[j].y) + (V[j].z * V[j].z + V[j].w * V[j].w); } \
        const float rstd = rsqrtf(wave_sum(s2) * (1.f / DM) + LN_EPS); \
        _Pragma("unroll") for (int j = 0; j < 8; ++j) { const int k = F.lane * 4 + 256 * j; const f32x4 w = *(const f32x4*)(F.ln2_w + k), b = *(const f32x4*)(F.ln2_b + k); xw_[64 * j] = V[j] * rstd * w + b; } } while (0)
    f32x4 va[8], vb[8];
    int rr = F.wave;
    if (rr < nrows) LN2_LOAD(va, row0 + rr);
    while (rr < nrows) {
        if (rr + NWAVES < nrows) LN2_LOAD(vb, row0 + rr + NWAVES);
        LN2_DO(va, row0 + rr);
        rr += NWAVES; if (rr >= nrows) break;
        if (rr + NWAVES < nrows) LN2_LOAD(va, row0 + rr + NWAVES);
        LN2_DO(vb, row0 + rr);
        rr += NWAVES;
    }
#undef LN2_LOAD
#undef LN2_DO
}
__device__ __forceinline__ bool ln2_panel_fused(Frame& F) {
    pg8::StaticOrder S; S.init(M_TOK, DM, F.G, F.bid, WGM_P7); pg8::Unit u0, u1, u2;
    if (F.G != 256 || !S.next(0, u0) || !S.next(1, u1) || S.next(2, u2)) return false;
    gu32* c0 = F.ctl + CW_PANEL + 64 * u0.pm; gu32* c1 = F.ctl + CW_PANEL + 64 * u1.pm;
    asm volatile("s_waitcnt vmcnt(0)" ::: "memory");
    __syncthreads();
    if (F.tid == 0) {
        __builtin_amdgcn_fence(__ATOMIC_RELEASE, "agent"); asm volatile("s_waitcnt vmcnt(0)" ::: "memory");
        __hip_atomic_fetch_add(c0, 1u, __ATOMIC_RELAXED, __HIP_MEMORY_SCOPE_AGENT);
        __hip_atomic_fetch_add(c1, 1u, __ATOMIC_RELAXED, __HIP_MEMORY_SCOPE_AGENT);
        unsigned sp = 0;
        while (__hip_atomic_load(c0, __ATOMIC_RELAXED, __HIP_MEMORY_SCOPE_AGENT) < 8u || __hip_atomic_load(c1, __ATOMIC_RELAXED, __HIP_MEMORY_SCOPE_AGENT) < 8u) { __builtin_amdgcn_s_sleep(2); if (++sp > (1u << 22)) break; }
        __builtin_amdgcn_fence(__ATOMIC_ACQUIRE, "agent"); asm volatile("s_waitcnt vmcnt(0)" ::: "memory");
    }
    __syncthreads();
    ln2_rows(F, u0.pm * 256 + 32 * u0.pn, 32);
    ln2_rows(F, u1.pm * 256 + 32 * u1.pn, 32);
    return true;
}
__device__ __forceinline__ void ln2_phase(Frame& F) {
    for (int row = F.bid * NWAVES + F.wave; row < M_TOK; row += F.G * NWAVES) {
        GAS f32x4* xr = (GAS f32x4*)(F.out + (size_t)row * DM) + F.lane;
        f32x4 v[8]; float s = 0.f;
#pragma unroll
        for (int j = 0; j < 8; ++j) { v[j] = xr[64 * j]; s += (v[j].x + v[j].y) + (v[j].z + v[j].w); }
        const float mean = wave_sum(s) * (1.f / DM); float s2 = 0.f;
#pragma unroll
        for (int j = 0; j < 8; ++j) { v[j] = v[j] - mean; s2 += (v[j].x * v[j].x + v[j].y * v[j].y) + (v[j].z * v[j].z + v[j].w * v[j].w); }
        const float rstd = rsqrtf(wave_sum(s2) * (1.f / DM) + LN_EPS);
#pragma unroll
        for (int j = 0; j < 8; ++j) { const int k = F.lane * 4 + 256 * j; const f32x4 w = *(const f32x4*)(F.ln2_w + k), b = *(const f32x4*)(F.ln2_b + k); xr[64 * j] = v[j] * rstd * w + b; }
    }
}
typedef short s16x4 __attribute__((ext_vector_type(4)));
typedef float f32x16 __attribute__((ext_vector_type(16)));
typedef unsigned u32x4v __attribute__((ext_vector_type(4)));
#define MFMA32(a, b, c) __builtin_amdgcn_mfma_f32_32x32x16_bf16((a), (b), (c), 0, 0, 0)
#define SBAR() __builtin_amdgcn_sched_barrier(0)
__device__ __forceinline__ int crow(int r, int hi) { return (r & 3) + 8 * (r >> 2) + 4 * hi; }
typedef float cv_f32x2_t __attribute__((ext_vector_type(2))); typedef __bf16 cv_bf16x2_t __attribute__((ext_vector_type(2)));
__device__ __forceinline__ unsigned cvtpk(float lo, float hi) { cv_f32x2_t v = {lo, hi}; cv_bf16x2_t b = __builtin_convertvector(v, cv_bf16x2_t); return __builtin_bit_cast(unsigned, b); }

constexpr int LIST_HSTRIDE = 256 * 2016;
__device__ __forceinline__ int list_off(int h, int j) { return h * LIST_HSTRIDE + 256 * (63 * j - (j * (j - 1)) / 2); }
__device__ __forceinline__ unsigned short* part_ptr(unsigned char* ws, int slot) {
    return (unsigned short*)(ws + (slot == 0 ? WS_PART0 : slot == 1 ? WS_PART1 : slot == 2 ? WS_PART2 : WS_PART3));
}

#define TOP3_INS(S_, J_) do { const float s__ = (S_); const int j__ = (J_); \
    if (s__ > v0 || (s__ == v0 && j__ < i0)) { v2 = v1; i2 = i1; v1 = v0; i1 = i0; v0 = s__; i0 = j__; } \
    else if (s__ > v1 || (s__ == v1 && j__ < i1)) { v2 = v1; i2 = i1; v1 = s__; i1 = j__; } \
    else if (s__ > v2 || (s__ == v2 && j__ < i2)) { v2 = s__; i2 = j__; } } while (0)
__device__ __forceinline__ void moba_select_item(Frame& F, int b, int h) {
    const int tid = F.tid, lane = F.lane, r32 = lane & 31, hi = lane >> 5, w = F.wave;
    constexpr int KS = 136;
    LAS unsigned short* kmh = (LAS unsigned short*)F.lds;
    LAS unsigned short* kml = kmh + 64 * KS;
    LAS int* hist = (LAS int*)(F.lds + 2 * 64 * KS * 2);
    LAS int* base = hist + 64;
    {   const float* src = SMALLF(SM_KMEAN) + (size_t)h * 64 * 128;
        for (int i = tid; i < 64 * 32; i += 512) { const int j = i >> 5, c4 = (i & 31) * 4; f32x4 f = {0.f, 0.f, 0.f, 0.f}; if (j < b) f = *(const f32x4*)(src + j * 128 + c4);
            const unsigned h0 = f2bf(f.x), h1 = f2bf(f.y), h2 = f2bf(f.z), h3 = f2bf(f.w);
            const float l0 = f.x - bf2f((unsigned short)h0), l1 = f.y - bf2f((unsigned short)h1), l2 = f.z - bf2f((unsigned short)h2), l3 = f.w - bf2f((unsigned short)h3);
            *(LAS u32x2*)(kmh + j * KS + c4) = (u32x2){h0 | (h1 << 16), h2 | (h3 << 16)};
            *(LAS u32x2*)(kml + j * KS + c4) = (u32x2){pk2(l0, l1), pk2(l2, l3)}; }
        if (tid < 64) hist[tid] = 0; }
    __syncthreads();
    const int p = b * 256 + 32 * w + r32;
    bf16x8 qf[8];
    {   const unsigned short* qp = (const unsigned short*)(F.ws + WS_MIX) + (size_t)p * 2048 + 1024 + h * 128 + 8 * hi;
#pragma unroll
        for (int kd = 0; kd < 8; ++kd) qf[kd] = *(const bf16x8*)(qp + 16 * kd); }
    float v0 = -INFINITY, v1 = -INFINITY, v2 = -INFINITY; int i0 = 64, i1 = 64, i2 = 64;
    const int ntile = (b + 31) >> 5;
#pragma unroll 1
    for (int tile = 0; tile < ntile; ++tile) {
        f32x16 acc = {};
#pragma unroll
        for (int kd = 0; kd < 8; ++kd) {
            const bf16x8 ah = *(const LAS bf16x8*)(kmh + (32 * tile + r32) * KS + 16 * kd + 8 * hi), al = *(const LAS bf16x8*)(kml + (32 * tile + r32) * KS + 16 * kd + 8 * hi);
            acc = MFMA32(ah, qf[kd], acc); acc = MFMA32(al, qf[kd], acc);
        }
#pragma unroll
        for (int r = 0; r < 16; ++r) { const int j = 32 * tile + crow(r, hi); const float s = (j < b) ? acc[r] : -INFINITY; TOP3_INS(s, j); }
    }
    {
        const float u0 = __shfl_xor(v0, 32), u1 = __shfl_xor(v1, 32), u2 = __shfl_xor(v2, 32); const int k0 = __shfl_xor(i0, 32), k1 = __shfl_xor(i1, 32), k2 = __shfl_xor(i2, 32);
        TOP3_INS(u0, k0); TOP3_INS(u1, k1); TOP3_INS(u2, k2); }
    const int nsel = b < 3 ? b : 3; int sel[3] = {i0, i1, i2}, rank[3] = {0, 0, 0};
    if (hi == 0) {
#pragma unroll
        for (int k = 0; k < 3; ++k) if (k < nsel) rank[k] = atomicAdd((int*)&hist[sel[k]], 1);
    }
    __syncthreads();
    if (tid < 64) { const int n = hist[tid]; base[tid] = n ? (int)atomicAdd((unsigned*)(F.ctl + CW_CNT + h * 64 + tid), (unsigned)n) : 0; }
    __syncthreads();
    if (hi == 0) { unsigned* lists = (unsigned*)(F.ws + WS_LISTS);
#pragma unroll
        for (int k = 0; k < 3; ++k) if (k < nsel) lists[list_off(h, sel[k]) + base[sel[k]] + rank[k]] = ((unsigned)p << 2) | (unsigned)k; }
    __syncthreads();
}
#undef TOP3_INS

namespace moba {
constexpr int D = 128, NW = 8, QBLK = 32, KVBLK = 64, LDK = 1024;
constexpr float SCALE = 0.088388347648318440f, THR = 8.f;
constexpr size_t SHM_V = KVBLK * D * 2, SHM_K = KVBLK * D * 2, SHM_ATTN = 2 * SHM_V + 2 * SHM_K + NW * 128 * 4;
#define KSWZ(row, colB) ((row) * 256 + ((colB) ^ (((row) & 7) << 4)))
__device__ __forceinline__ void partialSM(f32x16& p0, f32x16& p1, float& m_reg, float& mn, float& alpha) {
  constexpr float C = SCALE * 1.4426950408889634f;
  float pmax = p0[0]; for (int r = 1; r < 16; ++r) pmax = fmaxf(pmax, p0[r]); for (int r = 0; r < 16; ++r) pmax = fmaxf(pmax, p1[r]);
  { auto rr = __builtin_amdgcn_permlane32_swap(__float_as_uint(pmax), __float_as_uint(pmax), false, false);
    pmax = fmaxf(__uint_as_float(rr[0]), __uint_as_float(rr[1])); }
  if (__builtin_expect(__all(pmax - m_reg <= THR / SCALE), 1)) { mn = m_reg; alpha = 1.f; }
  else { mn = fmaxf(m_reg, pmax); alpha = __builtin_amdgcn_exp2f((m_reg - mn) * C); m_reg = mn; }
  float mnC = -mn * C;
  for (int r = 0; r < 16; ++r) p0[r] = fmaf(p0[r], C, mnC); for (int r = 0; r < 16; ++r) p1[r] = fmaf(p1[r], C, mnC);
  for (int r = 0; r < 16; ++r) p0[r] = __builtin_amdgcn_exp2f(p0[r]);
}
__device__ __forceinline__ void finishSM(f32x16& p0, f32x16& p1, float alpha, float& l_reg, bf16x8& pa0, bf16x8& pa1, bf16x8& pa2, bf16x8& pa3) {
  for (int r = 0; r < 16; ++r) p1[r] = __builtin_amdgcn_exp2f(p1[r]);
  float ps = 0; for (int r = 0; r < 16; ++r) ps += p0[r]; for (int r = 0; r < 16; ++r) ps += p1[r];
  { auto rr = __builtin_amdgcn_permlane32_swap(__float_as_uint(ps), __float_as_uint(ps), false, false);
    ps = __uint_as_float(rr[0]) + __uint_as_float(rr[1]); }
  l_reg = l_reg * alpha + ps;
#define PK4(P, BASE, OUT) do { unsigned a0 = cvtpk(P[BASE + 0], P[BASE + 1]), a1 = cvtpk(P[BASE + 2], P[BASE + 3]);   \
    unsigned b0 = cvtpk(P[BASE + 4], P[BASE + 5]), b1 = cvtpk(P[BASE + 6], P[BASE + 7]);                              \
    auto r0 = __builtin_amdgcn_permlane32_swap(a0, b0, false, false); auto r1 = __builtin_amdgcn_permlane32_swap(a1, b1, false, false); \
    u32x4v w = {r0[0], r1[0], r0[1], r1[1]}; OUT = *reinterpret_cast<bf16x8*>(&w); } while (0)
  PK4(p0, 0, pa0); PK4(p0, 8, pa1); PK4(p1, 0, pa2); PK4(p1, 8, pa3);
#undef PK4
}
__device__ __forceinline__ void qkt(f32x16& p0, f32x16& p1, const char* Ks, const bf16x8* qr, int r32, int hi) {
  const f32x16 z = {};
  bf16x8 a0 = *reinterpret_cast<const bf16x8*>(Ks + KSWZ(r32, (hi * 8) * 2)), a1 = *reinterpret_cast<const bf16x8*>(Ks + KSWZ(32 + r32, (hi * 8) * 2));
#pragma unroll
  for (int d0 = 0; d0 < 8; ++d0) {
    bf16x8 n0 = a0, n1 = a1;
    if (d0 < 7) { const int cb = ((d0 + 1) * 16 + hi * 8) * 2; n0 = *reinterpret_cast<const bf16x8*>(Ks + KSWZ(r32, cb)); n1 = *reinterpret_cast<const bf16x8*>(Ks + KSWZ(32 + r32, cb)); }
    p0 = MFMA32(a0, qr[d0], d0 == 0 ? z : p0);
    p1 = MFMA32(a1, qr[d0], d0 == 0 ? z : p1);
    a0 = n0; a1 = n1;
  }
}
__device__ __forceinline__ int v_st(int k, int c) { const int kk = (k & ~0xC) | ((k & 4) << 1) | ((k & 8) >> 1); return ((kk >> 3) * 4 + (c >> 5)) * 512 + ((kk & 7) * 32 + (c & 31)) * 2; }
__device__ __forceinline__ int v_rd_base(int lane) { return ((lane & 3) << 3) | (((lane >> 2) & 3) << 6) | (((lane >> 4) & 1) << 5) | (((lane >> 5) & 1) << 8); }
constexpr int v_rd_off(int d0, int ks, int half) { return d0 * 512 + ks * 4096 + half * 2048; }
template <int OFF> __device__ __forceinline__ s16x4 tr_read(int vb) {
  s16x4 r; asm volatile("ds_read_b64_tr_b16 %0, %1 offset:%2" : "=&v"(r) : "v"(vb), "i"(OFF) : "memory"); return r;
}
template <int D0> __device__ __forceinline__ void pv_one(f32x16& od, int vb, bf16x8 pa0, bf16x8 pa1, bf16x8 pa2, bf16x8 pa3) {
  const s16x4 l0 = tr_read<v_rd_off(D0, 0, 0)>(vb), h0 = tr_read<v_rd_off(D0, 0, 1)>(vb), l1 = tr_read<v_rd_off(D0, 1, 0)>(vb), h1 = tr_read<v_rd_off(D0, 1, 1)>(vb);
  const s16x4 l2 = tr_read<v_rd_off(D0, 2, 0)>(vb), h2 = tr_read<v_rd_off(D0, 2, 1)>(vb), l3 = tr_read<v_rd_off(D0, 3, 0)>(vb), h3 = tr_read<v_rd_off(D0, 3, 1)>(vb);
  asm volatile("s_waitcnt lgkmcnt(0)" ::: "memory"); SBAR();
#define PK(L, H) (bf16x8){L[0], L[1], L[2], L[3], H[0], H[1], H[2], H[3]}
  od = MFMA32(pa0, PK(l0, h0), od);
  od = MFMA32(pa1, PK(l1, h1), od);
  od = MFMA32(pa2, PK(l2, h2), od);
  od = MFMA32(pa3, PK(l3, h3), od);
#undef PK
}
__device__ __forceinline__ void pv_d0(f32x16* o, int vb, bf16x8 pa0, bf16x8 pa1, bf16x8 pa2, bf16x8 pa3) {
  pv_one<0>(o[0], vb, pa0, pa1, pa2, pa3); pv_one<1>(o[1], vb, pa0, pa1, pa2, pa3); pv_one<2>(o[2], vb, pa0, pa1, pa2, pa3); pv_one<3>(o[3], vb, pa0, pa1, pa2, pa3);
}
__device__ __forceinline__ void cmask(f32x16& p0, f32x16& p1, int tile, int qloc, int hi) {
#pragma unroll
  for (int r = 0; r < 16; ++r) { const int key = 64 * tile + crow(r, hi); if (key > qloc) p0[r] = -1e30f; if (key + 32 > qloc) p1[r] = -1e30f; }
}
#ifndef MOBA_STAGGER
#define MOBA_STAGGER 24
#endif
constexpr int MAXWC = 24;
constexpr int TILE_B = 16384;
__device__ __forceinline__ void wave_chunk(const bf16x8 (&qr)[8], int nt, bool causal, int qloc, const char* K_lds, int vb0, float* ws, unsigned rowoff, unsigned lseoff, unsigned char* wsb, int r32, int hi) {
  float* li_l = ws; float* al_l = ws + 32; unsigned* id_l = (unsigned*)(ws + 64);
  float m_reg = -1e30f, l_reg = 0; f32x16 o[4] = {};
#pragma unroll 1
  for (int t = 0; t < nt; ++t) {
    f32x16 p0, p1; float mn, alpha; bf16x8 pa0, pa1, pa2, pa3;
    __builtin_amdgcn_s_setprio(1); qkt(p0, p1, K_lds + t * TILE_B, qr, r32, hi); __builtin_amdgcn_s_setprio(0);
    if (causal && t == nt - 1) cmask(p0, p1, t, qloc, hi);
    partialSM(p0, p1, m_reg, mn, alpha);
    finishSM(p0, p1, alpha, l_reg, pa0, pa1, pa2, pa3);
    if (__any(alpha < 1.f)) { if (hi == 0) al_l[r32] = alpha; asm volatile("s_waitcnt lgkmcnt(0)" ::: "memory");
#pragma unroll
      for (int d = 0; d < 4; ++d)
#pragma unroll
        for (int r = 0; r < 16; ++r) o[d][r] *= al_l[crow(r, hi)]; }
    SBAR();
    __builtin_amdgcn_s_setprio(1); pv_d0(o, vb0 + t * TILE_B, pa0, pa1, pa2, pa3); __builtin_amdgcn_s_setprio(0);
  }
  if (hi == 0) { li_l[r32] = l_reg; id_l[r32] = rowoff; *(float*)(wsb + lseoff) = m_reg * (SCALE * 1.4426950408889634f) + __builtin_amdgcn_logf(l_reg); }
  asm volatile("s_waitcnt lgkmcnt(0)" ::: "memory");
#pragma unroll
  for (int r = 0; r < 16; ++r) { const int orow = crow(r, hi); const unsigned off = id_l[orow]; const float rl = __builtin_amdgcn_rcpf(li_l[orow]);
    unsigned short* dst = (unsigned short*)(wsb + off) + r32;
#pragma unroll
    for (int d0 = 0; d0 < 4; ++d0) dst[d0 * 32] = (unsigned short)(cvtpk(o[d0][r] * rl, 0.f)); }
  asm volatile("s_waitcnt lgkmcnt(0)" ::: "memory");
}
#undef KSWZ
}

__device__ __forceinline__ void moba_attn_phase(Frame& F) {
    constexpr int SCR_OFF = LDSCTL_OFF + 1024, PREF_OFF = SCR_OFF + 4096;
    LAS int* prefF = (LAS int*)(F.lds + PREF_OFF);
    LAS int* prefP = prefF + 520;
    LAS int* wsum = prefP + 520;
    LAS int* tk = wsum + 16;
    const int tid = F.tid;
    {   const unsigned n = __hip_atomic_load(F.ctl + CW_CNT + tid, __ATOMIC_RELAXED, __HIP_MEMORY_SCOPE_AGENT);
        const int wc = 8 + (int)((n + 31u) >> 5); const int nf = wc / moba::MAXWC, np = (wc % moba::MAXWC) ? 1 : 0;
        int v = nf, u = np;
#pragma unroll
        for (int o = 1; o < 64; o <<= 1) { const int t = __shfl_up(v, o), t2 = __shfl_up(u, o); if (F.lane >= o) { v += t; u += t2; } }
        if (F.lane == 63) { wsum[F.wave] = v; wsum[8 + F.wave] = u; }
        __syncthreads();
        int add = 0, add2 = 0;
#pragma unroll
        for (int w = 0; w < 8; ++w) { add += (w < F.wave) ? wsum[w] : 0; add2 += (w < F.wave) ? wsum[8 + w] : 0; }
        prefF[tid] = v - nf + add; prefP[tid] = u - np + add2;
        if (tid == 511) { prefF[512] = v + add; prefP[512] = u + add2; }
        if (tid == 0) tk[0] = (int)atomicAdd((unsigned*)(F.ctl + CW_QUEUE), 1u);
        __syncthreads();
    }
    const int totalF = prefF[512], total = totalF + prefP[512];
    const unsigned short* MIXq = (const unsigned short*)(F.ws + WS_MIX) + 1024;
    const unsigned short* KB = (const unsigned short*)(F.ws + WS_KB); const unsigned short* VB = (const unsigned short*)(F.ws + WS_VB);
    const unsigned* lists = (const unsigned*)(F.ws + WS_LISTS);
    const int r32 = F.lane & 31, hi = F.lane >> 5, w = F.wave;
    char* K_lds = (char*)F.lds; char* V_lds = (char*)F.lds + 4 * moba::TILE_B;
    float* scr = (float*)((char*)F.lds + SCR_OFF) + w * 128;
    const int vb0 = (int)(uintptr_t)V_lds + moba::v_rd_base(F.lane);
    const int sr = tid >> 4, sc = (tid & 15) * 8, vst0 = moba::v_st(sr, sc), vst1 = moba::v_st(32 + sr, sc);
    int it = tk[0];
    while (it < total) {
        const bool isfull = it < totalF; const int r_ = isfull ? it : it - totalF; LAS int* pref = isfull ? prefF : prefP;
        int lo = 0, hi_ = 512;
        while (hi_ - lo > 1) { const int mid = (lo + hi_) >> 1; if (pref[mid] <= r_) lo = mid; else hi_ = mid; }
        const int e = lo, h = e >> 6, j = e & 63;
        const int n = (int)__hip_atomic_load(F.ctl + CW_CNT + e, __ATOMIC_RELAXED, __HIP_MEMORY_SCOPE_AGENT);
        const int wc_e = 8 + ((n + 31) >> 5); const int sub = isfull ? (r_ - pref[e]) : (wc_e / moba::MAXWC);
        const int q_lo = sub * moba::MAXWC, q_hi = (q_lo + moba::MAXWC < wc_e) ? q_lo + moba::MAXWC : wc_e;
        const unsigned short* Kh = KB + (size_t)(j * 256) * 1024 + h * 128; const unsigned short* Vh = VB + (size_t)(j * 256) * 1024 + h * 128;
        { TPA_BEGIN(130);
        __syncthreads();
        if (tid == 0) tk[0] = (int)atomicAdd((unsigned*)(F.ctl + CW_QUEUE), 1u);
        {   bf16x8 kv[16];
#pragma unroll
            for (int tt = 0; tt < 4; ++tt) { const int k0 = tt * 64;
                kv[4 * tt + 0] = *(const bf16x8*)(Vh + (size_t)(k0 + sr) * 1024 + sc); kv[4 * tt + 1] = *(const bf16x8*)(Vh + (size_t)(k0 + 32 + sr) * 1024 + sc);
                kv[4 * tt + 2] = *(const bf16x8*)(Kh + (size_t)(k0 + sr) * 1024 + sc); kv[4 * tt + 3] = *(const bf16x8*)(Kh + (size_t)(k0 + 32 + sr) * 1024 + sc); }
#pragma unroll
            for (int tt = 0; tt < 4; ++tt) { const int tb = tt * moba::TILE_B, kc = sc * 2;
                *(bf16x8*)(V_lds + tb + vst0) = kv[4 * tt + 0]; *(bf16x8*)(V_lds + tb + vst1) = kv[4 * tt + 1];
                *(bf16x8*)(K_lds + tb + ((sr) * 256 + ((kc) ^ (((sr) & 7) << 4)))) = kv[4 * tt + 2];
                *(bf16x8*)(K_lds + tb + ((32 + sr) * 256 + ((kc) ^ (((32 + sr) & 7) << 4)))) = kv[4 * tt + 3]; }
        }
        __syncthreads();
        TPA_END(130); }
        it = tk[0];
        TPA_BEGIN(131);
        if (w >= 4) __builtin_amdgcn_s_sleep(MOBA_STAGGER);
        bf16x8 qa[8], qb[8]; unsigned ida = 0, idb = 0, lsa = 0, lsb = 0; int nta = 4, ntb = 4, qla = 0, qlb = 0; bool ca = false, cb = false;
        const unsigned dump = (unsigned)WS_KWT + (unsigned)((F.bid * 8 + w) * 512);
#define PART_OFF(slot_) ((unsigned)(((slot_) & 2) ? WS_PART2 : WS_PART0) + (unsigned)((slot_) & 1) * (unsigned)(32 * MiB))
#define WC_SETUP(Q_, QF, ID, LS, NT, QL, CZ) do { const int q__ = (Q_); const unsigned short* qp__; \
        if (q__ < 8) { const int p__ = j * 256 + 32 * q__ + r32; qp__ = MIXq + (size_t)p__ * 2048 + h * 128 + hi * 8; ID = PART_OFF(3) + (unsigned)(p__ * 8 + h) * 256u; LS = (unsigned)WS_LSE + (unsigned)((p__ * 8 + h) * 4 + 3) * 4u; NT = (q__ >> 1) + 1; QL = 32 * q__ + r32; CZ = true; } \
        else { const int idx__ = 32 * (q__ - 8) + r32; const bool v__ = idx__ < n; const unsigned ent__ = lists[list_off(h, j) + (v__ ? idx__ : 0)]; const int p__ = (int)(ent__ >> 2); const int sl__ = (int)(ent__ & 3u); \
               qp__ = MIXq + (size_t)p__ * 2048 + h * 128 + hi * 8; ID = v__ ? PART_OFF(sl__) + (unsigned)(p__ * 8 + h) * 256u : dump; LS = v__ ? (unsigned)WS_LSE + (unsigned)((p__ * 8 + h) * 4 + sl__) * 4u : dump + 256u; NT = 4; QL = 0; CZ = false; } \
        _Pragma("unroll") for (int d0 = 0; d0 < 8; ++d0) QF[d0] = *reinterpret_cast<const bf16x8*>(qp__ + d0 * 16); } while (0)
        int q = q_lo + w;
        if (q < q_hi) WC_SETUP(q, qa, ida, lsa, nta, qla, ca);
        while (q < q_hi) {
            if (q + 8 < q_hi) WC_SETUP(q + 8, qb, idb, lsb, ntb, qlb, cb);
            moba::wave_chunk(qa, nta, ca, qla, K_lds, vb0, scr, ida, lsa, F.ws, r32, hi);
            q += 8; if (q >= q_hi) break;
            if (q + 8 < q_hi) WC_SETUP(q + 8, qa, ida, lsa, nta, qla, ca);
            moba::wave_chunk(qb, ntb, cb, qlb, K_lds, vb0, scr, idb, lsb, F.ws, r32, hi);
            q += 8;
        }
#undef PART_OFF
#undef WC_SETUP
        TPA_END(131);
    }
}

__device__ __forceinline__ void moba_merge_phase(Frame& F, int wg, int nwg) {
    const float* lse = (const float*)(F.ws + WS_LSE);
    const u32x4v* P0 = (const u32x4v*)(F.ws + WS_PART0); const u32x4v* P1 = (const u32x4v*)(F.ws + WS_PART1);
    const u32x4v* P2 = (const u32x4v*)(F.ws + WS_PART2); const u32x4v* P3 = (const u32x4v*)(F.ws + WS_PART3);
    for (int g = wg * 512 + F.tid; g < M_TOK * MB_H * 16; g += nwg * 512) {
        const int ph = g >> 4, dg = g & 15, p = ph >> 3;
#if defined(DBG_OWN_ONLY)
        const int nsel = 0;
#else
        const int nsel = (p >> 8) < 3 ? (p >> 8) : 3;
#endif
        const f32x4 l4 = *(const f32x4*)(lse + (size_t)ph * 4);
        const size_t po = (size_t)ph * 16 + dg;
        const u32x4v v0 = P0[po], v1 = P1[po], v2 = P2[po], v3 = P3[po];
        const float l0 = nsel > 0 ? l4[0] : -INFINITY, l1 = nsel > 1 ? l4[1] : -INFINITY, l2 = nsel > 2 ? l4[2] : -INFINITY, l3 = l4[3];
        const float mx = fmaxf(fmaxf(l0, l1), fmaxf(l2, l3));
        const float w0 = nsel > 0 ? __builtin_amdgcn_exp2f(l0 - mx) : 0.f, w1 = nsel > 1 ? __builtin_amdgcn_exp2f(l1 - mx) : 0.f, w2 = nsel > 2 ? __builtin_amdgcn_exp2f(l2 - mx) : 0.f, w3 = __builtin_amdgcn_exp2f(l3 - mx);
        const u32x4v z = {0u, 0u, 0u, 0u};
        const u32x4v a0 = nsel > 0 ? v0 : z, a1 = nsel > 1 ? v1 : z, a2 = nsel > 2 ? v2 : z;
        const float inv = 1.f / ((w0 + w1) + (w2 + w3));
        float acc[8];
#define MRG(E, F_) acc[E] = (w0 * F_(a0[E >> 1]) + w1 * F_(a1[E >> 1])) + (w2 * F_(a2[E >> 1]) + w3 * F_(v3[E >> 1]))
        MRG(0, bflo); MRG(1, bfhi); MRG(2, bflo); MRG(3, bfhi); MRG(4, bflo); MRG(5, bfhi); MRG(6, bflo); MRG(7, bfhi);
#undef MRG
        u32x4v o; o.x = pk2(acc[0] * inv, acc[1] * inv); o.y = pk2(acc[2] * inv, acc[3] * inv); o.z = pk2(acc[4] * inv, acc[5] * inv); o.w = pk2(acc[6] * inv, acc[7] * inv);
        *(u32x4v*)((unsigned short*)(F.ws + WS_MIX) + (size_t)p * 2048 + 1024 + (ph & 7) * 128 + dg * 8) = o;
    }
}

__device__ __forceinline__ void ml_mscan(const float* chsum, int h, int c, int lane, float& m_c, float& m_c1) {
    float a[4], g[4]; float A = 0.f, G = -INFINITY;
#pragma unroll
    for (int i = 0; i < 4; ++i) { const int cc = 4 * lane + i; const float bl = chsum[(cc * 4 + h) * 2], m1 = chsum[(cc * 4 + h) * 2 + 1]; a[i] = bl; g[i] = bl + m1; G = fmaxf(G + a[i], g[i]); A += a[i]; }
#pragma unroll
    for (int o = 1; o < 64; o <<= 1) { const float Ao = __shfl_up(A, o), Go = __shfl_up(G, o); if (lane >= o) { G = fmaxf(Go + A, G); A = Ao + A; } }
    float Ae = __shfl_up(A, 1), Ge = __shfl_up(G, 1); if (lane == 0) { Ae = 0.f; Ge = -INFINITY; }
    float m = fmaxf(Ae, Ge), mc = 0.f, mc1 = 0.f;
#pragma unroll
    for (int i = 0; i < 4; ++i) { if (i == (c & 3)) mc = m; m = fmaxf(m + a[i], g[i]); if (i == (c & 3)) mc1 = m; }
    m_c = __shfl(mc, c >> 2); m_c1 = __shfl(mc1, c >> 2);
}
__device__ __forceinline__ void ml_tables(const float* chsum, int h, int lane, LAS float* dec, LAS float* scl) {
    float a[4], g[4]; float A = 0.f, G = -INFINITY;
#pragma unroll
    for (int i = 0; i < 4; ++i) { const int cc = 4 * lane + i; const float bl = chsum[(cc * 4 + h) * 2], m1 = chsum[(cc * 4 + h) * 2 + 1]; a[i] = bl; g[i] = bl + m1; G = fmaxf(G + a[i], g[i]); A += a[i]; }
#pragma unroll
    for (int o = 1; o < 64; o <<= 1) { const float Ao = __shfl_up(A, o), Go = __shfl_up(G, o); if (lane >= o) { G = fmaxf(Go + A, G); A = Ao + A; } }
    float Ae = __shfl_up(A, 1), Ge = __shfl_up(G, 1); if (lane == 0) { Ae = 0.f; Ge = -INFINITY; }
    float m = fmaxf(Ae, Ge);
#pragma unroll
    for (int i = 0; i < 4; ++i) { const float mn = fmaxf(m + a[i], g[i]); dec[4 * lane + i] = expf(a[i] + m - mn); scl[4 * lane + i] = expf(g[i] - mn); m = mn; }
}
__device__ __forceinline__ void ml_scan_item(Frame& F, int item) {
    LAS float* dec = (LAS float*)F.lds; LAS float* scl = dec + 1024;
    if (item < 32) {
        const int gid = item * 512 + F.tid, h = gid >> 12, rem = gid & 4095;
        if (F.wave == 0) ml_tables(SMALLF(SM_CHSUM), h, F.lane, dec, scl);
        __syncthreads();
        u32x4v* base = (u32x4v*)((unsigned short*)(F.ws + WS_LOCAL) + (size_t)h * 256 * 128) + rem;
        constexpr size_t CST = (size_t)4 * 256 * 128 / 8;
        float C[8];
#pragma unroll
        for (int e = 0; e < 8; ++e) C[e] = 0.f;
        u32x4v la[16], lb[16];
#define SC_LOAD(L, c0_) do { _Pragma("unroll") for (int i = 0; i < 16; ++i) L[i] = base[(size_t)((c0_) + i) * CST]; } while (0)
#define SC_STEP(L, c0_) do { _Pragma("unroll") for (int i = 0; i < 16; ++i) { \
            u32x4v st; st.x = cvtpk(C[0], C[1]); st.y = cvtpk(C[2], C[3]); st.z = cvtpk(C[4], C[5]); st.w = cvtpk(C[6], C[7]); \
            base[(size_t)((c0_) + i) * CST] = st; \
            const u32x4v v = L[i]; const float d = dec[(c0_) + i], s = scl[(c0_) + i]; \
            C[0] = d * C[0] + s * bflo(v.x); C[1] = d * C[1] + s * bfhi(v.x); C[2] = d * C[2] + s * bflo(v.y); C[3] = d * C[3] + s * bfhi(v.y); \
            C[4] = d * C[4] + s * bflo(v.z); C[5] = d * C[5] + s * bfhi(v.z); C[6] = d * C[6] + s * bflo(v.w); C[7] = d * C[7] + s * bfhi(v.w); } } while (0)
        SC_LOAD(la, 0);
#pragma unroll 1
        for (int c0 = 0; c0 < ML_NC; c0 += 32) {
            SC_LOAD(lb, c0 + 16);
            SC_STEP(la, c0);
            if (c0 + 32 < ML_NC) SC_LOAD(la, c0 + 32);
            SC_STEP(lb, c0 + 16);
        }
#undef SC_LOAD
#undef SC_STEP
        __syncthreads();
    } else {
        if (F.wave < 4) ml_tables(SMALLF(SM_CHSUM), F.wave, F.lane, dec + F.wave * 256, scl + F.wave * 256);
        __syncthreads();
        const int h = F.tid >> 7, d = F.tid & 127; float* nl = SMALLF(SM_NLOC) + h * 128 + d; float n = 0.f;
#pragma unroll 1
        for (int c0 = 0; c0 < ML_NC; c0 += 32) {
            float lv[32];
#pragma unroll
            for (int i = 0; i < 32; ++i) lv[i] = nl[(size_t)(c0 + i) * 512];
#pragma unroll
            for (int i = 0; i < 32; ++i) { nl[(size_t)(c0 + i) * 512] = n; n = dec[h * 256 + c0 + i] * n + scl[h * 256 + c0 + i] * lv[i]; }
        }
        __syncthreads();
    }
}
__device__ __forceinline__ float dpp_row_sum(float x) {
    x += __builtin_bit_cast(float, __builtin_amdgcn_update_dpp(0, __builtin_bit_cast(int, x), 0xB1, 0xF, 0xF, true));
    x += __builtin_bit_cast(float, __builtin_amdgcn_update_dpp(0, __builtin_bit_cast(int, x), 0x4E, 0xF, 0xF, true));
    x += __builtin_bit_cast(float, __builtin_amdgcn_update_dpp(0, __builtin_bit_cast(int, x), 0x141, 0xF, 0xF, true));
    x += __builtin_bit_cast(float, __builtin_amdgcn_update_dpp(0, __builtin_bit_cast(int, x), 0x140, 0xF, 0xF, true));
    return x;
}
struct MlRegs { v4u gq[2], gk[2], gm[4]; bf16x8 cf[8]; u32x2 vlo[4], vhi[4]; };
__device__ __forceinline__ void ml_load_tiles(Frame& F, int c, int h, MlRegs& R) {
    const int tid = F.tid, t0 = c * ML_L;
    const v4u* QC = (const v4u*)(F.ws + WS_QC); const v4u* KC = (const v4u*)(F.ws + WS_KC); const v4u* MX = (const v4u*)(F.ws + WS_MIX);
#pragma unroll
    for (int i = 0; i < 2; ++i) { const int idx = tid + 512 * i, row = idx >> 4, ch = idx & 15; R.gq[i] = QC[(size_t)(t0 + row) * 64 + h * 16 + ch]; R.gk[i] = KC[(size_t)(t0 + row) * 64 + h * 16 + ch]; }
    (void)MX;
}
__device__ __forceinline__ void ml_load_state(Frame& F, int c, int h, MlRegs& R) {
    const int hh = F.lane >> 5, vcol = 32 * F.wave + (F.lane & 31);
    const unsigned short* ST = (const unsigned short*)(F.ws + WS_LOCAL) + (size_t)(c * 4 + h) * 256 * 128 + (size_t)vcol * 8;
#pragma unroll
    for (int kd = 0; kd < 8; ++kd) R.cf[kd] = *(const bf16x8*)(ST + (2 * kd + hh) * 2048);
}
__device__ __forceinline__ void ml_load_vt(Frame& F, int c, int h, MlRegs& R) {
    const int hh = F.lane >> 5, vcol = 32 * F.wave + (F.lane & 31);
    const unsigned short* VTv = (const unsigned short*)(F.ws + WS_VT) + (size_t)(c * 4 + h) * 256 * 64 + (size_t)vcol * 4;
#pragma unroll
    for (int i = 0; i < 4; ++i) { R.vlo[i] = *(const u32x2*)(VTv + (4 * i + hh) * 1024); R.vhi[i] = *(const u32x2*)(VTv + (4 * i + 2 + hh) * 1024); }
}
__device__ __forceinline__ void ml_out_item(Frame& F, int c, int h, MlRegs& R, bool has_next, int cn, int hn) {
    const int lane = F.lane, r = lane & 31, hh = lane >> 5, w = F.wave, tid = F.tid, t0 = c * ML_L;
    constexpr int QS = 136, MS = 264;
    LAS float* tb_u = (LAS float*)F.lds;
    LAS float* tb_mt = tb_u + 64;
    LAS float* tb_wi = tb_mt + 64;
    LAS float* tb_em = tb_wi + 64;
    LAS float* tb_n = tb_em + 64;
    LAS float* tb_den = tb_n + 128;
    LAS float* tb_ln = tb_den + 512;
    LAS float* tb_mr = tb_ln + 1024;
    LAS unsigned short* Ql = (LAS unsigned short*)(F.lds + 8192);
    LAS unsigned short* Kl = Ql + 64 * QS;
    LAS unsigned short* Ml = Kl + 64 * QS;
    const int vcol = 32 * w + r;
    ml_load_tiles(F, c, h, R);
    {   const v4u* MX = (const v4u*)(F.ws + WS_MIX);
#pragma unroll
        for (int i = 0; i < 4; ++i) { const int idx = tid + 512 * i, row = idx >> 5, ch = idx & 31; R.gm[i] = MX[(size_t)(t0 + row) * 256 + h * 32 + ch]; } }
    float m_c, m_c1; ml_mscan(SMALLF(SM_CHSUM), h, c, lane, m_c, m_c1);
    if (tid < 64) { const f32x4 ts = *(const f32x4*)(SMALLF(SM_TOKSC) + (size_t)((t0 + tid) * 4 + h) * 4);
        const float mt = fmaxf(m_c, ts.z); tb_u[tid] = ts.y; tb_mt[tid] = mt; tb_wi[tid] = expf(m_c - mt); tb_em[tid] = expf(-(ts.x + mt)); }
    if (tid >= 64 && tid < 192) tb_n[tid - 64] = SMALLF(SM_NLOC)[(c * 4 + h) * 128 + tid - 64];
#pragma unroll
    for (int i = 0; i < 2; ++i) { const int idx = tid + 512 * i, row = idx >> 4, ch = idx & 15; *(LAS v4u*)(Ql + row * QS + ch * 8) = R.gq[i]; *(LAS v4u*)(Kl + row * QS + ch * 8) = R.gk[i]; }
#pragma unroll
    for (int i = 0; i < 4; ++i) { const int idx = tid + 512 * i, row = idx >> 5, ch = idx & 31; *(LAS v4u*)(Ml + row * MS + ch * 8) = R.gm[i]; }
    __syncthreads();
    f32x16 s00 = {}, s01 = {}, s11 = {};
    float qn0 = 0.f, qn1 = 0.f;
#pragma unroll 1
    for (int kd = 0; kd < 8; ++kd) {
        const bf16x8 q0 = *(const LAS bf16x8*)(Ql + r * QS + 16 * kd + 8 * hh), q1 = *(const LAS bf16x8*)(Ql + (32 + r) * QS + 16 * kd + 8 * hh);
        const bf16x8 k0 = *(const LAS bf16x8*)(Kl + r * QS + 16 * kd + 8 * hh), k1 = *(const LAS bf16x8*)(Kl + (32 + r) * QS + 16 * kd + 8 * hh);
        s00 = MFMA32(k0, q0, s00); s01 = MFMA32(k0, q1, s01); s11 = MFMA32(k1, q1, s11);
        const f32x4 n0 = *(const LAS f32x4*)(tb_n + 16 * kd + 8 * hh), n1 = *(const LAS f32x4*)(tb_n + 16 * kd + 8 * hh + 4);
        const u32x4v a = __builtin_bit_cast(u32x4v, q0), b = __builtin_bit_cast(u32x4v, q1);
        qn0 += bflo(a.x) * n0.x + bfhi(a.x) * n0.y + bflo(a.y) * n0.z + bfhi(a.y) * n0.w + bflo(a.z) * n1.x + bfhi(a.z) * n1.y + bflo(a.w) * n1.z + bfhi(a.w) * n1.w;
        qn1 += bflo(b.x) * n0.x + bfhi(b.x) * n0.y + bflo(b.y) * n0.z + bfhi(b.y) * n0.w + bflo(b.z) * n1.x + bfhi(b.z) * n1.y + bflo(b.w) * n1.z + bfhi(b.w) * n1.w;
    }
    const float mt0 = tb_mt[r], mt1 = tb_mt[32 + r];
    float rs0 = 0.f, rs1 = 0.f;
#pragma unroll
    for (int q = 0; q < 16; ++q) {
        const int s = crow(q, hh); const float u0 = tb_u[s], u1 = tb_u[32 + s];
        s00[q] = (s <= r) ? s00[q] * __expf(u0 - mt0) : 0.f;
        s01[q] = s01[q] * __expf(u0 - mt1);
        s11[q] = (s <= r) ? s11[q] * __expf(u1 - mt1) : 0.f;
        rs0 += s00[q]; rs1 += s01[q] + s11[q];
    }
    rs0 += __shfl_xor(rs0, 32); rs1 += __shfl_xor(rs1, 32); qn0 += __shfl_xor(qn0, 32); qn1 += __shfl_xor(qn1, 32);
    {   const float den0 = tb_wi[r] * qn0 + rs0, den1 = tb_wi[32 + r] * qn1 + rs1;
        if (hh == 0) { tb_den[w * 64 + r] = 1.f / fmaxf(fabsf(den0), tb_em[r]); tb_den[w * 64 + 32 + r] = 1.f / fmaxf(fabsf(den1), tb_em[32 + r]); } }
    bf16x8 p00[2], p01[2], p11[2];
#pragma unroll
    for (int ks = 0; ks < 2; ++ks) {
        u32x4v x; x.x = cvtpk(s00[8 * ks], s00[8 * ks + 1]); x.y = cvtpk(s00[8 * ks + 2], s00[8 * ks + 3]); x.z = cvtpk(s00[8 * ks + 4], s00[8 * ks + 5]); x.w = cvtpk(s00[8 * ks + 6], s00[8 * ks + 7]); p00[ks] = __builtin_bit_cast(bf16x8, x);
        x.x = cvtpk(s01[8 * ks], s01[8 * ks + 1]); x.y = cvtpk(s01[8 * ks + 2], s01[8 * ks + 3]); x.z = cvtpk(s01[8 * ks + 4], s01[8 * ks + 5]); x.w = cvtpk(s01[8 * ks + 6], s01[8 * ks + 7]); p01[ks] = __builtin_bit_cast(bf16x8, x);
        x.x = cvtpk(s11[8 * ks], s11[8 * ks + 1]); x.y = cvtpk(s11[8 * ks + 2], s11[8 * ks + 3]); x.z = cvtpk(s11[8 * ks + 4], s11[8 * ks + 5]); x.w = cvtpk(s11[8 * ks + 6], s11[8 * ks + 7]); p11[ks] = __builtin_bit_cast(bf16x8, x);
    }
    f32x16 o0 = {}, o1 = {};
#pragma unroll
    for (int kd = 0; kd < 8; ++kd) {
        const bf16x8 q0 = *(const LAS bf16x8*)(Ql + r * QS + 16 * kd + 8 * hh), q1 = *(const LAS bf16x8*)(Ql + (32 + r) * QS + 16 * kd + 8 * hh);
        o0 = MFMA32(q0, R.cf[kd], o0); o1 = MFMA32(q1, R.cf[kd], o1); }
    asm volatile("" ::: "memory");
    if (has_next) ml_load_state(F, cn, hn, R);
#pragma unroll
    for (int q = 0; q < 16; ++q) { o0[q] *= tb_wi[crow(q, hh)]; o1[q] *= tb_wi[32 + crow(q, hh)]; }
#pragma unroll
    for (int st = 0; st < 2; ++st)
#pragma unroll
        for (int ks = 0; ks < 2; ++ks) {
            u32x4v bb; bb.x = R.vlo[2 * st + ks].x; bb.y = R.vlo[2 * st + ks].y; bb.z = R.vhi[2 * st + ks].x; bb.w = R.vhi[2 * st + ks].y; const bf16x8 vf = __builtin_bit_cast(bf16x8, bb);
            if (st == 0) { o0 = MFMA32(p00[ks], vf, o0); o1 = MFMA32(p01[ks], vf, o1); } else { o1 = MFMA32(p11[ks], vf, o1); }
        }
    asm volatile("" ::: "memory");
    if (has_next) ml_load_vt(F, cn, hn, R);
#pragma unroll
    for (int q = 0; q < 16; ++q) { o0[q] *= tb_den[w * 64 + crow(q, hh)]; o1[q] *= tb_den[w * 64 + 32 + crow(q, hh)]; }
#pragma unroll
    for (int q = 0; q < 16; ++q) {
        float a = dpp_row_sum(o0[q]), a2 = dpp_row_sum(o0[q] * o0[q]), b = dpp_row_sum(o1[q]), b2 = dpp_row_sum(o1[q] * o1[q]);
        a += __shfl_xor(a, 16); a2 += __shfl_xor(a2, 16); b += __shfl_xor(b, 16); b2 += __shfl_xor(b2, 16);
        if (r == 0) { const int t = crow(q, hh); tb_ln[(w * 64 + t) * 2] = a; tb_ln[(w * 64 + t) * 2 + 1] = a2; tb_ln[(w * 64 + 32 + t) * 2] = b; tb_ln[(w * 64 + 32 + t) * 2 + 1] = b2; }
    }
    __syncthreads();
    if (tid < 64) { float s = 0.f, s2 = 0.f;
#pragma unroll
        for (int ww = 0; ww < 8; ++ww) { s += tb_ln[(ww * 64 + tid) * 2]; s2 += tb_ln[(ww * 64 + tid) * 2 + 1]; }
        const float mu = s * (1.f / 256.f), var = fmaxf(s2 * (1.f / 256.f) - mu * mu, 0.f); tb_mr[tid * 2] = mu; tb_mr[tid * 2 + 1] = rsqrtf(var + LN_EPS); }
    __syncthreads();
    const float nw = F.normw[h * 256 + vcol];
#pragma unroll
    for (int tt = 0; tt < 2; ++tt)
#pragma unroll
        for (int q = 0; q < 16; ++q) {
            const int t = 32 * tt + crow(q, hh); const float mu = tb_mr[t * 2], rstd = tb_mr[t * 2 + 1];
            const float hv = tt ? o1[q] : o0[q];
            LAS unsigned short* op = Ml + t * MS + vcol; const float mo = bf2f(*op);
            *op = (unsigned short)f2bf((hv - mu) * rstd * nw * sigmoid_f(mo));
        }
    __syncthreads();
    {   v4u* MX = (v4u*)(F.ws + WS_MIX);
#pragma unroll
        for (int i = 0; i < 4; ++i) { const int idx = tid + 512 * i, row = idx >> 5, ch = idx & 31; MX[(size_t)(t0 + row) * 256 + h * 32 + ch] = *(LAS v4u*)(Ml + row * MS + ch * 8); } }
    __syncthreads();
}

__device__ __forceinline__ void x2_phase(Frame& F) {
    constexpr int NSCAN = 33;
#if defined(NAIVE_MOBA)
    for (int i = F.bid; i < NSCAN; i += F.G) ml_scan_item(F, i);
#elif defined(NAIVE_MLSTM)
    moba_attn_phase(F);
#else
    for (int i = F.bid; i < NSCAN; i += F.G) { TP_BEGIN(100); ml_scan_item(F, i); TP_END(100); }
    __syncthreads();
    TP_BEGIN(101); moba_attn_phase(F); TP_END(101);
#endif
}
__device__ __forceinline__ void x3_phase(Frame& F) {
#if !defined(NAIVE_MLSTM)
    TP_BEGIN(150);
    {   MlRegs R; int it = F.bid;
        if (it < ML_NC * ML_H) { ml_load_state(F, it >> 2, it & 3, R); ml_load_vt(F, it >> 2, it & 3, R); }
        for (; it < ML_NC * ML_H; it += F.G) { const int nx = it + F.G; const bool hn = nx < ML_NC * ML_H; ml_out_item(F, it >> 2, it & 3, R, hn, nx >> 2, nx & 3); } }
    TP_END(150);
#endif
#if !defined(NAIVE_MOBA) && !defined(DBG_SKIP_MERGE)
    TP_BEGIN(151); moba_merge_phase(F, F.bid, F.G); TP_END(151);
#endif
}
__global__ void __launch_bounds__(512) naive_moba(unsigned char* ws) {
    __shared__ float qf_s[8][128];
    __shared__ float pb_s[8][1024];
    const int wave = threadIdx.x >> 6, lane = threadIdx.x & 63;
    const int gw = blockIdx.x * 8 + wave; const int p = gw >> 3, h = gw & 7;
    unsigned short* MIX = (unsigned short*)(ws + WS_MIX);
    const unsigned short* KB = (const unsigned short*)(ws + WS_KB); const unsigned short* VB = (const unsigned short*)(ws + WS_VB);
    const float* kmean = (const float*)(ws + WS_SMALL + SM_KMEAN);
    float* qf = qf_s[wave]; float* pb = pb_s[wave];
    unsigned short* qp = MIX + (size_t)p * 2048 + 1024 + h * 128;
    qf[lane * 2] = bf2f(qp[lane * 2]); qf[lane * 2 + 1] = bf2f(qp[lane * 2 + 1]);
    __syncthreads();
    const int b = p >> 8;
    float sc = -INFINITY;
    if (lane < b) { const float* km = kmean + (size_t)(h * 64 + lane) * 128; float s = 0.f; for (int d = 0; d < 128; ++d) s += qf[d] * km[d]; sc = s; }
    int sel[3]; const int nsel = b < 3 ? b : 3;
#pragma unroll
    for (int k = 0; k < 3; ++k) {
        float bv = sc; int bi = lane;
        for (int o = 1; o < 64; o <<= 1) { const float ov = __shfl_xor(bv, o); const int oi = __shfl_xor(bi, o); if (ov > bv || (ov == bv && oi < bi)) { bv = ov; bi = oi; } }
        sel[k] = bi; if (lane == bi) sc = -INFINITY;
    }
    float s[16]; float mx = -INFINITY;
#pragma unroll
    for (int bi = 0; bi < 4; ++bi) {
        const bool valid = (bi < nsel) || (bi == 3); const int blk = (bi == 3) ? b : sel[bi < 3 ? bi : 0];
#pragma unroll
        for (int kk = 0; kk < 4; ++kk) {
            float v = -INFINITY;
            if (valid) { const int key = blk * 256 + kk * 64 + lane; const unsigned short* kr = KB + (size_t)key * 1024 + h * 128; float a = 0.f; for (int d = 0; d < 128; ++d) a += qf[d] * bf2f(kr[d]); a *= K_SCALE; if (bi == 3 && key > p) a = -INFINITY; v = a; }
            s[bi * 4 + kk] = v; mx = fmaxf(mx, v);
        }
    }
    for (int o = 1; o < 64; o <<= 1) mx = fmaxf(mx, __shfl_xor(mx, o));
    float sum = 0.f;
#pragma unroll
    for (int i = 0; i < 16; ++i) { const float e = (s[i] == -INFINITY) ? 0.f : expf(s[i] - mx); pb[i * 64 + lane] = e; sum += e; }
    sum = wave_sum(sum);
    __syncthreads();
    float o0 = 0.f, o1 = 0.f;
#pragma unroll
    for (int bi = 0; bi < 4; ++bi) {
        const bool valid = (bi < nsel) || (bi == 3); if (!valid) continue; const int blk = (bi == 3) ? b : sel[bi];
        for (int kk = 0; kk < 256; ++kk) { const float pv = pb[bi * 256 + kk]; const unsigned v = *(const unsigned*)(VB + (size_t)(blk * 256 + kk) * 1024 + h * 128 + lane * 2); o0 += pv * bflo(v); o1 += pv * bfhi(v); }
    }
    const float inv = 1.f / sum;
    *(unsigned*)(qp + lane * 2) = pk2(o0 * inv, o1 * inv);
}
__global__ void __launch_bounds__(256) naive_mlstm(unsigned char* ws, const float* igb, const float* fgb, const float* normw) {
    __shared__ float q[128], k[128], nn[128], red[4], red2[4];
    const int h = blockIdx.x, v = threadIdx.x, lane = v & 63, wv = v >> 6;
    const unsigned short* QC = (const unsigned short*)(ws + WS_QC); const unsigned short* KC = (const unsigned short*)(ws + WS_KC); const unsigned short* MV = (const unsigned short*)(ws + WS_MV);
    const float* gates = (const float*)(ws + WS_SMALL + SM_GATES); unsigned short* MIX = (unsigned short*)(ws + WS_MIX);
    float C[128];
#pragma unroll
    for (int d = 0; d < 128; ++d) C[d] = 0.f;
    float m = 0.f; if (v < 128) nn[v] = 0.f;
    const float ib = igb[h], fb = fgb[h], nw = normw[h * 256 + v];
    for (int t = 0; t < M_TOK; ++t) {
        if (v < 128) q[v] = bf2f(QC[(size_t)t * 512 + h * 128 + v]); else k[v - 128] = bf2f(KC[(size_t)t * 512 + h * 128 + v - 128]);
        const float ig = gates[t * 8 + h] + ib, lf = logsigmoid_f(gates[t * 8 + 4 + h] + fb);
        const float mn = fmaxf(lf + m, ig), fd = expf(lf + m - mn), iw = expf(ig - mn); m = mn;
        const float vv = bf2f(MV[(size_t)t * 1024 + h * 256 + v]);
        __syncthreads();
        if (v < 128) nn[v] = fd * nn[v] + iw * k[v];
        float num = 0.f;
#pragma unroll
        for (int d = 0; d < 128; ++d) { C[d] = fd * C[d] + iw * k[d] * vv; num += q[d] * C[d]; }
        __syncthreads();
        float den = 0.f;
#pragma unroll 16
        for (int d = 0; d < 128; ++d) den += q[d] * nn[d];
        const float hv = num / fmaxf(fabsf(den), expf(-m));
        float s = wave_sum(hv); if (lane == 0) red[wv] = s;
        __syncthreads();
        const float mu = (red[0] + red[1] + red[2] + red[3]) * (1.f / 256.f);
        const float dv = hv - mu; float s2 = wave_sum(dv * dv); if (lane == 0) red2[wv] = s2;
        __syncthreads();
        const float var = (red2[0] + red2[1] + red2[2] + red2[3]) * (1.f / 256.f);
        unsigned short* op = MIX + (size_t)t * 2048 + h * 256 + v;
        const float mo = bf2f(*op);
        *op = (unsigned short)f2bf(dv * rsqrtf(var + LN_EPS) * nw * sigmoid_f(mo));
    }
}
__global__ void __launch_bounds__(256) dbg_cmp_u32(const unsigned* a, const unsigned* b, size_t n, unsigned* cnt) {
    unsigned c = 0;
    for (size_t i = blockIdx.x * 256ull + threadIdx.x; i < n; i += gridDim.x * 256ull) c += (a[i] != b[i]) ? 1u : 0u;
    if (c) atomicAdd(cnt, c);
}
__global__ void __launch_bounds__(512) dbg_check_own(unsigned char* ws, unsigned* cnt) {
    __shared__ float qf_s[8][128];
    __shared__ float pb_s[8][256];
    const int wave = threadIdx.x >> 6, lane = threadIdx.x & 63;
    const int gw = blockIdx.x * 8 + wave; const int p = gw >> 3, h = gw & 7;
    const unsigned short* MIX = (const unsigned short*)(ws + WS_MIX);
    const unsigned short* KB = (const unsigned short*)(ws + WS_KB); const unsigned short* VB = (const unsigned short*)(ws + WS_VB);
    float* qf = qf_s[wave]; float* pb = pb_s[wave];
    const unsigned short* qp = MIX + (size_t)p * 2048 + 1024 + h * 128;
    qf[lane * 2] = bf2f(qp[lane * 2]); qf[lane * 2 + 1] = bf2f(qp[lane * 2 + 1]);
    __syncthreads();
    const int b = p >> 8; float s[4], mx = -INFINITY;
#pragma unroll
    for (int kk = 0; kk < 4; ++kk) { const int key = b * 256 + kk * 64 + lane; const unsigned short* kr = KB + (size_t)key * 1024 + h * 128; float a = 0.f; for (int d = 0; d < 128; ++d) a += qf[d] * bf2f(kr[d]); a *= K_SCALE; if (key > p) a = -INFINITY; s[kk] = a; mx = fmaxf(mx, a); }
    for (int o = 1; o < 64; o <<= 1) mx = fmaxf(mx, __shfl_xor(mx, o));
    float sum = 0.f;
#pragma unroll
    for (int kk = 0; kk < 4; ++kk) { const float e = (s[kk] == -INFINITY) ? 0.f : expf(s[kk] - mx); pb[kk * 64 + lane] = e; sum += e; }
    sum = wave_sum(sum);
    __syncthreads();
    float o0 = 0.f, o1 = 0.f;
    for (int kk = 0; kk < 256; ++kk) { const float pv = pb[kk]; const unsigned v = *(const unsigned*)(VB + (size_t)(b * 256 + kk) * 1024 + h * 128 + lane * 2); o0 += pv * bflo(v); o1 += pv * bfhi(v); }
    o0 /= sum; o1 /= sum;
    const unsigned short* pr = (const unsigned short*)(ws + WS_PART3) + (size_t)(p * 8 + h) * 128 + lane * 2;
    float d = fmaxf(fabsf(o0 - bf2f(pr[0])), fabsf(o1 - bf2f(pr[1])));
    for (int o = 1; o < 64; o <<= 1) d = fmaxf(d, __shfl_xor(d, o));
    const float lse_ref = mx * 1.4426950408889634f + log2f(sum); const float lse = ((const float*)(ws + WS_LSE))[(p * 8 + h) * 4 + 3];
    if (lane == 0) { if (d > 0.02f) atomicAdd(cnt, 1u); if (!(fabsf(lse - lse_ref) < 0.05f)) atomicAdd(cnt + 1, 1u); }
}
__global__ void dbg_flag(const unsigned* cnt, float* out) {
    if (threadIdx.x == 0) { if (cnt[0]) out[0] += 1000.f; if (cnt[1]) out[1] += 2000.f; if (cnt[2]) out[2] += 4000.f; if (cnt[3]) out[3] += 8000.f; }
}
#ifndef PG8_SP2
#define PG8_SP2 true
#endif
#ifndef PG8_ALIGN
#define PG8_ALIGN true
#endif
constexpr int N_PHASES = 12;
struct Args { const float* in[17]; float* out; unsigned char* ws; int ph_lo, ph_hi, li, pad; };
__global__ void __launch_bounds__(NWAVES * 64, 2) mk_fwd(Args args) {
    extern __shared__ __attribute__((aligned(16))) unsigned char lds[];
    Frame F;
    F.lds = (LAS unsigned char*)lds;
    F.MISC = (volatile LAS unsigned*)(F.lds + MISC_OFF);
    F.tid = threadIdx.x; F.lane = F.tid & 63; F.wave = __builtin_amdgcn_readfirstlane(F.tid >> 6);
    F.G = gridDim.x; F.bid = blockIdx.x; F.tp0 = 0; F.tp1 = 0;
    F.ws = args.ws; F.ctl = (gu32*)(args.ws + WS_CTL); F.out = args.out;
    F.x = args.in[0]; F.c = args.in[1]; F.w_ada = args.in[2]; F.b_ada = args.in[3]; F.w_in = args.in[4]; F.conv_w = args.in[5]; F.conv_b = args.in[6];
    F.igb = args.in[7]; F.fgb = args.in[8]; F.normw = args.in[9]; F.w_out = args.in[10]; F.ln1_w = args.in[11]; F.ln1_b = args.in[12];
    F.w_gu = args.in[13]; F.w_down = args.in[14]; F.ln2_w = args.in[15]; F.ln2_b = args.in[16];
    for (int u = F.tid; u < (LDS_BYTES - LDSCTL_OFF) / 4; u += NWAVES * 64) ((LAS unsigned*)(F.lds + LDSCTL_OFF))[u] = 0u;
    __syncthreads();
    const int lo = args.ph_lo, hi = args.ph_hi;
    XcdBarrier bar; bar.bar = (unsigned*)(F.ctl + CW_BAR) + args.li * XCD_BAR_WORDS; bar.x = 0; bar.st = nullptr;
    if (hi - lo > 1) bar = xcd_barrier_post((unsigned*)(F.ctl + CW_BAR) + args.li * XCD_BAR_WORDS, F.MISC + 8);
#ifndef PHMASK
#define PHMASK 0xFFF
#endif
#define IN(k) (((PHMASK >> (k)) & 1) && lo <= (k) && (k) < hi)
#if defined(TIME_PHASE)
    unsigned long long tp0 = 0, tp1 = 0;
#define TSTAMP(k) do { if ((k) + 1 == TIME_PHASE) tp0 = __builtin_amdgcn_s_memrealtime(); if ((k) == TIME_PHASE) tp1 = __builtin_amdgcn_s_memrealtime(); } while (0)
#else
#define TSTAMP(k) do { } while (0)
#endif
#define SEAM(k) do { if (IN(k) && IN((k) + 1)) xcd_barrier(bar); TSTAMP(k); } while (0)
    float* ada = SMALLF(SM_ADA);
#if defined(TIME_PHASE)
    if (TIME_PHASE == 0) tp0 = __builtin_amdgcn_s_memrealtime();
#endif
    if (IN(0)) { p0_phase(F); } SEAM(0);
    if (IN(1)) { p1_phase(F); } SEAM(1);
    if (IN(2)) {
        pg8::Gemm g{(const pg8::bf16_t*)(F.ws + WS_U), (const pg8::bf16_t*)(F.ws + WS_WIN), M_TOK, NPROJ, DM}; pg8::StaticOrder S; S.init(M_TOK, NPROJ, F.G, F.bid, WGM_P2);
        pg8::EpiProj E{(pg8::bf16_t*)(F.ws + WS_MIX), (pg8::bf16_t*)(F.ws + WS_KB), (pg8::bf16_t*)(F.ws + WS_VB), (pg8::bf16_t*)(F.ws + WS_MQK), (pg8::bf16_t*)(F.ws + WS_MV), (const float*)(F.ws + WS_ROPE), SMALLF(SM_KMEAN)};
        pg8::gemm_phase<pg8::EpiProj, pg8::StaticOrder, PG8_ALIGN, PG8_SP2>(F.lds, g, S, E);
    } SEAM(2);
    if (IN(3)) { p3_phase(F); } SEAM(3);
    TSTAMP(4);
    if (IN(5)) { x2_phase(F); } SEAM(5);
    if (IN(6)) { x3_phase(F); } SEAM(6);
    if (IN(7)) {
        pg8::Gemm g{(const pg8::bf16_t*)(F.ws + WS_MIX), (const pg8::bf16_t*)(F.ws + WS_WOUT), M_TOK, DM, DM}; pg8::StaticOrder S; S.init(M_TOK, DM, F.G, F.bid, WGM_P5);
        pg8::EpiY1 E{F.x, ada + 2 * DM, (pg8::bf16_t*)(F.ws + WS_Y1B), (unsigned long long*)SMALLF(SM_MUR)};
        pg8::gemm_phase<pg8::EpiY1, pg8::StaticOrder, PG8_ALIGN, PG8_SP2>(F.lds, g, S, E);
    } SEAM(7);
    TSTAMP(8);
    if (IN(9)) {
        pg8::Gemm g{(const pg8::bf16_t*)(F.ws + WS_Y1B), (const pg8::bf16_t*)(F.ws + WS_WGU), M_TOK, NGU, DM}; pg8::StaticOrder S; S.init(M_TOK, NGU, F.G, F.bid, WGM_P6);
        pg8::EpiSwiGLU E{(const unsigned long long*)SMALLF(SM_MUR), SMALLF(SM_C1), SMALLF(SM_C2), (pg8::bf16_t*)(F.ws + WS_H)};
        pg8::gemm_phase<pg8::EpiSwiGLU, pg8::StaticOrder, PG8_ALIGN, PG8_SP2>(F.lds, g, S, E);
    } SEAM(9);
    if (IN(10)) {
        pg8::Gemm g{(const pg8::bf16_t*)(F.ws + WS_H), (const pg8::bf16_t*)(F.ws + WS_WDOWN), M_TOK, DM, DFF}; pg8::StaticOrder S; S.init(M_TOK, DM, F.G, F.bid, WGM_P7);
        pg8::EpiY2 E{(const pg8::bf16_t*)(F.ws + WS_Y1B), (const unsigned long long*)SMALLF(SM_MUR), ada + 5 * DM, F.ln1_w, F.ln1_b, F.out};
        TP_BEGIN(141); pg8::gemm_phase<pg8::EpiY2, pg8::StaticOrder, PG8_ALIGN, PG8_SP2>(F.lds, g, S, E); TP_END(141);
    }
    {
        const bool both = IN(10) && IN(11);
        bool fused = false;
        if (both) { TP_BEGIN(140); fused = ln2_panel_fused(F); TP_END(140); }
        if (!fused) { SEAM(10); if (IN(11)) { ln2_phase(F); } }
    }
#if defined(TIME_PHASE)
    if (TIME_PHASE == 11) tp1 = __builtin_amdgcn_s_memrealtime();
    if (TIME_PHASE >= 100) { tp0 = F.tp0; tp1 = F.tp1; }
    if ((F.bid == 0 || TIME_PHASE >= 100) && F.tid == 0 && tp1 > tp0) { const unsigned long long te = __builtin_amdgcn_s_memrealtime(); const unsigned long long want = (tp1 - tp0) * TIME_MULT;
        while (__builtin_amdgcn_s_memrealtime() - te < want) __builtin_amdgcn_s_sleep(32); }
#endif
#undef IN
#undef SEAM
}

#ifndef MK_MODE
#define MK_MODE 1
#endif
extern "C" void kernel_launch(void* const* d_in, const int* in_sizes, int n_in, void* d_out, int out_size, void* d_ws, size_t ws_size, hipStream_t stream) {
    static int grid = 0;
    if (grid == 0) {
        if (n_in != 17 || in_sizes[0] != M_TOK * DM || out_size != M_TOK * DM || ws_size < WS_END) {
            fprintf(stderr, "kernel_launch: shape mismatch: n_in %d in0 %d out %d ws %zu (need %zu)\n", n_in, n_in > 0 ? in_sizes[0] : -1, out_size, ws_size, (size_t)WS_END); grid = -1; return; }
        int dev = 0, cus = 0, per_cu = 0;
        if (hipGetDevice(&dev) != hipSuccess || hipDeviceGetAttribute(&cus, hipDeviceAttributeMultiprocessorCount, dev) != hipSuccess) { fprintf(stderr, "kernel_launch: device query failed\n"); grid = -1; return; }
        if (hipFuncSetAttribute((const void*)mk_fwd, hipFuncAttributeMaxDynamicSharedMemorySize, LDS_BYTES) != hipSuccess) { fprintf(stderr, "kernel_launch: hipFuncSetAttribute failed\n"); grid = -1; return; }
        if (hipOccupancyMaxActiveBlocksPerMultiprocessor(&per_cu, (const void*)mk_fwd, NWAVES * 64, LDS_BYTES) != hipSuccess || per_cu < 1) { fprintf(stderr, "kernel_launch: occupancy query says %d blocks per CU\n", per_cu); (void)hipGetLastError(); grid = -1; return; }
        grid = cus;
    }
    if (grid < 0) return;
    (void)hipMemsetAsync((char*)d_ws + WS_CTL, 0, CTL_ZERO_BYTES, stream);
    Args a{};
    for (int i = 0; i < 17; ++i) a.in[i] = (const float*)d_in[i];
    a.out = (float*)d_out; a.ws = (unsigned char*)d_ws;
#if MK_MODE == 0
    for (int ph = 0; ph < N_PHASES; ++ph) {
#if defined(NAIVE_MOBA)
        if (ph == 4) hipLaunchKernelGGL(naive_moba, dim3(M_TOK), dim3(512), 0, stream, (unsigned char*)d_ws);
#endif
#if defined(DBG_NAIVE_MOBA_LATE)
        if (ph == 7) hipLaunchKernelGGL(naive_moba, dim3(M_TOK), dim3(512), 0, stream, (unsigned char*)d_ws);
#endif
#if defined(NAIVE_MLSTM)
        if (ph == 4) hipLaunchKernelGGL(naive_mlstm, dim3(ML_H), dim3(256), 0, stream, (unsigned char*)d_ws, (const float*)d_in[7], (const float*)d_in[8], (const float*)d_in[9]);
#endif
        a.ph_lo = ph; a.ph_hi = ph + 1; a.li = 0;
        hipLaunchKernelGGL(mk_fwd, dim3(grid), dim3(NWAVES * 64), LDS_BYTES, stream, a);
#if defined(DBG_X2_TWICE)
        if (ph == 5) {
            unsigned* dc = (unsigned*)((char*)d_ws + WS_CTL) + 32768;
            (void)hipMemcpyAsync((char*)d_ws + WS_LOCAL, (char*)d_ws + WS_PART3, 32 * MiB, hipMemcpyDeviceToDevice, stream);
            hipLaunchKernelGGL(mk_fwd, dim3(grid), dim3(NWAVES * 64), LDS_BYTES, stream, a);
            hipLaunchKernelGGL(dbg_cmp_u32, dim3(1024), dim3(256), 0, stream, (const unsigned*)((char*)d_ws + WS_LOCAL), (const unsigned*)((char*)d_ws + WS_PART3), (size_t)(8 * MiB), dc);
            hipLaunchKernelGGL(dbg_check_own, dim3(M_TOK), dim3(512), 0, stream, (unsigned char*)d_ws, dc + 1);
        }
#endif
    }
#if defined(DBG_X2_TWICE)
    hipLaunchKernelGGL(dbg_flag, dim3(1), dim3(64), 0, stream, (const unsigned*)((char*)d_ws + WS_CTL) + 32768, (float*)d_out);
#endif
#else
    a.ph_lo = 0; a.ph_hi = N_PHASES; a.li = 0;
    hipLaunchKernelGGL(mk_fwd, dim3(grid), dim3(NWAVES * 64), LDS_BYTES, stream, a);
#endif
    const hipError_t le = hipPeekAtLastError();
    if (le != hipSuccess) fprintf(stderr, "kernel_launch: launch failed: %s\n", hipGetErrorName(le));
}
```

```cpp
#include <hip/hip_runtime.h>
#include <cstdio>
#include <cstdint>
#include <cmath>
namespace pg8 {
#define PG8_LAS __attribute__((address_space(3)))
typedef unsigned short bf16_t;
typedef short bf16x8 __attribute__((ext_vector_type(8)));
typedef float f32x4 __attribute__((ext_vector_type(4)));
typedef unsigned u32x4 __attribute__((ext_vector_type(4)));
constexpr int BM = 256, BK = 64, HALF = 128, HTB = HALF * BK * 2  , STAGE_BYTES = 8 * HTB, NXCD = 8, WGM = 4;

__host__ __device__ __forceinline__ int lds_byte(int r, int c) { const int st = (r >> 4) * 2 + (c >> 5), rr = r & 15, cc = c & 31, ob = rr * 64 + cc * 2; return st * 1024 + (ob ^ (((ob >> 9) & 1) << 5)); }
__host__ __device__ __forceinline__ void stage_rc(int b, int& R, int& C) { const int st = b / 1024, sb = b % 1024, swz = sb ^ (((sb >> 9) & 1) << 5); R = (st >> 1) * 16 + swz / 64; C = (st & 1) * 32 + (swz % 64) / 2; }
__host__ __device__ __forceinline__ int perm32(int rho) { const int n = rho >> 4, i = rho & 15; return 8 * (i >> 2) + 4 * n + (i & 3); }

struct Unit { int pm, pn; };
struct Gemm { const bf16_t* A; const bf16_t* Bt; int M, N, K; };

struct StaticOrder {
    int nM, nN, nwg, G, c, wgm;
    __host__ __device__ void init(int M, int N, int G_, int c_, int wgm_ = WGM) { nM = M / BM; nN = N / BM; nwg = nM * nN; G = G_; c = c_; wgm = wgm_; }
    __host__ __device__ bool next(int i, Unit& u) const {
        const long L = (long)i * G + c; if (L >= nwg) return false;
        int wgid = (int)L; { const int q = nwg / NXCD, r = nwg % NXCD, xcd = wgid % NXCD, off = wgid / NXCD; wgid = (xcd < r ? xcd * (q + 1) : r * (q + 1) + (xcd - r) * q) + off; }
        const int nig = wgm * nN, gid = wgid / nig, fm = gid * wgm, gsz = (nM - fm) < wgm ? (nM - fm) : wgm;
        u.pm = fm + ((wgid % nig) % gsz); u.pn = (wgid % nig) / gsz; return true;
    }
    __device__ __forceinline__ void a_ready(const Unit&) const {}
    __device__ __forceinline__ void done(const Unit&) const {}
};

typedef float cvp_f32x2_t __attribute__((ext_vector_type(2))); typedef __bf16 cvp_bf16x2_t __attribute__((ext_vector_type(2)));
__device__ __forceinline__ unsigned cvt_pk_bf16(float lo, float hi) { cvp_f32x2_t v = {lo, hi}; cvp_bf16x2_t b = __builtin_convertvector(v, cvp_bf16x2_t); return __builtin_bit_cast(unsigned, b); }
typedef float f32x2 __attribute__((ext_vector_type(2)));
__device__ __forceinline__ f32x2 gelu_pk(f32x2 v) {
    const f32x2 av = __builtin_elementwise_abs(v), d = av * 0.2316418882f + 1.0f;
    f32x2 t; t.x = __builtin_amdgcn_rcpf(d.x); t.y = __builtin_amdgcn_rcpf(d.y);
    f32x2 q = t * 0.5307027145f + (-0.7265760135f); q = q * t + 0.7107068705f; q = q * t + (-0.142248368f); q = q * t + 0.127414796f; q = q * t;
    const f32x2 s = (v * v) * (-0.72134752044f);
    f32x2 e; e.x = __builtin_amdgcn_exp2f(s.x); e.y = __builtin_amdgcn_exp2f(s.y);
    const f32x2 m = v * (q * e), r = v - m;
    f32x2 o; o.x = v.x < 0.f ? m.x : r.x; o.y = v.y < 0.f ? m.y : r.y; return o;
}

template <int ACT  > struct EpiBf16 {
    static constexpr bool PERM = true, AFTER_DRAIN = false; static_assert(ACT == 0 || ACT == 1, "EpiBf16: ACT is 0 (none) or 1 (gelu_pk)");
    bf16_t* O; int ldc; const float* bias; int split_cols; size_t split_stride; float scale0;
    __device__ __forceinline__ void operator()(const f32x4 (&acc)[2][2][4][2], const Unit& u, int wr, int wc, int fr, int fq) const {
        const int row0 = u.pm * BM + wr * 64 + fr; int colt = u.pn * BM; bf16_t* base = O;
        float sc = 1.f; if (split_cols) { const int t = colt / split_cols; base += (size_t)t * split_stride; colt -= t * split_cols; if (t == 0) sc = scale0; }
        const int col0 = colt + wc * 32 + 8 * fq, bcol0 = u.pn * BM + wc * 32 + 8 * fq;
        f32x4 bv[2][2];
#pragma unroll
        for (int bj = 0; bj < 2; ++bj)
#pragma unroll
            for (int n = 0; n < 2; ++n) bv[bj][n] = bias ? *(const f32x4*)(bias + bcol0 + bj * HALF + 4 * n) : (f32x4){0.f, 0.f, 0.f, 0.f};
#pragma unroll
        for (int ai = 0; ai < 2; ++ai)
#pragma unroll
            for (int m = 0; m < 4; ++m) { bf16_t* rowp = base + (size_t)(row0 + ai * HALF + m * 16) * ldc + col0;
#pragma unroll
                for (int bj = 0; bj < 2; ++bj) { f32x4 v0 = acc[ai][bj][m][0] + bv[bj][0], v1 = acc[ai][bj][m][1] + bv[bj][1];
                    if (ACT == 1) { f32x2 a = gelu_pk((f32x2){v0[0], v0[1]}), b = gelu_pk((f32x2){v0[2], v0[3]}), c = gelu_pk((f32x2){v1[0], v1[1]}), d = gelu_pk((f32x2){v1[2], v1[3]});
                        v0 = (f32x4){a.x, a.y, b.x, b.y}; v1 = (f32x4){c.x, c.y, d.x, d.y}; }
                    v0 = v0 * sc; v1 = v1 * sc; u32x4 w; w.x = cvt_pk_bf16(v0[0], v0[1]); w.y = cvt_pk_bf16(v0[2], v0[3]); w.z = cvt_pk_bf16(v1[0], v1[1]); w.w = cvt_pk_bf16(v1[2], v1[3]);
                    *(u32x4*)(rowp + bj * HALF) = w; } }
    }
};

struct PanelStats {
    unsigned* xbuf;
    unsigned* cnt;
    unsigned* tmo;
    int ntn; float eps;
    unsigned code;
    __device__ __forceinline__ bool run(const f32x4 (&v)[2][2][4][2], const Unit& u, int wr, int wc, int fr, int fq, PG8_LAS unsigned char* lds, int wid, int lane) const {
        typedef float f32x2v __attribute__((ext_vector_type(2)));
        PG8_LAS f32x2v* P = (PG8_LAS f32x2v*)lds;
        PG8_LAS f32x2v* S = (PG8_LAS f32x2v*)(lds + 8192);
        PG8_LAS unsigned* flag = (PG8_LAS unsigned*)(lds + 8192 + 2048);
#pragma unroll
        for (int ai = 0; ai < 2; ++ai)
#pragma unroll
            for (int m = 0; m < 4; ++m) {
                float s = 0.f;
#pragma unroll
                for (int bj = 0; bj < 2; ++bj)
#pragma unroll
                    for (int n = 0; n < 2; ++n) { const f32x4 x = v[ai][bj][m][n]; s += (x[0] + x[1]) + (x[2] + x[3]); }
                s += __shfl_xor(s, 16); s += __shfl_xor(s, 32);
                const float mw = s * (1.0f / 64.0f); float q = 0.f;
#pragma unroll
                for (int bj = 0; bj < 2; ++bj)
#pragma unroll
                    for (int n = 0; n < 2; ++n) { const f32x4 d = v[ai][bj][m][n] - mw; q += (d[0] * d[0] + d[1] * d[1]) + (d[2] * d[2] + d[3] * d[3]); }
                q += __shfl_xor(q, 16); q += __shfl_xor(q, 32);
                if (fq == 0) P[(ai * HALF + wr * 64 + m * 16 + fr) * 4 + wc] = (f32x2v){mw, q};
            }
        asm volatile("s_waitcnt lgkmcnt(0)" ::: "memory"); __builtin_amdgcn_s_barrier(); asm volatile("" ::: "memory");
#if defined(BROKEN_EXCHANGE_NO_WAIT)
#warning BROKEN CONTROL BUILD: the row-statistics exchange does not wait; results are wrong by design
        if (blockIdx.x >= 64) { const long long t0_ = clock64(); while (clock64() - t0_ < 60000) __builtin_amdgcn_s_sleep(8); }
#endif
        const int row = wid * 32 + (lane & 31);
        if (lane < 32) {
            const f32x2v a = P[row * 4 + 0], b = P[row * 4 + 1], c = P[row * 4 + 2], d = P[row * 4 + 3];
            const float mt = (a.x + b.x + c.x + d.x) * 0.25f;
            const float da = a.x - mt, db = b.x - mt, dc = c.x - mt, dd = d.x - mt;
            const float m2 = (a.y + b.y) + (c.y + d.y) + 64.0f * ((da * da + db * db) + (dc * dc + dd * dd));
            unsigned long long* slot = (unsigned long long*)xbuf + ((size_t)(u.pm * BM + row) * 4 + u.pn);
            __hip_atomic_store(slot, ((unsigned long long)__float_as_uint(m2) << 32) | __float_as_uint(mt), __ATOMIC_RELAXED, __HIP_MEMORY_SCOPE_AGENT);
        }
        asm volatile("s_waitcnt vmcnt(0)" ::: "memory");
        if (lane == 0) __hip_atomic_fetch_add(cnt + 64 * u.pm, 1u, __ATOMIC_RELAXED, __HIP_MEMORY_SCOPE_AGENT);
        if (wid == 0) {
            bool dead = false; const unsigned long long t0 = __builtin_amdgcn_s_memrealtime(); const unsigned want = 8u * (unsigned)ntn;
            for (;;) {
#if defined(BROKEN_EXCHANGE_NO_WAIT)
                break;
#endif
                if ((unsigned)__builtin_amdgcn_readfirstlane(__hip_atomic_load(cnt + 64 * u.pm, __ATOMIC_RELAXED, __HIP_MEMORY_SCOPE_AGENT)) >= want) break;
                if (__builtin_amdgcn_s_memrealtime() - t0 > 2000000ull) {
                    if (lane == 0) { unsigned expect = 0u; __hip_atomic_compare_exchange_strong(tmo + 1, &expect, code | (unsigned)(u.pm & 0xff), __ATOMIC_RELAXED, __ATOMIC_RELAXED, __HIP_MEMORY_SCOPE_AGENT);
                                     __hip_atomic_store(tmo, 1u, __ATOMIC_RELAXED, __HIP_MEMORY_SCOPE_AGENT); }
                    dead = true; break; }
                __builtin_amdgcn_s_sleep(2);
            }
            __builtin_amdgcn_fence(__ATOMIC_ACQUIRE, "agent");
            if (lane == 0) flag[0] = dead ? 1u : 0u;
        }
        asm volatile("s_waitcnt vmcnt(0) lgkmcnt(0)" ::: "memory"); __builtin_amdgcn_s_barrier(); asm volatile("" ::: "memory");
        const bool bad = flag[0] != 0u;
        if (lane < 32) {
            const unsigned long long* slot = (const unsigned long long*)xbuf + (size_t)(u.pm * BM + row) * 4; float mt[4], m2[4]; float ms = 0.f;
#pragma unroll
            for (int t = 0; t < 4; ++t) { if (t < ntn) { const unsigned long long w = __hip_atomic_load(slot + t, __ATOMIC_RELAXED, __HIP_MEMORY_SCOPE_AGENT); mt[t] = __uint_as_float((unsigned)w); m2[t] = __uint_as_float((unsigned)(w >> 32)); } else { mt[t] = 0.f; m2[t] = 0.f; } ms += mt[t]; }
            const float mean = ms / (float)ntn; float q = 0.f;
#pragma unroll
            for (int t = 0; t < 4; ++t) if (t < ntn) { const float dm = mt[t] - mean; q += m2[t] + 256.0f * dm * dm; }
            S[row] = (f32x2v){mean, 1.0f / sqrtf(q / (256.0f * (float)ntn) + eps)};
        }
        asm volatile("s_waitcnt lgkmcnt(0)" ::: "memory"); __builtin_amdgcn_s_barrier(); asm volatile("" ::: "memory");
        return bad;
    }
};
struct EpiLnRes {
    static constexpr bool PERM = false, AFTER_DRAIN = true;
    const float* base; float* out; int ldc; const float* bias; PanelStats st; unsigned poison;
    __device__ __forceinline__ void fused(f32x4 (&acc)[2][2][4][2], const Unit& u, int wr, int wc, int fr, int fq, PG8_LAS unsigned char* lds, int wid, int lane) const {
        typedef float f32x2v __attribute__((ext_vector_type(2)));
        const PG8_LAS f32x2v* S = (const PG8_LAS f32x2v*)(lds + 8192);
        const int col0 = u.pn * BM + wc * 32 + 4 * fq;
#pragma unroll
        for (int bj = 0; bj < 2; ++bj)
#pragma unroll
            for (int n = 0; n < 2; ++n) { const f32x4 bv = bias ? *(const f32x4*)(bias + col0 + bj * HALF + n * 16) : (f32x4){0.f, 0.f, 0.f, 0.f};
#pragma unroll
                for (int ai = 0; ai < 2; ++ai)
#pragma unroll
                    for (int m = 0; m < 4; ++m) acc[ai][bj][m][n] += bv; }
        f32x4 pre[4][2][2];
#pragma unroll
        for (int m = 0; m < 4; ++m) { const size_t off = (size_t)(u.pm * BM + wr * 64 + m * 16 + fr) * ldc + col0;
#pragma unroll
            for (int bj = 0; bj < 2; ++bj)
#pragma unroll
                for (int n = 0; n < 2; ++n) pre[m][bj][n] = *(const f32x4*)(base + off + bj * HALF + n * 16); }
        const bool bad = st.run(acc, u, wr, wc, fr, fq, lds, wid, lane) || poison != 0u;
        const float qnan = __builtin_nanf("");
#pragma unroll
        for (int ai = 0; ai < 2; ++ai)
#pragma unroll
            for (int m = 0; m < 4; ++m) { const int r = ai * HALF + wr * 64 + m * 16 + fr; const f32x2v sr = S[r]; const size_t off = (size_t)(u.pm * BM + r) * ldc + col0;
#pragma unroll
                for (int bj = 0; bj < 2; ++bj)
#pragma unroll
                    for (int n = 0; n < 2; ++n) { const f32x4 bs = ai == 0 ? pre[m][bj][n] : *(const f32x4*)(base + off + bj * HALF + n * 16); f32x4 o = bs + (acc[ai][bj][m][n] - sr.x) * sr.y;
                        if (bad) o = (f32x4){qnan, qnan, qnan, qnan}; *(f32x4*)(out + off + bj * HALF + n * 16) = o; }
                if (m & 1) asm volatile("" ::: "memory"); }
    }
};
struct EpiLnResLn {
    static constexpr bool PERM = false, AFTER_DRAIN = true;
    const float* base; float* out; bf16_t* xn; int ldc; const float* bias; PanelStats st1, st2; unsigned poison;
    __device__ __forceinline__ void fused(f32x4 (&acc)[2][2][4][2], const Unit& u, int wr, int wc, int fr, int fq, PG8_LAS unsigned char* lds, int wid, int lane) const {
        typedef float f32x2v __attribute__((ext_vector_type(2))); typedef unsigned u32x2v __attribute__((ext_vector_type(2)));
        const PG8_LAS f32x2v* S = (const PG8_LAS f32x2v*)(lds + 8192);
        const int col0 = u.pn * BM + wc * 32 + 4 * fq;
#pragma unroll
        for (int bj = 0; bj < 2; ++bj)
#pragma unroll
            for (int n = 0; n < 2; ++n) { const f32x4 bv = bias ? *(const f32x4*)(bias + col0 + bj * HALF + n * 16) : (f32x4){0.f, 0.f, 0.f, 0.f};
#pragma unroll
                for (int ai = 0; ai < 2; ++ai)
#pragma unroll
                    for (int m = 0; m < 4; ++m) acc[ai][bj][m][n] += bv; }
        bool bad = st1.run(acc, u, wr, wc, fr, fq, lds, wid, lane) || poison != 0u;
        const float qnan = __builtin_nanf("");
#pragma unroll
        for (int ai = 0; ai < 2; ++ai)
#pragma unroll
            for (int m = 0; m < 4; ++m) { const int r = ai * HALF + wr * 64 + m * 16 + fr; const f32x2v sr = S[r]; const size_t off = (size_t)(u.pm * BM + r) * ldc + col0;
#pragma unroll
                for (int bj = 0; bj < 2; ++bj)
#pragma unroll
                    for (int n = 0; n < 2; ++n) { const f32x4 bs = *(const f32x4*)(base + off + bj * HALF + n * 16); acc[ai][bj][m][n] = bs + (acc[ai][bj][m][n] - sr.x) * sr.y; }
                asm volatile("" : "+v"(acc[ai][0][m][0]), "+v"(acc[ai][0][m][1]), "+v"(acc[ai][1][m][0]), "+v"(acc[ai][1][m][1]));
                if (m & 1) asm volatile("" ::: "memory"); }
        const bool bad1 = bad;
        bad = st2.run(acc, u, wr, wc, fr, fq, lds, wid, lane) || bad;
#pragma unroll
        for (int ai = 0; ai < 2; ++ai)
#pragma unroll
            for (int m = 0; m < 4; ++m) { const int r = ai * HALF + wr * 64 + m * 16 + fr; const f32x2v sr = S[r]; const size_t off = (size_t)(u.pm * BM + r) * ldc + col0;
#pragma unroll
                for (int bj = 0; bj < 2; ++bj)
#pragma unroll
                    for (int n = 0; n < 2; ++n) { const f32x4 x1 = acc[ai][bj][m][n]; *(f32x4*)(out + off + bj * HALF + n * 16) = bad1 ? (f32x4){qnan, qnan, qnan, qnan} : x1;
                        const f32x4 o = (x1 - sr.x) * sr.y; u32x2v w; w.x = cvt_pk_bf16(o[0], o[1]); w.y = cvt_pk_bf16(o[2], o[3]);
                        if (bad) { w.x = 0x7fc07fc0u; w.y = 0x7fc07fc0u; } *(u32x2v*)(xn + off + bj * HALF + n * 16) = w; }
                asm volatile("" ::: "memory"); }
    }
};

template <class Epi, class Sched, bool ALIGN_EPI = false, bool SP2 = false>
__device__ __forceinline__ void gemm_phase(PG8_LAS unsigned char* lds, const Gemm g, const Sched& S, const Epi& E) {
    const int tid = threadIdx.x, wid = __builtin_amdgcn_readfirstlane(tid >> 6), lane = tid & 63, wr = wid >> 2, wc = wid & 3, fr = lane & 15, fq = lane >> 4;
    const int K = g.K, nt = K / BK;
    unsigned voffA[2], voffB[2];
#pragma unroll
    for (int i = 0; i < 2; ++i) { int R, C; stage_rc(tid * 16 + i * 8192, R, C); const int Rb = Epi::PERM ? ((R & ~31) + perm32(R & 31)) : R;
        voffA[i] = (unsigned)(R * K + C) * 2u; voffB[i] = (unsigned)(Rb * K + C) * 2u; }
    const size_t kstep = (size_t)(BK * 2);
    const size_t hstep = (size_t)HALF * K * 2;
    const size_t tstep = 2 * hstep;
    const unsigned ldsw = (unsigned)wid * 1024u;
    const int aoff = lds_byte(wr * 64 + fr, fq * 8), boff = lds_byte(wc * 32 + fr, fq * 8);
#define PG8_SA(b, h) (((b) * 2 + (h)) * HTB)
#define PG8_SB(b, h) ((4 + (b) * 2 + (h)) * HTB)
#define PG8_STAGE(bufoff, gbase, voff) do { _Pragma("unroll") for (int _i = 0; _i < 2; ++_i) \
        __builtin_amdgcn_global_load_lds((const unsigned*)((const char*)(gbase) + (voff)[_i]), (PG8_LAS unsigned*)(lds + (bufoff) + ldsw + _i * 8192), 16, 0, 0); } while (0)
#define PG8_LDA(dst, b, h) do { _Pragma("unroll") for (int m = 0; m < 4; ++m) _Pragma("unroll") for (int k = 0; k < 2; ++k) dst[m][k] = *(const PG8_LAS bf16x8*)(lds + PG8_SA(b, h) + aoff + m * 2048 + k * 1024); } while (0)
#define PG8_LDB(dst, b, h) do { _Pragma("unroll") for (int n = 0; n < 2; ++n) _Pragma("unroll") for (int k = 0; k < 2; ++k) dst[n][k] = *(const PG8_LAS bf16x8*)(lds + PG8_SB(b, h) + boff + n * 2048 + k * 1024); } while (0)
#define PG8_MMA(ai, bj, At, Bt) do { __builtin_amdgcn_s_setprio(1); _Pragma("unroll") for (int m = 0; m < 4; ++m) _Pragma("unroll") for (int n = 0; n < 2; ++n) _Pragma("unroll") for (int k = 0; k < 2; ++k) \
        acc[ai][bj][m][n] = __builtin_amdgcn_mfma_f32_16x16x32_bf16(Bt[n][k], At[m][k], acc[ai][bj][m][n], 0, 0, 0); __builtin_amdgcn_s_setprio(0); } while (0)
#define PG8_WAIT_V(n) asm volatile("s_waitcnt vmcnt(" #n ")" ::: "memory")
#define PG8_WAIT_L(n) asm volatile("s_waitcnt lgkmcnt(" #n ")" ::: "memory")
#define PG8_BAR __builtin_amdgcn_s_barrier()
#define PG8_SCHED __builtin_amdgcn_sched_barrier(0)
    Unit cur, nxt; int ui = 0;
    if (!S.next(0, cur)) return;
    f32x4 acc[2][2][4][2];
#pragma unroll
    for (int a = 0; a < 2; ++a)
#pragma unroll
        for (int b = 0; b < 2; ++b)
#pragma unroll
            for (int m = 0; m < 4; ++m)
#pragma unroll
                for (int n = 0; n < 2; ++n) acc[a][b][m][n] = (f32x4){0.f, 0.f, 0.f, 0.f};
    bf16x8 At[4][2], B0[2][2], B1[2][2];
    const char* cA = (const char*)g.A + (size_t)cur.pm * tstep; const char* cB = (const char*)g.Bt + (size_t)cur.pn * tstep;
    S.a_ready(cur);
    if constexpr (SP2) {
        PG8_STAGE(PG8_SB(0, 0), cB, voffB); PG8_STAGE(PG8_SB(0, 1), cB + hstep, voffB); PG8_STAGE(PG8_SA(0, 0), cA, voffA); PG8_STAGE(PG8_SA(0, 1), cA + hstep, voffA);
        if (wr == 1) PG8_BAR;
        PG8_WAIT_V(2); PG8_BAR;
        PG8_STAGE(PG8_SB(1, 0), cB + kstep, voffB); PG8_STAGE(PG8_SA(1, 0), cA + kstep, voffA); PG8_STAGE(PG8_SB(1, 1), cB + hstep + kstep, voffB);
        PG8_WAIT_V(6); PG8_BAR;
    } else {
        PG8_STAGE(PG8_SB(0, 0), cB, voffB); PG8_STAGE(PG8_SA(0, 0), cA, voffA); PG8_STAGE(PG8_SB(0, 1), cB + hstep, voffB); PG8_STAGE(PG8_SA(0, 1), cA + hstep, voffA);
        if (wr == 1) PG8_BAR;
        PG8_WAIT_V(4); PG8_BAR;
        PG8_STAGE(PG8_SB(1, 0), cB + kstep, voffB); PG8_STAGE(PG8_SA(1, 0), cA + kstep, voffA); PG8_STAGE(PG8_SB(1, 1), cB + hstep + kstep, voffB);
        PG8_WAIT_V(6); PG8_BAR;
    }
    for (;;) {
        const bool has_next = S.next(ui + 1, nxt);
        const char* nA = has_next ? (const char*)g.A + (size_t)nxt.pm * tstep : cA; const char* nB = has_next ? (const char*)g.Bt + (size_t)nxt.pn * tstep : cB;
        for (int t = 0; t < nt; t += 2) {
            const bool last = (t == nt - 2);
            const char* a1 = cA + (size_t)(t + 1) * kstep;
            const char* a2 = last ? nA : cA + (size_t)(t + 2) * kstep; const char* b2 = last ? nB : cB + (size_t)(t + 2) * kstep;
            const char* a3 = a2 + kstep; const char* b3 = b2 + kstep;
            if (last && has_next) S.a_ready(nxt);
            if constexpr (SP2) {
            PG8_LDB(B0, 0, 0); PG8_LDB(B1, 0, 1); PG8_SCHED; PG8_LDA(At, 0, 0); PG8_STAGE(PG8_SA(1, 1), a1 + hstep, voffA);
            PG8_WAIT_V(8); PG8_WAIT_L(0); PG8_BAR; PG8_MMA(0, 0, At, B0); PG8_MMA(0, 1, At, B1); PG8_BAR; PG8_SCHED;
            PG8_LDA(At, 0, 1); PG8_STAGE(PG8_SB(0, 0), b2, voffB); PG8_STAGE(PG8_SB(0, 1), b2 + hstep, voffB); PG8_STAGE(PG8_SA(0, 0), a2, voffA);
            PG8_WAIT_V(8); PG8_WAIT_L(0); PG8_BAR; PG8_MMA(1, 0, At, B0); PG8_MMA(1, 1, At, B1); PG8_BAR; PG8_SCHED;
            PG8_LDB(B0, 1, 0); PG8_LDB(B1, 1, 1); PG8_SCHED; PG8_LDA(At, 1, 0); PG8_STAGE(PG8_SA(0, 1), a2 + hstep, voffA);
            PG8_WAIT_V(8); PG8_WAIT_L(0); PG8_BAR; PG8_MMA(0, 0, At, B0); PG8_MMA(0, 1, At, B1); PG8_BAR; PG8_SCHED;
            PG8_LDA(At, 1, 1); PG8_STAGE(PG8_SB(1, 0), b3, voffB); PG8_STAGE(PG8_SB(1, 1), b3 + hstep, voffB); PG8_STAGE(PG8_SA(1, 0), a3, voffA);
            PG8_WAIT_V(8); PG8_WAIT_L(0); PG8_BAR; PG8_MMA(1, 0, At, B0); PG8_MMA(1, 1, At, B1); PG8_BAR; PG8_SCHED;
            } else {
            PG8_LDB(B0, 0, 0); PG8_SCHED; PG8_LDA(At, 0, 0); PG8_STAGE(PG8_SA(1, 1), a1 + hstep, voffA);
            PG8_WAIT_L(8); PG8_BAR; PG8_WAIT_L(0); PG8_MMA(0, 0, At, B0); PG8_BAR; PG8_SCHED;
            PG8_LDB(B1, 0, 1); PG8_STAGE(PG8_SB(0, 0), b2, voffB);
            PG8_BAR; PG8_WAIT_L(0); PG8_MMA(0, 1, At, B1); PG8_BAR;
            PG8_LDA(At, 0, 1); PG8_STAGE(PG8_SA(0, 0), a2, voffA);
            PG8_BAR; PG8_WAIT_L(0); PG8_MMA(1, 0, At, B0); PG8_BAR; PG8_SCHED;
            PG8_STAGE(PG8_SB(0, 1), b2 + hstep, voffB);
            PG8_WAIT_V(6); PG8_BAR; PG8_MMA(1, 1, At, B1); PG8_BAR;
            PG8_LDB(B0, 1, 0); PG8_SCHED; PG8_LDA(At, 1, 0); PG8_STAGE(PG8_SA(0, 1), a2 + hstep, voffA);
            PG8_WAIT_L(8); PG8_BAR; PG8_WAIT_L(0); PG8_MMA(0, 0, At, B0); PG8_BAR; PG8_SCHED;
            PG8_LDB(B1, 1, 1); PG8_STAGE(PG8_SB(1, 0), b3, voffB);
            PG8_BAR; PG8_WAIT_L(0); PG8_MMA(0, 1, At, B1); PG8_BAR;
            PG8_LDA(At, 1, 1); PG8_STAGE(PG8_SA(1, 0), a3, voffA);
            PG8_BAR; PG8_WAIT_L(0); PG8_MMA(1, 0, At, B0); PG8_BAR; PG8_SCHED;
            PG8_STAGE(PG8_SB(1, 1), b3 + hstep, voffB);
            PG8_WAIT_V(6); PG8_BAR; PG8_MMA(1, 1, At, B1); PG8_BAR;
            }
        }
        if constexpr (ALIGN_EPI) { if (wr == 0) PG8_BAR; }
        if constexpr (!Epi::AFTER_DRAIN) { E(acc, cur, wr, wc, fr, fq); S.done(cur); }
        if (!has_next) break;
#pragma unroll
        for (int a = 0; a < 2; ++a)
#pragma unroll
            for (int b = 0; b < 2; ++b)
#pragma unroll
                for (int m = 0; m < 4; ++m)
#pragma unroll
                    for (int n = 0; n < 2; ++n) acc[a][b][m][n] = (f32x4){0.f, 0.f, 0.f, 0.f};
        cur = nxt; cA = nA; cB = nB; ++ui;
        if constexpr (ALIGN_EPI) { if (wr == 1) PG8_BAR; }
    }
    PG8_WAIT_V(0);
    if constexpr (!ALIGN_EPI) { if (wr == 0) PG8_BAR; }
    PG8_BAR;
    if constexpr (Epi::AFTER_DRAIN) { E.fused(acc, cur, wr, wc, fr, fq, lds, wid, lane); S.done(cur); }
#undef PG8_SA
#undef PG8_SB
#undef PG8_STAGE
#undef PG8_LDA
#undef PG8_LDB
#undef PG8_MMA
#undef PG8_WAIT_V
#undef PG8_WAIT_L
#undef PG8_BAR
#undef PG8_SCHED
}
}
#define GAS __attribute__((address_space(1)))
#define LAS __attribute__((address_space(3)))
typedef unsigned short bf16;
typedef unsigned v4u __attribute__((ext_vector_type(4)));
typedef float f32x4 __attribute__((ext_vector_type(4)));
typedef short bf16x8 __attribute__((ext_vector_type(8)));
typedef GAS unsigned gu32;
typedef GAS unsigned long long gu64;
#define RLX_AGENT __ATOMIC_RELAXED, __HIP_MEMORY_SCOPE_AGENT
#define LDS_WAIT() asm volatile("s_waitcnt lgkmcnt(0)" ::: "memory")
#define VM_WAIT() asm volatile("s_waitcnt vmcnt(0)" ::: "memory")
__device__ __forceinline__ unsigned long long rt() { return __builtin_amdgcn_s_memrealtime(); }
__device__ __forceinline__ unsigned f2bf(float f) { unsigned u = __builtin_bit_cast(unsigned, f); return (u + 0x7fffu + ((u >> 16) & 1u)) >> 16; }
__device__ __forceinline__ unsigned pk2(float lo, float hi) { return f2bf(lo) | (f2bf(hi) << 16); }
#define XB_TMO      128
#define XB_XCNT(j)  (256  + 64 * (j))
#define XB_XSUB(j)  (1280 + 64 * (j))
#define XB_XGEN(j)  (2304 + 64 * (j))
#define XB_TOP      3328
#define XB_TOPGEN   3392
#define XCD_BAR_WORDS 3456
#define XB_SPIN_CAP (1u << 18)

__device__ __forceinline__ unsigned xb_ld(unsigned* p)              { return __hip_atomic_load(p, __ATOMIC_RELAXED, __HIP_MEMORY_SCOPE_AGENT); }
__device__ __forceinline__ unsigned xb_add(unsigned* p, unsigned v) { return __hip_atomic_fetch_add(p, v, __ATOMIC_RELAXED, __HIP_MEMORY_SCOPE_AGENT); }
__device__ __forceinline__ unsigned xb_xcc_id() { return (unsigned)__builtin_amdgcn_s_getreg((3 << 11) | 20) & 0xFu; }
#define XB_SPIN(cond, bar) do { unsigned _sp = 0; while (cond) { __builtin_amdgcn_s_sleep(1); \
    if ((++_sp & 255u) == 0u) { if (xb_ld(&(bar)[XB_TMO])) break; if (_sp > XB_SPIN_CAP) { atomicAdd(&(bar)[XB_TMO], 1u); break; } } } } while (0)

struct XcdBarrier {
    unsigned* bar; unsigned x;
    volatile LAS unsigned* st;
};

__device__ __forceinline__ XcdBarrier xcd_barrier_post(unsigned* bar, volatile LAS unsigned* st) {
    XcdBarrier b; b.bar = bar; b.x = xb_xcc_id(); b.st = st;
    if (threadIdx.x == 0) (void)xb_add(&bar[XB_XCNT(b.x)], 1u);
    return b;
}
__device__ __forceinline__ void xcd_barrier_complete(unsigned* bar, unsigned x, unsigned& nloc, unsigned& nx) {
    const unsigned G = gridDim.x * gridDim.y * gridDim.z;
    unsigned sum, cnt, mine, sp = 0u;
    for (;;) {
        sum = 0u; cnt = 0u; mine = 0u;
#pragma unroll
        for (unsigned j = 0; j < 16; ++j) { const unsigned c = xb_ld(&bar[XB_XCNT(j)]); sum += c; cnt += (c > 0u) ? 1u : 0u; mine = (j == x) ? c : mine; }
        if (sum == G) break;
        __builtin_amdgcn_s_sleep(1);
        if ((++sp & 255u) == 0u) { if (xb_ld(&bar[XB_TMO])) break; if (sp > XB_SPIN_CAP) { atomicAdd(&bar[XB_TMO], 1u); break; } }
    }
    nloc = mine > 0u ? mine : 1u; nx = cnt > 0u ? cnt : 1u;
}

__device__ __forceinline__ void xcd_barrier(const XcdBarrier& b) {
    asm volatile("s_waitcnt vmcnt(0)" ::: "memory");
    __syncthreads();
    if (threadIdx.x == 0) {
        unsigned* bar = b.bar;
        __builtin_amdgcn_s_waitcnt(0);
        unsigned nloc = b.st[0], nx = b.st[1];
        if (nloc == 0u) { xcd_barrier_complete(bar, b.x, nloc, nx); b.st[0] = nloc; b.st[1] = nx; }
        const unsigned old = xb_add(&bar[XB_XSUB(b.x)], 1u);
        const unsigned gen = old / nloc;
        if (old + 1u == (gen + 1u) * nloc) {
            __builtin_amdgcn_fence(__ATOMIC_RELEASE, "agent");
            asm volatile("s_waitcnt vmcnt(0)" ::: "memory");
            const unsigned og = xb_add(&bar[XB_TOP], 1u);
            const unsigned tg = og / nx;
            if (og + 1u == (tg + 1u) * nx) xb_add(&bar[XB_TOPGEN], 1u);
            else XB_SPIN(xb_ld(&bar[XB_TOPGEN]) == tg, bar);
            __builtin_amdgcn_fence(__ATOMIC_ACQUIRE, "agent");
            xb_add(&bar[XB_XGEN(b.x)], 1u);
            asm volatile("s_waitcnt vmcnt(0)" ::: "memory");
        } else {
            XB_SPIN(xb_ld(&bar[XB_XGEN(b.x)]) == gen, bar);
            __builtin_amdgcn_fence(__ATOMIC_ACQUIRE, "agent");
            asm volatile("s_waitcnt vmcnt(0)" ::: "memory");
        }
    }
    __syncthreads();
}
constexpr int NWAVES = 8;
#ifndef WGM_P2
#define WGM_P2 4
#endif
#ifndef WGM_P5
#define WGM_P5 4
#endif
#ifndef WGM_P6
#define WGM_P6 4
#endif
#ifndef WGM_P7
#define WGM_P7 1
#endif
constexpr int M_TOK = 16384, DM = 2048, NPROJ = 6144, WIN_LD = 6152, DFF = 5632, NGU = 11264, NADA = 12288;
constexpr int MB_H = 8, MB_DH = 128, MB_BLK = 256, MB_NB = 64;
constexpr int ML_H = 4, ML_DQK = 128, ML_DV = 256, ML_L = 64, ML_NC = 256;
constexpr float DN_ALPHA = 1.189207115002721f;
constexpr float LN_EPS = 1e-5f;
constexpr float K_SCALE = 0.08838834764831845f;

constexpr size_t MiB = 1u << 20;
constexpr size_t WS_CTL = 0, CTL_ZERO_BYTES = 128 * 1024;
constexpr size_t WS_SMALL = 1 * MiB;
constexpr size_t SM_ADA = 0, SM_C1 = 64 * 1024, SM_C2 = 128 * 1024, SM_KMEAN = 256 * 1024, SM_GATES = 512 * 1024, SM_TOKSC = 1 * MiB,
                 SM_CHSUM = 2 * MiB, SM_DECAY = 2 * MiB + 16 * 1024, SM_NLOC = 2 * MiB + 64 * 1024, SM_MUR = 3 * MiB;
constexpr size_t WS_WIN = 6 * MiB, WS_LISTS = 6 * MiB, WS_STATP = 6 * MiB;
constexpr size_t WS_WOUT = 30 * MiB, WS_WGU = 38 * MiB, WS_WDOWN = 82 * MiB;
constexpr size_t WS_U = 104 * MiB, WS_LOCAL = 104 * MiB, WS_Y1B = 104 * MiB;
constexpr size_t WS_MIX = 168 * MiB, WS_H = 168 * MiB;
constexpr size_t WS_KB = 232 * MiB, WS_VB = 264 * MiB, WS_MQK = 296 * MiB, WS_MV = 328 * MiB;
constexpr size_t WS_PART0 = 296 * MiB, WS_PART1 = 328 * MiB, WS_PART2 = 440 * MiB, WS_PART3 = 472 * MiB, WS_LSE = 504 * MiB;
constexpr size_t WS_QC = 360 * MiB, WS_KC = 376 * MiB, WS_KWT = 392 * MiB, WS_VT = 408 * MiB;
constexpr size_t WS_ROPE = 506 * MiB, WS_C12P = 508 * MiB, WS_ADAP = 511 * MiB;
constexpr size_t WS_Y1F = 384 * MiB, WS_END = 512 * MiB;
constexpr int CW_TMO = 0, CW_BAR = 4096, CW_CNT = 16384, CW_QUEUE = 20480, CW_PANEL = 24576;

constexpr int RING_BYTES = 131072, LDSCTL_OFF = RING_BYTES, MISC_OFF = LDSCTL_OFF + 320, LDS_BYTES = 147456;

typedef float f32x2 __attribute__((ext_vector_type(2)));
typedef unsigned u32x2 __attribute__((ext_vector_type(2)));

__device__ __forceinline__ float bf2f(unsigned short b) { return __builtin_bit_cast(float, (unsigned)b << 16); }
__device__ __forceinline__ float bflo(unsigned w) { return __builtin_bit_cast(float, w << 16); }
__device__ __forceinline__ float bfhi(unsigned w) { return __builtin_bit_cast(float, w & 0xffff0000u); }
__device__ __forceinline__ float sigmoid_f(float v) { return 1.f / (1.f + __expf(-v)); }
__device__ __forceinline__ float silu_f(float v) { return v / (1.f + __expf(-v)); }
__device__ __forceinline__ float logsigmoid_f(float v) { return fminf(v, 0.f) - log1pf(expf(-fabsf(v))); }

struct Frame {
    LAS unsigned char* lds;
    volatile LAS unsigned* MISC;
    gu32* ctl;
    int tid, lane, wave, G, bid;
    const float *x, *c, *w_ada, *b_ada, *w_in, *conv_w, *conv_b, *igb, *fgb, *normw, *w_out, *ln1_w, *ln1_b, *w_gu, *w_down, *ln2_w, *ln2_b;
    float* out; unsigned char* ws; unsigned long long tp0, tp1;
};
#if defined(TIME_PHASE)
#define TP_BEGIN(id) do { if (TIME_PHASE == (id)) F.tp0 = __builtin_amdgcn_s_memrealtime(); } while (0)
#define TP_END(id) do { if (TIME_PHASE == (id)) F.tp1 = __builtin_amdgcn_s_memrealtime(); } while (0)
#define TPA_BEGIN(id) unsigned long long tpa_t0_ = (TIME_PHASE == (id)) ? __builtin_amdgcn_s_memrealtime() : 0ull
#define TPA_END(id) do { if (TIME_PHASE == (id)) F.tp1 += __builtin_amdgcn_s_memrealtime() - tpa_t0_; } while (0)
#else
#define TPA_BEGIN(id) do { } while (0)
#define TPA_END(id) do { } while (0)
#define TP_BEGIN(id) do { } while (0)
#define TP_END(id) do { } while (0)
#endif
#define SMALLF(off) ((float*)(F.ws + WS_SMALL + (off)))

__device__ __forceinline__ float wave_sum(float v) {
#pragma unroll
    for (int o = 1; o < 64; o <<= 1) v += __shfl_xor(v, o);
    return v;
}

__device__ __forceinline__ void p0_transpose_item(const float* W, int K, int N, int ld, bf16* WT, LAS float* scr, int item, int lane) {
    const int nblk = N / 32, kb = item / nblk, nb = item % nblk, k0 = 64 * kb, n0 = 32 * nb;
    float ldv[32];
#pragma unroll
    for (int i = 0; i < 32; ++i) ldv[i] = W[(size_t)(k0 + 2 * i + (lane >> 5)) * ld + n0 + (lane & 31)];
#pragma unroll
    for (int i = 0; i < 32; ++i) scr[(2 * i + (lane >> 5)) * 33 + (lane & 31)] = ldv[i];
    LDS_WAIT(); asm volatile("" ::: "memory");
    const int c = lane & 7;
#pragma unroll
    for (int j = 0; j < 4; ++j) { const int n = (lane >> 3) + 8 * j; const LAS float* s = scr + (8 * c) * 33 + n;
        v4u o; o.x = pk2(s[0 * 33], s[1 * 33]); o.y = pk2(s[2 * 33], s[3 * 33]); o.z = pk2(s[4 * 33], s[5 * 33]); o.w = pk2(s[6 * 33], s[7 * 33]);
        *(GAS v4u*)(WT + (size_t)(n0 + n) * K + k0 + 8 * c) = o; }
    LDS_WAIT(); asm volatile("" ::: "memory");
}

__device__ __forceinline__ void p0_phase(Frame& F) {
    TP_BEGIN(120);
    {
        LAS float* sc = (LAS float*)(F.lds); LAS float* red = sc + 2048;
        for (int k = F.tid; k < DM; k += 512) sc[k] = silu_f(F.c[k]);
        __syncthreads();
        float* adap = (float*)(F.ws + WS_ADAP);
        for (int item = F.bid; item < 256; item += F.G) {
            const int kq = item >> 6, slab = item & 63;
            const int rg = F.tid / 48, cq = F.tid % 48;
            if (F.tid < 480) {
                f32x4 acc = {0.f, 0.f, 0.f, 0.f};
                const float* wp = F.w_ada + (size_t)(kq * 512) * NADA + slab * 192 + cq * 4;
#pragma unroll 13
                for (int k = rg; k < 512; k += 10) { const f32x4 w = *(const f32x4*)(wp + (size_t)k * NADA); acc += w * sc[kq * 512 + k]; }
                *(LAS f32x4*)(red + rg * 192 + cq * 4) = acc;
            }
            __syncthreads();
            if (F.tid < 192) { float s = 0.f;
#pragma unroll
                for (int g = 0; g < 10; ++g) s += red[g * 192 + F.tid];
                adap[(size_t)kq * NADA + slab * 192 + F.tid] = s; }
            __syncthreads();
        }
    }
    TP_END(120); TP_BEGIN(121);
    {
        LAS float* scr = (LAS float*)(F.lds + F.wave * 16384);
        const int gw = F.bid * NWAVES + F.wave, NGW = F.G * NWAVES;
        constexpr int I_IN = (DM / 64) * (NPROJ / 32), I_OUT = (DM / 64) * (DM / 32), I_DN = (DFF / 64) * (DM / 32);
        for (int it = gw; it < I_IN + I_OUT + I_DN; it += NGW) {
            int r = it;
            if (r < I_IN) { p0_transpose_item(F.w_in, DM, NPROJ, WIN_LD, (bf16*)(F.ws + WS_WIN), scr, r, F.lane); continue; } r -= I_IN;
            if (r < I_OUT) { p0_transpose_item(F.w_out, DM, DM, DM, (bf16*)(F.ws + WS_WOUT), scr, r, F.lane); continue; } r -= I_OUT;
            p0_transpose_item(F.w_down, DFF, DM, DM, (bf16*)(F.ws + WS_WDOWN), scr, r, F.lane);
        }
    }
    TP_END(121); TP_BEGIN(122);
    for (int i = F.bid * 512 + F.tid; i < MB_H * MB_NB * MB_DH; i += F.G * 512) SMALLF(SM_KMEAN)[i] = 0.f;
    for (int i = F.bid * 512 + F.tid; i < M_TOK * 2; i += F.G * 512) ((unsigned long long*)SMALLF(SM_MUR))[i] = 0ull;
    {
        const double INV[16] = {1.0, 0.44036660267178046, 0.19392274474868576, 0.08539710028576561, 0.03760603093086393, 0.016560440080994446, 0.007292664737217109, 0.003211445994752591,
                                0.001414213562373095, 0.000622772421914596, 0.0002742481756762073, 0.00012076973741146504, 5.318295896944988e-05, 2.341999896140934e-05, 1.031338537721246e-05, 4.5416704806078695e-06};
        float* rope = (float*)(F.ws + WS_ROPE);
        for (int idx = F.bid * 512 + F.tid; idx < M_TOK * 16; idx += F.G * 512) {
            const int pos = idx >> 4, i = idx & 15;
            double inv = INV[0];
#pragma unroll
            for (int j = 1; j < 16; ++j) inv = (i == j) ? INV[j] : inv;
            const double ang = (double)pos * inv;
            const double q = __builtin_floor(ang * 0.6366197723675814 + 0.5);
            double r = __builtin_fma(-q, 1.5707963267948966, ang); r = __builtin_fma(-q, 6.123233995736766e-17, r);
            const int qi = ((int)q) & 3; const double r2 = r * r;
            double cs = 1.0 + r2 * (-0.5 + r2 * (1.0 / 24 + r2 * (-1.0 / 720 + r2 * (1.0 / 40320 + r2 * (-1.0 / 3628800 + r2 * (1.0 / 479001600 + r2 * (-1.0 / 87178291200.0)))))));
            double sn = r * (1.0 + r2 * (-1.0 / 6 + r2 * (1.0 / 120 + r2 * (-1.0 / 5040 + r2 * (1.0 / 362880 + r2 * (-1.0 / 39916800 + r2 * (1.0 / 6227020800.0 + r2 * (-1.0 / 1307674368000.0))))))));
            double co, si;
            if (qi == 0) { co = cs; si = sn; } else if (qi == 1) { co = -sn; si = cs; } else if (qi == 2) { co = -cs; si = -sn; } else { co = sn; si = -cs; }
            rope[pos * 32 + i] = (float)co; rope[pos * 32 + 16 + i] = (float)si;
        }
    }
    TP_END(122);
}

__device__ __forceinline__ float ada_val(const Frame& F, int n) {
    const float* p = (const float*)(F.ws + WS_ADAP) + n;
    return ((p[0] + p[NADA]) + (p[2 * NADA] + p[3 * NADA])) + F.b_ada[n];
}
__device__ __forceinline__ void p1_wgu_item(Frame& F, LAS float* scr, int item) {
    const int lane = F.lane;
    constexpr int nblk = NGU / 32; const int kb = item / nblk, nb = item % nblk, k0 = 64 * kb, n0 = 32 * nb;
    const int pn = n0 >> 8, bj = (n0 >> 7) & 1, idx0 = n0 & 127;
    const int src0 = (bj ? DFF : 0) + pn * 128 + idx0;
    LAS float* wv = scr + 64 * 33; LAS float* bv = wv + 64;
    {   const int k = k0 + lane;
        const float s2 = 1.f + ada_val(F, 4 * DM + k); wv[lane] = F.ln1_w[k] * s2; bv[lane] = F.ln1_b[k] * s2 + ada_val(F, 3 * DM + k); }
    float ldv[32];
#pragma unroll
    for (int i = 0; i < 32; ++i) ldv[i] = F.w_gu[(size_t)(k0 + 2 * i + (lane >> 5)) * NGU + src0 + (lane & 31)];
#pragma unroll
    for (int i = 0; i < 32; ++i) scr[(2 * i + (lane >> 5)) * 33 + (lane & 31)] = ldv[i];
    LDS_WAIT(); asm volatile("" ::: "memory");
    const int c = lane & 7; bf16* WT = (bf16*)(F.ws + WS_WGU);
    float* c1p = (float*)(F.ws + WS_C12P) + (size_t)kb * NGU; float* c2p = (float*)(F.ws + WS_C12P) + (size_t)(32 + kb) * NGU;
#pragma unroll
    for (int j = 0; j < 4; ++j) { const int n = (lane >> 3) + 8 * j; const LAS float* s = scr + (8 * c) * 33 + n;
        float v[8], s1 = 0.f, s2 = 0.f; unsigned short b[8];
#pragma unroll
        for (int e = 0; e < 8; ++e) { const float raw = s[e * 33]; v[e] = raw * wv[8 * c + e]; b[e] = (unsigned short)f2bf(v[e]); s1 += bf2f(b[e]); s2 += raw * bv[8 * c + e]; }
        v4u o; o.x = b[0] | ((unsigned)b[1] << 16); o.y = b[2] | ((unsigned)b[3] << 16); o.z = b[4] | ((unsigned)b[5] << 16); o.w = b[6] | ((unsigned)b[7] << 16);
        *(GAS v4u*)(WT + (size_t)(n0 + n) * DM + k0 + 8 * c) = o;
        s1 += __shfl_xor(s1, 1); s1 += __shfl_xor(s1, 2); s1 += __shfl_xor(s1, 4);
        s2 += __shfl_xor(s2, 1); s2 += __shfl_xor(s2, 2); s2 += __shfl_xor(s2, 4);
        if (c == 0) { c1p[n0 + n] = s1; c2p[n0 + n] = s2; } }
    LDS_WAIT(); asm volatile("" ::: "memory");
}

__device__ __forceinline__ void p1_phase(Frame& F) {
    {   float* ada = SMALLF(SM_ADA);
        for (int n = F.bid * 512 + F.tid; n < NADA; n += F.G * 512) ada[n] = ada_val(F, n); }
    TP_BEGIN(110);
    {
        LAS float* sc1 = (LAS float*)(F.lds);
        LAS float* sh1 = sc1 + 2048;
        LAS float* wgT = sh1 + 2048;
        for (int k = F.tid; k < DM; k += 512) { sc1[k] = 1.f + ada_val(F, DM + k); sh1[k] = ada_val(F, k); }
        for (int i = F.tid; i < DM * 2; i += 512) { const int k = i >> 1, hf = i & 1; const f32x4 v = *(const f32x4*)(F.w_in + (size_t)k * WIN_LD + NPROJ + hf * 4);
            wgT[(hf * 4 + 0) * DM + k] = v.x; wgT[(hf * 4 + 1) * DM + k] = v.y; wgT[(hf * 4 + 2) * DM + k] = v.z; wgT[(hf * 4 + 3) * DM + k] = v.w; }
        __syncthreads();
        bf16* U = (bf16*)(F.ws + WS_U); float* gates = SMALLF(SM_GATES);
        const int rstep = F.G * NWAVES;
#define XROW_LOAD(X, row_) do { const GAS f32x4* xr_ = (const GAS f32x4*)(F.x + (size_t)(row_) * DM) + F.lane; _Pragma("unroll") for (int j = 0; j < 8; ++j) X[j] = xr_[64 * j]; } while (0)
#define XROW_DO(X, row_) do { float g[8]; _Pragma("unroll") for (int e = 0; e < 8; ++e) g[e] = 0.f; \
            GAS unsigned long long* o8 = (GAS unsigned long long*)(U + (size_t)(row_) * DM) + F.lane; \
            _Pragma("unroll") for (int j = 0; j < 8; ++j) { asm volatile("" ::: "memory"); const int k = F.lane * 4 + 256 * j; \
                const f32x4 s = *(LAS f32x4*)(sc1 + k), h = *(LAS f32x4*)(sh1 + k); const f32x4 u = X[j] * s + h; \
                o8[64 * j] = (unsigned long long)pk2(u.x, u.y) | ((unsigned long long)pk2(u.z, u.w) << 32); \
                _Pragma("unroll") for (int e = 0; e < 8; ++e) { const f32x4 w = *(LAS f32x4*)(wgT + e * DM + k); g[e] += (u.x * w.x + u.y * w.y) + (u.z * w.z + u.w * w.w); } } \
            _Pragma("unroll") for (int e = 0; e < 8; ++e) { float t = g[e]; \
                t += __builtin_bit_cast(float, __builtin_amdgcn_update_dpp(0, __builtin_bit_cast(int, t), 0xB1, 0xF, 0xF, true)); \
                t += __builtin_bit_cast(float, __builtin_amdgcn_update_dpp(0, __builtin_bit_cast(int, t), 0x4E, 0xF, 0xF, true)); \
                t += __builtin_bit_cast(float, __builtin_amdgcn_update_dpp(0, __builtin_bit_cast(int, t), 0x141, 0xF, 0xF, true)); \
                t += __builtin_bit_cast(float, __builtin_amdgcn_update_dpp(0, __builtin_bit_cast(int, t), 0x140, 0xF, 0xF, true)); \
                t += __shfl_xor(t, 16); t += __shfl_xor(t, 32); g[e] = t; } \
            if (F.lane == 0) { *(f32x4*)(gates + (row_) * 8) = (f32x4){g[0], g[1], g[2], g[3]}; *(f32x4*)(gates + (row_) * 8 + 4) = (f32x4){g[4], g[5], g[6], g[7]}; } } while (0)
        f32x4 xa[8], xb[8];
        int row = F.bid * NWAVES + F.wave;
        if (row < M_TOK) XROW_LOAD(xa, row);
        while (row < M_TOK) {
            if (row + rstep < M_TOK) XROW_LOAD(xb, row + rstep);
            XROW_DO(xa, row);
            row += rstep; if (row >= M_TOK) break;
            if (row + rstep < M_TOK) XROW_LOAD(xa, row + rstep);
            XROW_DO(xb, row);
            row += rstep;
        }
#undef XROW_LOAD
#undef XROW_DO
        __syncthreads();
    }
    TP_END(110); TP_BEGIN(111);
    {
        LAS float* scr = (LAS float*)(F.lds + F.wave * 16384);
        const int gw = F.bid * NWAVES + F.wave, NGW = F.G * NWAVES;
        constexpr int I_GU = (DM / 64) * (NGU / 32);
        for (int it = gw; it < I_GU; it += NGW) p1_wgu_item(F, scr, it);
    }
    TP_END(111);
}

namespace pg8 {
struct EpiProj {
    static constexpr bool PERM = true, AFTER_DRAIN = false;
    bf16_t *mix, *kb, *vb, *mqk, *mv; const float* rope; float* kmean;
    __device__ __forceinline__ void operator()(const f32x4 (&acc)[2][2][4][2], const Unit& u, int wr, int wc, int fr, int fq) const {
        const int row0 = u.pm * BM + wr * 64 + fr; const int colt = u.pn * BM; const int t = colt >> 10, cl = colt & 1023;
        bf16_t* base; int ldc;
        if (t == 0) { base = mix + 1024; ldc = 2048; } else if (t == 1) { base = kb; ldc = 1024; } else if (t == 2) { base = vb; ldc = 1024; }
        else if (t == 3) { base = mqk; ldc = 1024; } else if (t == 4) { base = mv; ldc = 1024; } else { base = mix; ldc = 2048; }
        const int col0 = cl + wc * 32 + 8 * fq;
        const bool dorope = (t < 2) && (wc == 0);
        const float sgn = (fq < 2) ? -1.f : 1.f;
        f32x4 ks0[2] = {{0.f, 0.f, 0.f, 0.f}, {0.f, 0.f, 0.f, 0.f}}, ks1[2] = {{0.f, 0.f, 0.f, 0.f}, {0.f, 0.f, 0.f, 0.f}};
#pragma unroll
        for (int ai = 0; ai < 2; ++ai) {
            f32x4 rc0[4], rc1[4], rs0[4], rs1[4];
            if (dorope) {
#pragma unroll
                for (int m = 0; m < 4; ++m) { const float* rp = rope + (size_t)(row0 + ai * HALF + m * 16) * 32 + 8 * (fq & 1);
                    rc0[m] = *(const f32x4*)(rp); rc1[m] = *(const f32x4*)(rp + 4); rs0[m] = *(const f32x4*)(rp + 16); rs1[m] = *(const f32x4*)(rp + 20); }
            }
#pragma unroll
            for (int m = 0; m < 4; ++m) {
                const int row = row0 + ai * HALF + m * 16;
                bf16_t* rowp = base + (size_t)row * ldc + col0;
#pragma unroll
                for (int bj = 0; bj < 2; ++bj) {
                    f32x4 v0 = acc[ai][bj][m][0], v1 = acc[ai][bj][m][1];
                    if (dorope) {
                        f32x4 p0, p1;
#pragma unroll
                        for (int i = 0; i < 4; ++i) { p0[i] = __shfl_xor(v0[i], 32); p1[i] = __shfl_xor(v1[i], 32); }
                        v0 = v0 * rc0[m] + p0 * rs0[m] * sgn; v1 = v1 * rc1[m] + p1 * rs1[m] * sgn;
                    }
                    u32x4 w; w.x = cvt_pk_bf16(v0[0], v0[1]); w.y = cvt_pk_bf16(v0[2], v0[3]); w.z = cvt_pk_bf16(v1[0], v1[1]); w.w = cvt_pk_bf16(v1[2], v1[3]);
                    *(u32x4*)(rowp + bj * HALF) = w;
                    if (t == 1) { ks0[bj] += v0; ks1[bj] += v1; }
                }
            }
        }
        if (t == 1) {
#pragma unroll
            for (int bj = 0; bj < 2; ++bj) {
                float s8[8] = {ks0[bj][0], ks0[bj][1], ks0[bj][2], ks0[bj][3], ks1[bj][0], ks1[bj][1], ks1[bj][2], ks1[bj][3]};
#pragma unroll
                for (int e = 0; e < 8; ++e) {
                    float x = s8[e];
                    x += __builtin_bit_cast(float, __builtin_amdgcn_update_dpp(0, __builtin_bit_cast(int, x), 0xB1, 0xF, 0xF, true));
                    x += __builtin_bit_cast(float, __builtin_amdgcn_update_dpp(0, __builtin_bit_cast(int, x), 0x4E, 0xF, 0xF, true));
                    x += __builtin_bit_cast(float, __builtin_amdgcn_update_dpp(0, __builtin_bit_cast(int, x), 0x141, 0xF, 0xF, true));
                    x += __builtin_bit_cast(float, __builtin_amdgcn_update_dpp(0, __builtin_bit_cast(int, x), 0x140, 0xF, 0xF, true));
                    s8[e] = x;
                }
                if (fr == 0) { const int col = cl + bj * HALF + wc * 32 + 8 * fq; float* kp = kmean + ((size_t)(col >> 7) * 64 + u.pm) * 128 + (col & 127);
#pragma unroll
                    for (int e = 0; e < 8; ++e) atomicAdd(kp + e, s8[e] * (1.f / 256.f)); }
            }
        }
    }
};
struct EpiY1 {
    static constexpr bool PERM = false, AFTER_DRAIN = false;
    const float* x; const float* gate1; bf16_t* y1b; unsigned long long* stat;
    __device__ __forceinline__ void operator()(const f32x4 (&acc)[2][2][4][2], const Unit& u, int wr, int wc, int fr, int fq) const {
        const int row0 = u.pm * BM + wr * 64 + fr, col0 = u.pn * BM + wc * 32 + 4 * fq;
        float s[8], ss[8];
#pragma unroll
        for (int i = 0; i < 8; ++i) { s[i] = 0.f; ss[i] = 0.f; }
#pragma unroll
        for (int bj = 0; bj < 2; ++bj)
#pragma unroll
            for (int n = 0; n < 2; ++n) {
                const int c = col0 + bj * HALF + n * 16;
                const f32x4 g1 = *(const f32x4*)(gate1 + c) + 1.0f;
                f32x4 xv[8];
#pragma unroll
                for (int i = 0; i < 8; ++i) xv[i] = *(const f32x4*)(x + (size_t)(row0 + (i >> 2) * HALF + (i & 3) * 16) * 2048 + c);
                asm volatile("" ::: "memory");
#pragma unroll
                for (int i = 0; i < 8; ++i) {
                    const size_t off = (size_t)(row0 + (i >> 2) * HALF + (i & 3) * 16) * 2048 + c;
                    const f32x4 y = xv[i] * 1.189207115002721f + g1 * acc[i >> 2][bj][i & 3][n];
                    typedef unsigned u32x2v __attribute__((ext_vector_type(2)));
                    u32x2v w; w.x = cvt_pk_bf16(y[0], y[1]); w.y = cvt_pk_bf16(y[2], y[3]);
                    *(u32x2v*)(y1b + off) = w;
                    s[i] += (y[0] + y[1]) + (y[2] + y[3]); ss[i] += (y[0] * y[0] + y[1] * y[1]) + (y[2] * y[2] + y[3] * y[3]);
                }
                asm volatile("" ::: "memory");
            }
#pragma unroll
        for (int i = 0; i < 8; ++i) {
            float a = s[i], a2 = ss[i];
            a += __shfl_xor(a, 16); a += __shfl_xor(a, 32); a2 += __shfl_xor(a2, 16); a2 += __shfl_xor(a2, 32);
            if (fq == 0) { unsigned long long* sp = stat + (size_t)(row0 + (i >> 2) * HALF + (i & 3) * 16) * 2;
                atomicAdd(sp, (unsigned long long)(long long)(a * 16777216.f)); atomicAdd(sp + 1, (unsigned long long)(long long)(a2 * 16777216.f)); }
        }
    }
};
__device__ __forceinline__ f32x2 ln_stats_from_fixed(const unsigned long long* sp) {
    typedef unsigned long long u64x2 __attribute__((ext_vector_type(2)));
    const u64x2 v = *(const u64x2*)sp;
    const float s = (float)((double)(long long)v.x * (1.0 / (16777216.0 * 2048.0))), q = (float)((double)(long long)v.y * (1.0 / (16777216.0 * 2048.0)));
    const float var = fmaxf(q - s * s, 0.f);
    return (f32x2){s, rsqrtf(var + 1e-5f)};
}
struct EpiSwiGLU {
    static constexpr bool PERM = true, AFTER_DRAIN = false;
    const unsigned long long* stat; const float* c1; const float* c2; bf16_t* H;
    __device__ __forceinline__ void operator()(const f32x4 (&acc)[2][2][4][2], const Unit& u, int wr, int wc, int fr, int fq) const {
        const int row0 = u.pm * BM + wr * 64 + fr; const int cl = wc * 32 + 8 * fq; const int cg = u.pn * BM + cl;
        f32x4 c1g[2], c2g[2], c1u[2], c2u[2];
#pragma unroll
        for (int n = 0; n < 2; ++n) { c1g[n] = *(const f32x4*)(c1 + cg + 4 * n); c2g[n] = *(const f32x4*)(c2 + cg + 4 * n); c1u[n] = *(const f32x4*)(c1 + cg + HALF + 4 * n); c2u[n] = *(const f32x4*)(c2 + cg + HALF + 4 * n); }
        typedef float f32x2v __attribute__((ext_vector_type(2)));
        f32x2v mrs[8];
#pragma unroll
        for (int i = 0; i < 8; ++i) { const f32x2 t_ = ln_stats_from_fixed(stat + (size_t)(row0 + (i >> 2) * HALF + (i & 3) * 16) * 2); mrs[i] = (f32x2v){t_.x, t_.y}; }
#pragma unroll
        for (int ai = 0; ai < 2; ++ai)
#pragma unroll
            for (int m = 0; m < 4; ++m) {
                const int row = row0 + ai * HALF + m * 16;
                const f32x2v mr = mrs[ai * 4 + m];
                f32x4 hv[2];
#pragma unroll
                for (int n = 0; n < 2; ++n) {
                    const f32x4 g = (acc[ai][0][m][n] - c1g[n] * mr.x) * mr.y + c2g[n];
                    const f32x4 up = (acc[ai][1][m][n] - c1u[n] * mr.x) * mr.y + c2u[n];
#pragma unroll
                    for (int i = 0; i < 4; ++i) { const float e = __builtin_amdgcn_exp2f(g[i] * -1.4426950408889634f); hv[n][i] = g[i] * __builtin_amdgcn_rcpf(1.f + e) * up[i]; }
                }
                u32x4 w; w.x = cvt_pk_bf16(hv[0][0], hv[0][1]); w.y = cvt_pk_bf16(hv[0][2], hv[0][3]); w.z = cvt_pk_bf16(hv[1][0], hv[1][1]); w.w = cvt_pk_bf16(hv[1][2], hv[1][3]);
                *(u32x4*)(H + (size_t)row * 5632 + u.pn * HALF + cl) = w;
            }
    }
};
struct EpiY2 {
    static constexpr bool PERM = false, AFTER_DRAIN = false;
    const bf16_t* y1b; const unsigned long long* stat; const float* gate2; const float* lw; const float* lb; float* out;
    __device__ __forceinline__ void operator()(const f32x4 (&acc)[2][2][4][2], const Unit& u, int wr, int wc, int fr, int fq) const {
        const int row0 = u.pm * BM + wr * 64 + fr, col0 = u.pn * BM + wc * 32 + 4 * fq;
        typedef float f32x2v __attribute__((ext_vector_type(2)));
        f32x2v mrs[8];
#pragma unroll
        for (int i = 0; i < 8; ++i) { const f32x2 t_ = ln_stats_from_fixed(stat + (size_t)(row0 + (i >> 2) * HALF + (i & 3) * 16) * 2); mrs[i] = (f32x2v){t_.x, t_.y}; }
#pragma unroll
        for (int bj = 0; bj < 2; ++bj)
#pragma unroll
            for (int n = 0; n < 2; ++n) {
                const int c = col0 + bj * HALF + n * 16;
                const f32x4 g2 = *(const f32x4*)(gate2 + c) + 1.0f, w = *(const f32x4*)(lw + c), b = *(const f32x4*)(lb + c);
                f32x4 yv[8];
                {   typedef unsigned u32x2v __attribute__((ext_vector_type(2))); u32x2v yr[8];
#pragma unroll
                    for (int i = 0; i < 8; ++i) yr[i] = *(const u32x2v*)(y1b + (size_t)(row0 + (i >> 2) * HALF + (i & 3) * 16) * 2048 + c);
                    asm volatile("" ::: "memory");
#pragma unroll
                    for (int i = 0; i < 8; ++i) yv[i] = (f32x4){__builtin_bit_cast(float, yr[i].x << 16), __builtin_bit_cast(float, yr[i].x & 0xffff0000u), __builtin_bit_cast(float, yr[i].y << 16), __builtin_bit_cast(float, yr[i].y & 0xffff0000u)}; }
#pragma unroll
                for (int i = 0; i < 8; ++i) {
                    const size_t off = (size_t)(row0 + (i >> 2) * HALF + (i & 3) * 16) * 2048 + c;
                    const f32x4 x1 = (yv[i] - mrs[i].x) * mrs[i].y * w + b;
                    *(f32x4*)(out + off) = x1 * 1.189207115002721f + g2 * acc[i >> 2][bj][i & 3][n];
                }
                asm volatile("" ::: "memory");
            }
    }
};
}

__device__ __forceinline__ float wave_incl_scan_add(float v, int lane) {
#pragma unroll
    for (int o = 1; o < 64; o <<= 1) { const float t = __shfl_up(v, o); if (lane >= o) v += t; }
    return v;
}
__device__ __forceinline__ float wave_incl_scan_max(float v, int lane) {
#pragma unroll
    for (int o = 1; o < 64; o <<= 1) { const float t = __shfl_up(v, o); if (lane >= o) v = fmaxf(v, t); }
    return v;
}
__device__ __forceinline__ void p3_chunk_item(Frame& F, int c) {
    const int t0 = c * ML_L, tid = F.tid, lane = F.lane;
    LAS float* wgt = (LAS float*)F.lds;
    LAS unsigned short* KT = (LAS unsigned short*)(F.lds + 1024);
    LAS unsigned short* VTh = (LAS unsigned short*)(F.lds + 1024 + 512 * 72 * 2);
    const float* gates = SMALLF(SM_GATES);
    if (F.wave < 4) {
        const int h = F.wave, t = t0 + lane;
        const float ig = gates[t * 8 + h] + F.igb[h], fg = gates[t * 8 + 4 + h] + F.fgb[h];
        const float lf = logsigmoid_f(fg);
        const float b = wave_incl_scan_add(lf, lane), u = ig - b, m1 = wave_incl_scan_max(u, lane);
        const float m1l = __shfl(m1, 63), bl = __shfl(b, 63);
        *(f32x4*)(SMALLF(SM_TOKSC) + (size_t)(t * 4 + h) * 4) = (f32x4){b, u, m1, 0.f};
        if (lane == 63) { SMALLF(SM_CHSUM)[(c * 4 + h) * 2] = bl; SMALLF(SM_CHSUM)[(c * 4 + h) * 2 + 1] = m1l; }
        wgt[h * 64 + lane] = expf(u - m1l);
    }
    {
        const int cgp = tid & 127, rq = tid >> 7, ch0 = cgp * 8, r0 = 16 * rq;
        const v4u* MQK = (const v4u*)(F.ws + WS_MQK);
        float w[4][8], bs[8];
#pragma unroll
        for (int j = 0; j < 4; ++j) { const f32x4 a = *(const f32x4*)(F.conv_w + j * 1024 + ch0), b = *(const f32x4*)(F.conv_w + j * 1024 + ch0 + 4);
            w[j][0] = a.x; w[j][1] = a.y; w[j][2] = a.z; w[j][3] = a.w; w[j][4] = b.x; w[j][5] = b.y; w[j][6] = b.z; w[j][7] = b.w; }
        { const f32x4 a = *(const f32x4*)(F.conv_b + ch0), b = *(const f32x4*)(F.conv_b + ch0 + 4); bs[0] = a.x; bs[1] = a.y; bs[2] = a.z; bs[3] = a.w; bs[4] = b.x; bs[5] = b.y; bs[6] = b.z; bs[7] = b.w; }
        __syncthreads();
        const bool isq = ch0 < 512; const int hh = (ch0 - 512) >> 7;
        v4u* QC = (v4u*)(F.ws + WS_QC); v4u* KC = (v4u*)(F.ws + WS_KC);
#pragma unroll 1
        for (int hf = 0; hf < 2; ++hf) {
        v4u xin[11];
#pragma unroll
        for (int i = 0; i < 11; ++i) { const int t = t0 + r0 + 8 * hf - 3 + i; xin[i] = (t >= 0) ? MQK[(size_t)t * 128 + cgp] : (v4u){0u, 0u, 0u, 0u}; }
#pragma unroll
        for (int r = 0; r < 8; ++r) {
            float y[8];
#pragma unroll
            for (int e = 0; e < 8; ++e) y[e] = bs[e];
#pragma unroll
            for (int j = 0; j < 4; ++j) { const v4u x = xin[r + j];
                y[0] += w[j][0] * bflo(x.x); y[1] += w[j][1] * bfhi(x.x); y[2] += w[j][2] * bflo(x.y); y[3] += w[j][3] * bfhi(x.y);
                y[4] += w[j][4] * bflo(x.z); y[5] += w[j][5] * bfhi(x.z); y[6] += w[j][6] * bflo(x.w); y[7] += w[j][7] * bfhi(x.w); }
#pragma unroll
            for (int e = 0; e < 8; ++e) y[e] = silu_f(y[e]);
            const int s = r0 + 8 * hf + r;
            if (isq) { v4u o; o.x = pk2(y[0], y[1]); o.y = pk2(y[2], y[3]); o.z = pk2(y[4], y[5]); o.w = pk2(y[6], y[7]); QC[(size_t)(t0 + s) * 64 + cgp] = o; }
            else {
#pragma unroll
                for (int e = 0; e < 8; ++e) y[e] *= K_SCALE;
                v4u o; o.x = pk2(y[0], y[1]); o.y = pk2(y[2], y[3]); o.z = pk2(y[4], y[5]); o.w = pk2(y[6], y[7]); KC[(size_t)(t0 + s) * 64 + (cgp - 64)] = o;
                const float wg_ = wgt[hh * 64 + s];
#pragma unroll
                for (int e = 0; e < 8; ++e) KT[(ch0 - 512 + e) * 72 + s] = (unsigned short)f2bf(y[e] * wg_);
            }
        }
        }
    }
    __syncthreads();
    {
        float sm = 0.f;
#pragma unroll
        for (int i = 0; i < 8; ++i) { const v4u v = *(LAS v4u*)(KT + tid * 72 + i * 8); sm += bflo(v.x) + bfhi(v.x) + bflo(v.y) + bfhi(v.y) + bflo(v.z) + bfhi(v.z) + bflo(v.w) + bfhi(v.w); }
        SMALLF(SM_NLOC)[(size_t)c * 512 + tid] = sm;
    }
    const v4u* MV = (const v4u*)(F.ws + WS_MV);
    const int r = lane & 31, hh2 = lane >> 5, w = F.wave;
    const int vg = tid & 31, sq = tid >> 5;
    v4u vin[4];
#pragma unroll
    for (int i = 0; i < 4; ++i) vin[i] = MV[(size_t)(t0 + 4 * sq + i) * 128 + vg];
#pragma unroll 1
    for (int h = 0; h < 4; ++h) {
#pragma unroll
        for (int i = 0; i < 4; ++i) { const int s = 4 * sq + i; LAS unsigned short* p = VTh + (8 * vg) * 72 + s;
            p[0] = (unsigned short)vin[i].x; p[72] = (unsigned short)(vin[i].x >> 16); p[144] = (unsigned short)vin[i].y; p[216] = (unsigned short)(vin[i].y >> 16);
            p[288] = (unsigned short)vin[i].z; p[360] = (unsigned short)(vin[i].z >> 16); p[432] = (unsigned short)vin[i].w; p[504] = (unsigned short)(vin[i].w >> 16); }
        __syncthreads();
        if (h < 3) {
#pragma unroll
            for (int i = 0; i < 4; ++i) vin[i] = MV[(size_t)(t0 + 4 * sq + i) * 128 + (h + 1) * 32 + vg];
        }
        {
            unsigned long long* VT8 = (unsigned long long*)(F.ws + WS_VT) + (size_t)(c * 4 + h) * 4096;
#pragma unroll
            for (int p = 0; p < 8; ++p) { const int idx = p * 512 + tid, sb = idx >> 8, v = idx & 255;
                VT8[idx] = *(LAS unsigned long long*)(VTh + v * 72 + sb * 4); } }
        {
            pg8::bf16x8 bfr[4];
#pragma unroll
            for (int ks = 0; ks < 4; ++ks) bfr[ks] = *(LAS pg8::bf16x8*)(VTh + (32 * w + r) * 72 + 16 * ks + 8 * hh2);
            unsigned short* LOC = (unsigned short*)(F.ws + WS_LOCAL) + (size_t)(c * 4 + h) * 256 * 128 + (size_t)(32 * w + r) * 8 + 4 * hh2;
#pragma unroll
            for (int dt = 0; dt < 4; ++dt) {
                __attribute__((ext_vector_type(16))) float acc = {};
#pragma unroll
                for (int ks = 0; ks < 4; ++ks) { const pg8::bf16x8 af = *(LAS pg8::bf16x8*)(KT + (h * 128 + 32 * dt + r) * 72 + 16 * ks + 8 * hh2);
                    acc = __builtin_amdgcn_mfma_f32_32x32x16_bf16(af, bfr[ks], acc, 0, 0, 0); }
#pragma unroll
                for (int g = 0; g < 4; ++g) { u32x2 o; o.x = pk2(acc[4 * g], acc[4 * g + 1]); o.y = pk2(acc[4 * g + 2], acc[4 * g + 3]);
                    *(u32x2*)(LOC + (size_t)(4 * dt + g) * 2048) = o; }
            }
        }
        __syncthreads();
    }
}
__device__ __forceinline__ void p3_kmean_item(Frame& F, int j) {
    const v4u* KB = (const v4u*)(F.ws + WS_KB);
    const int cg = F.tid & 127, rg = F.tid >> 7;
    float s[8];
#pragma unroll
    for (int e = 0; e < 8; ++e) s[e] = 0.f;
#pragma unroll 16
    for (int r = 0; r < 64; ++r) { const v4u v = KB[(size_t)(j * MB_BLK + rg * 64 + r) * 128 + cg];
        s[0] += bflo(v.x); s[1] += bfhi(v.x); s[2] += bflo(v.y); s[3] += bfhi(v.y); s[4] += bflo(v.z); s[5] += bfhi(v.z); s[6] += bflo(v.w); s[7] += bfhi(v.w); }
    LAS float* red = (LAS float*)F.lds;
#pragma unroll
    for (int e = 0; e < 8; ++e) red[rg * 1024 + cg * 8 + e] = s[e];
    __syncthreads();
#pragma unroll
    for (int e = 0; e < 2; ++e) { const int col = F.tid * 2 + e; const float t = (red[col] + red[1024 + col]) + (red[2048 + col] + red[3072 + col]);
        SMALLF(SM_KMEAN)[(size_t)((col >> 7) * 64 + j) * 128 + (col & 127)] = t * (1.f / 256.f); }
    __syncthreads();
}
__device__ __forceinline__ void p3_c12_item(Frame& F, int it) {
    const int n = it * 512 + F.tid; if (n >= NGU) return;
    const float* p = (const float*)(F.ws + WS_C12P);
    float a = 0.f, b = 0.f;
    for (int k = 0; k < 32; ++k) { a += p[(size_t)k * NGU + n]; b += p[(size_t)(32 + k) * NGU + n]; }
    SMALLF(SM_C1)[n] = a; SMALLF(SM_C2)[n] = b;
}
__device__ __forceinline__ void moba_select_item(Frame& F, int b, int h);
__device__ __forceinline__ void p3_phase(Frame& F) {
    constexpr int N_CH = ML_NC, N_SEL = MB_NB * MB_H, N_C12 = NGU / 512;
    for (int it = F.bid; it < N_CH + N_SEL + N_C12; it += F.G) {
        if (it < N_CH) { TP_BEGIN(160); p3_chunk_item(F, it); TP_END(160); }
        else if (it < N_CH + N_SEL) {
#if !defined(NAIVE_MOBA)
            const int i = it - N_CH, b = 63 - (i >> 3), h = i & 7; if (b > 0) moba_select_item(F, b, h);
#endif
        }
        else p3_c12_item(F, it - N_CH - N_SEL);
    }
}

__device__ __forceinline__ void stat_phase(Frame& F) {
    const float* sp = (const float*)(F.ws + WS_STATP); float* mur = SMALLF(SM_MUR);
    for (int row = F.bid * 512 + F.tid; row < M_TOK; row += F.G * 512) {
        float s = 0.f, ss = 0.f;
#pragma unroll
        for (int i = 0; i < 16; ++i) { const f32x4 v = *(const f32x4*)(sp + (size_t)row * 64 + i * 4); s += v.x + v.z; ss += v.y + v.w; }
        const float mean = s * (1.f / DM); const float var = fmaxf(ss * (1.f / DM) - mean * mean, 0.f);
        mur[row * 2] = mean; mur[row * 2 + 1] = rsqrtf(var + LN_EPS);
    }
}
__device__ __forceinline__ void ln2_rows(Frame& F, int row0, int nrows) {
#define LN2_LOAD(V, row_) do { const GAS f32x4* xr_ = (const GAS f32x4*)(F.out + (size_t)(row_) * DM) + F.lane; _Pragma("unroll") for (int j = 0; j < 8; ++j) V[j] = xr_[64 * j]; } while (0)
#define LN2_DO(V, row_) do { GAS f32x4* xw_ = (GAS f32x4*)(F.out + (size_t)(row_) * DM) + F.lane; float s = 0.f; \
        _Pragma("unroll") for (int j = 0; j < 8; ++j) s += (V[j].x + V[j].y) + (V[j].z + V[j].w); \
        const float mean = wave_sum(s) * (1.f / DM); float s2 = 0.f; \
        _Pragma("unroll") for (int j = 0; j < 8; ++j) { V[j] = V[j] - mean; s2 += (V[j].x * V[j].x + V[j].y * V[j].y) + (V[j].z * V[j].z + V[j].w * V[j].w); } \
        const float rstd = rsqrtf(wave_sum(s2) * (1.f / DM) + LN_EPS); \
        _Pragma("unroll") for (int j = 0; j < 8; ++j) { const int k = F.lane * 4 + 256 * j; const f32x4 w = *(const f32x4*)(F.ln2_w + k), b = *(const f32x4*)(F.ln2_b + k); xw_[64 * j] = V[j] * rstd * w + b; } } while (0)
    f32x4 va[8], vb[8];
    int rr = F.wave;
    if (rr < nrows) LN2_LOAD(va, row0 + rr);
    while (rr < nrows) {
        if (rr + NWAVES < nrows) LN2_LOAD(vb, row0 + rr + NWAVES);
        LN2_DO(va, row0 + rr);
        rr += NWAVES; if (rr >= nrows) break;
        if (rr + NWAVES < nrows) LN2_LOAD(va, row0 + rr + NWAVES);
        LN2_DO(vb, row0 + rr);
        rr += NWAVES;
    }
#undef LN2_LOAD
#undef LN2_DO
}
__device__ __forceinline__ bool ln2_panel_fused(Frame& F) {
    pg8::StaticOrder S; S.init(M_TOK, DM, F.G, F.bid, WGM_P7); pg8::Unit u0, u1, u2;
    if (F.G != 256 || !S.next(0, u0) || !S.next(1, u1) || S.next(2, u2)) return false;
    gu32* c0 = F.ctl + CW_PANEL + 64 * u0.pm; gu32* c1 = F.ctl + CW_PANEL + 64 * u1.pm;
    asm volatile("s_waitcnt vmcnt(0)" ::: "memory");
    __syncthreads();
    if (F.tid == 0) {
        __builtin_amdgcn_fence(__ATOMIC_RELEASE, "agent"); asm volatile("s_waitcnt vmcnt(0)" ::: "memory");
        __hip_atomic_fetch_add(c0, 1u, __ATOMIC_RELAXED, __HIP_MEMORY_SCOPE_AGENT);
        __hip_atomic_fetch_add(c1, 1u, __ATOMIC_RELAXED, __HIP_MEMORY_SCOPE_AGENT);
        unsigned sp = 0;
        while (__hip_atomic_load(c0, __ATOMIC_RELAXED, __HIP_MEMORY_SCOPE_AGENT) < 8u || __hip_atomic_load(c1, __ATOMIC_RELAXED, __HIP_MEMORY_SCOPE_AGENT) < 8u) { __builtin_amdgcn_s_sleep(2); if (++sp > (1u << 22)) break; }
        __builtin_amdgcn_fence(__ATOMIC_ACQUIRE, "agent"); asm volatile("s_waitcnt vmcnt(0)" ::: "memory");
    }
    __syncthreads();
    ln2_rows(F, u0.pm * 256 + 32 * u0.pn, 32);
    ln2_rows(F, u1.pm * 256 + 32 * u1.pn, 32);
    return true;
}
__device__ __forceinline__ void ln2_phase(Frame& F) {
    for (int row = F.bid * NWAVES + F.wave; row < M_TOK; row += F.G * NWAVES) {
        GAS f32x4* xr = (GAS f32x4*)(F.out + (size_t)row * DM) + F.lane;
        f32x4 v[8]; float s = 0.f;
#pragma unroll
        for (int j = 0; j < 8; ++j) { v[j] = xr[64 * j]; s += (v[j].x + v[j].y) + (v[j].z + v[j].w); }
        const float mean = wave_sum(s) * (1.f / DM); float s2 = 0.f;
#pragma unroll
        for (int j = 0; j < 8; ++j) { v[j] = v[j] - mean; s2 += (v[j].x * v[j].x + v[j].y * v[j].y) + (v[j].z * v[j].z + v[j].w * v[j].w); }
        const float rstd = rsqrtf(wave_sum(s2) * (1.f / DM) + LN_EPS);
#pragma unroll
        for (int j = 0; j < 8; ++j) { const int k = F.lane * 4 + 256 * j; const f32x4 w = *(const f32x4*)(F.ln2_w + k), b = *(const f32x4*)(F.ln2_b + k); xr[64 * j] = v[j] * rstd * w + b; }
    }
}
typedef short s16x4 __attribute__((ext_vector_type(4)));
typedef float f32x16 __attribute__((ext_vector_type(16)));
typedef unsigned u32x4v __attribute__((ext_vector_type(4)));
#define MFMA32(a, b, c) __builtin_amdgcn_mfma_f32_32x32x16_bf16((a), (b), (c), 0, 0, 0)
#define SBAR() __builtin_amdgcn_sched_barrier(0)
__device__ __forceinline__ int crow(int r, int hi) { return (r & 3) + 8 * (r >> 2) + 4 * hi; }
typedef float cv_f32x2_t __attribute__((ext_vector_type(2))); typedef __bf16 cv_bf16x2_t __attribute__((ext_vector_type(2)));
__device__ __forceinline__ unsigned cvtpk(float lo, float hi) { cv_f32x2_t v = {lo, hi}; cv_bf16x2_t b = __builtin_convertvector(v, cv_bf16x2_t); return __builtin_bit_cast(unsigned, b); }

constexpr int LIST_HSTRIDE = 256 * 2016;
__device__ __forceinline__ int list_off(int h, int j) { return h * LIST_HSTRIDE + 256 * (63 * j - (j * (j - 1)) / 2); }
__device__ __forceinline__ unsigned short* part_ptr(unsigned char* ws, int slot) {
    return (unsigned short*)(ws + (slot == 0 ? WS_PART0 : slot == 1 ? WS_PART1 : slot == 2 ? WS_PART2 : WS_PART3));
}

#define TOP3_INS(S_, J_) do { const float s__ = (S_); const int j__ = (J_); \
    if (s__ > v0 || (s__ == v0 && j__ < i0)) { v2 = v1; i2 = i1; v1 = v0; i1 = i0; v0 = s__; i0 = j__; } \
    else if (s__ > v1 || (s__ == v1 && j__ < i1)) { v2 = v1; i2 = i1; v1 = s__; i1 = j__; } \
    else if (s__ > v2 || (s__ == v2 && j__ < i2)) { v2 = s__; i2 = j__; } } while (0)
__device__ __forceinline__ void moba_select_item(Frame& F, int b, int h) {
    const int tid = F.tid, lane = F.lane, r32 = lane & 31, hi = lane >> 5, w = F.wave;
    constexpr int KS = 136;
    LAS unsigned short* kmh = (LAS unsigned short*)F.lds;
    LAS unsigned short* kml = kmh + 64 * KS;
    LAS int* hist = (LAS int*)(F.lds + 2 * 64 * KS * 2);
    LAS int* base = hist + 64;
    {   const float* src = SMALLF(SM_KMEAN) + (size_t)h * 64 * 128;
        for (int i = tid; i < 64 * 32; i += 512) { const int j = i >> 5, c4 = (i & 31) * 4; f32x4 f = {0.f, 0.f, 0.f, 0.f}; if (j < b) f = *(const f32x4*)(src + j * 128 + c4);
            const unsigned h0 = f2bf(f.x), h1 = f2bf(f.y), h2 = f2bf(f.z), h3 = f2bf(f.w);
            const float l0 = f.x - bf2f((unsigned short)h0), l1 = f.y - bf2f((unsigned short)h1), l2 = f.z - bf2f((unsigned short)h2), l3 = f.w - bf2f((unsigned short)h3);
            *(LAS u32x2*)(kmh + j * KS + c4) = (u32x2){h0 | (h1 << 16), h2 | (h3 << 16)};
            *(LAS u32x2*)(kml + j * KS + c4) = (u32x2){pk2(l0, l1), pk2(l2, l3)}; }
        if (tid < 64) hist[tid] = 0; }
    __syncthreads();
    const int p = b * 256 + 32 * w + r32;
    bf16x8 qf[8];
    {   const unsigned short* qp = (const unsigned short*)(F.ws + WS_MIX) + (size_t)p * 2048 + 1024 + h * 128 + 8 * hi;
#pragma unroll
        for (int kd = 0; kd < 8; ++kd) qf[kd] = *(const bf16x8*)(qp + 16 * kd); }
    float v0 = -INFINITY, v1 = -INFINITY, v2 = -INFINITY; int i0 = 64, i1 = 64, i2 = 64;
    const int ntile = (b + 31) >> 5;
#pragma unroll 1
    for (int tile = 0; tile < ntile; ++tile) {
        f32x16 acc = {};
#pragma unroll
        for (int kd = 0; kd < 8; ++kd) {
            const bf16x8 ah = *(const LAS bf16x8*)(kmh + (32 * tile + r32) * KS + 16 * kd + 8 * hi), al = *(const LAS bf16x8*)(kml + (32 * tile + r32) * KS + 16 * kd + 8 * hi);
            acc = MFMA32(ah, qf[kd], acc); acc = MFMA32(al, qf[kd], acc);
        }
#pragma unroll
        for (int r = 0; r < 16; ++r) { const int j = 32 * tile + crow(r, hi); const float s = (j < b) ? acc[r] : -INFINITY; TOP3_INS(s, j); }
    }
    {
        const float u0 = __shfl_xor(v0, 32), u1 = __shfl_xor(v1, 32), u2 = __shfl_xor(v2, 32); const int k0 = __shfl_xor(i0, 32), k1 = __shfl_xor(i1, 32), k2 = __shfl_xor(i2, 32);
        TOP3_INS(u0, k0); TOP3_INS(u1, k1); TOP3_INS(u2, k2); }
    const int nsel = b < 3 ? b : 3; int sel[3] = {i0, i1, i2}, rank[3] = {0, 0, 0};
    if (hi == 0) {
#pragma unroll
        for (int k = 0; k < 3; ++k) if (k < nsel) rank[k] = atomicAdd((int*)&hist[sel[k]], 1);
    }
    __syncthreads();
    if (tid < 64) { const int n = hist[tid]; base[tid] = n ? (int)atomicAdd((unsigned*)(F.ctl + CW_CNT + h * 64 + tid), (unsigned)n) : 0; }
    __syncthreads();
    if (hi == 0) { unsigned* lists = (unsigned*)(F.ws + WS_LISTS);
#pragma unroll
        for (int k = 0; k < 3; ++k) if (k < nsel) lists[list_off(h, sel[k]) + base[sel[k]] + rank[k]] = ((unsigned)p << 2) | (unsigned)k; }
    __syncthreads();
}
#undef TOP3_INS

namespace moba {
constexpr int D = 128, NW = 8, QBLK = 32, KVBLK = 64, LDK = 1024;
constexpr float SCALE = 0.088388347648318440f, THR = 8.f;
constexpr size_t SHM_V = KVBLK * D * 2, SHM_K = KVBLK * D * 2, SHM_ATTN = 2 * SHM_V + 2 * SHM_K + NW * 128 * 4;
#define KSWZ(row, colB) ((row) * 256 + ((colB) ^ (((row) & 7) << 4)))
__device__ __forceinline__ void partialSM(f32x16& p0, f32x16& p1, float& m_reg, float& mn, float& alpha) {
  constexpr float C = SCALE * 1.4426950408889634f;
  float pmax = p0[0]; for (int r = 1; r < 16; ++r) pmax = fmaxf(pmax, p0[r]); for (int r = 0; r < 16; ++r) pmax = fmaxf(pmax, p1[r]);
  { auto rr = __builtin_amdgcn_permlane32_swap(__float_as_uint(pmax), __float_as_uint(pmax), false, false);
    pmax = fmaxf(__uint_as_float(rr[0]), __uint_as_float(rr[1])); }
  if (__builtin_expect(__all(pmax - m_reg <= THR / SCALE), 1)) { mn = m_reg; alpha = 1.f; }
  else { mn = fmaxf(m_reg, pmax); alpha = __builtin_amdgcn_exp2f((m_reg - mn) * C); m_reg = mn; }
  float mnC = -mn * C;
  for (int r = 0; r < 16; ++r) p0[r] = fmaf(p0[r], C, mnC); for (int r = 0; r < 16; ++r) p1[r] = fmaf(p1[r], C, mnC);
  for (int r = 0; r < 16; ++r) p0[r] = __builtin_amdgcn_exp2f(p0[r]);
}
__device__ __forceinline__ void finishSM(f32x16& p0, f32x16& p1, float alpha, float& l_reg, bf16x8& pa0, bf16x8& pa1, bf16x8& pa2, bf16x8& pa3) {
  for (int r = 0; r < 16; ++r) p1[r] = __builtin_amdgcn_exp2f(p1[r]);
  float ps = 0; for (int r = 0; r < 16; ++r) ps += p0[r]; for (int r = 0; r < 16; ++r) ps += p1[r];
  { auto rr = __builtin_amdgcn_permlane32_swap(__float_as_uint(ps), __float_as_uint(ps), false, false);
    ps = __uint_as_float(rr[0]) + __uint_as_float(rr[1]); }
  l_reg = l_reg * alpha + ps;
#define PK4(P, BASE, OUT) do { unsigned a0 = cvtpk(P[BASE + 0], P[BASE + 1]), a1 = cvtpk(P[BASE + 2], P[BASE + 3]);   \
    unsigned b0 = cvtpk(P[BASE + 4], P[BASE + 5]), b1 = cvtpk(P[BASE + 6], P[BASE + 7]);                              \
    auto r0 = __builtin_amdgcn_permlane32_swap(a0, b0, false, false); auto r1 = __builtin_amdgcn_permlane32_swap(a1, b1, false, false); \
    u32x4v w = {r0[0], r1[0], r0[1], r1[1]}; OUT = *reinterpret_cast<bf16x8*>(&w); } while (0)
  PK4(p0, 0, pa0); PK4(p0, 8, pa1); PK4(p1, 0, pa2); PK4(p1, 8, pa3);
#undef PK4
}
__device__ __forceinline__ void qkt(f32x16& p0, f32x16& p1, const char* Ks, const bf16x8* qr, int r32, int hi) {
  const f32x16 z = {};
  bf16x8 a0 = *reinterpret_cast<const bf16x8*>(Ks + KSWZ(r32, (hi * 8) * 2)), a1 = *reinterpret_cast<const bf16x8*>(Ks + KSWZ(32 + r32, (hi * 8) * 2));
#pragma unroll
  for (int d0 = 0; d0 < 8; ++d0) {
    bf16x8 n0 = a0, n1 = a1;
    if (d0 < 7) { const int cb = ((d0 + 1) * 16 + hi * 8) * 2; n0 = *reinterpret_cast<const bf16x8*>(Ks + KSWZ(r32, cb)); n1 = *reinterpret_cast<const bf16x8*>(Ks + KSWZ(32 + r32, cb)); }
    p0 = MFMA32(a0, qr[d0], d0 == 0 ? z : p0);
    p1 = MFMA32(a1, qr[d0], d0 == 0 ? z : p1);
    a0 = n0; a1 = n1;
  }
}
__device__ __forceinline__ int v_st(int k, int c) { const int kk = (k & ~0xC) | ((k & 4) << 1) | ((k & 8) >> 1); return ((kk >> 3) * 4 + (c >> 5)) * 512 + ((kk & 7) * 32 + (c & 31)) * 2; }
__device__ __forceinline__ int v_rd_base(int lane) { return ((lane & 3) << 3) | (((lane >> 2) & 3) << 6) | (((lane >> 4) & 1) << 5) | (((lane >> 5) & 1) << 8); }
constexpr int v_rd_off(int d0, int ks, int half) { return d0 * 512 + ks * 4096 + half * 2048; }
template <int OFF> __device__ __forceinline__ s16x4 tr_read(int vb) {
  s16x4 r; asm volatile("ds_read_b64_tr_b16 %0, %1 offset:%2" : "=&v"(r) : "v"(vb), "i"(OFF) : "memory"); return r;
}
template <int D0> __device__ __forceinline__ void pv_one(f32x16& od, int vb, bf16x8 pa0, bf16x8 pa1, bf16x8 pa2, bf16x8 pa3) {
  const s16x4 l0 = tr_read<v_rd_off(D0, 0, 0)>(vb), h0 = tr_read<v_rd_off(D0, 0, 1)>(vb), l1 = tr_read<v_rd_off(D0, 1, 0)>(vb), h1 = tr_read<v_rd_off(D0, 1, 1)>(vb);
  const s16x4 l2 = tr_read<v_rd_off(D0, 2, 0)>(vb), h2 = tr_read<v_rd_off(D0, 2, 1)>(vb), l3 = tr_read<v_rd_off(D0, 3, 0)>(vb), h3 = tr_read<v_rd_off(D0, 3, 1)>(vb);
  asm volatile("s_waitcnt lgkmcnt(0)" ::: "memory"); SBAR();
#define PK(L, H) (bf16x8){L[0], L[1], L[2], L[3], H[0], H[1], H[2], H[3]}
  od = MFMA32(pa0, PK(l0, h0), od);
  od = MFMA32(pa1, PK(l1, h1), od);
  od = MFMA32(pa2, PK(l2, h2), od);
  od = MFMA32(pa3, PK(l3, h3), od);
#undef PK
}
__device__ __forceinline__ void pv_d0(f32x16* o, int vb, bf16x8 pa0, bf16x8 pa1, bf16x8 pa2, bf16x8 pa3) {
  pv_one<0>(o[0], vb, pa0, pa1, pa2, pa3); pv_one<1>(o[1], vb, pa0, pa1, pa2, pa3); pv_one<2>(o[2], vb, pa0, pa1, pa2, pa3); pv_one<3>(o[3], vb, pa0, pa1, pa2, pa3);
}
__device__ __forceinline__ void cmask(f32x16& p0, f32x16& p1, int tile, int qloc, int hi) {
#pragma unroll
  for (int r = 0; r < 16; ++r) { const int key = 64 * tile + crow(r, hi); if (key > qloc) p0[r] = -1e30f; if (key + 32 > qloc) p1[r] = -1e30f; }
}
#ifndef MOBA_STAGGER
#define MOBA_STAGGER 24
#endif
constexpr int MAXWC = 24;
constexpr int TILE_B = 16384;
__device__ __forceinline__ void wave_chunk(const bf16x8 (&qr)[8], int nt, bool causal, int qloc, const char* K_lds, int vb0, float* ws, unsigned rowoff, unsigned lseoff, unsigned char* wsb, int r32, int hi) {
  float* li_l = ws; float* al_l = ws + 32; unsigned* id_l = (unsigned*)(ws + 64);
  float m_reg = -1e30f, l_reg = 0; f32x16 o[4] = {};
#pragma unroll 1
  for (int t = 0; t < nt; ++t) {
    f32x16 p0, p1; float mn, alpha; bf16x8 pa0, pa1, pa2, pa3;
    __builtin_amdgcn_s_setprio(1); qkt(p0, p1, K_lds + t * TILE_B, qr, r32, hi); __builtin_amdgcn_s_setprio(0);
    if (causal && t == nt - 1) cmask(p0, p1, t, qloc, hi);
    partialSM(p0, p1, m_reg, mn, alpha);
    finishSM(p0, p1, alpha, l_reg, pa0, pa1, pa2, pa3);
    if (__any(alpha < 1.f)) { if (hi == 0) al_l[r32] = alpha; asm volatile("s_waitcnt lgkmcnt(0)" ::: "memory");
#pragma unroll
      for (int d = 0; d < 4; ++d)
#pragma unroll
        for (int r = 0; r < 16; ++r) o[d][r] *= al_l[crow(r, hi)]; }
    SBAR();
    __builtin_amdgcn_s_setprio(1); pv_d0(o, vb0 + t * TILE_B, pa0, pa1, pa2, pa3); __builtin_amdgcn_s_setprio(0);
  }
  if (hi == 0) { li_l[r32] = l_reg; id_l[r32] = rowoff; *(float*)(wsb + lseoff) = m_reg * (SCALE * 1.4426950408889634f) + __builtin_amdgcn_logf(l_reg); }
  asm volatile("s_waitcnt lgkmcnt(0)" ::: "memory");
#pragma unroll
  for (int r = 0; r < 16; ++r) { const int orow = crow(r, hi); const unsigned off = id_l[orow]; const float rl = __builtin_amdgcn_rcpf(li_l[orow]);
    unsigned short* dst = (unsigned short*)(wsb + off) + r32;
#pragma unroll
    for (int d0 = 0; d0 < 4; ++d0) dst[d0 * 32] = (unsigned short)(cvtpk(o[d0][r] * rl, 0.f)); }
  asm volatile("s_waitcnt lgkmcnt(0)" ::: "memory");
}
#undef KSWZ
}

__device__ __forceinline__ void moba_attn_phase(Frame& F) {
    constexpr int SCR_OFF = LDSCTL_OFF + 1024, PREF_OFF = SCR_OFF + 4096;
    LAS int* prefF = (LAS int*)(F.lds + PREF_OFF);
    LAS int* prefP = prefF + 520;
    LAS int* wsum = prefP + 520;
    LAS int* tk = wsum + 16;
    const int tid = F.tid;
    {   const unsigned n = __hip_atomic_load(F.ctl + CW_CNT + tid, __ATOMIC_RELAXED, __HIP_MEMORY_SCOPE_AGENT);
        const int wc = 8 + (int)((n + 31u) >> 5); const int nf = wc / moba::MAXWC, np = (wc % moba::MAXWC) ? 1 : 0;
        int v = nf, u = np;
#pragma unroll
        for (int o = 1; o < 64; o <<= 1) { const int t = __shfl_up(v, o), t2 = __shfl_up(u, o); if (F.lane >= o) { v += t; u += t2; } }
        if (F.lane == 63) { wsum[F.wave] = v; wsum[8 + F.wave] = u; }
        __syncthreads();
        int add = 0, add2 = 0;
#pragma unroll
        for (int w = 0; w < 8; ++w) { add += (w < F.wave) ? wsum[w] : 0; add2 += (w < F.wave) ? wsum[8 + w] : 0; }
        prefF[tid] = v - nf + add; prefP[tid] = u - np + add2;
        if (tid == 511) { prefF[512] = v + add; prefP[512] = u + add2; }
        if (tid == 0) tk[0] = (int)atomicAdd((unsigned*)(F.ctl + CW_QUEUE), 1u);
        __syncthreads();
    }
    const int totalF = prefF[512], total = totalF + prefP[512];
    const unsigned short* MIXq = (const unsigned short*)(F.ws + WS_MIX) + 1024;
    const unsigned short* KB = (const unsigned short*)(F.ws + WS_KB); const unsigned short* VB = (const unsigned short*)(F.ws + WS_VB);
    const unsigned* lists = (const unsigned*)(F.ws + WS_LISTS);
    const int r32 = F.lane & 31, hi = F.lane >> 5, w = F.wave;
    char* K_lds = (char*)F.lds; char* V_lds = (char*)F.lds + 4 * moba::TILE_B;
    float* scr = (float*)((char*)F.lds + SCR_OFF) + w * 128;
    const int vb0 = (int)(uintptr_t)V_lds + moba::v_rd_base(F.lane);
    const int sr = tid >> 4, sc = (tid & 15) * 8, vst0 = moba::v_st(sr, sc), vst1 = moba::v_st(32 + sr, sc);
    int it = tk[0];
    while (it < total) {
        const bool isfull = it < totalF; const int r_ = isfull ? it : it - totalF; LAS int* pref = isfull ? prefF : prefP;
        int lo = 0, hi_ = 512;
        while (hi_ - lo > 1) { const int mid = (lo + hi_) >> 1; if (pref[mid] <= r_) lo = mid; else hi_ = mid; }
        const int e = lo, h = e >> 6, j = e & 63;
        const int n = (int)__hip_atomic_load(F.ctl + CW_CNT + e, __ATOMIC_RELAXED, __HIP_MEMORY_SCOPE_AGENT);
        const int wc_e = 8 + ((n + 31) >> 5); const int sub = isfull ? (r_ - pref[e]) : (wc_e / moba::MAXWC);
        const int q_lo = sub * moba::MAXWC, q_hi = (q_lo + moba::MAXWC < wc_e) ? q_lo + moba::MAXWC : wc_e;
        const unsigned short* Kh = KB + (size_t)(j * 256) * 1024 + h * 128; const unsigned short* Vh = VB + (size_t)(j * 256) * 1024 + h * 128;
        { TPA_BEGIN(130);
        __syncthreads();
        if (tid == 0) tk[0] = (int)atomicAdd((unsigned*)(F.ctl + CW_QUEUE), 1u);
        {   bf16x8 kv[16];
#pragma unroll
            for (int tt = 0; tt < 4; ++tt) { const int k0 = tt * 64;
                kv[4 * tt + 0] = *(const bf16x8*)(Vh + (size_t)(k0 + sr) * 1024 + sc); kv[4 * tt + 1] = *(const bf16x8*)(Vh + (size_t)(k0 + 32 + sr) * 1024 + sc);
                kv[4 * tt + 2] = *(const bf16x8*)(Kh + (size_t)(k0 + sr) * 1024 + sc); kv[4 * tt + 3] = *(const bf16x8*)(Kh + (size_t)(k0 + 32 + sr) * 1024 + sc); }
#pragma unroll
            for (int tt = 0; tt < 4; ++tt) { const int tb = tt * moba::TILE_B, kc = sc * 2;
                *(bf16x8*)(V_lds + tb + vst0) = kv[4 * tt + 0]; *(bf16x8*)(V_lds + tb + vst1) = kv[4 * tt + 1];
                *(bf16x8*)(K_lds + tb + ((sr) * 256 + ((kc) ^ (((sr) & 7) << 4)))) = kv[4 * tt + 2];
                *(bf16x8*)(K_lds + tb + ((32 + sr) * 256 + ((kc) ^ (((32 + sr) & 7) << 4)))) = kv[4 * tt + 3]; }
        }
        __syncthreads();
        TPA_END(130); }
        it = tk[0];
        TPA_BEGIN(131);
        if (w >= 4) __builtin_amdgcn_s_sleep(MOBA_STAGGER);
        bf16x8 qa[8], qb[8]; unsigned ida = 0, idb = 0, lsa = 0, lsb = 0; int nta = 4, ntb = 4, qla = 0, qlb = 0; bool ca = false, cb = false;
        const unsigned dump = (unsigned)WS_KWT + (unsigned)((F.bid * 8 + w) * 512);
#define PART_OFF(slot_) ((unsigned)(((slot_) & 2) ? WS_PART2 : WS_PART0) + (unsigned)((slot_) & 1) * (unsigned)(32 * MiB))
#define WC_SETUP(Q_, QF, ID, LS, NT, QL, CZ) do { const int q__ = (Q_); const unsigned short* qp__; \
        if (q__ < 8) { const int p__ = j * 256 + 32 * q__ + r32; qp__ = MIXq + (size_t)p__ * 2048 + h * 128 + hi * 8; ID = PART_OFF(3) + (unsigned)(p__ * 8 + h) * 256u; LS = (unsigned)WS_LSE + (unsigned)((p__ * 8 + h) * 4 + 3) * 4u; NT = (q__ >> 1) + 1; QL = 32 * q__ + r32; CZ = true; } \
        else { const int idx__ = 32 * (q__ - 8) + r32; const bool v__ = idx__ < n; const unsigned ent__ = lists[list_off(h, j) + (v__ ? idx__ : 0)]; const int p__ = (int)(ent__ >> 2); const int sl__ = (int)(ent__ & 3u); \
               qp__ = MIXq + (size_t)p__ * 2048 + h * 128 + hi * 8; ID = v__ ? PART_OFF(sl__) + (unsigned)(p__ * 8 + h) * 256u : dump; LS = v__ ? (unsigned)WS_LSE + (unsigned)((p__ * 8 + h) * 4 + sl__) * 4u : dump + 256u; NT = 4; QL = 0; CZ = false; } \
        _Pragma("unroll") for (int d0 = 0; d0 < 8; ++d0) QF[d0] = *reinterpret_cast<const bf16x8*>(qp__ + d0 * 16); } while (0)
        int q = q_lo + w;
        if (q < q_hi) WC_SETUP(q, qa, ida, lsa, nta, qla, ca);
        while (q < q_hi) {
            if (q + 8 < q_hi) WC_SETUP(q + 8, qb, idb, lsb, ntb, qlb, cb);
            moba::wave_chunk(qa, nta, ca, qla, K_lds, vb0, scr, ida, lsa, F.ws, r32, hi);
            q += 8; if (q >= q_hi) break;
            if (q + 8 < q_hi) WC_SETUP(q + 8, qa, ida, lsa, nta, qla, ca);
            moba::wave_chunk(qb, ntb, cb, qlb, K_lds, vb0, scr, idb, lsb, F.ws, r32, hi);
            q += 8;
        }
#undef PART_OFF
#undef WC_SETUP
        TPA_END(131);
    }
}

__device__ __forceinline__ void moba_merge_phase(Frame& F, int wg, int nwg) {
    const float* lse = (const float*)(F.ws + WS_LSE);
    const u32x4v* P0 = (const u32x4v*)(F.ws + WS_PART0); const u32x4v* P1 = (const u32x4v*)(F.ws + WS_PART1);
    const u32x4v* P2 = (const u32x4v*)(F.ws + WS_PART2); const u32x4v* P3 = (const u32x4v*)(F.ws + WS_PART3);
    for (int g = wg * 512 + F.tid; g < M_TOK * MB_H * 16; g += nwg * 512) {
        const int ph = g >> 4, dg = g & 15, p = ph >> 3;
#if defined(DBG_OWN_ONLY)
        const int nsel = 0;
#else
        const int nsel = (p >> 8) < 3 ? (p >> 8) : 3;
#endif
        const f32x4 l4 = *(const f32x4*)(lse + (size_t)ph * 4);
        const size_t po = (size_t)ph * 16 + dg;
        const u32x4v v0 = P0[po], v1 = P1[po], v2 = P2[po], v3 = P3[po];
        const float l0 = nsel > 0 ? l4[0] : -INFINITY, l1 = nsel > 1 ? l4[1] : -INFINITY, l2 = nsel > 2 ? l4[2] : -INFINITY, l3 = l4[3];
        const float mx = fmaxf(fmaxf(l0, l1), fmaxf(l2, l3));
        const float w0 = nsel > 0 ? __builtin_amdgcn_exp2f(l0 - mx) : 0.f, w1 = nsel > 1 ? __builtin_amdgcn_exp2f(l1 - mx) : 0.f, w2 = nsel > 2 ? __builtin_amdgcn_exp2f(l2 - mx) : 0.f, w3 = __builtin_amdgcn_exp2f(l3 - mx);
        const u32x4v z = {0u, 0u, 0u, 0u};
        const u32x4v a0 = nsel > 0 ? v0 : z, a1 = nsel > 1 ? v1 : z, a2 = nsel > 2 ? v2 : z;
        const float inv = 1.f / ((w0 + w1) + (w2 + w3));
        float acc[8];
#define MRG(E, F_) acc[E] = (w0 * F_(a0[E >> 1]) + w1 * F_(a1[E >> 1])) + (w2 * F_(a2[E >> 1]) + w3 * F_(v3[E >> 1]))
        MRG(0, bflo); MRG(1, bfhi); MRG(2, bflo); MRG(3, bfhi); MRG(4, bflo); MRG(5, bfhi); MRG(6, bflo); MRG(7, bfhi);
#undef MRG
        u32x4v o; o.x = pk2(acc[0] * inv, acc[1] * inv); o.y = pk2(acc[2] * inv, acc[3] * inv); o.z = pk2(acc[4] * inv, acc[5] * inv); o.w = pk2(acc[6] * inv, acc[7] * inv);
        *(u32x4v*)((unsigned short*)(F.ws + WS_MIX) + (size_t)p * 2048 + 1024 + (ph & 7) * 128 + dg * 8) = o;
    }
}

__device__ __forceinline__ void ml_mscan(const float* chsum, int h, int c, int lane, float& m_c, float& m_c1) {
    float a[4], g[4]; float A = 0.f, G = -INFINITY;
#pragma unroll
    for (int i = 0; i < 4; ++i) { const int cc = 4 * lane + i; const float bl = chsum[(cc * 4 + h) * 2], m1 = chsum[(cc * 4 + h) * 2 + 1]; a[i] = bl; g[i] = bl + m1; G = fmaxf(G + a[i], g[i]); A += a[i]; }
#pragma unroll
    for (int o = 1; o < 64; o <<= 1) { const float Ao = __shfl_up(A, o), Go = __shfl_up(G, o); if (lane >= o) { G = fmaxf(Go + A, G); A = Ao + A; } }
    float Ae = __shfl_up(A, 1), Ge = __shfl_up(G, 1); if (lane == 0) { Ae = 0.f; Ge = -INFINITY; }
    float m = fmaxf(Ae, Ge), mc = 0.f, mc1 = 0.f;
#pragma unroll
    for (int i = 0; i < 4; ++i) { if (i == (c & 3)) mc = m; m = fmaxf(m + a[i], g[i]); if (i == (c & 3)) mc1 = m; }
    m_c = __shfl(mc, c >> 2); m_c1 = __shfl(mc1, c >> 2);
}
__device__ __forceinline__ void ml_tables(const float* chsum, int h, int lane, LAS float* dec, LAS float* scl) {
    float a[4], g[4]; float A = 0.f, G = -INFINITY;
#pragma unroll
    for (int i = 0; i < 4; ++i) { const int cc = 4 * lane + i; const float bl = chsum[(cc * 4 + h) * 2], m1 = chsum[(cc * 4 + h) * 2 + 1]; a[i] = bl; g[i] = bl + m1; G = fmaxf(G + a[i], g[i]); A += a[i]; }
#pragma unroll
    for (int o = 1; o < 64; o <<= 1) { const float Ao = __shfl_up(A, o), Go = __shfl_up(G, o); if (lane >= o) { G = fmaxf(Go + A, G); A = Ao + A; } }
    float Ae = __shfl_up(A, 1), Ge = __shfl_up(G, 1); if (lane == 0) { Ae = 0.f; Ge = -INFINITY; }
    float m = fmaxf(Ae, Ge);
#pragma unroll
    for (int i = 0; i < 4; ++i) { const float mn = fmaxf(m + a[i], g[i]); dec[4 * lane + i] = expf(a[i] + m - mn); scl[4 * lane + i] = expf(g[i] - mn); m = mn; }
}
__device__ __forceinline__ void ml_scan_item(Frame& F, int item) {
    LAS float* dec = (LAS float*)F.lds; LAS float* scl = dec + 1024;
    if (item < 32) {
        const int gid = item * 512 + F.tid, h = gid >> 12, rem = gid & 4095;
        if (F.wave == 0) ml_tables(SMALLF(SM_CHSUM), h, F.lane, dec, scl);
        __syncthreads();
        u32x4v* base = (u32x4v*)((unsigned short*)(F.ws + WS_LOCAL) + (size_t)h * 256 * 128) + rem;
        constexpr size_t CST = (size_t)4 * 256 * 128 / 8;
        float C[8];
#pragma unroll
        for (int e = 0; e < 8; ++e) C[e] = 0.f;
        u32x4v la[16], lb[16];
#define SC_LOAD(L, c0_) do { _Pragma("unroll") for (int i = 0; i < 16; ++i) L[i] = base[(size_t)((c0_) + i) * CST]; } while (0)
#define SC_STEP(L, c0_) do { _Pragma("unroll") for (int i = 0; i < 16; ++i) { \
            u32x4v st; st.x = cvtpk(C[0], C[1]); st.y = cvtpk(C[2], C[3]); st.z = cvtpk(C[4], C[5]); st.w = cvtpk(C[6], C[7]); \
            base[(size_t)((c0_) + i) * CST] = st; \
            const u32x4v v = L[i]; const float d = dec[(c0_) + i], s = scl[(c0_) + i]; \
            C[0] = d * C[0] + s * bflo(v.x); C[1] = d * C[1] + s * bfhi(v.x); C[2] = d * C[2] + s * bflo(v.y); C[3] = d * C[3] + s * bfhi(v.y); \
            C[4] = d * C[4] + s * bflo(v.z); C[5] = d * C[5] + s * bfhi(v.z); C[6] = d * C[6] + s * bflo(v.w); C[7] = d * C[7] + s * bfhi(v.w); } } while (0)
        SC_LOAD(la, 0);
#pragma unroll 1
        for (int c0 = 0; c0 < ML_NC; c0 += 32) {
            SC_LOAD(lb, c0 + 16);
            SC_STEP(la, c0);
            if (c0 + 32 < ML_NC) SC_LOAD(la, c0 + 32);
            SC_STEP(lb, c0 + 16);
        }
#undef SC_LOAD
#undef SC_STEP
        __syncthreads();
    } else {
        if (F.wave < 4) ml_tables(SMALLF(SM_CHSUM), F.wave, F.lane, dec + F.wave * 256, scl + F.wave * 256);
        __syncthreads();
        const int h = F.tid >> 7, d = F.tid & 127; float* nl = SMALLF(SM_NLOC) + h * 128 + d; float n = 0.f;
#pragma unroll 1
        for (int c0 = 0; c0 < ML_NC; c0 += 32) {
            float lv[32];
#pragma unroll
            for (int i = 0; i < 32; ++i) lv[i] = nl[(size_t)(c0 + i) * 512];
#pragma unroll
            for (int i = 0; i < 32; ++i) { nl[(size_t)(c0 + i) * 512] = n; n = dec[h * 256 + c0 + i] * n + scl[h * 256 + c0 + i] * lv[i]; }
        }
        __syncthreads();
    }
}
__device__ __forceinline__ float dpp_row_sum(float x) {
    x += __builtin_bit_cast(float, __builtin_amdgcn_update_dpp(0, __builtin_bit_cast(int, x), 0xB1, 0xF, 0xF, true));
    x += __builtin_bit_cast(float, __builtin_amdgcn_update_dpp(0, __builtin_bit_cast(int, x), 0x4E, 0xF, 0xF, true));
    x += __builtin_bit_cast(float, __builtin_amdgcn_update_dpp(0, __builtin_bit_cast(int, x), 0x141, 0xF, 0xF, true));
    x += __builtin_bit_cast(float, __builtin_amdgcn_update_dpp(0, __builtin_bit_cast(int, x), 0x140, 0xF, 0xF, true));
    return x;
}
struct MlRegs { v4u gq[2], gk[2], gm[4]; bf16x8 cf[8]; u32x2 vlo[4], vhi[4]; };
__device__ __forceinline__ void ml_load_tiles(Frame& F, int c, int h, MlRegs& R) {
    const int tid = F.tid, t0 = c * ML_L;
    const v4u* QC = (const v4u*)(F.ws + WS_QC); const v4u* KC = (const v4u*)(F.ws + WS_KC); const v4u* MX = (const v4u*)(F.ws + WS_MIX);
#pragma unroll
    for (int i = 0; i < 2; ++i) { const int idx = tid + 512 * i, row = idx >> 4, ch = idx & 15; R.gq[i] = QC[(size_t)(t0 + row) * 64 + h * 16 + ch]; R.gk[i] = KC[(size_t)(t0 + row) * 64 + h * 16 + ch]; }
    (void)MX;
}
__device__ __forceinline__ void ml_load_state(Frame& F, int c, int h, MlRegs& R) {
    const int hh = F.lane >> 5, vcol = 32 * F.wave + (F.lane & 31);
    const unsigned short* ST = (const unsigned short*)(F.ws + WS_LOCAL) + (size_t)(c * 4 + h) * 256 * 128 + (size_t)vcol * 8;
#pragma unroll
    for (int kd = 0; kd < 8; ++kd) R.cf[kd] = *(const bf16x8*)(ST + (2 * kd + hh) * 2048);
}
__device__ __forceinline__ void ml_load_vt(Frame& F, int c, int h, MlRegs& R) {
    const int hh = F.lane >> 5, vcol = 32 * F.wave + (F.lane & 31);
    const unsigned short* VTv = (const unsigned short*)(F.ws + WS_VT) + (size_t)(c * 4 + h) * 256 * 64 + (size_t)vcol * 4;
#pragma unroll
    for (int i = 0; i < 4; ++i) { R.vlo[i] = *(const u32x2*)(VTv + (4 * i + hh) * 1024); R.vhi[i] = *(const u32x2*)(VTv + (4 * i + 2 + hh) * 1024); }
}
__device__ __forceinline__ void ml_out_item(Frame& F, int c, int h, MlRegs& R, bool has_next, int cn, int hn) {
    const int lane = F.lane, r = lane & 31, hh = lane >> 5, w = F.wave, tid = F.tid, t0 = c * ML_L;
    constexpr int QS = 136, MS = 264;
    LAS float* tb_u = (LAS float*)F.lds;
    LAS float* tb_mt = tb_u + 64;
    LAS float* tb_wi = tb_mt + 64;
    LAS float* tb_em = tb_wi + 64;
    LAS float* tb_n = tb_em + 64;
    LAS float* tb_den = tb_n + 128;
    LAS float* tb_ln = tb_den + 512;
    LAS float* tb_mr = tb_ln + 1024;
    LAS unsigned short* Ql = (LAS unsigned short*)(F.lds + 8192);
    LAS unsigned short* Kl = Ql + 64 * QS;
    LAS unsigned short* Ml = Kl + 64 * QS;
    const int vcol = 32 * w + r;
    ml_load_tiles(F, c, h, R);
    {   const v4u* MX = (const v4u*)(F.ws + WS_MIX);
#pragma unroll
        for (int i = 0; i < 4; ++i) { const int idx = tid + 512 * i, row = idx >> 5, ch = idx & 31; R.gm[i] = MX[(size_t)(t0 + row) * 256 + h * 32 + ch]; } }
    float m_c, m_c1; ml_mscan(SMALLF(SM_CHSUM), h, c, lane, m_c, m_c1);
    if (tid < 64) { const f32x4 ts = *(const f32x4*)(SMALLF(SM_TOKSC) + (size_t)((t0 + tid) * 4 + h) * 4);
        const float mt = fmaxf(m_c, ts.z); tb_u[tid] = ts.y; tb_mt[tid] = mt; tb_wi[tid] = expf(m_c - mt); tb_em[tid] = expf(-(ts.x + mt)); }
    if (tid >= 64 && tid < 192) tb_n[tid - 64] = SMALLF(SM_NLOC)[(c * 4 + h) * 128 + tid - 64];
#pragma unroll
    for (int i = 0; i < 2; ++i) { const int idx = tid + 512 * i, row = idx >> 4, ch = idx & 15; *(LAS v4u*)(Ql + row * QS + ch * 8) = R.gq[i]; *(LAS v4u*)(Kl + row * QS + ch * 8) = R.gk[i]; }
#pragma unroll
    for (int i = 0; i < 4; ++i) { const int idx = tid + 512 * i, row = idx >> 5, ch = idx & 31; *(LAS v4u*)(Ml + row * MS + ch * 8) = R.gm[i]; }
    __syncthreads();
    f32x16 s00 = {}, s01 = {}, s11 = {};
    float qn0 = 0.f, qn1 = 0.f;
#pragma unroll 1
    for (int kd = 0; kd < 8; ++kd) {
        const bf16x8 q0 = *(const LAS bf16x8*)(Ql + r * QS + 16 * kd + 8 * hh), q1 = *(const LAS bf16x8*)(Ql + (32 + r) * QS + 16 * kd + 8 * hh);
        const bf16x8 k0 = *(const LAS bf16x8*)(Kl + r * QS + 16 * kd + 8 * hh), k1 = *(const LAS bf16x8*)(Kl + (32 + r) * QS + 16 * kd + 8 * hh);
        s00 = MFMA32(k0, q0, s00); s01 = MFMA32(k0, q1, s01); s11 = MFMA32(k1, q1, s11);
        const f32x4 n0 = *(const LAS f32x4*)(tb_n + 16 * kd + 8 * hh), n1 = *(const LAS f32x4*)(tb_n + 16 * kd + 8 * hh + 4);
        const u32x4v a = __builtin_bit_cast(u32x4v, q0), b = __builtin_bit_cast(u32x4v, q1);
        qn0 += bflo(a.x) * n0.x + bfhi(a.x) * n0.y + bflo(a.y) * n0.z + bfhi(a.y) * n0.w + bflo(a.z) * n1.x + bfhi(a.z) * n1.y + bflo(a.w) * n1.z + bfhi(a.w) * n1.w;
        qn1 += bflo(b.x) * n0.x + bfhi(b.x) * n0.y + bflo(b.y) * n0.z + bfhi(b.y) * n0.w + bflo(b.z) * n1.x + bfhi(b.z) * n1.y + bflo(b.w) * n1.z + bfhi(b.w) * n1.w;
    }
    const float mt0 = tb_mt[r], mt1 = tb_mt[32 + r];
    float rs0 = 0.f, rs1 = 0.f;
#pragma unroll
    for (int q = 0; q < 16; ++q) {
        const int s = crow(q, hh); const float u0 = tb_u[s], u1 = tb_u[32 + s];
        s00[q] = (s <= r) ? s00[q] * __expf(u0 - mt0) : 0.f;
        s01[q] = s01[q] * __expf(u0 - mt1);
        s11[q] = (s <= r) ? s11[q] * __expf(u1 - mt1) : 0.f;
        rs0 += s00[q]; rs1 += s01[q] + s11[q];
    }
    rs0 += __shfl_xor(rs0, 32); rs1 += __shfl_xor(rs1, 32); qn0 += __shfl_xor(qn0, 32); qn1 += __shfl_xor(qn1, 32);
    {   const float den0 = tb_wi[r] * qn0 + rs0, den1 = tb_wi[32 + r] * qn1 + rs1;
        if (hh == 0) { tb_den[w * 64 + r] = 1.f / fmaxf(fabsf(den0), tb_em[r]); tb_den[w * 64 + 32 + r] = 1.f / fmaxf(fabsf(den1), tb_em[32 + r]); } }
    bf16x8 p00[2], p01[2], p11[2];
#pragma unroll
    for (int ks = 0; ks < 2; ++ks) {
        u32x4v x; x.x = cvtpk(s00[8 * ks], s00[8 * ks + 1]); x.y = cvtpk(s00[8 * ks + 2], s00[8 * ks + 3]); x.z = cvtpk(s00[8 * ks + 4], s00[8 * ks + 5]); x.w = cvtpk(s00[8 * ks + 6], s00[8 * ks + 7]); p00[ks] = __builtin_bit_cast(bf16x8, x);
        x.x = cvtpk(s01[8 * ks], s01[8 * ks + 1]); x.y = cvtpk(s01[8 * ks + 2], s01[8 * ks + 3]); x.z = cvtpk(s01[8 * ks + 4], s01[8 * ks + 5]); x.w = cvtpk(s01[8 * ks + 6], s01[8 * ks + 7]); p01[ks] = __builtin_bit_cast(bf16x8, x);
        x.x = cvtpk(s11[8 * ks], s11[8 * ks + 1]); x.y = cvtpk(s11[8 * ks + 2], s11[8 * ks + 3]); x.z = cvtpk(s11[8 * ks + 4], s11[8 * ks + 5]); x.w = cvtpk(s11[8 * ks + 6], s11[8 * ks + 7]); p11[ks] = __builtin_bit_cast(bf16x8, x);
    }
    f32x16 o0 = {}, o1 = {};
#pragma unroll
    for (int kd = 0; kd < 8; ++kd) {
        const bf16x8 q0 = *(const LAS bf16x8*)(Ql + r * QS + 16 * kd + 8 * hh), q1 = *(const LAS bf16x8*)(Ql + (32 + r) * QS + 16 * kd + 8 * hh);
        o0 = MFMA32(q0, R.cf[kd], o0); o1 = MFMA32(q1, R.cf[kd], o1); }
    asm volatile("" ::: "memory");
    if (has_next) ml_load_state(F, cn, hn, R);
#pragma unroll
    for (int q = 0; q < 16; ++q) { o0[q] *= tb_wi[crow(q, hh)]; o1[q] *= tb_wi[32 + crow(q, hh)]; }
#pragma unroll
    for (int st = 0; st < 2; ++st)
#pragma unroll
        for (int ks = 0; ks < 2; ++ks) {
            u32x4v bb; bb.x = R.vlo[2 * st + ks].x; bb.y = R.vlo[2 * st + ks].y; bb.z = R.vhi[2 * st + ks].x; bb.w = R.vhi[2 * st + ks].y; const bf16x8 vf = __builtin_bit_cast(bf16x8, bb);
            if (st == 0) { o0 = MFMA32(p00[ks], vf, o0); o1 = MFMA32(p01[ks], vf, o1); } else { o1 = MFMA32(p11[ks], vf, o1); }
        }
    asm volatile("" ::: "memory");
    if (has_next) ml_load_vt(F, cn, hn, R);
#pragma unroll
    for (int q = 0; q < 16; ++q) { o0[q] *= tb_den[w * 64 + crow(q, hh)]; o1[q] *= tb_den[w * 64 + 32 + crow(q, hh)]; }
#pragma unroll
    for (int q = 0; q < 16; ++q) {
        float a = dpp_row_sum(o0[q]), a2 = dpp_row_sum(o0[q] * o0[q]), b = dpp_row_sum(o1[q]), b2 = dpp_row_sum(o1[q] * o1[q]);
        a += __shfl_xor(a, 16); a2 += __shfl_xor(a2, 16); b += __shfl_xor(b, 16); b2 += __shfl_xor(b2, 16);
        if (r == 0) { const int t = crow(q, hh); tb_ln[(w * 64 + t) * 2] = a; tb_ln[(w * 64 + t) * 2 + 1] = a2; tb_ln[(w * 64 + 32 + t) * 2] = b; tb_ln[(w * 64 + 32 + t) * 2 + 1] = b2; }
    }
    __syncthreads();
    if (tid < 64) { float s = 0.f, s2 = 0.f;
#pragma unroll
        for (int ww = 0; ww < 8; ++ww) { s += tb_ln[(ww * 64 + tid) * 2]; s2 += tb_ln[(ww * 64 + tid) * 2 + 1]; }
        const float mu = s * (1.f / 256.f), var = fmaxf(s2 * (1.f / 256.f) - mu * mu, 0.f); tb_mr[tid * 2] = mu; tb_mr[tid * 2 + 1] = rsqrtf(var + LN_EPS); }
    __syncthreads();
    const float nw = F.normw[h * 256 + vcol];
#pragma unroll
    for (int tt = 0; tt < 2; ++tt)
#pragma unroll
        for (int q = 0; q < 16; ++q) {
            const int t = 32 * tt + crow(q, hh); const float mu = tb_mr[t * 2], rstd = tb_mr[t * 2 + 1];
            const float hv = tt ? o1[q] : o0[q];
            LAS unsigned short* op = Ml + t * MS + vcol; const float mo = bf2f(*op);
            *op = (unsigned short)f2bf((hv - mu) * rstd * nw * sigmoid_f(mo));
        }
    __syncthreads();
    {   v4u* MX = (v4u*)(F.ws + WS_MIX);
#pragma unroll
        for (int i = 0; i < 4; ++i) { const int idx = tid + 512 * i, row = idx >> 5, ch = idx & 31; MX[(size_t)(t0 + row) * 256 + h * 32 + ch] = *(LAS v4u*)(Ml + row * MS + ch * 8); } }
    __syncthreads();
}

__device__ __forceinline__ void x2_phase(Frame& F) {
    constexpr int NSCAN = 33;
#if defined(NAIVE_MOBA)
    for (int i = F.bid; i < NSCAN; i += F.G) ml_scan_item(F, i);
#elif defined(NAIVE_MLSTM)
    moba_attn_phase(F);
#else
    for (int i = F.bid; i < NSCAN; i += F.G) { TP_BEGIN(100); ml_scan_item(F, i); TP_END(100); }
    __syncthreads();
    TP_BEGIN(101); moba_attn_phase(F); TP_END(101);
#endif
}
__device__ __forceinline__ void x3_phase(Frame& F) {
#if !defined(NAIVE_MLSTM)
    TP_BEGIN(150);
    {   MlRegs R; int it = F.bid;
        if (it < ML_NC * ML_H) { ml_load_state(F, it >> 2, it & 3, R); ml_load_vt(F, it >> 2, it & 3, R); }
        for (; it < ML_NC * ML_H; it += F.G) { const int nx = it + F.G; const bool hn = nx < ML_NC * ML_H; ml_out_item(F, it >> 2, it & 3, R, hn, nx >> 2, nx & 3); } }
    TP_END(150);
#endif
#if !defined(NAIVE_MOBA) && !defined(DBG_SKIP_MERGE)
    TP_BEGIN(151); moba_merge_phase(F, F.bid, F.G); TP_END(151);
#endif
}
__global__ void __launch_bounds__(512) naive_moba(unsigned char* ws) {
    __shared__ float qf_s[8][128];
    __shared__ float pb_s[8][1024];
    const int wave = threadIdx.x >> 6, lane = threadIdx.x & 63;
    const int gw = blockIdx.x * 8 + wave; const int p = gw >> 3, h = gw & 7;
    unsigned short* MIX = (unsigned short*)(ws + WS_MIX);
    const unsigned short* KB = (const unsigned short*)(ws + WS_KB); const unsigned short* VB = (const unsigned short*)(ws + WS_VB);
    const float* kmean = (const float*)(ws + WS_SMALL + SM_KMEAN);
    float* qf = qf_s[wave]; float* pb = pb_s[wave];
    unsigned short* qp = MIX + (size_t)p * 2048 + 1024 + h * 128;
    qf[lane * 2] = bf2f(qp[lane * 2]); qf[lane * 2 + 1] = bf2f(qp[lane * 2 + 1]);
    __syncthreads();
    const int b = p >> 8;
    float sc = -INFINITY;
    if (lane < b) { const float* km = kmean + (size_t)(h * 64 + lane) * 128; float s = 0.f; for (int d = 0; d < 128; ++d) s += qf[d] * km[d]; sc = s; }
    int sel[3]; const int nsel = b < 3 ? b : 3;
#pragma unroll
    for (int k = 0; k < 3; ++k) {
        float bv = sc; int bi = lane;
        for (int o = 1; o < 64; o <<= 1) { const float ov = __shfl_xor(bv, o); const int oi = __shfl_xor(bi, o); if (ov > bv || (ov == bv && oi < bi)) { bv = ov; bi = oi; } }
        sel[k] = bi; if (lane == bi) sc = -INFINITY;
    }
    float s[16]; float mx = -INFINITY;
#pragma unroll
    for (int bi = 0; bi < 4; ++bi) {
        const bool valid = (bi < nsel) || (bi == 3); const int blk = (bi == 3) ? b : sel[bi < 3 ? bi : 0];
#pragma unroll
        for (int kk = 0; kk < 4; ++kk) {
            float v = -INFINITY;
            if (valid) { const int key = blk * 256 + kk * 64 + lane; const unsigned short* kr = KB + (size_t)key * 1024 + h * 128; float a = 0.f; for (int d = 0; d < 128; ++d) a += qf[d] * bf2f(kr[d]); a *= K_SCALE; if (bi == 3 && key > p) a = -INFINITY; v = a; }
            s[bi * 4 + kk] = v; mx = fmaxf(mx, v);
        }
    }
    for (int o = 1; o < 64; o <<= 1) mx = fmaxf(mx, __shfl_xor(mx, o));
    float sum = 0.f;
#pragma unroll
    for (int i = 0; i < 16; ++i) { const float e = (s[i] == -INFINITY) ? 0.f : expf(s[i] - mx); pb[i * 64 + lane] = e; sum += e; }
    sum = wave_sum(sum);
    __syncthreads();
    float o0 = 0.f, o1 = 0.f;
#pragma unroll
    for (int bi = 0; bi < 4; ++bi) {
        const bool valid = (bi < nsel) || (bi == 3); if (!valid) continue; const int blk = (bi == 3) ? b : sel[bi];
        for (int kk = 0; kk < 256; ++kk) { const float pv = pb[bi * 256 + kk]; const unsigned v = *(const unsigned*)(VB + (size_t)(blk * 256 + kk) * 1024 + h * 128 + lane * 2); o0 += pv * bflo(v); o1 += pv * bfhi(v); }
    }
    const float inv = 1.f / sum;
    *(unsigned*)(qp + lane * 2) = pk2(o0 * inv, o1 * inv);
}
__global__ void __launch_bounds__(256) naive_mlstm(unsigned char* ws, const float* igb, const float* fgb, const float* normw) {
    __shared__ float q[128], k[128], nn[128], red[4], red2[4];
    const int h = blockIdx.x, v = threadIdx.x, lane = v & 63, wv = v >> 6;
    const unsigned short* QC = (const unsigned short*)(ws + WS_QC); const unsigned short* KC = (const unsigned short*)(ws + WS_KC); const unsigned short* MV = (const unsigned short*)(ws + WS_MV);
    const float* gates = (const float*)(ws + WS_SMALL + SM_GATES); unsigned short* MIX = (unsigned short*)(ws + WS_MIX);
    float C[128];
#pragma unroll
    for (int d = 0; d < 128; ++d) C[d] = 0.f;
    float m = 0.f; if (v < 128) nn[v] = 0.f;
    const float ib = igb[h], fb = fgb[h], nw = normw[h * 256 + v];
    for (int t = 0; t < M_TOK; ++t) {
        if (v < 128) q[v] = bf2f(QC[(size_t)t * 512 + h * 128 + v]); else k[v - 128] = bf2f(KC[(size_t)t * 512 + h * 128 + v - 128]);
        const float ig = gates[t * 8 + h] + ib, lf = logsigmoid_f(gates[t * 8 + 4 + h] + fb);
        const float mn = fmaxf(lf + m, ig), fd = expf(lf + m - mn), iw = expf(ig - mn); m = mn;
        const float vv = bf2f(MV[(size_t)t * 1024 + h * 256 + v]);
        __syncthreads();
        if (v < 128) nn[v] = fd * nn[v] + iw * k[v];
        float num = 0.f;
#pragma unroll
        for (int d = 0; d < 128; ++d) { C[d] = fd * C[d] + iw * k[d] * vv; num += q[d] * C[d]; }
        __syncthreads();
        float den = 0.f;
#pragma unroll 16
        for (int d = 0; d < 128; ++d) den += q[d] * nn[d];
        const float hv = num / fmaxf(fabsf(den), expf(-m));
        float s = wave_sum(hv); if (lane == 0) red[wv] = s;
        __syncthreads();
        const float mu = (red[0] + red[1] + red[2] + red[3]) * (1.f / 256.f);
        const float dv = hv - mu; float s2 = wave_sum(dv * dv); if (lane == 0) red2[wv] = s2;
        __syncthreads();
        const float var = (red2[0] + red2[1] + red2[2] + red2[3]) * (1.f / 256.f);
        unsigned short* op = MIX + (size_t)t * 2048 + h * 256 + v;
        const float mo = bf2f(*op);
        *op = (unsigned short)f2bf(dv * rsqrtf(var + LN_EPS) * nw * sigmoid_f(mo));
    }
}
__global__ void __launch_bounds__(256) dbg_cmp_u32(const unsigned* a, const unsigned* b, size_t n, unsigned* cnt) {
    unsigned c = 0;
    for (size_t i = blockIdx.x * 256ull + threadIdx.x; i < n; i += gridDim.x * 256ull) c += (a[i] != b[i]) ? 1u : 0u;
    if (c) atomicAdd(cnt, c);
}
__global__ void __launch_bounds__(512) dbg_check_own(unsigned char* ws, unsigned* cnt) {
    __shared__ float qf_s[8][128];
    __shared__ float pb_s[8][256];
    const int wave = threadIdx.x >> 6, lane = threadIdx.x & 63;
    const int gw = blockIdx.x * 8 + wave; const int p = gw >> 3, h = gw & 7;
    const unsigned short* MIX = (const unsigned short*)(ws + WS_MIX);
    const unsigned short* KB = (const unsigned short*)(ws + WS_KB); const unsigned short* VB = (const unsigned short*)(ws + WS_VB);
    float* qf = qf_s[wave]; float* pb = pb_s[wave];
    const unsigned short* qp = MIX + (size_t)p * 2048 + 1024 + h * 128;
    qf[lane * 2] = bf2f(qp[lane * 2]); qf[lane * 2 + 1] = bf2f(qp[lane * 2 + 1]);
    __syncthreads();
    const int b = p >> 8; float s[4], mx = -INFINITY;
#pragma unroll
    for (int kk = 0; kk < 4; ++kk) { const int key = b * 256 + kk * 64 + lane; const unsigned short* kr = KB + (size_t)key * 1024 + h * 128; float a = 0.f; for (int d = 0; d < 128; ++d) a += qf[d] * bf2f(kr[d]); a *= K_SCALE; if (key > p) a = -INFINITY; s[kk] = a; mx = fmaxf(mx, a); }
    for (int o = 1; o < 64; o <<= 1) mx = fmaxf(mx, __shfl_xor(mx, o));
    float sum = 0.f;
#pragma unroll
    for (int kk = 0; kk < 4; ++kk) { const float e = (s[kk] == -INFINITY) ? 0.f : expf(s[kk] - mx); pb[kk * 64 + lane] = e; sum += e; }
    sum = wave_sum(sum);
    __syncthreads();
    float o0 = 0.f, o1 = 0.f;
    for (int kk = 0; kk < 256; ++kk) { const float pv = pb[kk]; const unsigned v = *(const unsigned*)(VB + (size_t)(b * 256 + kk) * 1024 + h * 128 + lane * 2); o0 += pv * bflo(v); o1 += pv * bfhi(v); }
    o0 /= sum; o1 /= sum;
    const unsigned short* pr = (const unsigned short*)(ws + WS_PART3) + (size_t)(p * 8 + h) * 128 + lane * 2;
    float d = fmaxf(fabsf(o0 - bf2f(pr[0])), fabsf(o1 - bf2f(pr[1])));
    for (int o = 1; o < 64; o <<= 1) d = fmaxf(d, __shfl_xor(d, o));
    const float lse_ref = mx * 1.4426950408889634f + log2f(sum); const float lse = ((const float*)(ws + WS_LSE))[(p * 8 + h) * 4 + 3];
    if (lane == 0) { if (d > 0.02f) atomicAdd(cnt, 1u); if (!(fabsf(lse - lse_ref) < 0.05f)) atomicAdd(cnt + 1, 1u); }
}
__global__ void dbg_flag(const unsigned* cnt, float* out) {
    if (threadIdx.x == 0) { if (cnt[0]) out[0] += 1000.f; if (cnt[1]) out[1] += 2000.f; if (cnt[2]) out[2] += 4000.f; if (cnt[3]) out[3] += 8000.f; }
}
#ifndef PG8_SP2
#define PG8_SP2 true
#endif
#ifndef PG8_ALIGN
#define PG8_ALIGN true
#endif
constexpr int N_PHASES = 12;
struct Args { const float* in[17]; float* out; unsigned char* ws; int ph_lo, ph_hi, li, pad; };
__global__ void __launch_bounds__(NWAVES * 64, 2) mk_fwd(Args args) {
    extern __shared__ __attribute__((aligned(16))) unsigned char lds[];
    Frame F;
    F.lds = (LAS unsigned char*)lds;
    F.MISC = (volatile LAS unsigned*)(F.lds + MISC_OFF);
    F.tid = threadIdx.x; F.lane = F.tid & 63; F.wave = __builtin_amdgcn_readfirstlane(F.tid >> 6);
    F.G = gridDim.x; F.bid = blockIdx.x; F.tp0 = 0; F.tp1 = 0;
    F.ws = args.ws; F.ctl = (gu32*)(args.ws + WS_CTL); F.out = args.out;
    F.x = args.in[0]; F.c = args.in[1]; F.w_ada = args.in[2]; F.b_ada = args.in[3]; F.w_in = args.in[4]; F.conv_w = args.in[5]; F.conv_b = args.in[6];
    F.igb = args.in[7]; F.fgb = args.in[8]; F.normw = args.in[9]; F.w_out = args.in[10]; F.ln1_w = args.in[11]; F.ln1_b = args.in[12];
    F.w_gu = args.in[13]; F.w_down = args.in[14]; F.ln2_w = args.in[15]; F.ln2_b = args.in[16];
    for (int u = F.tid; u < (LDS_BYTES - LDSCTL_OFF) / 4; u += NWAVES * 64) ((LAS unsigned*)(F.lds + LDSCTL_OFF))[u] = 0u;
    __syncthreads();
    const int lo = args.ph_lo, hi = args.ph_hi;
    XcdBarrier bar; bar.bar = (unsigned*)(F.ctl + CW_BAR) + args.li * XCD_BAR_WORDS; bar.x = 0; bar.st = nullptr;
    if (hi - lo > 1) bar = xcd_barrier_post((unsigned*)(F.ctl + CW_BAR) + args.li * XCD_BAR_WORDS, F.MISC + 8);
#ifndef PHMASK
#define PHMASK 0xFFF
#endif
#define IN(k) (((PHMASK >> (k)) & 1) && lo <= (k) && (k) < hi)
#if defined(TIME_PHASE)
    unsigned long long tp0 = 0, tp1 = 0;
#define TSTAMP(k) do { if ((k) + 1 == TIME_PHASE) tp0 = __builtin_amdgcn_s_memrealtime(); if ((k) == TIME_PHASE) tp1 = __builtin_amdgcn_s_memrealtime(); } while (0)
#else
#define TSTAMP(k) do { } while (0)
#endif
#define SEAM(k) do { if (IN(k) && IN((k) + 1)) xcd_barrier(bar); TSTAMP(k); } while (0)
    float* ada = SMALLF(SM_ADA);
#if defined(TIME_PHASE)
    if (TIME_PHASE == 0) tp0 = __builtin_amdgcn_s_memrealtime();
#endif
    if (IN(0)) { p0_phase(F); } SEAM(0);
    if (IN(1)) { p1_phase(F); } SEAM(1);
    if (IN(2)) {
        pg8::Gemm g{(const pg8::bf16_t*)(F.ws + WS_U), (const pg8::bf16_t*)(F.ws + WS_WIN), M_TOK, NPROJ, DM}; pg8::StaticOrder S; S.init(M_TOK, NPROJ, F.G, F.bid, WGM_P2);
        pg8::EpiProj E{(pg8::bf16_t*)(F.ws + WS_MIX), (pg8::bf16_t*)(F.ws + WS_KB), (pg8::bf16_t*)(F.ws + WS_VB), (pg8::bf16_t*)(F.ws + WS_MQK), (pg8::bf16_t*)(F.ws + WS_MV), (const float*)(F.ws + WS_ROPE), SMALLF(SM_KMEAN)};
        pg8::gemm_phase<pg8::EpiProj, pg8::StaticOrder, PG8_ALIGN, PG8_SP2>(F.lds, g, S, E);
    } SEAM(2);
    if (IN(3)) { p3_phase(F); } SEAM(3);
    TSTAMP(4);
    if (IN(5)) { x2_phase(F); } SEAM(5);
    if (IN(6)) { x3_phase(F); } SEAM(6);
    if (IN(7)) {
        pg8::Gemm g{(const pg8::bf16_t*)(F.ws + WS_MIX), (const pg8::bf16_t*)(F.ws + WS_WOUT), M_TOK, DM, DM}; pg8::StaticOrder S; S.init(M_TOK, DM, F.G, F.bid, WGM_P5);
        pg8::EpiY1 E{F.x, ada + 2 * DM, (pg8::bf16_t*)(F.ws + WS_Y1B), (unsigned long long*)SMALLF(SM_MUR)};
        pg8::gemm_phase<pg8::EpiY1, pg8::StaticOrder, PG8_ALIGN, PG8_SP2>(F.lds, g, S, E);
    } SEAM(7);
    TSTAMP(8);
    if (IN(9)) {
        pg8::Gemm g{(const pg8::bf16_t*)(F.ws + WS_Y1B), (const pg8::bf16_t*)(F.ws + WS_WGU), M_TOK, NGU, DM}; pg8::StaticOrder S; S.init(M_TOK, NGU, F.G, F.bid, WGM_P6);
        pg8::EpiSwiGLU E{(const unsigned long long*)SMALLF(SM_MUR), SMALLF(SM_C1), SMALLF(SM_C2), (pg8::bf16_t*)(F.ws + WS_H)};
        pg8::gemm_phase<pg8::EpiSwiGLU, pg8::StaticOrder, PG8_ALIGN, PG8_SP2>(F.lds, g, S, E);
    } SEAM(9);
    if (IN(10)) {
        pg8::Gemm g{(const pg8::bf16_t*)(F.ws + WS_H), (const pg8::bf16_t*)(F.ws + WS_WDOWN), M_TOK, DM, DFF}; pg8::StaticOrder S; S.init(M_TOK, DM, F.G, F.bid, WGM_P7);
        pg8::EpiY2 E{(const pg8::bf16_t*)(F.ws + WS_Y1B), (const unsigned long long*)SMALLF(SM_MUR), ada + 5 * DM, F.ln1_w, F.ln1_b, F.out};
        TP_BEGIN(141); pg8::gemm_phase<pg8::EpiY2, pg8::StaticOrder, PG8_ALIGN, PG8_SP2>(F.lds, g, S, E); TP_END(141);
    }
    {
        const bool both = IN(10) && IN(11);
        bool fused = false;
        if (both) { TP_BEGIN(140); fused = ln2_panel_fused(F); TP_END(140); }
        if (!fused) { SEAM(10); if (IN(11)) { ln2_phase(F); } }
    }
#if defined(TIME_PHASE)
    if (TIME_PHASE == 11) tp1 = __builtin_amdgcn_s_memrealtime();
    if (TIME_PHASE >= 100) { tp0 = F.tp0; tp1 = F.tp1; }
    if ((F.bid == 0 || TIME_PHASE >= 100) && F.tid == 0 && tp1 > tp0) { const unsigned long long te = __builtin_amdgcn_s_memrealtime(); const unsigned long long want = (tp1 - tp0) * TIME_MULT;
        while (__builtin_amdgcn_s_memrealtime() - te < want) __builtin_amdgcn_s_sleep(32); }
#endif
#undef IN
#undef SEAM
}

#ifndef MK_MODE
#define MK_MODE 1
#endif
extern "C" void kernel_launch(void* const* d_in, const int* in_sizes, int n_in, void* d_out, int out_size, void* d_ws, size_t ws_size, hipStream_t stream) {
    static int grid = 0;
    if (grid == 0) {
        if (n_in != 17 || in_sizes[0] != M_TOK * DM || out_size != M_TOK * DM || ws_size < WS_END) {
            fprintf(stderr, "kernel_launch: shape mismatch: n_in %d in0 %d out %d ws %zu (need %zu)\n", n_in, n_in > 0 ? in_sizes[0] : -1, out_size, ws_size, (size_t)WS_END); grid = -1; return; }
        int dev = 0, cus = 0, per_cu = 0;
        if (hipGetDevice(&dev) != hipSuccess || hipDeviceGetAttribute(&cus, hipDeviceAttributeMultiprocessorCount, dev) != hipSuccess) { fprintf(stderr, "kernel_launch: device query failed\n"); grid = -1; return; }
        if (hipFuncSetAttribute((const void*)mk_fwd, hipFuncAttributeMaxDynamicSharedMemorySize, LDS_BYTES) != hipSuccess) { fprintf(stderr, "kernel_launch: hipFuncSetAttribute failed\n"); grid = -1; return; }
        if (hipOccupancyMaxActiveBlocksPerMultiprocessor(&per_cu, (const void*)mk_fwd, NWAVES * 64, LDS_BYTES) != hipSuccess || per_cu < 1) { fprintf(stderr, "kernel_launch: occupancy query says %d blocks per CU\n", per_cu); (void)hipGetLastError(); grid = -1; return; }
        grid = cus;
    }
    if (grid < 0) return;
    (void)hipMemsetAsync((char*)d_ws + WS_CTL, 0, CTL_ZERO_BYTES, stream);
    Args a{};
    for (int i = 0; i < 17; ++i) a.in[i] = (const float*)d_in[i];
    a.out = (float*)d_out; a.ws = (unsigned char*)d_ws;
#if MK_MODE == 0
    for (int ph = 0; ph < N_PHASES; ++ph) {
#if defined(NAIVE_MOBA)
        if (ph == 4) hipLaunchKernelGGL(naive_moba, dim3(M_TOK), dim3(512), 0, stream, (unsigned char*)d_ws);
#endif
#if defined(DBG_NAIVE_MOBA_LATE)
        if (ph == 7) hipLaunchKernelGGL(naive_moba, dim3(M_TOK), dim3(512), 0, stream, (unsigned char*)d_ws);
#endif
#if defined(NAIVE_MLSTM)
        if (ph == 4) hipLaunchKernelGGL(naive_mlstm, dim3(ML_H), dim3(256), 0, stream, (unsigned char*)d_ws, (const float*)d_in[7], (const float*)d_in[8], (const float*)d_in[9]);
#endif
        a.ph_lo = ph; a.ph_hi = ph + 1; a.li = 0;
        hipLaunchKernelGGL(mk_fwd, dim3(grid), dim3(NWAVES * 64), LDS_BYTES, stream, a);
#if defined(DBG_X2_TWICE)
        if (ph == 5) {
            unsigned* dc = (unsigned*)((char*)d_ws + WS_CTL) + 32768;
            (void)hipMemcpyAsync((char*)d_ws + WS_LOCAL, (char*)d_ws + WS_PART3, 32 * MiB, hipMemcpyDeviceToDevice, stream);
            hipLaunchKernelGGL(mk_fwd, dim3(grid), dim3(NWAVES * 64), LDS_BYTES, stream, a);
            hipLaunchKernelGGL(dbg_cmp_u32, dim3(1024), dim3(256), 0, stream, (const unsigned*)((char*)d_ws + WS_LOCAL), (const unsigned*)((char*)d_ws + WS_PART3), (size_t)(8 * MiB), dc);
            hipLaunchKernelGGL(dbg_check_own, dim3(M_TOK), dim3(512), 0, stream, (unsigned char*)d_ws, dc + 1);
        }
#endif
    }
#if defined(DBG_X2_TWICE)
    hipLaunchKernelGGL(dbg_flag, dim3(1), dim3(64), 0, stream, (const unsigned*)((char*)d_ws + WS_CTL) + 32768, (float*)d_out);
#endif
#else
    a.ph_lo = 0; a.ph_hi = N_PHASES; a.li = 0;
    hipLaunchKernelGGL(mk_fwd, dim3(grid), dim3(NWAVES * 64), LDS_BYTES, stream, a);
#endif
    const hipError_t le = hipPeekAtLastError();
    if (le != hipSuccess) fprintf(stderr, "kernel_launch: launch failed: %s\n", hipGetErrorName(le));
}
```

```cpp
#include <hip/hip_runtime.h>
#include <cstdio>
#include <cstdint>
#include <cmath>
namespace pg8 {
#define PG8_LAS __attribute__((address_space(3)))
typedef unsigned short bf16_t;
typedef short bf16x8 __attribute__((ext_vector_type(8)));
typedef float f32x4 __attribute__((ext_vector_type(4)));
typedef unsigned u32x4 __attribute__((ext_vector_type(4)));
constexpr int BM = 256, BK = 64, HALF = 128, HTB = HALF * BK * 2  , STAGE_BYTES = 8 * HTB, NXCD = 8, WGM = 4;

__host__ __device__ __forceinline__ int lds_byte(int r, int c) { const int st = (r >> 4) * 2 + (c >> 5), rr = r & 15, cc = c & 31, ob = rr * 64 + cc * 2; return st * 1024 + (ob ^ (((ob >> 9) & 1) << 5)); }
__host__ __device__ __forceinline__ void stage_rc(int b, int& R, int& C) { const int st = b / 1024, sb = b % 1024, swz = sb ^ (((sb >> 9) & 1) << 5); R = (st >> 1) * 16 + swz / 64; C = (st & 1) * 32 + (swz % 64) / 2; }
__host__ __device__ __forceinline__ int perm32(int rho) { const int n = rho >> 4, i = rho & 15; return 8 * (i >> 2) + 4 * n + (i & 3); }

struct Unit { int pm, pn; };
struct Gemm { const bf16_t* A; const bf16_t* Bt; int M, N, K; };

struct StaticOrder {
    int nM, nN, nwg, G, c, wgm;
    __host__ __device__ void init(int M, int N, int G_, int c_, int wgm_ = WGM) { nM = M / BM; nN = N / BM; nwg = nM * nN; G = G_; c = c_; wgm = wgm_; }
    __host__ __device__ bool next(int i, Unit& u) const {
        const long L = (long)i * G + c; if (L >= nwg) return false;
        int wgid = (int)L; { const int q = nwg / NXCD, r = nwg % NXCD, xcd = wgid % NXCD, off = wgid / NXCD; wgid = (xcd < r ? xcd * (q + 1) : r * (q + 1) + (xcd - r) * q) + off; }
        const int nig = wgm * nN, gid = wgid / nig, fm = gid * wgm, gsz = (nM - fm) < wgm ? (nM - fm) : wgm;
        u.pm = fm + ((wgid % nig) % gsz); u.pn = (wgid % nig) / gsz; return true;
    }
    __device__ __forceinline__ void a_ready(const Unit&) const {}
    __device__ __forceinline__ void done(const Unit&) const {}
};

typedef float cvp_f32x2_t __attribute__((ext_vector_type(2))); typedef __bf16 cvp_bf16x2_t __attribute__((ext_vector_type(2)));
__device__ __forceinline__ unsigned cvt_pk_bf16(float lo, float hi) { cvp_f32x2_t v = {lo, hi}; cvp_bf16x2_t b = __builtin_convertvector(v, cvp_bf16x2_t); return __builtin_bit_cast(unsigned, b); }
typedef float f32x2 __attribute__((ext_vector_type(2)));
__device__ __forceinline__ f32x2 gelu_pk(f32x2 v) {
    const f32x2 av = __builtin_elementwise_abs(v), d = av * 0.2316418882f + 1.0f;
    f32x2 t; t.x = __builtin_amdgcn_rcpf(d.x); t.y = __builtin_amdgcn_rcpf(d.y);
    f32x2 q = t * 0.5307027145f + (-0.7265760135f); q = q * t + 0.7107068705f; q = q * t + (-0.142248368f); q = q * t + 0.127414796f; q = q * t;
    const f32x2 s = (v * v) * (-0.72134752044f);
    f32x2 e; e.x = __builtin_amdgcn_exp2f(s.x); e.y = __builtin_amdgcn_exp2f(s.y);
    const f32x2 m = v * (q * e), r = v - m;
    f32x2 o; o.x = v.x < 0.f ? m.x : r.x; o.y = v.y < 0.f ? m.y : r.y; return o;
}

template <int ACT  > struct EpiBf16 {
    static constexpr bool PERM = true, AFTER_DRAIN = false; static_assert(ACT == 0 || ACT == 1, "EpiBf16: ACT is 0 (none) or 1 (gelu_pk)");
    bf16_t* O; int ldc; const float* bias; int split_cols; size_t split_stride; float scale0;
    __device__ __forceinline__ void operator()(const f32x4 (&acc)[2][2][4][2], const Unit& u, int wr, int wc, int fr, int fq) const {
        const int row0 = u.pm * BM + wr * 64 + fr; int colt = u.pn * BM; bf16_t* base = O;
        float sc = 1.f; if (split_cols) { const int t = colt / split_cols; base += (size_t)t * split_stride; colt -= t * split_cols; if (t == 0) sc = scale0; }
        const int col0 = colt + wc * 32 + 8 * fq, bcol0 = u.pn * BM + wc * 32 + 8 * fq;
        f32x4 bv[2][2];
#pragma unroll
        for (int bj = 0; bj < 2; ++bj)
#pragma unroll
            for (int n = 0; n < 2; ++n) bv[bj][n] = bias ? *(const f32x4*)(bias + bcol0 + bj * HALF + 4 * n) : (f32x4){0.f, 0.f, 0.f, 0.f};
#pragma unroll
        for (int ai = 0; ai < 2; ++ai)
#pragma unroll
            for (int m = 0; m < 4; ++m) { bf16_t* rowp = base + (size_t)(row0 + ai * HALF + m * 16) * ldc + col0;
#pragma unroll
                for (int bj = 0; bj < 2; ++bj) { f32x4 v0 = acc[ai][bj][m][0] + bv[bj][0], v1 = acc[ai][bj][m][1] + bv[bj][1];
                    if (ACT == 1) { f32x2 a = gelu_pk((f32x2){v0[0], v0[1]}), b = gelu_pk((f32x2){v0[2], v0[3]}), c = gelu_pk((f32x2){v1[0], v1[1]}), d = gelu_pk((f32x2){v1[2], v1[3]});
                        v0 = (f32x4){a.x, a.y, b.x, b.y}; v1 = (f32x4){c.x, c.y, d.x, d.y}; }
                    v0 = v0 * sc; v1 = v1 * sc; u32x4 w; w.x = cvt_pk_bf16(v0[0], v0[1]); w.y = cvt_pk_bf16(v0[2], v0[3]); w.z = cvt_pk_bf16(v1[0], v1[1]); w.w = cvt_pk_bf16(v1[2], v1[3]);
                    *(u32x4*)(rowp + bj * HALF) = w; } }
    }
};

struct PanelStats {
    unsigned* xbuf;
    unsigned* cnt;
    unsigned* tmo;
    int ntn; float eps;
    unsigned code;
    __device__ __forceinline__ bool run(const f32x4 (&v)[2][2][4][2], const Unit& u, int wr, int wc, int fr, int fq, PG8_LAS unsigned char* lds, int wid, int lane) const {
        typedef float f32x2v __attribute__((ext_vector_type(2)));
        PG8_LAS f32x2v* P = (PG8_LAS f32x2v*)lds;
        PG8_LAS f32x2v* S = (PG8_LAS f32x2v*)(lds + 8192);
        PG8_LAS unsigned* flag = (PG8_LAS unsigned*)(lds + 8192 + 2048);
#pragma unroll
        for (int ai = 0; ai < 2; ++ai)
#pragma unroll
            for (int m = 0; m < 4; ++m) {
                float s = 0.f;
#pragma unroll
                for (int bj = 0; bj < 2; ++bj)
#pragma unroll
                    for (int n = 0; n < 2; ++n) { const f32x4 x = v[ai][bj][m][n]; s += (x[0] + x[1]) + (x[2] + x[3]); }
                s += __shfl_xor(s, 16); s += __shfl_xor(s, 32);
                const float mw = s * (1.0f / 64.0f); float q = 0.f;
#pragma unroll
                for (int bj = 0; bj < 2; ++bj)
#pragma unroll
                    for (int n = 0; n < 2; ++n) { const f32x4 d = v[ai][bj][m][n] - mw; q += (d[0] * d[0] + d[1] * d[1]) + (d[2] * d[2] + d[3] * d[3]); }
                q += __shfl_xor(q, 16); q += __shfl_xor(q, 32);
                if (fq == 0) P[(ai * HALF + wr * 64 + m * 16 + fr) * 4 + wc] = (f32x2v){mw, q};
            }
        asm volatile("s_waitcnt lgkmcnt(0)" ::: "memory"); __builtin_amdgcn_s_barrier(); asm volatile("" ::: "memory");
#if defined(BROKEN_EXCHANGE_NO_WAIT)
#warning BROKEN CONTROL BUILD: the row-statistics exchange does not wait; results are wrong by design
        if (blockIdx.x >= 64) { const long long t0_ = clock64(); while (clock64() - t0_ < 60000) __builtin_amdgcn_s_sleep(8); }
#endif
        const int row = wid * 32 + (lane & 31);
        if (lane < 32) {
            const f32x2v a = P[row * 4 + 0], b = P[row * 4 + 1], c = P[row * 4 + 2], d = P[row * 4 + 3];
            const float mt = (a.x + b.x + c.x + d.x) * 0.25f;
            const float da = a.x - mt, db = b.x - mt, dc = c.x - mt, dd = d.x - mt;
            const float m2 = (a.y + b.y) + (c.y + d.y) + 64.0f * ((da * da + db * db) + (dc * dc + dd * dd));
            unsigned long long* slot = (unsigned long long*)xbuf + ((size_t)(u.pm * BM + row) * 4 + u.pn);
            __hip_atomic_store(slot, ((unsigned long long)__float_as_uint(m2) << 32) | __float_as_uint(mt), __ATOMIC_RELAXED, __HIP_MEMORY_SCOPE_AGENT);
        }
        asm volatile("s_waitcnt vmcnt(0)" ::: "memory");
        if (lane == 0) __hip_atomic_fetch_add(cnt + 64 * u.pm, 1u, __ATOMIC_RELAXED, __HIP_MEMORY_SCOPE_AGENT);
        if (wid == 0) {
            bool dead = false; const unsigned long long t0 = __builtin_amdgcn_s_memrealtime(); const unsigned want = 8u * (unsigned)ntn;
            for (;;) {
#if defined(BROKEN_EXCHANGE_NO_WAIT)
                break;
#endif
                if ((unsigned)__builtin_amdgcn_readfirstlane(__hip_atomic_load(cnt + 64 * u.pm, __ATOMIC_RELAXED, __HIP_MEMORY_SCOPE_AGENT)) >= want) break;
                if (__builtin_amdgcn_s_memrealtime() - t0 > 2000000ull) {
                    if (lane == 0) { unsigned expect = 0u; __hip_atomic_compare_exchange_strong(tmo + 1, &expect, code | (unsigned)(u.pm & 0xff), __ATOMIC_RELAXED, __ATOMIC_RELAXED, __HIP_MEMORY_SCOPE_AGENT);
                                     __hip_atomic_store(tmo, 1u, __ATOMIC_RELAXED, __HIP_MEMORY_SCOPE_AGENT); }
                    dead = true; break; }
                __builtin_amdgcn_s_sleep(2);
            }
            __builtin_amdgcn_fence(__ATOMIC_ACQUIRE, "agent");
            if (lane == 0) flag[0] = dead ? 1u : 0u;
        }
        asm volatile("s_waitcnt vmcnt(0) lgkmcnt(0)" ::: "memory"); __builtin_amdgcn_s_barrier(); asm volatile("" ::: "memory");
        const bool bad = flag[0] != 0u;
        if (lane < 32) {
            const unsigned long long* slot = (const unsigned long long*)xbuf + (size_t)(u.pm * BM + row) * 4; float mt[4], m2[4]; float ms = 0.f;
#pragma unroll
            for (int t = 0; t < 4; ++t) { if (t < ntn) { const unsigned long long w = __hip_atomic_load(slot + t, __ATOMIC_RELAXED, __HIP_MEMORY_SCOPE_AGENT); mt[t] = __uint_as_float((unsigned)w); m2[t] = __uint_as_float((unsigned)(w >> 32)); } else { mt[t] = 0.f; m2[t] = 0.f; } ms += mt[t]; }
            const float mean = ms / (float)ntn; float q = 0.f;
#pragma unroll
            for (int t = 0; t < 4; ++t) if (t < ntn) { const float dm = mt[t] - mean; q += m2[t] + 256.0f * dm * dm; }
            S[row] = (f32x2v){mean, 1.0f / sqrtf(q / (256.0f * (float)ntn) + eps)};
        }
        asm volatile("s_waitcnt lgkmcnt(0)" ::: "memory"); __builtin_amdgcn_s_barrier(); asm volatile("" ::: "memory");
        return bad;
    }
};
struct EpiLnRes {
    static constexpr bool PERM = false, AFTER_DRAIN = true;
    const float* base; float* out; int ldc; const float* bias; PanelStats st; unsigned poison;
    __device__ __forceinline__ void fused(f32x4 (&acc)[2][2][4][2], const Unit& u, int wr, int wc, int fr, int fq, PG8_LAS unsigned char* lds, int wid, int lane) const {
        typedef float f32x2v __attribute__((ext_vector_type(2)));
        const PG8_LAS f32x2v* S = (const PG8_LAS f32x2v*)(lds + 8192);
        const int col0 = u.pn * BM + wc * 32 + 4 * fq;
#pragma unroll
        for (int bj = 0; bj < 2; ++bj)
#pragma unroll
            for (int n = 0; n < 2; ++n) { const f32x4 bv = bias ? *(const f32x4*)(bias + col0 + bj * HALF + n * 16) : (f32x4){0.f, 0.f, 0.f, 0.f};
#pragma unroll
                for (int ai = 0; ai < 2; ++ai)
#pragma unroll
                    for (int m = 0; m < 4; ++m) acc[ai][bj][m][n] += bv; }
        f32x4 pre[4][2][2];
#pragma unroll
        for (int m = 0; m < 4; ++m) { const size_t off = (size_t)(u.pm * BM + wr * 64 + m * 16 + fr) * ldc + col0;
#pragma unroll
            for (int bj = 0; bj < 2; ++bj)
#pragma unroll
                for (int n = 0; n < 2; ++n) pre[m][bj][n] = *(const f32x4*)(base + off + bj * HALF + n * 16); }
        const bool bad = st.run(acc, u, wr, wc, fr, fq, lds, wid, lane) || poison != 0u;
        const float qnan = __builtin_nanf("");
#pragma unroll
        for (int ai = 0; ai < 2; ++ai)
#pragma unroll
            for (int m = 0; m < 4; ++m) { const int r = ai * HALF + wr * 64 + m * 16 + fr; const f32x2v sr = S[r]; const size_t off = (size_t)(u.pm * BM + r) * ldc + col0;
#pragma unroll
                for (int bj = 0; bj < 2; ++bj)
#pragma unroll
                    for (int n = 0; n < 2; ++n) { const f32x4 bs = ai == 0 ? pre[m][bj][n] : *(const f32x4*)(base + off + bj * HALF + n * 16); f32x4 o = bs + (acc[ai][bj][m][n] - sr.x) * sr.y;
                        if (bad) o = (f32x4){qnan, qnan, qnan, qnan}; *(f32x4*)(out + off + bj * HALF + n * 16) = o; }
                if (m & 1) asm volatile("" ::: "memory"); }
    }
};
struct EpiLnResLn {
    static constexpr bool PERM = false, AFTER_DRAIN = true;
    const float* base; float* out; bf16_t* xn; int ldc; const float* bias; PanelStats st1, st2; unsigned poison;
    __device__ __forceinline__ void fused(f32x4 (&acc)[2][2][4][2], const Unit& u, int wr, int wc, int fr, int fq, PG8_LAS unsigned char* lds, int wid, int lane) const {
        typedef float f32x2v __attribute__((ext_vector_type(2))); typedef unsigned u32x2v __attribute__((ext_vector_type(2)));
        const PG8_LAS f32x2v* S = (const PG8_LAS f32x2v*)(lds + 8192);
        const int col0 = u.pn * BM + wc * 32 + 4 * fq;
#pragma unroll
        for (int bj = 0; bj < 2; ++bj)
#pragma unroll
            for (int n = 0; n < 2; ++n) { const f32x4 bv = bias ? *(const f32x4*)(bias + col0 + bj * HALF + n * 16) : (f32x4){0.f, 0.f, 0.f, 0.f};
#pragma unroll
                for (int ai = 0; ai < 2; ++ai)
#pragma unroll
                    for (int m = 0; m < 4; ++m) acc[ai][bj][m][n] += bv; }
        bool bad = st1.run(acc, u, wr, wc, fr, fq, lds, wid, lane) || poison != 0u;
        const float qnan = __builtin_nanf("");
#pragma unroll
        for (int ai = 0; ai < 2; ++ai)
#pragma unroll
            for (int m = 0; m < 4; ++m) { const int r = ai * HALF + wr * 64 + m * 16 + fr; const f32x2v sr = S[r]; const size_t off = (size_t)(u.pm * BM + r) * ldc + col0;
#pragma unroll
                for (int bj = 0; bj < 2; ++bj)
#pragma unroll
                    for (int n = 0; n < 2; ++n) { const f32x4 bs = *(const f32x4*)(base + off + bj * HALF + n * 16); acc[ai][bj][m][n] = bs + (acc[ai][bj][m][n] - sr.x) * sr.y; }
                asm volatile("" : "+v"(acc[ai][0][m][0]), "+v"(acc[ai][0][m][1]), "+v"(acc[ai][1][m][0]), "+v"(acc[ai][1][m][1]));
                if (m & 1) asm volatile("" ::: "memory"); }
        const bool bad1 = bad;
        bad = st2.run(acc, u, wr, wc, fr, fq, lds, wid, lane) || bad;
#pragma unroll
        for (int ai = 0; ai < 2; ++ai)
#pragma unroll
            for (int m = 0; m < 4; ++m) { const int r = ai * HALF + wr * 64 + m * 16 + fr; const f32x2v sr = S[r]; const size_t off = (size_t)(u.pm * BM + r) * ldc + col0;
#pragma unroll
                for (int bj = 0; bj < 2; ++bj)
#pragma unroll
                    for (int n = 0; n < 2; ++n) { const f32x4 x1 = acc[ai][bj][m][n]; *(f32x4*)(out + off + bj * HALF + n * 16) = bad1 ? (f32x4){qnan, qnan, qnan, qnan} : x1;
                        const f32x4 o = (x1 - sr.x) * sr.y; u32x2v w; w.x = cvt_pk_bf16(o[0], o[1]); w.y = cvt_pk_bf16(o[2], o[3]);
                        if (bad) { w.x = 0x7fc07fc0u; w.y = 0x7fc07fc0u; } *(u32x2v*)(xn + off + bj * HALF + n * 16) = w; }
                asm volatile("" ::: "memory"); }
    }
};

template <class Epi, class Sched, bool ALIGN_EPI = false, bool SP2 = false>
__device__ __forceinline__ void gemm_phase(PG8_LAS unsigned char* lds, const Gemm g, const Sched& S, const Epi& E) {
    const int tid = threadIdx.x, wid = __builtin_amdgcn_readfirstlane(tid >> 6), lane = tid & 63, wr = wid >> 2, wc = wid & 3, fr = lane & 15, fq = lane >> 4;
    const int K = g.K, nt = K / BK;
    unsigned voffA[2], voffB[2];
#pragma unroll
    for (int i = 0; i < 2; ++i) { int R, C; stage_rc(tid * 16 + i * 8192, R, C); const int Rb = Epi::PERM ? ((R & ~31) + perm32(R & 31)) : R;
        voffA[i] = (unsigned)(R * K + C) * 2u; voffB[i] = (unsigned)(Rb * K + C) * 2u; }
    const size_t kstep = (size_t)(BK * 2);
    const size_t hstep = (size_t)HALF * K * 2;
    const size_t tstep = 2 * hstep;
    const unsigned ldsw = (unsigned)wid * 1024u;
    const int aoff = lds_byte(wr * 64 + fr, fq * 8), boff = lds_byte(wc * 32 + fr, fq * 8);
#define PG8_SA(b, h) (((b) * 2 + (h)) * HTB)
#define PG8_SB(b, h) ((4 + (b) * 2 + (h)) * HTB)
#define PG8_STAGE(bufoff, gbase, voff) do { _Pragma("unroll") for (int _i = 0; _i < 2; ++_i) \
        __builtin_amdgcn_global_load_lds((const unsigned*)((const char*)(gbase) + (voff)[_i]), (PG8_LAS unsigned*)(lds + (bufoff) + ldsw + _i * 8192), 16, 0, 0); } while (0)
#define PG8_LDA(dst, b, h) do { _Pragma("unroll") for (int m = 0; m < 4; ++m) _Pragma("unroll") for (int k = 0; k < 2; ++k) dst[m][k] = *(const PG8_LAS bf16x8*)(lds + PG8_SA(b, h) + aoff + m * 2048 + k * 1024); } while (0)
#define PG8_LDB(dst, b, h) do { _Pragma("unroll") for (int n = 0; n < 2; ++n) _Pragma("unroll") for (int k = 0; k < 2; ++k) dst[n][k] = *(const PG8_LAS bf16x8*)(lds + PG8_SB(b, h) + boff + n * 2048 + k * 1024); } while (0)
#define PG8_MMA(ai, bj, At, Bt) do { __builtin_amdgcn_s_setprio(1); _Pragma("unroll") for (int m = 0; m < 4; ++m) _Pragma("unroll") for (int n = 0; n < 2; ++n) _Pragma("unroll") for (int k = 0; k < 2; ++k) \
        acc[ai][bj][m][n] = __builtin_amdgcn_mfma_f32_16x16x32_bf16(Bt[n][k], At[m][k], acc[ai][bj][m][n], 0, 0, 0); __builtin_amdgcn_s_setprio(0); } while (0)
#define PG8_WAIT_V(n) asm volatile("s_waitcnt vmcnt(" #n ")" ::: "memory")
#define PG8_WAIT_L(n) asm volatile("s_waitcnt lgkmcnt(" #n ")" ::: "memory")
#define PG8_BAR __builtin_amdgcn_s_barrier()
#define PG8_SCHED __builtin_amdgcn_sched_barrier(0)
    Unit cur, nxt; int ui = 0;
    if (!S.next(0, cur)) return;
    f32x4 acc[2][2][4][2];
#pragma unroll
    for (int a = 0; a < 2; ++a)
#pragma unroll
        for (int b = 0; b < 2; ++b)
#pragma unroll
            for (int m = 0; m < 4; ++m)
#pragma unroll
                for (int n = 0; n < 2; ++n) acc[a][b][m][n] = (f32x4){0.f, 0.f, 0.f, 0.f};
    bf16x8 At[4][2], B0[2][2], B1[2][2];
    const char* cA = (const char*)g.A + (size_t)cur.pm * tstep; const char* cB = (const char*)g.Bt + (size_t)cur.pn * tstep;
    S.a_ready(cur);
    if constexpr (SP2) {
        PG8_STAGE(PG8_SB(0, 0), cB, voffB); PG8_STAGE(PG8_SB(0, 1), cB + hstep, voffB); PG8_STAGE(PG8_SA(0, 0), cA, voffA); PG8_STAGE(PG8_SA(0, 1), cA + hstep, voffA);
        if (wr == 1) PG8_BAR;
        PG8_WAIT_V(2); PG8_BAR;
        PG8_STAGE(PG8_SB(1, 0), cB + kstep, voffB); PG8_STAGE(PG8_SA(1, 0), cA + kstep, voffA); PG8_STAGE(PG8_SB(1, 1), cB + hstep + kstep, voffB);
        PG8_WAIT_V(6); PG8_BAR;
    } else {
        PG8_STAGE(PG8_SB(0, 0), cB, voffB); PG8_STAGE(PG8_SA(0, 0), cA, voffA); PG8_STAGE(PG8_SB(0, 1), cB + hstep, voffB); PG8_STAGE(PG8_SA(0, 1), cA + hstep, voffA);
        if (wr == 1) PG8_BAR;
        PG8_WAIT_V(4); PG8_BAR;
        PG8_STAGE(PG8_SB(1, 0), cB + kstep, voffB); PG8_STAGE(PG8_SA(1, 0), cA + kstep, voffA); PG8_STAGE(PG8_SB(1, 1), cB + hstep + kstep, voffB);
        PG8_WAIT_V(6); PG8_BAR;
    }
    for (;;) {
        const bool has_next = S.next(ui + 1, nxt);
        const char* nA = has_next ? (const char*)g.A + (size_t)nxt.pm * tstep : cA; const char* nB = has_next ? (const char*)g.Bt + (size_t)nxt.pn * tstep : cB;
        for (int t = 0; t < nt; t += 2) {
            const bool last = (t == nt - 2);
            const char* a1 = cA + (size_t)(t + 1) * kstep;
            const char* a2 = last ? nA : cA + (size_t)(t + 2) * kstep; const char* b2 = last ? nB : cB + (size_t)(t + 2) * kstep;
            const char* a3 = a2 + kstep; const char* b3 = b2 + kstep;
            if (last && has_next) S.a_ready(nxt);
            if constexpr (SP2) {
            PG8_LDB(B0, 0, 0); PG8_LDB(B1, 0, 1); PG8_SCHED; PG8_LDA(At, 0, 0); PG8_STAGE(PG8_SA(1, 1), a1 + hstep, voffA);
            PG8_WAIT_V(8); PG8_WAIT_L(0); PG8_BAR; PG8_MMA(0, 0, At, B0); PG8_MMA(0, 1, At, B1); PG8_BAR; PG8_SCHED;
            PG8_LDA(At, 0, 1); PG8_STAGE(PG8_SB(0, 0), b2, voffB); PG8_STAGE(PG8_SB(0, 1), b2 + hstep, voffB); PG8_STAGE(PG8_SA(0, 0), a2, voffA);
            PG8_WAIT_V(8); PG8_WAIT_L(0); PG8_BAR; PG8_MMA(1, 0, At, B0); PG8_MMA(1, 1, At, B1); PG8_BAR; PG8_SCHED;
            PG8_LDB(B0, 1, 0); PG8_LDB(B1, 1, 1); PG8_SCHED; PG8_LDA(At, 1, 0); PG8_STAGE(PG8_SA(0, 1), a2 + hstep, voffA);
            PG8_WAIT_V(8); PG8_WAIT_L(0); PG8_BAR; PG8_MMA(0, 0, At, B0); PG8_MMA(0, 1, At, B1); PG8_BAR; PG8_SCHED;
            PG8_LDA(At, 1, 1); PG8_STAGE(PG8_SB(1, 0), b3, voffB); PG8_STAGE(PG8_SB(1, 1), b3 + hstep, voffB); PG8_STAGE(PG8_SA(1, 0), a3, voffA);
            PG8_WAIT_V(8); PG8_WAIT_L(0); PG8_BAR; PG8_MMA(1, 0, At, B0); PG8_MMA(1, 1, At, B1); PG8_BAR; PG8_SCHED;
            } else {
            PG8_LDB(B0, 0, 0); PG8_SCHED; PG8_LDA(At, 0, 0); PG8_STAGE(PG8_SA(1, 1), a1 + hstep, voffA);
            PG8_WAIT_L(8); PG8_BAR; PG8_WAIT_L(0); PG8_MMA(0, 0, At, B0); PG8_BAR; PG8_SCHED;
            PG8_LDB(B1, 0, 1); PG8_STAGE(PG8_SB(0, 0), b2, voffB);
            PG8_BAR; PG8_WAIT_L(0); PG8_MMA(0, 1, At, B1); PG8_BAR;
            PG8_LDA(At, 0, 1); PG8_STAGE(PG8_SA(0, 0), a2, voffA);
            PG8_BAR; PG8_WAIT_L(0); PG8_MMA(1, 0, At, B0); PG8_BAR; PG8_SCHED;
            PG8_STAGE(PG8_SB(0, 1), b2 + hstep, voffB);
            PG8_WAIT_V(6); PG8_BAR; PG8_MMA(1, 1, At, B1); PG8_BAR;
            PG8_LDB(B0, 1, 0); PG8_SCHED; PG8_LDA(At, 1, 0); PG8_STAGE(PG8_SA(0, 1), a2 + hstep, voffA);
            PG8_WAIT_L(8); PG8_BAR; PG8_WAIT_L(0); PG8_MMA(0, 0, At, B0); PG8_BAR; PG8_SCHED;
            PG8_LDB(B1, 1, 1); PG8_STAGE(PG8_SB(1, 0), b3, voffB);
            PG8_BAR; PG8_WAIT_L(0); PG8_MMA(0, 1, At, B1); PG8_BAR;
            PG8_LDA(At, 1, 1); PG8_STAGE(PG8_SA(1, 0), a3, voffA);
            PG8_BAR; PG8_WAIT_L(0); PG8_MMA(1, 0, At, B0); PG8_BAR; PG8_SCHED;
            PG8_STAGE(PG8_SB(1, 1), b3 + hstep, voffB);
            PG8_WAIT_V(6); PG8_BAR; PG8_MMA(1, 1, At, B1); PG8_BAR;
            }
        }
        if constexpr (ALIGN_EPI) { if (wr == 0) PG8_BAR; }
        if constexpr (!Epi::AFTER_DRAIN) { E(acc, cur, wr, wc, fr, fq); S.done(cur); }
        if (!has_next) break;
#pragma unroll
        for (int a = 0; a < 2; ++a)
#pragma unroll
            for (int b = 0; b < 2; ++b)
#pragma unroll
                for (int m = 0; m < 4; ++m)
#pragma unroll
                    for (int n = 0; n < 2; ++n) acc[a][b][m][n] = (f32x4){0.f, 0.f, 0.f, 0.f};
        cur = nxt; cA = nA; cB = nB; ++ui;
        if constexpr (ALIGN_EPI) { if (wr == 1) PG8_BAR; }
    }
    PG8_WAIT_V(0);
    if constexpr (!ALIGN_EPI) { if (wr == 0) PG8_BAR; }
    PG8_BAR;
    if constexpr (Epi::AFTER_DRAIN) { E.fused(acc, cur, wr, wc, fr, fq, lds, wid, lane); S.done(cur); }
#undef PG8_SA
#undef PG8_SB
#undef PG8_STAGE
#undef PG8_LDA
#undef PG8_LDB
#undef PG8_MMA
#undef PG8_WAIT_V
#undef PG8_WAIT_L
#undef PG8_BAR
#undef PG8_SCHED
}
}
#define GAS __attribute__((address_space(1)))
#define LAS __attribute__((address_space(3)))
typedef unsigned short bf16;
typedef unsigned v4u __attribute__((ext_vector_type(4)));
typedef float f32x4 __attribute__((ext_vector_type(4)));
typedef short bf16x8 __attribute__((ext_vector_type(8)));
typedef GAS unsigned gu32;
typedef GAS unsigned long long gu64;
#define RLX_AGENT __ATOMIC_RELAXED, __HIP_MEMORY_SCOPE_AGENT
#define LDS_WAIT() asm volatile("s_waitcnt lgkmcnt(0)" ::: "memory")
#define VM_WAIT() asm volatile("s_waitcnt vmcnt(0)" ::: "memory")
__device__ __forceinline__ unsigned long long rt() { return __builtin_amdgcn_s_memrealtime(); }
__device__ __forceinline__ unsigned f2bf(float f) { unsigned u = __builtin_bit_cast(unsigned, f); return (u + 0x7fffu + ((u >> 16) & 1u)) >> 16; }
__device__ __forceinline__ unsigned pk2(float lo, float hi) { return f2bf(lo) | (f2bf(hi) << 16); }
#define XB_TMO      128
#define XB_XCNT(j)  (256  + 64 * (j))
#define XB_XSUB(j)  (1280 + 64 * (j))
#define XB_XGEN(j)  (2304 + 64 * (j))
#define XB_TOP      3328
#define XB_TOPGEN   3392
#define XCD_BAR_WORDS 3456
#define XB_SPIN_CAP (1u << 18)

__device__ __forceinline__ unsigned xb_ld(unsigned* p)              { return __hip_atomic_load(p, __ATOMIC_RELAXED, __HIP_MEMORY_SCOPE_AGENT); }
__device__ __forceinline__ unsigned xb_add(unsigned* p, unsigned v) { return __hip_atomic_fetch_add(p, v, __ATOMIC_RELAXED, __HIP_MEMORY_SCOPE_AGENT); }
__device__ __forceinline__ unsigned xb_xcc_id() { return (unsigned)__builtin_amdgcn_s_getreg((3 << 11) | 20) & 0xFu; }
#define XB_SPIN(cond, bar) do { unsigned _sp = 0; while (cond) { __builtin_amdgcn_s_sleep(1); \
    if ((++_sp & 255u) == 0u) { if (xb_ld(&(bar)[XB_TMO])) break; if (_sp > XB_SPIN_CAP) { atomicAdd(&(bar)[XB_TMO], 1u); break; } } } } while (0)

struct XcdBarrier {
    unsigned* bar; unsigned x;
    volatile LAS unsigned* st;
};

__device__ __forceinline__ XcdBarrier xcd_barrier_post(unsigned* bar, volatile LAS unsigned* st) {
    XcdBarrier b; b.bar = bar; b.x = xb_xcc_id(); b.st = st;
    if (threadIdx.x == 0) (void)xb_add(&bar[XB_XCNT(b.x)], 1u);
    return b;
}
__device__ __forceinline__ void xcd_barrier_complete(unsigned* bar, unsigned x, unsigned& nloc, unsigned& nx) {
    const unsigned G = gridDim.x * gridDim.y * gridDim.z;
    unsigned sum, cnt, mine, sp = 0u;
    for (;;) {
        sum = 0u; cnt = 0u; mine = 0u;
#pragma unroll
        for (unsigned j = 0; j < 16; ++j) { const unsigned c = xb_ld(&bar[XB_XCNT(j)]); sum += c; cnt += (c > 0u) ? 1u : 0u; mine = (j == x) ? c : mine; }
        if (sum == G) break;
        __builtin_amdgcn_s_sleep(1);
        if ((++sp & 255u) == 0u) { if (xb_ld(&bar[XB_TMO])) break; if (sp > XB_SPIN_CAP) { atomicAdd(&bar[XB_TMO], 1u); break; } }
    }
    nloc = mine > 0u ? mine : 1u; nx = cnt > 0u ? cnt : 1u;
}

__device__ __forceinline__ void xcd_barrier(const XcdBarrier& b) {
    asm volatile("s_waitcnt vmcnt(0)" ::: "memory");
    __syncthreads();
    if (threadIdx.x == 0) {
        unsigned* bar = b.bar;
        __builtin_amdgcn_s_waitcnt(0);
        unsigned nloc = b.st[0], nx = b.st[1];
        if (nloc == 0u) { xcd_barrier_complete(bar, b.x, nloc, nx); b.st[0] = nloc; b.st[1] = nx; }
        const unsigned old = xb_add(&bar[XB_XSUB(b.x)], 1u);
        const unsigned gen = old / nloc;
        if (old + 1u == (gen + 1u) * nloc) {
            __builtin_amdgcn_fence(__ATOMIC_RELEASE, "agent");
            asm volatile("s_waitcnt vmcnt(0)" ::: "memory");
            const unsigned og = xb_add(&bar[XB_TOP], 1u);
            const unsigned tg = og / nx;
            if (og + 1u == (tg + 1u) * nx) xb_add(&bar[XB_TOPGEN], 1u);
            else XB_SPIN(xb_ld(&bar[XB_TOPGEN]) == tg, bar);
            __builtin_amdgcn_fence(__ATOMIC_ACQUIRE, "agent");
            xb_add(&bar[XB_XGEN(b.x)], 1u);
            asm volatile("s_waitcnt vmcnt(0)" ::: "memory");
        } else {
            XB_SPIN(xb_ld(&bar[XB_XGEN(b.x)]) == gen, bar);
            __builtin_amdgcn_fence(__ATOMIC_ACQUIRE, "agent");
            asm volatile("s_waitcnt vmcnt(0)" ::: "memory");
        }
    }
    __syncthreads();
}
constexpr int NWAVES = 8;
#ifndef WGM_P2
#define WGM_P2 4
#endif
#ifndef WGM_P5
#define WGM_P5 4
#endif
#ifndef WGM_P6
#define WGM_P6 4
#endif
#ifndef WGM_P7
#define WGM_P7 1
#endif
constexpr int M_TOK = 16384, DM = 2048, NPROJ = 6144, WIN_LD = 6152, DFF = 5632, NGU = 11264, NADA = 12288;
constexpr int MB_H = 8, MB_DH = 128, MB_BLK = 256, MB_NB = 64;
constexpr int ML_H = 4, ML_DQK = 128, ML_DV = 256, ML_L = 64, ML_NC = 256;
constexpr float DN_ALPHA = 1.189207115002721f;
constexpr float LN_EPS = 1e-5f;
constexpr float K_SCALE = 0.08838834764831845f;

constexpr size_t MiB = 1u << 20;
constexpr size_t WS_CTL = 0, CTL_ZERO_BYTES = 128 * 1024;
constexpr size_t WS_SMALL = 1 * MiB;
constexpr size_t SM_ADA = 0, SM_C1 = 64 * 1024, SM_C2 = 128 * 1024, SM_KMEAN = 256 * 1024, SM_GATES = 512 * 1024, SM_TOKSC = 1 * MiB,
                 SM_CHSUM = 2 * MiB, SM_DECAY = 2 * MiB + 16 * 1024, SM_NLOC = 2 * MiB + 64 * 1024, SM_MUR = 3 * MiB;
constexpr size_t WS_WIN = 6 * MiB, WS_LISTS = 6 * MiB, WS_STATP = 6 * MiB;
constexpr size_t WS_WOUT = 30 * MiB, WS_WGU = 38 * MiB, WS_WDOWN = 82 * MiB;
constexpr size_t WS_U = 104 * MiB, WS_LOCAL = 104 * MiB, WS_Y1B = 104 * MiB;
constexpr size_t WS_MIX = 168 * MiB, WS_H = 168 * MiB;
constexpr size_t WS_KB = 232 * MiB, WS_VB = 264 * MiB, WS_MQK = 296 * MiB, WS_MV = 328 * MiB;
constexpr size_t WS_PART0 = 296 * MiB, WS_PART1 = 328 * MiB, WS_PART2 = 440 * MiB, WS_PART3 = 472 * MiB, WS_LSE = 504 * MiB;
constexpr size_t WS_QC = 360 * MiB, WS_KC = 376 * MiB, WS_KWT = 392 * MiB, WS_VT = 408 * MiB;
constexpr size_t WS_Y2B = 384 * MiB;
constexpr size_t WS_ROPE = 506 * MiB, WS_C12P = 508 * MiB, WS_ADAP = 511 * MiB;
constexpr size_t WS_Y1F = 384 * MiB, WS_END = 512 * MiB;
constexpr int CW_TMO = 0, CW_BAR = 4096, CW_CNT = 16384, CW_QUEUE = 20480, CW_PANEL = 24576;

constexpr int RING_BYTES = 131072, LDSCTL_OFF = RING_BYTES, MISC_OFF = LDSCTL_OFF + 320, LDS_BYTES = 147456;

typedef float f32x2 __attribute__((ext_vector_type(2)));
typedef unsigned u32x2 __attribute__((ext_vector_type(2)));

__device__ __forceinline__ float bf2f(unsigned short b) { return __builtin_bit_cast(float, (unsigned)b << 16); }
__device__ __forceinline__ float bflo(unsigned w) { return __builtin_bit_cast(float, w << 16); }
__device__ __forceinline__ float bfhi(unsigned w) { return __builtin_bit_cast(float, w & 0xffff0000u); }
__device__ __forceinline__ float sigmoid_f(float v) { return 1.f / (1.f + __expf(-v)); }
__device__ __forceinline__ float silu_f(float v) { return v / (1.f + __expf(-v)); }
__device__ __forceinline__ float logsigmoid_f(float v) { return fminf(v, 0.f) - log1pf(expf(-fabsf(v))); }

struct Frame {
    LAS unsigned char* lds;
    volatile LAS unsigned* MISC;
    gu32* ctl;
    int tid, lane, wave, G, bid;
    const float *x, *c, *w_ada, *b_ada, *w_in, *conv_w, *conv_b, *igb, *fgb, *normw, *w_out, *ln1_w, *ln1_b, *w_gu, *w_down, *ln2_w, *ln2_b;
    float* out; unsigned char* ws; unsigned long long tp0, tp1;
};
#if defined(TIME_PHASE)
#define TP_BEGIN(id) do { if (TIME_PHASE == (id)) F.tp0 = __builtin_amdgcn_s_memrealtime(); } while (0)
#define TP_END(id) do { if (TIME_PHASE == (id)) F.tp1 = __builtin_amdgcn_s_memrealtime(); } while (0)
#define TPA_BEGIN(id) unsigned long long tpa_t0_ = (TIME_PHASE == (id)) ? __builtin_amdgcn_s_memrealtime() : 0ull
#define TPA_END(id) do { if (TIME_PHASE == (id)) F.tp1 += __builtin_amdgcn_s_memrealtime() - tpa_t0_; } while (0)
#else
#define TPA_BEGIN(id) do { } while (0)
#define TPA_END(id) do { } while (0)
#define TP_BEGIN(id) do { } while (0)
#define TP_END(id) do { } while (0)
#endif
#define SMALLF(off) ((float*)(F.ws + WS_SMALL + (off)))

__device__ __forceinline__ float wave_sum(float v) {
#pragma unroll
    for (int o = 1; o < 64; o <<= 1) v += __shfl_xor(v, o);
    return v;
}

__device__ __forceinline__ void p0_transpose_item(const float* W, int K, int N, int ld, bf16* WT, LAS float* scr, int item, int lane) {
    const int nblk = N / 32, kb = item / nblk, nb = item % nblk, k0 = 64 * kb, n0 = 32 * nb;
    float ldv[32];
#pragma unroll
    for (int i = 0; i < 32; ++i) ldv[i] = W[(size_t)(k0 + 2 * i + (lane >> 5)) * ld + n0 + (lane & 31)];
#pragma unroll
    for (int i = 0; i < 32; ++i) scr[(2 * i + (lane >> 5)) * 33 + (lane & 31)] = ldv[i];
    LDS_WAIT(); asm volatile("" ::: "memory");
    const int c = lane & 7;
#pragma unroll
    for (int j = 0; j < 4; ++j) { const int n = (lane >> 3) + 8 * j; const LAS float* s = scr + (8 * c) * 33 + n;
        v4u o; o.x = pk2(s[0 * 33], s[1 * 33]); o.y = pk2(s[2 * 33], s[3 * 33]); o.z = pk2(s[4 * 33], s[5 * 33]); o.w = pk2(s[6 * 33], s[7 * 33]);
        *(GAS v4u*)(WT + (size_t)(n0 + n) * K + k0 + 8 * c) = o; }
    LDS_WAIT(); asm volatile("" ::: "memory");
}

__device__ __forceinline__ void p0_phase(Frame& F) {
    TP_BEGIN(120);
    {
        LAS float* sc = (LAS float*)(F.lds); LAS float* red = sc + 2048;
        for (int k = F.tid; k < DM; k += 512) sc[k] = silu_f(F.c[k]);
        __syncthreads();
        float* adap = (float*)(F.ws + WS_ADAP);
        for (int item = F.bid; item < 256; item += F.G) {
            const int kq = item >> 6, slab = item & 63;
            const int rg = F.tid / 48, cq = F.tid % 48;
            if (F.tid < 480) {
                f32x4 acc = {0.f, 0.f, 0.f, 0.f};
                const float* wp = F.w_ada + (size_t)(kq * 512) * NADA + slab * 192 + cq * 4;
#pragma unroll 13
                for (int k = rg; k < 512; k += 10) { const f32x4 w = *(const f32x4*)(wp + (size_t)k * NADA); acc += w * sc[kq * 512 + k]; }
                *(LAS f32x4*)(red + rg * 192 + cq * 4) = acc;
            }
            __syncthreads();
            if (F.tid < 192) { float s = 0.f;
#pragma unroll
                for (int g = 0; g < 10; ++g) s += red[g * 192 + F.tid];
                adap[(size_t)kq * NADA + slab * 192 + F.tid] = s; }
            __syncthreads();
        }
    }
    TP_END(120); TP_BEGIN(121);
    {
        LAS float* scr = (LAS float*)(F.lds + F.wave * 16384);
        const int gw = F.bid * NWAVES + F.wave, NGW = F.G * NWAVES;
        constexpr int I_IN = (DM / 64) * (NPROJ / 32), I_OUT = (DM / 64) * (DM / 32), I_DN = (DFF / 64) * (DM / 32);
        for (int it = gw; it < I_IN + I_OUT + I_DN; it += NGW) {
            int r = it;
            if (r < I_IN) { p0_transpose_item(F.w_in, DM, NPROJ, WIN_LD, (bf16*)(F.ws + WS_WIN), scr, r, F.lane); continue; } r -= I_IN;
            if (r < I_OUT) { p0_transpose_item(F.w_out, DM, DM, DM, (bf16*)(F.ws + WS_WOUT), scr, r, F.lane); continue; } r -= I_OUT;
            p0_transpose_item(F.w_down, DFF, DM, DM, (bf16*)(F.ws + WS_WDOWN), scr, r, F.lane);
        }
    }
    TP_END(121); TP_BEGIN(122);
    for (int i = F.bid * 512 + F.tid; i < MB_H * MB_NB * MB_DH; i += F.G * 512) SMALLF(SM_KMEAN)[i] = 0.f;
    for (int i = F.bid * 512 + F.tid; i < M_TOK * 2; i += F.G * 512) ((unsigned long long*)SMALLF(SM_MUR))[i] = 0ull;
    {
        const double INV[16] = {1.0, 0.44036660267178046, 0.19392274474868576, 0.08539710028576561, 0.03760603093086393, 0.016560440080994446, 0.007292664737217109, 0.003211445994752591,
                                0.001414213562373095, 0.000622772421914596, 0.0002742481756762073, 0.00012076973741146504, 5.318295896944988e-05, 2.341999896140934e-05, 1.031338537721246e-05, 4.5416704806078695e-06};
        float* rope = (float*)(F.ws + WS_ROPE);
        for (int idx = F.bid * 512 + F.tid; idx < M_TOK * 16; idx += F.G * 512) {
            const int pos = idx >> 4, i = idx & 15;
            double inv = INV[0];
#pragma unroll
            for (int j = 1; j < 16; ++j) inv = (i == j) ? INV[j] : inv;
            const double ang = (double)pos * inv;
            const double q = __builtin_floor(ang * 0.6366197723675814 + 0.5);
            double r = __builtin_fma(-q, 1.5707963267948966, ang); r = __builtin_fma(-q, 6.123233995736766e-17, r);
            const int qi = ((int)q) & 3; const double r2 = r * r;
            double cs = 1.0 + r2 * (-0.5 + r2 * (1.0 / 24 + r2 * (-1.0 / 720 + r2 * (1.0 / 40320 + r2 * (-1.0 / 3628800 + r2 * (1.0 / 479001600 + r2 * (-1.0 / 87178291200.0)))))));
            double sn = r * (1.0 + r2 * (-1.0 / 6 + r2 * (1.0 / 120 + r2 * (-1.0 / 5040 + r2 * (1.0 / 362880 + r2 * (-1.0 / 39916800 + r2 * (1.0 / 6227020800.0 + r2 * (-1.0 / 1307674368000.0))))))));
            double co, si;
            if (qi == 0) { co = cs; si = sn; } else if (qi == 1) { co = -sn; si = cs; } else if (qi == 2) { co = -cs; si = -sn; } else { co = sn; si = -cs; }
            rope[pos * 32 + i] = (float)co; rope[pos * 32 + 16 + i] = (float)si;
        }
    }
    TP_END(122);
}

__device__ __forceinline__ float ada_val(const Frame& F, int n) {
    const float* p = (const float*)(F.ws + WS_ADAP) + n;
    return ((p[0] + p[NADA]) + (p[2 * NADA] + p[3 * NADA])) + F.b_ada[n];
}
__device__ __forceinline__ void p1_wgu_item(Frame& F, LAS float* scr, int item) {
    const int lane = F.lane;
    constexpr int nblk = NGU / 32; const int kb = item / nblk, nb = item % nblk, k0 = 64 * kb, n0 = 32 * nb;
    const int pn = n0 >> 8, bj = (n0 >> 7) & 1, idx0 = n0 & 127;
    const int src0 = (bj ? DFF : 0) + pn * 128 + idx0;
    LAS float* wv = scr + 64 * 33; LAS float* bv = wv + 64;
    {   const int k = k0 + lane;
        const float s2 = 1.f + ada_val(F, 4 * DM + k); wv[lane] = F.ln1_w[k] * s2; bv[lane] = F.ln1_b[k] * s2 + ada_val(F, 3 * DM + k); }
    float ldv[32];
#pragma unroll
    for (int i = 0; i < 32; ++i) ldv[i] = F.w_gu[(size_t)(k0 + 2 * i + (lane >> 5)) * NGU + src0 + (lane & 31)];
#pragma unroll
    for (int i = 0; i < 32; ++i) scr[(2 * i + (lane >> 5)) * 33 + (lane & 31)] = ldv[i];
    LDS_WAIT(); asm volatile("" ::: "memory");
    const int c = lane & 7; bf16* WT = (bf16*)(F.ws + WS_WGU);
    float* c1p = (float*)(F.ws + WS_C12P) + (size_t)kb * NGU; float* c2p = (float*)(F.ws + WS_C12P) + (size_t)(32 + kb) * NGU;
#pragma unroll
    for (int j = 0; j < 4; ++j) { const int n = (lane >> 3) + 8 * j; const LAS float* s = scr + (8 * c) * 33 + n;
        float v[8], s1 = 0.f, s2 = 0.f; unsigned short b[8];
#pragma unroll
        for (int e = 0; e < 8; ++e) { const float raw = s[e * 33]; v[e] = raw * wv[8 * c + e]; b[e] = (unsigned short)f2bf(v[e]); s1 += bf2f(b[e]); s2 += raw * bv[8 * c + e]; }
        v4u o; o.x = b[0] | ((unsigned)b[1] << 16); o.y = b[2] | ((unsigned)b[3] << 16); o.z = b[4] | ((unsigned)b[5] << 16); o.w = b[6] | ((unsigned)b[7] << 16);
        *(GAS v4u*)(WT + (size_t)(n0 + n) * DM + k0 + 8 * c) = o;
        s1 += __shfl_xor(s1, 1); s1 += __shfl_xor(s1, 2); s1 += __shfl_xor(s1, 4);
        s2 += __shfl_xor(s2, 1); s2 += __shfl_xor(s2, 2); s2 += __shfl_xor(s2, 4);
        if (c == 0) { c1p[n0 + n] = s1; c2p[n0 + n] = s2; } }
    LDS_WAIT(); asm volatile("" ::: "memory");
}

__device__ __forceinline__ void p1_phase(Frame& F) {
    {   float* ada = SMALLF(SM_ADA);
        for (int n = F.bid * 512 + F.tid; n < NADA; n += F.G * 512) ada[n] = ada_val(F, n); }
    TP_BEGIN(110);
    {
        LAS float* sc1 = (LAS float*)(F.lds);
        LAS float* sh1 = sc1 + 2048;
        LAS float* wgT = sh1 + 2048;
        for (int k = F.tid; k < DM; k += 512) { sc1[k] = 1.f + ada_val(F, DM + k); sh1[k] = ada_val(F, k); }
        for (int i = F.tid; i < DM * 2; i += 512) { const int k = i >> 1, hf = i & 1; const f32x4 v = *(const f32x4*)(F.w_in + (size_t)k * WIN_LD + NPROJ + hf * 4);
            wgT[(hf * 4 + 0) * DM + k] = v.x; wgT[(hf * 4 + 1) * DM + k] = v.y; wgT[(hf * 4 + 2) * DM + k] = v.z; wgT[(hf * 4 + 3) * DM + k] = v.w; }
        __syncthreads();
        bf16* U = (bf16*)(F.ws + WS_U); float* gates = SMALLF(SM_GATES);
        const int rstep = F.G * NWAVES;
#define XROW_LOAD(X, row_) do { const GAS f32x4* xr_ = (const GAS f32x4*)(F.x + (size_t)(row_) * DM) + F.lane; _Pragma("unroll") for (int j = 0; j < 8; ++j) X[j] = xr_[64 * j]; } while (0)
#define XROW_DO(X, row_) do { float g[8]; _Pragma("unroll") for (int e = 0; e < 8; ++e) g[e] = 0.f; \
            GAS unsigned long long* o8 = (GAS unsigned long long*)(U + (size_t)(row_) * DM) + F.lane; \
            _Pragma("unroll") for (int j = 0; j < 8; ++j) { asm volatile("" ::: "memory"); const int k = F.lane * 4 + 256 * j; \
                const f32x4 s = *(LAS f32x4*)(sc1 + k), h = *(LAS f32x4*)(sh1 + k); const f32x4 u = X[j] * s + h; \
                o8[64 * j] = (unsigned long long)pk2(u.x, u.y) | ((unsigned long long)pk2(u.z, u.w) << 32); \
                _Pragma("unroll") for (int e = 0; e < 8; ++e) { const f32x4 w = *(LAS f32x4*)(wgT + e * DM + k); g[e] += (u.x * w.x + u.y * w.y) + (u.z * w.z + u.w * w.w); } } \
            _Pragma("unroll") for (int e = 0; e < 8; ++e) { float t = g[e]; \
                t += __builtin_bit_cast(float, __builtin_amdgcn_update_dpp(0, __builtin_bit_cast(int, t), 0xB1, 0xF, 0xF, true)); \
                t += __builtin_bit_cast(float, __builtin_amdgcn_update_dpp(0, __builtin_bit_cast(int, t), 0x4E, 0xF, 0xF, true)); \
                t += __builtin_bit_cast(float, __builtin_amdgcn_update_dpp(0, __builtin_bit_cast(int, t), 0x141, 0xF, 0xF, true)); \
                t += __builtin_bit_cast(float, __builtin_amdgcn_update_dpp(0, __builtin_bit_cast(int, t), 0x140, 0xF, 0xF, true)); \
                t += __shfl_xor(t, 16); t += __shfl_xor(t, 32); g[e] = t; } \
            if (F.lane == 0) { *(f32x4*)(gates + (row_) * 8) = (f32x4){g[0], g[1], g[2], g[3]}; *(f32x4*)(gates + (row_) * 8 + 4) = (f32x4){g[4], g[5], g[6], g[7]}; } } while (0)
        f32x4 xa[8], xb[8];
        int row = F.bid * NWAVES + F.wave;
        if (row < M_TOK) XROW_LOAD(xa, row);
        while (row < M_TOK) {
            if (row + rstep < M_TOK) XROW_LOAD(xb, row + rstep);
            XROW_DO(xa, row);
            row += rstep; if (row >= M_TOK) break;
            if (row + rstep < M_TOK) XROW_LOAD(xa, row + rstep);
            XROW_DO(xb, row);
            row += rstep;
        }
#undef XROW_LOAD
#undef XROW_DO
        __syncthreads();
    }
    TP_END(110); TP_BEGIN(111);
    {
        LAS float* scr = (LAS float*)(F.lds + F.wave * 16384);
        const int gw = F.bid * NWAVES + F.wave, NGW = F.G * NWAVES;
        constexpr int I_GU = (DM / 64) * (NGU / 32);
        for (int it = gw; it < I_GU; it += NGW) p1_wgu_item(F, scr, it);
    }
    TP_END(111);
}

namespace pg8 {
struct EpiProj {
    static constexpr bool PERM = true, AFTER_DRAIN = false;
    bf16_t *mix, *kb, *vb, *mqk, *mv; const float* rope; float* kmean;
    __device__ __forceinline__ void operator()(const f32x4 (&acc)[2][2][4][2], const Unit& u, int wr, int wc, int fr, int fq) const {
        const int row0 = u.pm * BM + wr * 64 + fr; const int colt = u.pn * BM; const int t = colt >> 10, cl = colt & 1023;
        bf16_t* base; int ldc;
        if (t == 0) { base = mix + 1024; ldc = 2048; } else if (t == 1) { base = kb; ldc = 1024; } else if (t == 2) { base = vb; ldc = 1024; }
        else if (t == 3) { base = mqk; ldc = 1024; } else if (t == 4) { base = mv; ldc = 1024; } else { base = mix; ldc = 2048; }
        const int col0 = cl + wc * 32 + 8 * fq;
        const bool dorope = (t < 2) && (wc == 0);
        const float sgn = (fq < 2) ? -1.f : 1.f;
        f32x4 ks0[2] = {{0.f, 0.f, 0.f, 0.f}, {0.f, 0.f, 0.f, 0.f}}, ks1[2] = {{0.f, 0.f, 0.f, 0.f}, {0.f, 0.f, 0.f, 0.f}};
#pragma unroll
        for (int ai = 0; ai < 2; ++ai) {
            f32x4 rc0[4], rc1[4], rs0[4], rs1[4];
            if (dorope) {
#pragma unroll
                for (int m = 0; m < 4; ++m) { const float* rp = rope + (size_t)(row0 + ai * HALF + m * 16) * 32 + 8 * (fq & 1);
                    rc0[m] = *(const f32x4*)(rp); rc1[m] = *(const f32x4*)(rp + 4); rs0[m] = *(const f32x4*)(rp + 16); rs1[m] = *(const f32x4*)(rp + 20); }
            }
#pragma unroll
            for (int m = 0; m < 4; ++m) {
                const int row = row0 + ai * HALF + m * 16;
                bf16_t* rowp = base + (size_t)row * ldc + col0;
#pragma unroll
                for (int bj = 0; bj < 2; ++bj) {
                    f32x4 v0 = acc[ai][bj][m][0], v1 = acc[ai][bj][m][1];
                    if (dorope) {
                        f32x4 p0, p1;
#pragma unroll
                        for (int i = 0; i < 4; ++i) { p0[i] = __shfl_xor(v0[i], 32); p1[i] = __shfl_xor(v1[i], 32); }
                        v0 = v0 * rc0[m] + p0 * rs0[m] * sgn; v1 = v1 * rc1[m] + p1 * rs1[m] * sgn;
                    }
                    u32x4 w; w.x = cvt_pk_bf16(v0[0], v0[1]); w.y = cvt_pk_bf16(v0[2], v0[3]); w.z = cvt_pk_bf16(v1[0], v1[1]); w.w = cvt_pk_bf16(v1[2], v1[3]);
                    *(u32x4*)(rowp + bj * HALF) = w;
                    if (t == 1) { ks0[bj] += v0; ks1[bj] += v1; }
                }
            }
        }
        if (t == 1) {
#pragma unroll
            for (int bj = 0; bj < 2; ++bj) {
                float s8[8] = {ks0[bj][0], ks0[bj][1], ks0[bj][2], ks0[bj][3], ks1[bj][0], ks1[bj][1], ks1[bj][2], ks1[bj][3]};
#pragma unroll
                for (int e = 0; e < 8; ++e) {
                    float x = s8[e];
                    x += __builtin_bit_cast(float, __builtin_amdgcn_update_dpp(0, __builtin_bit_cast(int, x), 0xB1, 0xF, 0xF, true));
                    x += __builtin_bit_cast(float, __builtin_amdgcn_update_dpp(0, __builtin_bit_cast(int, x), 0x4E, 0xF, 0xF, true));
                    x += __builtin_bit_cast(float, __builtin_amdgcn_update_dpp(0, __builtin_bit_cast(int, x), 0x141, 0xF, 0xF, true));
                    x += __builtin_bit_cast(float, __builtin_amdgcn_update_dpp(0, __builtin_bit_cast(int, x), 0x140, 0xF, 0xF, true));
                    s8[e] = x;
                }
                if (fr == 0) { const int col = cl + bj * HALF + wc * 32 + 8 * fq; float* kp = kmean + ((size_t)(col >> 7) * 64 + u.pm) * 128 + (col & 127);
#pragma unroll
                    for (int e = 0; e < 8; ++e) atomicAdd(kp + e, s8[e] * (1.f / 256.f)); }
            }
        }
    }
};
struct EpiY1 {
    static constexpr bool PERM = false, AFTER_DRAIN = false;
    const float* x; const float* gate1; bf16_t* y1b; unsigned long long* stat;
    __device__ __forceinline__ void operator()(const f32x4 (&acc)[2][2][4][2], const Unit& u, int wr, int wc, int fr, int fq) const {
        const int row0 = u.pm * BM + wr * 64 + fr, col0 = u.pn * BM + wc * 32 + 4 * fq;
        float s[8], ss[8];
#pragma unroll
        for (int i = 0; i < 8; ++i) { s[i] = 0.f; ss[i] = 0.f; }
#pragma unroll
        for (int bj = 0; bj < 2; ++bj)
#pragma unroll
            for (int n = 0; n < 2; ++n) {
                const int c = col0 + bj * HALF + n * 16;
                const f32x4 g1 = *(const f32x4*)(gate1 + c) + 1.0f;
                f32x4 xv[8];
#pragma unroll
                for (int i = 0; i < 8; ++i) xv[i] = *(const f32x4*)(x + (size_t)(row0 + (i >> 2) * HALF + (i & 3) * 16) * 2048 + c);
                asm volatile("" ::: "memory");
#pragma unroll
                for (int i = 0; i < 8; ++i) {
                    const size_t off = (size_t)(row0 + (i >> 2) * HALF + (i & 3) * 16) * 2048 + c;
                    const f32x4 y = xv[i] * 1.189207115002721f + g1 * acc[i >> 2][bj][i & 3][n];
                    typedef unsigned u32x2v __attribute__((ext_vector_type(2)));
                    u32x2v w; w.x = cvt_pk_bf16(y[0], y[1]); w.y = cvt_pk_bf16(y[2], y[3]);
                    *(u32x2v*)(y1b + off) = w;
                    s[i] += (y[0] + y[1]) + (y[2] + y[3]); ss[i] += (y[0] * y[0] + y[1] * y[1]) + (y[2] * y[2] + y[3] * y[3]);
                }
                asm volatile("" ::: "memory");
            }
#pragma unroll
        for (int i = 0; i < 8; ++i) {
            float a = s[i], a2 = ss[i];
            a += __shfl_xor(a, 16); a += __shfl_xor(a, 32); a2 += __shfl_xor(a2, 16); a2 += __shfl_xor(a2, 32);
            if (fq == 0) { unsigned long long* sp = stat + (size_t)(row0 + (i >> 2) * HALF + (i & 3) * 16) * 2;
                atomicAdd(sp, (unsigned long long)(long long)(a * 16777216.f)); atomicAdd(sp + 1, (unsigned long long)(long long)(a2 * 16777216.f)); }
        }
    }
};
__device__ __forceinline__ f32x2 ln_stats_from_fixed(const unsigned long long* sp) {
    typedef unsigned long long u64x2 __attribute__((ext_vector_type(2)));
    const u64x2 v = *(const u64x2*)sp;
    const float s = (float)((double)(long long)v.x * (1.0 / (16777216.0 * 2048.0))), q = (float)((double)(long long)v.y * (1.0 / (16777216.0 * 2048.0)));
    const float var = fmaxf(q - s * s, 0.f);
    return (f32x2){s, rsqrtf(var + 1e-5f)};
}
struct EpiSwiGLU {
    static constexpr bool PERM = true, AFTER_DRAIN = false;
    const unsigned long long* stat; const float* c1; const float* c2; bf16_t* H; unsigned long long* tacc;
    __device__ __forceinline__ void operator()(const f32x4 (&acc)[2][2][4][2], const Unit& u, int wr, int wc, int fr, int fq) const {
#if defined(TIME_PHASE)
        const unsigned long long te0_ = (TIME_PHASE == 170) ? __builtin_amdgcn_s_memrealtime() : 0ull;
#endif
        const int row0 = u.pm * BM + wr * 64 + fr; const int cl = wc * 32 + 8 * fq; const int cg = u.pn * BM + cl;
        f32x4 c1g[2], c2g[2], c1u[2], c2u[2];
#pragma unroll
        for (int n = 0; n < 2; ++n) { c1g[n] = *(const f32x4*)(c1 + cg + 4 * n); c2g[n] = *(const f32x4*)(c2 + cg + 4 * n); c1u[n] = *(const f32x4*)(c1 + cg + HALF + 4 * n); c2u[n] = *(const f32x4*)(c2 + cg + HALF + 4 * n); }
        typedef float f32x2v __attribute__((ext_vector_type(2)));
        f32x2v mrs[8];
#pragma unroll
        for (int i = 0; i < 8; ++i) { const f32x2 t_ = ln_stats_from_fixed(stat + (size_t)(row0 + (i >> 2) * HALF + (i & 3) * 16) * 2); mrs[i] = (f32x2v){t_.x, t_.y}; }
#pragma unroll
        for (int ai = 0; ai < 2; ++ai)
#pragma unroll
            for (int m = 0; m < 4; ++m) {
                const int row = row0 + ai * HALF + m * 16;
                const f32x2v mr = mrs[ai * 4 + m];
                f32x4 hv[2];
#pragma unroll
                for (int n = 0; n < 2; ++n) {
                    const f32x4 g = (acc[ai][0][m][n] - c1g[n] * mr.x) * mr.y + c2g[n];
                    const f32x4 up = (acc[ai][1][m][n] - c1u[n] * mr.x) * mr.y + c2u[n];
#pragma unroll
                    for (int i = 0; i < 4; ++i) { const float e = __builtin_amdgcn_exp2f(g[i] * -1.4426950408889634f); hv[n][i] = g[i] * __builtin_amdgcn_rcpf(1.f + e) * up[i]; }
                }
                u32x4 w; w.x = cvt_pk_bf16(hv[0][0], hv[0][1]); w.y = cvt_pk_bf16(hv[0][2], hv[0][3]); w.z = cvt_pk_bf16(hv[1][0], hv[1][1]); w.w = cvt_pk_bf16(hv[1][2], hv[1][3]);
                *(u32x4*)(H + (size_t)row * 5632 + u.pn * HALF + cl) = w;
            }
#if defined(TIME_PHASE)
        if (TIME_PHASE == 170) *tacc += __builtin_amdgcn_s_memrealtime() - te0_;
#endif
    }
};
struct EpiY2 {
    static constexpr bool PERM = false, AFTER_DRAIN = false;
    const bf16_t* y1b; const unsigned long long* stat; const float* gate2; const float* lw; const float* lb; bf16_t* y2b;
    __device__ __forceinline__ void operator()(const f32x4 (&acc)[2][2][4][2], const Unit& u, int wr, int wc, int fr, int fq) const {
        const int row0 = u.pm * BM + wr * 64 + fr, col0 = u.pn * BM + wc * 32 + 4 * fq;
        typedef float f32x2v __attribute__((ext_vector_type(2)));
        f32x2v mrs[8];
#pragma unroll
        for (int i = 0; i < 8; ++i) { const f32x2 t_ = ln_stats_from_fixed(stat + (size_t)(row0 + (i >> 2) * HALF + (i & 3) * 16) * 2); mrs[i] = (f32x2v){t_.x, t_.y}; }
#pragma unroll
        for (int bj = 0; bj < 2; ++bj)
#pragma unroll
            for (int n = 0; n < 2; ++n) {
                const int c = col0 + bj * HALF + n * 16;
                const f32x4 g2 = *(const f32x4*)(gate2 + c) + 1.0f, w = *(const f32x4*)(lw + c), b = *(const f32x4*)(lb + c);
                f32x4 yv[8];
                {   typedef unsigned u32x2v __attribute__((ext_vector_type(2))); u32x2v yr[8];
#pragma unroll
                    for (int i = 0; i < 8; ++i) yr[i] = *(const u32x2v*)(y1b + (size_t)(row0 + (i >> 2) * HALF + (i & 3) * 16) * 2048 + c);
                    asm volatile("" ::: "memory");
#pragma unroll
                    for (int i = 0; i < 8; ++i) yv[i] = (f32x4){__builtin_bit_cast(float, yr[i].x << 16), __builtin_bit_cast(float, yr[i].x & 0xffff0000u), __builtin_bit_cast(float, yr[i].y << 16), __builtin_bit_cast(float, yr[i].y & 0xffff0000u)}; }
#pragma unroll
                for (int i = 0; i < 8; ++i) {
                    const size_t off = (size_t)(row0 + (i >> 2) * HALF + (i & 3) * 16) * 2048 + c;
                    const f32x4 x1 = (yv[i] - mrs[i].x) * mrs[i].y * w + b;
                    const f32x4 y2 = x1 * 1.189207115002721f + g2 * acc[i >> 2][bj][i & 3][n];
                    typedef unsigned u32x2w __attribute__((ext_vector_type(2))); u32x2w pk; pk.x = cvt_pk_bf16(y2[0], y2[1]); pk.y = cvt_pk_bf16(y2[2], y2[3]);
                    *(u32x2w*)(y2b + off) = pk;
                }
                asm volatile("" ::: "memory");
            }
    }
};
}

__device__ __forceinline__ float wave_incl_scan_add(float v, int lane) {
#pragma unroll
    for (int o = 1; o < 64; o <<= 1) { const float t = __shfl_up(v, o); if (lane >= o) v += t; }
    return v;
}
__device__ __forceinline__ float wave_incl_scan_max(float v, int lane) {
#pragma unroll
    for (int o = 1; o < 64; o <<= 1) { const float t = __shfl_up(v, o); if (lane >= o) v = fmaxf(v, t); }
    return v;
}
__device__ __forceinline__ void p3_chunk_item(Frame& F, int c) {
    const int t0 = c * ML_L, tid = F.tid, lane = F.lane;
    LAS float* wgt = (LAS float*)F.lds;
    LAS unsigned short* KT = (LAS unsigned short*)(F.lds + 1024);
    LAS unsigned short* VTh = (LAS unsigned short*)(F.lds + 1024 + 512 * 72 * 2);
    const float* gates = SMALLF(SM_GATES);
    if (F.wave < 4) {
        const int h = F.wave, t = t0 + lane;
        const float ig = gates[t * 8 + h] + F.igb[h], fg = gates[t * 8 + 4 + h] + F.fgb[h];
        const float lf = logsigmoid_f(fg);
        const float b = wave_incl_scan_add(lf, lane), u = ig - b, m1 = wave_incl_scan_max(u, lane);
        const float m1l = __shfl(m1, 63), bl = __shfl(b, 63);
        *(f32x4*)(SMALLF(SM_TOKSC) + (size_t)(t * 4 + h) * 4) = (f32x4){b, u, m1, 0.f};
        if (lane == 63) { SMALLF(SM_CHSUM)[(c * 4 + h) * 2] = bl; SMALLF(SM_CHSUM)[(c * 4 + h) * 2 + 1] = m1l; }
        wgt[h * 64 + lane] = expf(u - m1l);
    }
    {
        const int cgp = tid & 127, rq = tid >> 7, ch0 = cgp * 8, r0 = 16 * rq;
        const v4u* MQK = (const v4u*)(F.ws + WS_MQK);
        float w[4][8], bs[8];
#pragma unroll
        for (int j = 0; j < 4; ++j) { const f32x4 a = *(const f32x4*)(F.conv_w + j * 1024 + ch0), b = *(const f32x4*)(F.conv_w + j * 1024 + ch0 + 4);
            w[j][0] = a.x; w[j][1] = a.y; w[j][2] = a.z; w[j][3] = a.w; w[j][4] = b.x; w[j][5] = b.y; w[j][6] = b.z; w[j][7] = b.w; }
        { const f32x4 a = *(const f32x4*)(F.conv_b + ch0), b = *(const f32x4*)(F.conv_b + ch0 + 4); bs[0] = a.x; bs[1] = a.y; bs[2] = a.z; bs[3] = a.w; bs[4] = b.x; bs[5] = b.y; bs[6] = b.z; bs[7] = b.w; }
        __syncthreads();
        const bool isq = ch0 < 512; const int hh = (ch0 - 512) >> 7;
        v4u* QC = (v4u*)(F.ws + WS_QC); v4u* KC = (v4u*)(F.ws + WS_KC);
#pragma unroll 1
        for (int hf = 0; hf < 2; ++hf) {
        v4u xin[11];
#pragma unroll
        for (int i = 0; i < 11; ++i) { const int t = t0 + r0 + 8 * hf - 3 + i; xin[i] = (t >= 0) ? MQK[(size_t)t * 128 + cgp] : (v4u){0u, 0u, 0u, 0u}; }
#pragma unroll
        for (int r = 0; r < 8; ++r) {
            float y[8];
#pragma unroll
            for (int e = 0; e < 8; ++e) y[e] = bs[e];
#pragma unroll
            for (int j = 0; j < 4; ++j) { const v4u x = xin[r + j];
                y[0] += w[j][0] * bflo(x.x); y[1] += w[j][1] * bfhi(x.x); y[2] += w[j][2] * bflo(x.y); y[3] += w[j][3] * bfhi(x.y);
                y[4] += w[j][4] * bflo(x.z); y[5] += w[j][5] * bfhi(x.z); y[6] += w[j][6] * bflo(x.w); y[7] += w[j][7] * bfhi(x.w); }
#pragma unroll
            for (int e = 0; e < 8; ++e) y[e] = silu_f(y[e]);
            const int s = r0 + 8 * hf + r;
            if (isq) { v4u o; o.x = pk2(y[0], y[1]); o.y = pk2(y[2], y[3]); o.z = pk2(y[4], y[5]); o.w = pk2(y[6], y[7]); QC[(size_t)(t0 + s) * 64 + cgp] = o; }
            else {
#pragma unroll
                for (int e = 0; e < 8; ++e) y[e] *= K_SCALE;
                v4u o; o.x = pk2(y[0], y[1]); o.y = pk2(y[2], y[3]); o.z = pk2(y[4], y[5]); o.w = pk2(y[6], y[7]); KC[(size_t)(t0 + s) * 64 + (cgp - 64)] = o;
                const float wg_ = wgt[hh * 64 + s];
#pragma unroll
                for (int e = 0; e < 8; ++e) KT[(ch0 - 512 + e) * 72 + s] = (unsigned short)f2bf(y[e] * wg_);
            }
        }
        }
    }
    __syncthreads();
    {
        float sm = 0.f;
#pragma unroll
        for (int i = 0; i < 8; ++i) { const v4u v = *(LAS v4u*)(KT + tid * 72 + i * 8); sm += bflo(v.x) + bfhi(v.x) + bflo(v.y) + bfhi(v.y) + bflo(v.z) + bfhi(v.z) + bflo(v.w) + bfhi(v.w); }
        SMALLF(SM_NLOC)[(size_t)c * 512 + tid] = sm;
    }
    const v4u* MV = (const v4u*)(F.ws + WS_MV);
    const int r = lane & 31, hh2 = lane >> 5, w = F.wave;
    const int vg = tid & 31, sq = tid >> 5;
    v4u vin[4];
#pragma unroll
    for (int i = 0; i < 4; ++i) vin[i] = MV[(size_t)(t0 + 4 * sq + i) * 128 + vg];
#pragma unroll 1
    for (int h = 0; h < 4; ++h) {
#pragma unroll
        for (int i = 0; i < 4; ++i) { const int s = 4 * sq + i; LAS unsigned short* p = VTh + (8 * vg) * 72 + s;
            p[0] = (unsigned short)vin[i].x; p[72] = (unsigned short)(vin[i].x >> 16); p[144] = (unsigned short)vin[i].y; p[216] = (unsigned short)(vin[i].y >> 16);
            p[288] = (unsigned short)vin[i].z; p[360] = (unsigned short)(vin[i].z >> 16); p[432] = (unsigned short)vin[i].w; p[504] = (unsigned short)(vin[i].w >> 16); }
        __syncthreads();
        if (h < 3) {
#pragma unroll
            for (int i = 0; i < 4; ++i) vin[i] = MV[(size_t)(t0 + 4 * sq + i) * 128 + (h + 1) * 32 + vg];
        }
        {
            unsigned long long* VT8 = (unsigned long long*)(F.ws + WS_VT) + (size_t)(c * 4 + h) * 4096;
#pragma unroll
            for (int p = 0; p < 8; ++p) { const int idx = p * 512 + tid, sb = idx >> 8, v = idx & 255;
                VT8[idx] = *(LAS unsigned long long*)(VTh + v * 72 + sb * 4); } }
        {
            pg8::bf16x8 bfr[4];
#pragma unroll
            for (int ks = 0; ks < 4; ++ks) bfr[ks] = *(LAS pg8::bf16x8*)(VTh + (32 * w + r) * 72 + 16 * ks + 8 * hh2);
            unsigned short* LOC = (unsigned short*)(F.ws + WS_LOCAL) + (size_t)(c * 4 + h) * 256 * 128 + (size_t)(32 * w + r) * 8 + 4 * hh2;
#pragma unroll
            for (int dt = 0; dt < 4; ++dt) {
                __attribute__((ext_vector_type(16))) float acc = {};
#pragma unroll
                for (int ks = 0; ks < 4; ++ks) { const pg8::bf16x8 af = *(LAS pg8::bf16x8*)(KT + (h * 128 + 32 * dt + r) * 72 + 16 * ks + 8 * hh2);
                    acc = __builtin_amdgcn_mfma_f32_32x32x16_bf16(af, bfr[ks], acc, 0, 0, 0); }
#pragma unroll
                for (int g = 0; g < 4; ++g) { u32x2 o; o.x = pk2(acc[4 * g], acc[4 * g + 1]); o.y = pk2(acc[4 * g + 2], acc[4 * g + 3]);
                    *(u32x2*)(LOC + (size_t)(4 * dt + g) * 2048) = o; }
            }
        }
        __syncthreads();
    }
}
__device__ __forceinline__ void p3_kmean_item(Frame& F, int j) {
    const v4u* KB = (const v4u*)(F.ws + WS_KB);
    const int cg = F.tid & 127, rg = F.tid >> 7;
    float s[8];
#pragma unroll
    for (int e = 0; e < 8; ++e) s[e] = 0.f;
#pragma unroll 16
    for (int r = 0; r < 64; ++r) { const v4u v = KB[(size_t)(j * MB_BLK + rg * 64 + r) * 128 + cg];
        s[0] += bflo(v.x); s[1] += bfhi(v.x); s[2] += bflo(v.y); s[3] += bfhi(v.y); s[4] += bflo(v.z); s[5] += bfhi(v.z); s[6] += bflo(v.w); s[7] += bfhi(v.w); }
    LAS float* red = (LAS float*)F.lds;
#pragma unroll
    for (int e = 0; e < 8; ++e) red[rg * 1024 + cg * 8 + e] = s[e];
    __syncthreads();
#pragma unroll
    for (int e = 0; e < 2; ++e) { const int col = F.tid * 2 + e; const float t = (red[col] + red[1024 + col]) + (red[2048 + col] + red[3072 + col]);
        SMALLF(SM_KMEAN)[(size_t)((col >> 7) * 64 + j) * 128 + (col & 127)] = t * (1.f / 256.f); }
    __syncthreads();
}
__device__ __forceinline__ void p3_c12_item(Frame& F, int it) {
    const int n = it * 512 + F.tid; if (n >= NGU) return;
    const float* p = (const float*)(F.ws + WS_C12P);
    float a = 0.f, b = 0.f;
    for (int k = 0; k < 32; ++k) { a += p[(size_t)k * NGU + n]; b += p[(size_t)(32 + k) * NGU + n]; }
    SMALLF(SM_C1)[n] = a; SMALLF(SM_C2)[n] = b;
}
__device__ __forceinline__ void moba_select_item(Frame& F, int b, int h);
__device__ __forceinline__ void p3_phase(Frame& F) {
    constexpr int N_CH = ML_NC, N_SEL = MB_NB * MB_H, N_C12 = NGU / 512;
    for (int it = F.bid; it < N_CH + N_SEL + N_C12; it += F.G) {
        if (it < N_CH) { TP_BEGIN(160); p3_chunk_item(F, it); TP_END(160); }
        else if (it < N_CH + N_SEL) {
#if !defined(NAIVE_MOBA)
            const int i = it - N_CH, b = 63 - (i >> 3), h = i & 7; if (b > 0) moba_select_item(F, b, h);
#endif
        }
        else p3_c12_item(F, it - N_CH - N_SEL);
    }
}

__device__ __forceinline__ void stat_phase(Frame& F) {
    const float* sp = (const float*)(F.ws + WS_STATP); float* mur = SMALLF(SM_MUR);
    for (int row = F.bid * 512 + F.tid; row < M_TOK; row += F.G * 512) {
        float s = 0.f, ss = 0.f;
#pragma unroll
        for (int i = 0; i < 16; ++i) { const f32x4 v = *(const f32x4*)(sp + (size_t)row * 64 + i * 4); s += v.x + v.z; ss += v.y + v.w; }
        const float mean = s * (1.f / DM); const float var = fmaxf(ss * (1.f / DM) - mean * mean, 0.f);
        mur[row * 2] = mean; mur[row * 2 + 1] = rsqrtf(var + LN_EPS);
    }
}
__device__ __forceinline__ void ln2_rows(Frame& F, int row0, int nrows) {
    const v4u* Y2 = (const v4u*)(F.ws + WS_Y2B);
#define LN2_LOAD(V, row_) do { const v4u* xr_ = Y2 + (size_t)(row_) * 256 + F.lane; _Pragma("unroll") for (int j = 0; j < 4; ++j) V[j] = xr_[64 * j]; } while (0)
#define LN2_DO(V, row_) do { GAS f32x4* xw_ = (GAS f32x4*)(F.out + (size_t)(row_) * DM); float s = 0.f; f32x4 f[8]; \
        _Pragma("unroll") for (int j = 0; j < 4; ++j) { f[2 * j] = (f32x4){bflo(V[j].x), bfhi(V[j].x), bflo(V[j].y), bfhi(V[j].y)}; f[2 * j + 1] = (f32x4){bflo(V[j].z), bfhi(V[j].z), bflo(V[j].w), bfhi(V[j].w)}; } \
        _Pragma("unroll") for (int j = 0; j < 8; ++j) s += (f[j].x + f[j].y) + (f[j].z + f[j].w); \
        const float mean = wave_sum(s) * (1.f / DM); float s2 = 0.f; \
        _Pragma("unroll") for (int j = 0; j < 8; ++j) { f[j] = f[j] - mean; s2 += (f[j].x * f[j].x + f[j].y * f[j].y) + (f[j].z * f[j].z + f[j].w * f[j].w); } \
        const float rstd = rsqrtf(wave_sum(s2) * (1.f / DM) + LN_EPS); \
        _Pragma("unroll") for (int j = 0; j < 8; ++j) { const int k = (F.lane + 64 * (j >> 1)) * 8 + 4 * (j & 1); const f32x4 w = *(const f32x4*)(F.ln2_w + k), b = *(const f32x4*)(F.ln2_b + k); *(GAS f32x4*)((GAS float*)xw_ + k) = f[j] * rstd * w + b; } } while (0)
    v4u va[4], vb[4];
    int rr = F.wave;
    if (rr < nrows) LN2_LOAD(va, row0 + rr);
    while (rr < nrows) {
        if (rr + NWAVES < nrows) LN2_LOAD(vb, row0 + rr + NWAVES);
        LN2_DO(va, row0 + rr);
        rr += NWAVES; if (rr >= nrows) break;
        if (rr + NWAVES < nrows) LN2_LOAD(va, row0 + rr + NWAVES);
        LN2_DO(vb, row0 + rr);
        rr += NWAVES;
    }
#undef LN2_LOAD
#undef LN2_DO
}
__device__ __forceinline__ bool ln2_panel_fused(Frame& F) {
    pg8::StaticOrder S; S.init(M_TOK, DM, F.G, F.bid, WGM_P7); pg8::Unit u0, u1, u2;
    if (F.G != 256 || !S.next(0, u0) || !S.next(1, u1) || S.next(2, u2)) return false;
    gu32* c0 = F.ctl + CW_PANEL + 64 * u0.pm; gu32* c1 = F.ctl + CW_PANEL + 64 * u1.pm;
    asm volatile("s_waitcnt vmcnt(0)" ::: "memory");
    __syncthreads();
    if (F.tid == 0) {
        __builtin_amdgcn_fence(__ATOMIC_RELEASE, "agent"); asm volatile("s_waitcnt vmcnt(0)" ::: "memory");
        __hip_atomic_fetch_add(c0, 1u, __ATOMIC_RELAXED, __HIP_MEMORY_SCOPE_AGENT);
        __hip_atomic_fetch_add(c1, 1u, __ATOMIC_RELAXED, __HIP_MEMORY_SCOPE_AGENT);
        unsigned sp = 0;
        while (__hip_atomic_load(c0, __ATOMIC_RELAXED, __HIP_MEMORY_SCOPE_AGENT) < 8u || __hip_atomic_load(c1, __ATOMIC_RELAXED, __HIP_MEMORY_SCOPE_AGENT) < 8u) { __builtin_amdgcn_s_sleep(2); if (++sp > (1u << 22)) break; }
        __builtin_amdgcn_fence(__ATOMIC_ACQUIRE, "agent"); asm volatile("s_waitcnt vmcnt(0)" ::: "memory");
    }
    __syncthreads();
    ln2_rows(F, u0.pm * 256 + 32 * u0.pn, 32);
    ln2_rows(F, u1.pm * 256 + 32 * u1.pn, 32);
    return true;
}
__device__ __forceinline__ void ln2_phase(Frame& F) {
    for (int r0 = F.bid * NWAVES; r0 < M_TOK; r0 += F.G * NWAVES) ln2_rows(F, r0, NWAVES);
}
typedef short s16x4 __attribute__((ext_vector_type(4)));
typedef float f32x16 __attribute__((ext_vector_type(16)));
typedef unsigned u32x4v __attribute__((ext_vector_type(4)));
#define MFMA32(a, b, c) __builtin_amdgcn_mfma_f32_32x32x16_bf16((a), (b), (c), 0, 0, 0)
#define SBAR() __builtin_amdgcn_sched_barrier(0)
__device__ __forceinline__ int crow(int r, int hi) { return (r & 3) + 8 * (r >> 2) + 4 * hi; }
typedef float cv_f32x2_t __attribute__((ext_vector_type(2))); typedef __bf16 cv_bf16x2_t __attribute__((ext_vector_type(2)));
__device__ __forceinline__ unsigned cvtpk(float lo, float hi) { cv_f32x2_t v = {lo, hi}; cv_bf16x2_t b = __builtin_convertvector(v, cv_bf16x2_t); return __builtin_bit_cast(unsigned, b); }

constexpr int LIST_HSTRIDE = 256 * 2016;
__device__ __forceinline__ int list_off(int h, int j) { return h * LIST_HSTRIDE + 256 * (63 * j - (j * (j - 1)) / 2); }
__device__ __forceinline__ unsigned short* part_ptr(unsigned char* ws, int slot) {
    return (unsigned short*)(ws + (slot == 0 ? WS_PART0 : slot == 1 ? WS_PART1 : slot == 2 ? WS_PART2 : WS_PART3));
}

#define TOP3_INS(S_, J_) do { const float s__ = (S_); const int j__ = (J_); \
    if (s__ > v0 || (s__ == v0 && j__ < i0)) { v2 = v1; i2 = i1; v1 = v0; i1 = i0; v0 = s__; i0 = j__; } \
    else if (s__ > v1 || (s__ == v1 && j__ < i1)) { v2 = v1; i2 = i1; v1 = s__; i1 = j__; } \
    else if (s__ > v2 || (s__ == v2 && j__ < i2)) { v2 = s__; i2 = j__; } } while (0)
__device__ __forceinline__ void moba_select_item(Frame& F, int b, int h) {
    const int tid = F.tid, lane = F.lane, r32 = lane & 31, hi = lane >> 5, w = F.wave;
    constexpr int KS = 136;
    LAS unsigned short* kmh = (LAS unsigned short*)F.lds;
    LAS unsigned short* kml = kmh + 64 * KS;
    LAS int* hist = (LAS int*)(F.lds + 2 * 64 * KS * 2);
    LAS int* base = hist + 64;
    {   const float* src = SMALLF(SM_KMEAN) + (size_t)h * 64 * 128;
        for (int i = tid; i < 64 * 32; i += 512) { const int j = i >> 5, c4 = (i & 31) * 4; f32x4 f = {0.f, 0.f, 0.f, 0.f}; if (j < b) f = *(const f32x4*)(src + j * 128 + c4);
            const unsigned h0 = f2bf(f.x), h1 = f2bf(f.y), h2 = f2bf(f.z), h3 = f2bf(f.w);
            const float l0 = f.x - bf2f((unsigned short)h0), l1 = f.y - bf2f((unsigned short)h1), l2 = f.z - bf2f((unsigned short)h2), l3 = f.w - bf2f((unsigned short)h3);
            *(LAS u32x2*)(kmh + j * KS + c4) = (u32x2){h0 | (h1 << 16), h2 | (h3 << 16)};
            *(LAS u32x2*)(kml + j * KS + c4) = (u32x2){pk2(l0, l1), pk2(l2, l3)}; }
        if (tid < 64) hist[tid] = 0; }
    __syncthreads();
    const int p = b * 256 + 32 * w + r32;
    bf16x8 qf[8];
    {   const unsigned short* qp = (const unsigned short*)(F.ws + WS_MIX) + (size_t)p * 2048 + 1024 + h * 128 + 8 * hi;
#pragma unroll
        for (int kd = 0; kd < 8; ++kd) qf[kd] = *(const bf16x8*)(qp + 16 * kd); }
    float v0 = -INFINITY, v1 = -INFINITY, v2 = -INFINITY; int i0 = 64, i1 = 64, i2 = 64;
    const int ntile = (b + 31) >> 5;
#pragma unroll 1
    for (int tile = 0; tile < ntile; ++tile) {
        f32x16 acc = {};
#pragma unroll
        for (int kd = 0; kd < 8; ++kd) {
            const bf16x8 ah = *(const LAS bf16x8*)(kmh + (32 * tile + r32) * KS + 16 * kd + 8 * hi), al = *(const LAS bf16x8*)(kml + (32 * tile + r32) * KS + 16 * kd + 8 * hi);
            acc = MFMA32(ah, qf[kd], acc); acc = MFMA32(al, qf[kd], acc);
        }
#pragma unroll
        for (int r = 0; r < 16; ++r) { const int j = 32 * tile + crow(r, hi); const float s = (j < b) ? acc[r] : -INFINITY; TOP3_INS(s, j); }
    }
    {
        const float u0 = __shfl_xor(v0, 32), u1 = __shfl_xor(v1, 32), u2 = __shfl_xor(v2, 32); const int k0 = __shfl_xor(i0, 32), k1 = __shfl_xor(i1, 32), k2 = __shfl_xor(i2, 32);
        TOP3_INS(u0, k0); TOP3_INS(u1, k1); TOP3_INS(u2, k2); }
    const int nsel = b < 3 ? b : 3; int sel[3] = {i0, i1, i2}, rank[3] = {0, 0, 0};
    if (hi == 0) {
#pragma unroll
        for (int k = 0; k < 3; ++k) if (k < nsel) rank[k] = atomicAdd((int*)&hist[sel[k]], 1);
    }
    __syncthreads();
    if (tid < 64) { const int n = hist[tid]; base[tid] = n ? (int)atomicAdd((unsigned*)(F.ctl + CW_CNT + h * 64 + tid), (unsigned)n) : 0; }
    __syncthreads();
    if (hi == 0) { unsigned* lists = (unsigned*)(F.ws + WS_LISTS);
#pragma unroll
        for (int k = 0; k < 3; ++k) if (k < nsel) lists[list_off(h, sel[k]) + base[sel[k]] + rank[k]] = ((unsigned)p << 2) | (unsigned)k; }
    __syncthreads();
}
#undef TOP3_INS

namespace moba {
constexpr int D = 128, NW = 8, QBLK = 32, KVBLK = 64, LDK = 1024;
constexpr float SCALE = 0.088388347648318440f, THR = 8.f;
constexpr size_t SHM_V = KVBLK * D * 2, SHM_K = KVBLK * D * 2, SHM_ATTN = 2 * SHM_V + 2 * SHM_K + NW * 128 * 4;
#define KSWZ(row, colB) ((row) * 256 + ((colB) ^ (((row) & 7) << 4)))
__device__ __forceinline__ void partialSM(f32x16& p0, f32x16& p1, float& m_reg, float& mn, float& alpha) {
  constexpr float C = SCALE * 1.4426950408889634f;
  float pmax = p0[0]; for (int r = 1; r < 16; ++r) pmax = fmaxf(pmax, p0[r]); for (int r = 0; r < 16; ++r) pmax = fmaxf(pmax, p1[r]);
  { auto rr = __builtin_amdgcn_permlane32_swap(__float_as_uint(pmax), __float_as_uint(pmax), false, false);
    pmax = fmaxf(__uint_as_float(rr[0]), __uint_as_float(rr[1])); }
  if (__builtin_expect(__all(pmax - m_reg <= THR / SCALE), 1)) { mn = m_reg; alpha = 1.f; }
  else { mn = fmaxf(m_reg, pmax); alpha = __builtin_amdgcn_exp2f((m_reg - mn) * C); m_reg = mn; }
  float mnC = -mn * C;
  for (int r = 0; r < 16; ++r) p0[r] = fmaf(p0[r], C, mnC); for (int r = 0; r < 16; ++r) p1[r] = fmaf(p1[r], C, mnC);
  for (int r = 0; r < 16; ++r) p0[r] = __builtin_amdgcn_exp2f(p0[r]);
}
__device__ __forceinline__ void finishSM(f32x16& p0, f32x16& p1, float alpha, float& l_reg, bf16x8& pa0, bf16x8& pa1, bf16x8& pa2, bf16x8& pa3) {
  for (int r = 0; r < 16; ++r) p1[r] = __builtin_amdgcn_exp2f(p1[r]);
  float ps = 0; for (int r = 0; r < 16; ++r) ps += p0[r]; for (int r = 0; r < 16; ++r) ps += p1[r];
  { auto rr = __builtin_amdgcn_permlane32_swap(__float_as_uint(ps), __float_as_uint(ps), false, false);
    ps = __uint_as_float(rr[0]) + __uint_as_float(rr[1]); }
  l_reg = l_reg * alpha + ps;
#define PK4(P, BASE, OUT) do { unsigned a0 = cvtpk(P[BASE + 0], P[BASE + 1]), a1 = cvtpk(P[BASE + 2], P[BASE + 3]);   \
    unsigned b0 = cvtpk(P[BASE + 4], P[BASE + 5]), b1 = cvtpk(P[BASE + 6], P[BASE + 7]);                              \
    auto r0 = __builtin_amdgcn_permlane32_swap(a0, b0, false, false); auto r1 = __builtin_amdgcn_permlane32_swap(a1, b1, false, false); \
    u32x4v w = {r0[0], r1[0], r0[1], r1[1]}; OUT = *reinterpret_cast<bf16x8*>(&w); } while (0)
  PK4(p0, 0, pa0); PK4(p0, 8, pa1); PK4(p1, 0, pa2); PK4(p1, 8, pa3);
#undef PK4
}
__device__ __forceinline__ void qkt(f32x16& p0, f32x16& p1, const char* Ks, const bf16x8* qr, int r32, int hi) {
  const f32x16 z = {};
  bf16x8 a0 = *reinterpret_cast<const bf16x8*>(Ks + KSWZ(r32, (hi * 8) * 2)), a1 = *reinterpret_cast<const bf16x8*>(Ks + KSWZ(32 + r32, (hi * 8) * 2));
#pragma unroll
  for (int d0 = 0; d0 < 8; ++d0) {
    bf16x8 n0 = a0, n1 = a1;
    if (d0 < 7) { const int cb = ((d0 + 1) * 16 + hi * 8) * 2; n0 = *reinterpret_cast<const bf16x8*>(Ks + KSWZ(r32, cb)); n1 = *reinterpret_cast<const bf16x8*>(Ks + KSWZ(32 + r32, cb)); }
    p0 = MFMA32(a0, qr[d0], d0 == 0 ? z : p0);
    p1 = MFMA32(a1, qr[d0], d0 == 0 ? z : p1);
    a0 = n0; a1 = n1;
  }
}
__device__ __forceinline__ int v_st(int k, int c) { const int kk = (k & ~0xC) | ((k & 4) << 1) | ((k & 8) >> 1); return ((kk >> 3) * 4 + (c >> 5)) * 512 + ((kk & 7) * 32 + (c & 31)) * 2; }
__device__ __forceinline__ int v_rd_base(int lane) { return ((lane & 3) << 3) | (((lane >> 2) & 3) << 6) | (((lane >> 4) & 1) << 5) | (((lane >> 5) & 1) << 8); }
constexpr int v_rd_off(int d0, int ks, int half) { return d0 * 512 + ks * 4096 + half * 2048; }
template <int OFF> __device__ __forceinline__ s16x4 tr_read(int vb) {
  s16x4 r; asm volatile("ds_read_b64_tr_b16 %0, %1 offset:%2" : "=&v"(r) : "v"(vb), "i"(OFF) : "memory"); return r;
}
template <int D0> __device__ __forceinline__ void pv_one(f32x16& od, int vb, bf16x8 pa0, bf16x8 pa1, bf16x8 pa2, bf16x8 pa3) {
  const s16x4 l0 = tr_read<v_rd_off(D0, 0, 0)>(vb), h0 = tr_read<v_rd_off(D0, 0, 1)>(vb), l1 = tr_read<v_rd_off(D0, 1, 0)>(vb), h1 = tr_read<v_rd_off(D0, 1, 1)>(vb);
  const s16x4 l2 = tr_read<v_rd_off(D0, 2, 0)>(vb), h2 = tr_read<v_rd_off(D0, 2, 1)>(vb), l3 = tr_read<v_rd_off(D0, 3, 0)>(vb), h3 = tr_read<v_rd_off(D0, 3, 1)>(vb);
  asm volatile("s_waitcnt lgkmcnt(0)" ::: "memory"); SBAR();
#define PK(L, H) (bf16x8){L[0], L[1], L[2], L[3], H[0], H[1], H[2], H[3]}
  od = MFMA32(pa0, PK(l0, h0), od);
  od = MFMA32(pa1, PK(l1, h1), od);
  od = MFMA32(pa2, PK(l2, h2), od);
  od = MFMA32(pa3, PK(l3, h3), od);
#undef PK
}
__device__ __forceinline__ void pv_d0(f32x16* o, int vb, bf16x8 pa0, bf16x8 pa1, bf16x8 pa2, bf16x8 pa3) {
  pv_one<0>(o[0], vb, pa0, pa1, pa2, pa3); pv_one<1>(o[1], vb, pa0, pa1, pa2, pa3); pv_one<2>(o[2], vb, pa0, pa1, pa2, pa3); pv_one<3>(o[3], vb, pa0, pa1, pa2, pa3);
}
__device__ __forceinline__ void cmask(f32x16& p0, f32x16& p1, int tile, int qloc, int hi) {
#pragma unroll
  for (int r = 0; r < 16; ++r) { const int key = 64 * tile + crow(r, hi); if (key > qloc) p0[r] = -1e30f; if (key + 32 > qloc) p1[r] = -1e30f; }
}
#ifndef MOBA_STAGGER
#define MOBA_STAGGER 24
#endif
constexpr int MAXWC = 24;
constexpr int TILE_B = 16384;
__device__ __forceinline__ void wave_chunk(const bf16x8 (&qr)[8], int nt, bool causal, int qloc, const char* K_lds, int vb0, float* ws, unsigned rowoff, unsigned lseoff, unsigned char* wsb, int r32, int hi) {
  float* li_l = ws; float* al_l = ws + 32; unsigned* id_l = (unsigned*)(ws + 64);
  float m_reg = -1e30f, l_reg = 0; f32x16 o[4] = {};
#pragma unroll 1
  for (int t = 0; t < nt; ++t) {
    f32x16 p0, p1; float mn, alpha; bf16x8 pa0, pa1, pa2, pa3;
    __builtin_amdgcn_s_setprio(1); qkt(p0, p1, K_lds + t * TILE_B, qr, r32, hi); __builtin_amdgcn_s_setprio(0);
    if (causal && t == nt - 1) cmask(p0, p1, t, qloc, hi);
    partialSM(p0, p1, m_reg, mn, alpha);
    finishSM(p0, p1, alpha, l_reg, pa0, pa1, pa2, pa3);
    if (__any(alpha < 1.f)) { if (hi == 0) al_l[r32] = alpha; asm volatile("s_waitcnt lgkmcnt(0)" ::: "memory");
#pragma unroll
      for (int d = 0; d < 4; ++d)
#pragma unroll
        for (int r = 0; r < 16; ++r) o[d][r] *= al_l[crow(r, hi)]; }
    SBAR();
    __builtin_amdgcn_s_setprio(1); pv_d0(o, vb0 + t * TILE_B, pa0, pa1, pa2, pa3); __builtin_amdgcn_s_setprio(0);
  }
  if (hi == 0) { li_l[r32] = l_reg; id_l[r32] = rowoff; *(float*)(wsb + lseoff) = m_reg * (SCALE * 1.4426950408889634f) + __builtin_amdgcn_logf(l_reg); }
  asm volatile("s_waitcnt lgkmcnt(0)" ::: "memory");
#pragma unroll
  for (int r = 0; r < 16; ++r) { const int orow = crow(r, hi); const unsigned off = id_l[orow]; const float rl = __builtin_amdgcn_rcpf(li_l[orow]);
    unsigned short* dst = (unsigned short*)(wsb + off) + r32;
#pragma unroll
    for (int d0 = 0; d0 < 4; ++d0) dst[d0 * 32] = (unsigned short)(cvtpk(o[d0][r] * rl, 0.f)); }
  asm volatile("s_waitcnt lgkmcnt(0)" ::: "memory");
}
#undef KSWZ
}

__device__ __forceinline__ void moba_attn_phase(Frame& F) {
    constexpr int SCR_OFF = LDSCTL_OFF + 1024, PREF_OFF = SCR_OFF + 4096;
    LAS int* prefF = (LAS int*)(F.lds + PREF_OFF);
    LAS int* prefP = prefF + 520;
    LAS int* wsum = prefP + 520;
    LAS int* tk = wsum + 16;
    const int tid = F.tid;
    {   const unsigned n = __hip_atomic_load(F.ctl + CW_CNT + tid, __ATOMIC_RELAXED, __HIP_MEMORY_SCOPE_AGENT);
        const int wc = 8 + (int)((n + 31u) >> 5); const int nf = wc / moba::MAXWC, np = (wc % moba::MAXWC) ? 1 : 0;
        int v = nf, u = np;
#pragma unroll
        for (int o = 1; o < 64; o <<= 1) { const int t = __shfl_up(v, o), t2 = __shfl_up(u, o); if (F.lane >= o) { v += t; u += t2; } }
        if (F.lane == 63) { wsum[F.wave] = v; wsum[8 + F.wave] = u; }
        __syncthreads();
        int add = 0, add2 = 0;
#pragma unroll
        for (int w = 0; w < 8; ++w) { add += (w < F.wave) ? wsum[w] : 0; add2 += (w < F.wave) ? wsum[8 + w] : 0; }
        prefF[tid] = v - nf + add; prefP[tid] = u - np + add2;
        if (tid == 511) { prefF[512] = v + add; prefP[512] = u + add2; }
        if (tid == 0) tk[0] = (int)atomicAdd((unsigned*)(F.ctl + CW_QUEUE), 1u);
        __syncthreads();
    }
    const int totalF = prefF[512], total = totalF + prefP[512];
    const unsigned short* MIXq = (const unsigned short*)(F.ws + WS_MIX) + 1024;
    const unsigned short* KB = (const unsigned short*)(F.ws + WS_KB); const unsigned short* VB = (const unsigned short*)(F.ws + WS_VB);
    const unsigned* lists = (const unsigned*)(F.ws + WS_LISTS);
    const int r32 = F.lane & 31, hi = F.lane >> 5, w = F.wave;
    char* K_lds = (char*)F.lds; char* V_lds = (char*)F.lds + 4 * moba::TILE_B;
    float* scr = (float*)((char*)F.lds + SCR_OFF) + w * 128;
    const int vb0 = (int)(uintptr_t)V_lds + moba::v_rd_base(F.lane);
    const int sr = tid >> 4, sc = (tid & 15) * 8, vst0 = moba::v_st(sr, sc), vst1 = moba::v_st(32 + sr, sc);
    int it = tk[0];
    while (it < total) {
        const bool isfull = it < totalF; const int r_ = isfull ? it : it - totalF; LAS int* pref = isfull ? prefF : prefP;
        int lo = 0, hi_ = 512;
        while (hi_ - lo > 1) { const int mid = (lo + hi_) >> 1; if (pref[mid] <= r_) lo = mid; else hi_ = mid; }
        const int e = lo, h = e >> 6, j = e & 63;
        const int n = (int)__hip_atomic_load(F.ctl + CW_CNT + e, __ATOMIC_RELAXED, __HIP_MEMORY_SCOPE_AGENT);
        const int wc_e = 8 + ((n + 31) >> 5); const int sub = isfull ? (r_ - pref[e]) : (wc_e / moba::MAXWC);
        const int q_lo = sub * moba::MAXWC, q_hi = (q_lo + moba::MAXWC < wc_e) ? q_lo + moba::MAXWC : wc_e;
        const unsigned short* Kh = KB + (size_t)(j * 256) * 1024 + h * 128; const unsigned short* Vh = VB + (size_t)(j * 256) * 1024 + h * 128;
        { TPA_BEGIN(130);
        __syncthreads();
        if (tid == 0) tk[0] = (int)atomicAdd((unsigned*)(F.ctl + CW_QUEUE), 1u);
        {   bf16x8 kv[16];
#pragma unroll
            for (int tt = 0; tt < 4; ++tt) { const int k0 = tt * 64;
                kv[4 * tt + 0] = *(const bf16x8*)(Vh + (size_t)(k0 + sr) * 1024 + sc); kv[4 * tt + 1] = *(const bf16x8*)(Vh + (size_t)(k0 + 32 + sr) * 1024 + sc);
                kv[4 * tt + 2] = *(const bf16x8*)(Kh + (size_t)(k0 + sr) * 1024 + sc); kv[4 * tt + 3] = *(const bf16x8*)(Kh + (size_t)(k0 + 32 + sr) * 1024 + sc); }
#pragma unroll
            for (int tt = 0; tt < 4; ++tt) { const int tb = tt * moba::TILE_B, kc = sc * 2;
                *(bf16x8*)(V_lds + tb + vst0) = kv[4 * tt + 0]; *(bf16x8*)(V_lds + tb + vst1) = kv[4 * tt + 1];
                *(bf16x8*)(K_lds + tb + ((sr) * 256 + ((kc) ^ (((sr) & 7) << 4)))) = kv[4 * tt + 2];
                *(bf16x8*)(K_lds + tb + ((32 + sr) * 256 + ((kc) ^ (((32 + sr) & 7) << 4)))) = kv[4 * tt + 3]; }
        }
        __syncthreads();
        TPA_END(130); }
        it = tk[0];
        TPA_BEGIN(131);
        if (w >= 4) __builtin_amdgcn_s_sleep(MOBA_STAGGER);
        bf16x8 qa[8], qb[8]; unsigned ida = 0, idb = 0, lsa = 0, lsb = 0; int nta = 4, ntb = 4, qla = 0, qlb = 0; bool ca = false, cb = false;
        const unsigned dump = (unsigned)WS_KWT + (unsigned)((F.bid * 8 + w) * 512);
#define PART_OFF(slot_) ((unsigned)(((slot_) & 2) ? WS_PART2 : WS_PART0) + (unsigned)((slot_) & 1) * (unsigned)(32 * MiB))
#define WC_SETUP(Q_, QF, ID, LS, NT, QL, CZ) do { const int q__ = (Q_); const unsigned short* qp__; \
        if (q__ < 8) { const int p__ = j * 256 + 32 * q__ + r32; qp__ = MIXq + (size_t)p__ * 2048 + h * 128 + hi * 8; ID = PART_OFF(3) + (unsigned)(p__ * 8 + h) * 256u; LS = (unsigned)WS_LSE + (unsigned)((p__ * 8 + h) * 4 + 3) * 4u; NT = (q__ >> 1) + 1; QL = 32 * q__ + r32; CZ = true; } \
        else { const int idx__ = 32 * (q__ - 8) + r32; const bool v__ = idx__ < n; const unsigned ent__ = lists[list_off(h, j) + (v__ ? idx__ : 0)]; const int p__ = (int)(ent__ >> 2); const int sl__ = (int)(ent__ & 3u); \
               qp__ = MIXq + (size_t)p__ * 2048 + h * 128 + hi * 8; ID = v__ ? PART_OFF(sl__) + (unsigned)(p__ * 8 + h) * 256u : dump; LS = v__ ? (unsigned)WS_LSE + (unsigned)((p__ * 8 + h) * 4 + sl__) * 4u : dump + 256u; NT = 4; QL = 0; CZ = false; } \
        _Pragma("unroll") for (int d0 = 0; d0 < 8; ++d0) QF[d0] = *reinterpret_cast<const bf16x8*>(qp__ + d0 * 16); } while (0)
        int q = q_lo + w;
        if (q < q_hi) WC_SETUP(q, qa, ida, lsa, nta, qla, ca);
        while (q < q_hi) {
            if (q + 8 < q_hi) WC_SETUP(q + 8, qb, idb, lsb, ntb, qlb, cb);
            moba::wave_chunk(qa, nta, ca, qla, K_lds, vb0, scr, ida, lsa, F.ws, r32, hi);
            q += 8; if (q >= q_hi) break;
            if (q + 8 < q_hi) WC_SETUP(q + 8, qa, ida, lsa, nta, qla, ca);
            moba::wave_chunk(qb, ntb, cb, qlb, K_lds, vb0, scr, idb, lsb, F.ws, r32, hi);
            q += 8;
        }
#undef PART_OFF
#undef WC_SETUP
        TPA_END(131);
    }
}

__device__ __forceinline__ void moba_merge_phase(Frame& F, int wg, int nwg) {
    const float* lse = (const float*)(F.ws + WS_LSE);
    const u32x4v* P0 = (const u32x4v*)(F.ws + WS_PART0); const u32x4v* P1 = (const u32x4v*)(F.ws + WS_PART1);
    const u32x4v* P2 = (const u32x4v*)(F.ws + WS_PART2); const u32x4v* P3 = (const u32x4v*)(F.ws + WS_PART3);
    for (int g = wg * 512 + F.tid; g < M_TOK * MB_H * 16; g += nwg * 512) {
        const int ph = g >> 4, dg = g & 15, p = ph >> 3;
#if defined(DBG_OWN_ONLY)
        const int nsel = 0;
#else
        const int nsel = (p >> 8) < 3 ? (p >> 8) : 3;
#endif
        const f32x4 l4 = *(const f32x4*)(lse + (size_t)ph * 4);
        const size_t po = (size_t)ph * 16 + dg;
        const u32x4v v0 = P0[po], v1 = P1[po], v2 = P2[po], v3 = P3[po];
        const float l0 = nsel > 0 ? l4[0] : -INFINITY, l1 = nsel > 1 ? l4[1] : -INFINITY, l2 = nsel > 2 ? l4[2] : -INFINITY, l3 = l4[3];
        const float mx = fmaxf(fmaxf(l0, l1), fmaxf(l2, l3));
        const float w0 = nsel > 0 ? __builtin_amdgcn_exp2f(l0 - mx) : 0.f, w1 = nsel > 1 ? __builtin_amdgcn_exp2f(l1 - mx) : 0.f, w2 = nsel > 2 ? __builtin_amdgcn_exp2f(l2 - mx) : 0.f, w3 = __builtin_amdgcn_exp2f(l3 - mx);
        const u32x4v z = {0u, 0u, 0u, 0u};
        const u32x4v a0 = nsel > 0 ? v0 : z, a1 = nsel > 1 ? v1 : z, a2 = nsel > 2 ? v2 : z;
        const float inv = 1.f / ((w0 + w1) + (w2 + w3));
        float acc[8];
#define MRG(E, F_) acc[E] = (w0 * F_(a0[E >> 1]) + w1 * F_(a1[E >> 1])) + (w2 * F_(a2[E >> 1]) + w3 * F_(v3[E >> 1]))
        MRG(0, bflo); MRG(1, bfhi); MRG(2, bflo); MRG(3, bfhi); MRG(4, bflo); MRG(5, bfhi); MRG(6, bflo); MRG(7, bfhi);
#undef MRG
        u32x4v o; o.x = pk2(acc[0] * inv, acc[1] * inv); o.y = pk2(acc[2] * inv, acc[3] * inv); o.z = pk2(acc[4] * inv, acc[5] * inv); o.w = pk2(acc[6] * inv, acc[7] * inv);
        *(u32x4v*)((unsigned short*)(F.ws + WS_MIX) + (size_t)p * 2048 + 1024 + (ph & 7) * 128 + dg * 8) = o;
    }
}

__device__ __forceinline__ void ml_mscan(const float* chsum, int h, int c, int lane, float& m_c, float& m_c1) {
    float a[4], g[4]; float A = 0.f, G = -INFINITY;
#pragma unroll
    for (int i = 0; i < 4; ++i) { const int cc = 4 * lane + i; const float bl = chsum[(cc * 4 + h) * 2], m1 = chsum[(cc * 4 + h) * 2 + 1]; a[i] = bl; g[i] = bl + m1; G = fmaxf(G + a[i], g[i]); A += a[i]; }
#pragma unroll
    for (int o = 1; o < 64; o <<= 1) { const float Ao = __shfl_up(A, o), Go = __shfl_up(G, o); if (lane >= o) { G = fmaxf(Go + A, G); A = Ao + A; } }
    float Ae = __shfl_up(A, 1), Ge = __shfl_up(G, 1); if (lane == 0) { Ae = 0.f; Ge = -INFINITY; }
    float m = fmaxf(Ae, Ge), mc = 0.f, mc1 = 0.f;
#pragma unroll
    for (int i = 0; i < 4; ++i) { if (i == (c & 3)) mc = m; m = fmaxf(m + a[i], g[i]); if (i == (c & 3)) mc1 = m; }
    m_c = __shfl(mc, c >> 2); m_c1 = __shfl(mc1, c >> 2);
}
__device__ __forceinline__ void ml_tables(const float* chsum, int h, int lane, LAS float* dec, LAS float* scl) {
    float a[4], g[4]; float A = 0.f, G = -INFINITY;
#pragma unroll
    for (int i = 0; i < 4; ++i) { const int cc = 4 * lane + i; const float bl = chsum[(cc * 4 + h) * 2], m1 = chsum[(cc * 4 + h) * 2 + 1]; a[i] = bl; g[i] = bl + m1; G = fmaxf(G + a[i], g[i]); A += a[i]; }
#pragma unroll
    for (int o = 1; o < 64; o <<= 1) { const float Ao = __shfl_up(A, o), Go = __shfl_up(G, o); if (lane >= o) { G = fmaxf(Go + A, G); A = Ao + A; } }
    float Ae = __shfl_up(A, 1), Ge = __shfl_up(G, 1); if (lane == 0) { Ae = 0.f; Ge = -INFINITY; }
    float m = fmaxf(Ae, Ge);
#pragma unroll
    for (int i = 0; i < 4; ++i) { const float mn = fmaxf(m + a[i], g[i]); dec[4 * lane + i] = expf(a[i] + m - mn); scl[4 * lane + i] = expf(g[i] - mn); m = mn; }
}
__device__ __forceinline__ void ml_scan_item(Frame& F, int item) {
    LAS float* dec = (LAS float*)F.lds; LAS float* scl = dec + 1024;
    if (item < 32) {
        const int gid = item * 512 + F.tid, h = gid >> 12, rem = gid & 4095;
        if (F.wave == 0) ml_tables(SMALLF(SM_CHSUM), h, F.lane, dec, scl);
        __syncthreads();
        u32x4v* base = (u32x4v*)((unsigned short*)(F.ws + WS_LOCAL) + (size_t)h * 256 * 128) + rem;
        constexpr size_t CST = (size_t)4 * 256 * 128 / 8;
        float C[8];
#pragma unroll
        for (int e = 0; e < 8; ++e) C[e] = 0.f;
        u32x4v la[16], lb[16];
#define SC_LOAD(L, c0_) do { _Pragma("unroll") for (int i = 0; i < 16; ++i) L[i] = base[(size_t)((c0_) + i) * CST]; } while (0)
#define SC_STEP(L, c0_) do { _Pragma("unroll") for (int i = 0; i < 16; ++i) { \
            u32x4v st; st.x = cvtpk(C[0], C[1]); st.y = cvtpk(C[2], C[3]); st.z = cvtpk(C[4], C[5]); st.w = cvtpk(C[6], C[7]); \
            base[(size_t)((c0_) + i) * CST] = st; \
            const u32x4v v = L[i]; const float d = dec[(c0_) + i], s = scl[(c0_) + i]; \
            C[0] = d * C[0] + s * bflo(v.x); C[1] = d * C[1] + s * bfhi(v.x); C[2] = d * C[2] + s * bflo(v.y); C[3] = d * C[3] + s * bfhi(v.y); \
            C[4] = d * C[4] + s * bflo(v.z); C[5] = d * C[5] + s * bfhi(v.z); C[6] = d * C[6] + s * bflo(v.w); C[7] = d * C[7] + s * bfhi(v.w); } } while (0)
        SC_LOAD(la, 0);
#pragma unroll 1
        for (int c0 = 0; c0 < ML_NC; c0 += 32) {
            SC_LOAD(lb, c0 + 16);
            SC_STEP(la, c0);
            if (c0 + 32 < ML_NC) SC_LOAD(la, c0 + 32);
            SC_STEP(lb, c0 + 16);
        }
#undef SC_LOAD
#undef SC_STEP
        __syncthreads();
    } else {
        if (F.wave < 4) ml_tables(SMALLF(SM_CHSUM), F.wave, F.lane, dec + F.wave * 256, scl + F.wave * 256);
        __syncthreads();
        const int h = F.tid >> 7, d = F.tid & 127; float* nl = SMALLF(SM_NLOC) + h * 128 + d; float n = 0.f;
#pragma unroll 1
        for (int c0 = 0; c0 < ML_NC; c0 += 32) {
            float lv[32];
#pragma unroll
            for (int i = 0; i < 32; ++i) lv[i] = nl[(size_t)(c0 + i) * 512];
#pragma unroll
            for (int i = 0; i < 32; ++i) { nl[(size_t)(c0 + i) * 512] = n; n = dec[h * 256 + c0 + i] * n + scl[h * 256 + c0 + i] * lv[i]; }
        }
        __syncthreads();
    }
}
__device__ __forceinline__ float dpp_row_sum(float x) {
    x += __builtin_bit_cast(float, __builtin_amdgcn_update_dpp(0, __builtin_bit_cast(int, x), 0xB1, 0xF, 0xF, true));
    x += __builtin_bit_cast(float, __builtin_amdgcn_update_dpp(0, __builtin_bit_cast(int, x), 0x4E, 0xF, 0xF, true));
    x += __builtin_bit_cast(float, __builtin_amdgcn_update_dpp(0, __builtin_bit_cast(int, x), 0x141, 0xF, 0xF, true));
    x += __builtin_bit_cast(float, __builtin_amdgcn_update_dpp(0, __builtin_bit_cast(int, x), 0x140, 0xF, 0xF, true));
    return x;
}
struct MlRegs { v4u gq[2], gk[2], gm[4]; bf16x8 cf[8]; u32x2 vlo[4], vhi[4]; };
__device__ __forceinline__ void ml_load_tiles(Frame& F, int c, int h, MlRegs& R) {
    const int tid = F.tid, t0 = c * ML_L;
    const v4u* QC = (const v4u*)(F.ws + WS_QC); const v4u* KC = (const v4u*)(F.ws + WS_KC); const v4u* MX = (const v4u*)(F.ws + WS_MIX);
#pragma unroll
    for (int i = 0; i < 2; ++i) { const int idx = tid + 512 * i, row = idx >> 4, ch = idx & 15; R.gq[i] = QC[(size_t)(t0 + row) * 64 + h * 16 + ch]; R.gk[i] = KC[(size_t)(t0 + row) * 64 + h * 16 + ch]; }
    (void)MX;
}
__device__ __forceinline__ void ml_load_state(Frame& F, int c, int h, MlRegs& R) {
    const int hh = F.lane >> 5, vcol = 32 * F.wave + (F.lane & 31);
    const unsigned short* ST = (const unsigned short*)(F.ws + WS_LOCAL) + (size_t)(c * 4 + h) * 256 * 128 + (size_t)vcol * 8;
#pragma unroll
    for (int kd = 0; kd < 8; ++kd) R.cf[kd] = *(const bf16x8*)(ST + (2 * kd + hh) * 2048);
}
__device__ __forceinline__ void ml_load_vt(Frame& F, int c, int h, MlRegs& R) {
    const int hh = F.lane >> 5, vcol = 32 * F.wave + (F.lane & 31);
    const unsigned short* VTv = (const unsigned short*)(F.ws + WS_VT) + (size_t)(c * 4 + h) * 256 * 64 + (size_t)vcol * 4;
#pragma unroll
    for (int i = 0; i < 4; ++i) { R.vlo[i] = *(const u32x2*)(VTv + (4 * i + hh) * 1024); R.vhi[i] = *(const u32x2*)(VTv + (4 * i + 2 + hh) * 1024); }
}
__device__ __forceinline__ void ml_out_item(Frame& F, int c, int h, MlRegs& R, bool has_next, int cn, int hn) {
    const int lane = F.lane, r = lane & 31, hh = lane >> 5, w = F.wave, tid = F.tid, t0 = c * ML_L;
    constexpr int QS = 136, MS = 264;
    LAS float* tb_u = (LAS float*)F.lds;
    LAS float* tb_mt = tb_u + 64;
    LAS float* tb_wi = tb_mt + 64;
    LAS float* tb_em = tb_wi + 64;
    LAS float* tb_n = tb_em + 64;
    LAS float* tb_den = tb_n + 128;
    LAS float* tb_ln = tb_den + 512;
    LAS float* tb_mr = tb_ln + 1024;
    LAS unsigned short* Ql = (LAS unsigned short*)(F.lds + 8192);
    LAS unsigned short* Kl = Ql + 64 * QS;
    LAS unsigned short* Ml = Kl + 64 * QS;
    const int vcol = 32 * w + r;
    ml_load_tiles(F, c, h, R);
    {   const v4u* MX = (const v4u*)(F.ws + WS_MIX);
#pragma unroll
        for (int i = 0; i < 4; ++i) { const int idx = tid + 512 * i, row = idx >> 5, ch = idx & 31; R.gm[i] = MX[(size_t)(t0 + row) * 256 + h * 32 + ch]; } }
    float m_c, m_c1; ml_mscan(SMALLF(SM_CHSUM), h, c, lane, m_c, m_c1);
    if (tid < 64) { const f32x4 ts = *(const f32x4*)(SMALLF(SM_TOKSC) + (size_t)((t0 + tid) * 4 + h) * 4);
        const float mt = fmaxf(m_c, ts.z); tb_u[tid] = ts.y; tb_mt[tid] = mt; tb_wi[tid] = expf(m_c - mt); tb_em[tid] = expf(-(ts.x + mt)); }
    if (tid >= 64 && tid < 192) tb_n[tid - 64] = SMALLF(SM_NLOC)[(c * 4 + h) * 128 + tid - 64];
#pragma unroll
    for (int i = 0; i < 2; ++i) { const int idx = tid + 512 * i, row = idx >> 4, ch = idx & 15; *(LAS v4u*)(Ql + row * QS + ch * 8) = R.gq[i]; *(LAS v4u*)(Kl + row * QS + ch * 8) = R.gk[i]; }
#pragma unroll
    for (int i = 0; i < 4; ++i) { const int idx = tid + 512 * i, row = idx >> 5, ch = idx & 31; *(LAS v4u*)(Ml + row * MS + ch * 8) = R.gm[i]; }
    __syncthreads();
    f32x16 s00 = {}, s01 = {}, s11 = {};
    float qn0 = 0.f, qn1 = 0.f;
#pragma unroll 1
    for (int kd = 0; kd < 8; ++kd) {
        const bf16x8 q0 = *(const LAS bf16x8*)(Ql + r * QS + 16 * kd + 8 * hh), q1 = *(const LAS bf16x8*)(Ql + (32 + r) * QS + 16 * kd + 8 * hh);
        const bf16x8 k0 = *(const LAS bf16x8*)(Kl + r * QS + 16 * kd + 8 * hh), k1 = *(const LAS bf16x8*)(Kl + (32 + r) * QS + 16 * kd + 8 * hh);
        s00 = MFMA32(k0, q0, s00); s01 = MFMA32(k0, q1, s01); s11 = MFMA32(k1, q1, s11);
        const f32x4 n0 = *(const LAS f32x4*)(tb_n + 16 * kd + 8 * hh), n1 = *(const LAS f32x4*)(tb_n + 16 * kd + 8 * hh + 4);
        const u32x4v a = __builtin_bit_cast(u32x4v, q0), b = __builtin_bit_cast(u32x4v, q1);
        qn0 += bflo(a.x) * n0.x + bfhi(a.x) * n0.y + bflo(a.y) * n0.z + bfhi(a.y) * n0.w + bflo(a.z) * n1.x + bfhi(a.z) * n1.y + bflo(a.w) * n1.z + bfhi(a.w) * n1.w;
        qn1 += bflo(b.x) * n0.x + bfhi(b.x) * n0.y + bflo(b.y) * n0.z + bfhi(b.y) * n0.w + bflo(b.z) * n1.x + bfhi(b.z) * n1.y + bflo(b.w) * n1.z + bfhi(b.w) * n1.w;
    }
    const float mt0 = tb_mt[r], mt1 = tb_mt[32 + r];
    float rs0 = 0.f, rs1 = 0.f;
#pragma unroll
    for (int q = 0; q < 16; ++q) {
        const int s = crow(q, hh); const float u0 = tb_u[s], u1 = tb_u[32 + s];
        s00[q] = (s <= r) ? s00[q] * __expf(u0 - mt0) : 0.f;
        s01[q] = s01[q] * __expf(u0 - mt1);
        s11[q] = (s <= r) ? s11[q] * __expf(u1 - mt1) : 0.f;
        rs0 += s00[q]; rs1 += s01[q] + s11[q];
    }
    rs0 += __shfl_xor(rs0, 32); rs1 += __shfl_xor(rs1, 32); qn0 += __shfl_xor(qn0, 32); qn1 += __shfl_xor(qn1, 32);
    {   const float den0 = tb_wi[r] * qn0 + rs0, den1 = tb_wi[32 + r] * qn1 + rs1;
        if (hh == 0) { tb_den[w * 64 + r] = 1.f / fmaxf(fabsf(den0), tb_em[r]); tb_den[w * 64 + 32 + r] = 1.f / fmaxf(fabsf(den1), tb_em[32 + r]); } }
    bf16x8 p00[2], p01[2], p11[2];
#pragma unroll
    for (int ks = 0; ks < 2; ++ks) {
        u32x4v x; x.x = cvtpk(s00[8 * ks], s00[8 * ks + 1]); x.y = cvtpk(s00[8 * ks + 2], s00[8 * ks + 3]); x.z = cvtpk(s00[8 * ks + 4], s00[8 * ks + 5]); x.w = cvtpk(s00[8 * ks + 6], s00[8 * ks + 7]); p00[ks] = __builtin_bit_cast(bf16x8, x);
        x.x = cvtpk(s01[8 * ks], s01[8 * ks + 1]); x.y = cvtpk(s01[8 * ks + 2], s01[8 * ks + 3]); x.z = cvtpk(s01[8 * ks + 4], s01[8 * ks + 5]); x.w = cvtpk(s01[8 * ks + 6], s01[8 * ks + 7]); p01[ks] = __builtin_bit_cast(bf16x8, x);
        x.x = cvtpk(s11[8 * ks], s11[8 * ks + 1]); x.y = cvtpk(s11[8 * ks + 2], s11[8 * ks + 3]); x.z = cvtpk(s11[8 * ks + 4], s11[8 * ks + 5]); x.w = cvtpk(s11[8 * ks + 6], s11[8 * ks + 7]); p11[ks] = __builtin_bit_cast(bf16x8, x);
    }
    f32x16 o0 = {}, o1 = {};
#pragma unroll
    for (int kd = 0; kd < 8; ++kd) {
        const bf16x8 q0 = *(const LAS bf16x8*)(Ql + r * QS + 16 * kd + 8 * hh), q1 = *(const LAS bf16x8*)(Ql + (32 + r) * QS + 16 * kd + 8 * hh);
        o0 = MFMA32(q0, R.cf[kd], o0); o1 = MFMA32(q1, R.cf[kd], o1); }
    asm volatile("" ::: "memory");
    if (has_next) ml_load_state(F, cn, hn, R);
#pragma unroll
    for (int q = 0; q < 16; ++q) { o0[q] *= tb_wi[crow(q, hh)]; o1[q] *= tb_wi[32 + crow(q, hh)]; }
#pragma unroll
    for (int st = 0; st < 2; ++st)
#pragma unroll
        for (int ks = 0; ks < 2; ++ks) {
            u32x4v bb; bb.x = R.vlo[2 * st + ks].x; bb.y = R.vlo[2 * st + ks].y; bb.z = R.vhi[2 * st + ks].x; bb.w = R.vhi[2 * st + ks].y; const bf16x8 vf = __builtin_bit_cast(bf16x8, bb);
            if (st == 0) { o0 = MFMA32(p00[ks], vf, o0); o1 = MFMA32(p01[ks], vf, o1); } else { o1 = MFMA32(p11[ks], vf, o1); }
        }
    asm volatile("" ::: "memory");
    if (has_next) ml_load_vt(F, cn, hn, R);
#pragma unroll
    for (int q = 0; q < 16; ++q) { o0[q] *= tb_den[w * 64 + crow(q, hh)]; o1[q] *= tb_den[w * 64 + 32 + crow(q, hh)]; }
#pragma unroll
    for (int q = 0; q < 16; ++q) {
        float a = dpp_row_sum(o0[q]), a2 = dpp_row_sum(o0[q] * o0[q]), b = dpp_row_sum(o1[q]), b2 = dpp_row_sum(o1[q] * o1[q]);
        a += __shfl_xor(a, 16); a2 += __shfl_xor(a2, 16); b += __shfl_xor(b, 16); b2 += __shfl_xor(b2, 16);
        if (r == 0) { const int t = crow(q, hh); tb_ln[(w * 64 + t) * 2] = a; tb_ln[(w * 64 + t) * 2 + 1] = a2; tb_ln[(w * 64 + 32 + t) * 2] = b; tb_ln[(w * 64 + 32 + t) * 2 + 1] = b2; }
    }
    __syncthreads();
    if (tid < 64) { float s = 0.f, s2 = 0.f;
#pragma unroll
        for (int ww = 0; ww < 8; ++ww) { s += tb_ln[(ww * 64 + tid) * 2]; s2 += tb_ln[(ww * 64 + tid) * 2 + 1]; }
        const float mu = s * (1.f / 256.f), var = fmaxf(s2 * (1.f / 256.f) - mu * mu, 0.f); tb_mr[tid * 2] = mu; tb_mr[tid * 2 + 1] = rsqrtf(var + LN_EPS); }
    __syncthreads();
    const float nw = F.normw[h * 256 + vcol];
#pragma unroll
    for (int tt = 0; tt < 2; ++tt)
#pragma unroll
        for (int q = 0; q < 16; ++q) {
            const int t = 32 * tt + crow(q, hh); const float mu = tb_mr[t * 2], rstd = tb_mr[t * 2 + 1];
            const float hv = tt ? o1[q] : o0[q];
            LAS unsigned short* op = Ml + t * MS + vcol; const float mo = bf2f(*op);
            *op = (unsigned short)f2bf((hv - mu) * rstd * nw * sigmoid_f(mo));
        }
    __syncthreads();
    {   v4u* MX = (v4u*)(F.ws + WS_MIX);
#pragma unroll
        for (int i = 0; i < 4; ++i) { const int idx = tid + 512 * i, row = idx >> 5, ch = idx & 31; MX[(size_t)(t0 + row) * 256 + h * 32 + ch] = *(LAS v4u*)(Ml + row * MS + ch * 8); } }
    __syncthreads();
}

__device__ __forceinline__ void x2_phase(Frame& F) {
    constexpr int NSCAN = 33;
#if defined(NAIVE_MOBA)
    for (int i = F.bid; i < NSCAN; i += F.G) ml_scan_item(F, i);
#elif defined(NAIVE_MLSTM)
    moba_attn_phase(F);
#else
    for (int i = F.bid; i < NSCAN; i += F.G) { TP_BEGIN(100); ml_scan_item(F, i); TP_END(100); }
    __syncthreads();
    TP_BEGIN(101); moba_attn_phase(F); TP_END(101);
#endif
}
__device__ __forceinline__ void x3_phase(Frame& F) {
#if !defined(NAIVE_MLSTM)
    TP_BEGIN(150);
    {   MlRegs R; int it = F.bid;
        if (it < ML_NC * ML_H) { ml_load_state(F, it >> 2, it & 3, R); ml_load_vt(F, it >> 2, it & 3, R); }
        for (; it < ML_NC * ML_H; it += F.G) { const int nx = it + F.G; const bool hn = nx < ML_NC * ML_H; ml_out_item(F, it >> 2, it & 3, R, hn, nx >> 2, nx & 3); } }
    TP_END(150);
#endif
#if !defined(NAIVE_MOBA) && !defined(DBG_SKIP_MERGE)
    TP_BEGIN(151); moba_merge_phase(F, F.bid, F.G); TP_END(151);
#endif
}
__global__ void __launch_bounds__(512) naive_moba(unsigned char* ws) {
    __shared__ float qf_s[8][128];
    __shared__ float pb_s[8][1024];
    const int wave = threadIdx.x >> 6, lane = threadIdx.x & 63;
    const int gw = blockIdx.x * 8 + wave; const int p = gw >> 3, h = gw & 7;
    unsigned short* MIX = (unsigned short*)(ws + WS_MIX);
    const unsigned short* KB = (const unsigned short*)(ws + WS_KB); const unsigned short* VB = (const unsigned short*)(ws + WS_VB);
    const float* kmean = (const float*)(ws + WS_SMALL + SM_KMEAN);
    float* qf = qf_s[wave]; float* pb = pb_s[wave];
    unsigned short* qp = MIX + (size_t)p * 2048 + 1024 + h * 128;
    qf[lane * 2] = bf2f(qp[lane * 2]); qf[lane * 2 + 1] = bf2f(qp[lane * 2 + 1]);
    __syncthreads();
    const int b = p >> 8;
    float sc = -INFINITY;
    if (lane < b) { const float* km = kmean + (size_t)(h * 64 + lane) * 128; float s = 0.f; for (int d = 0; d < 128; ++d) s += qf[d] * km[d]; sc = s; }
    int sel[3]; const int nsel = b < 3 ? b : 3;
#pragma unroll
    for (int k = 0; k < 3; ++k) {
        float bv = sc; int bi = lane;
        for (int o = 1; o < 64; o <<= 1) { const float ov = __shfl_xor(bv, o); const int oi = __shfl_xor(bi, o); if (ov > bv || (ov == bv && oi < bi)) { bv = ov; bi = oi; } }
        sel[k] = bi; if (lane == bi) sc = -INFINITY;
    }
    float s[16]; float mx = -INFINITY;
#pragma unroll
    for (int bi = 0; bi < 4; ++bi) {
        const bool valid = (bi < nsel) || (bi == 3); const int blk = (bi == 3) ? b : sel[bi < 3 ? bi : 0];
#pragma unroll
        for (int kk = 0; kk < 4; ++kk) {
            float v = -INFINITY;
            if (valid) { const int key = blk * 256 + kk * 64 + lane; const unsigned short* kr = KB + (size_t)key * 1024 + h * 128; float a = 0.f; for (int d = 0; d < 128; ++d) a += qf[d] * bf2f(kr[d]); a *= K_SCALE; if (bi == 3 && key > p) a = -INFINITY; v = a; }
            s[bi * 4 + kk] = v; mx = fmaxf(mx, v);
        }
    }
    for (int o = 1; o < 64; o <<= 1) mx = fmaxf(mx, __shfl_xor(mx, o));
    float sum = 0.f;
#pragma unroll
    for (int i = 0; i < 16; ++i) { const float e = (s[i] == -INFINITY) ? 0.f : expf(s[i] - mx); pb[i * 64 + lane] = e; sum += e; }
    sum = wave_sum(sum);
    __syncthreads();
    float o0 = 0.f, o1 = 0.f;
#pragma unroll
    for (int bi = 0; bi < 4; ++bi) {
        const bool valid = (bi < nsel) || (bi == 3); if (!valid) continue; const int blk = (bi == 3) ? b : sel[bi];
        for (int kk = 0; kk < 256; ++kk) { const float pv = pb[bi * 256 + kk]; const unsigned v = *(const unsigned*)(VB + (size_t)(blk * 256 + kk) * 1024 + h * 128 + lane * 2); o0 += pv * bflo(v); o1 += pv * bfhi(v); }
    }
    const float inv = 1.f / sum;
    *(unsigned*)(qp + lane * 2) = pk2(o0 * inv, o1 * inv);
}
__global__ void __launch_bounds__(256) naive_mlstm(unsigned char* ws, const float* igb, const float* fgb, const float* normw) {
    __shared__ float q[128], k[128], nn[128], red[4], red2[4];
    const int h = blockIdx.x, v = threadIdx.x, lane = v & 63, wv = v >> 6;
    const unsigned short* QC = (const unsigned short*)(ws + WS_QC); const unsigned short* KC = (const unsigned short*)(ws + WS_KC); const unsigned short* MV = (const unsigned short*)(ws + WS_MV);
    const float* gates = (const float*)(ws + WS_SMALL + SM_GATES); unsigned short* MIX = (unsigned short*)(ws + WS_MIX);
    float C[128];
#pragma unroll
    for (int d = 0; d < 128; ++d) C[d] = 0.f;
    float m = 0.f; if (v < 128) nn[v] = 0.f;
    const float ib = igb[h], fb = fgb[h], nw = normw[h * 256 + v];
    for (int t = 0; t < M_TOK; ++t) {
        if (v < 128) q[v] = bf2f(QC[(size_t)t * 512 + h * 128 + v]); else k[v - 128] = bf2f(KC[(size_t)t * 512 + h * 128 + v - 128]);
        const float ig = gates[t * 8 + h] + ib, lf = logsigmoid_f(gates[t * 8 + 4 + h] + fb);
        const float mn = fmaxf(lf + m, ig), fd = expf(lf + m - mn), iw = expf(ig - mn); m = mn;
        const float vv = bf2f(MV[(size_t)t * 1024 + h * 256 + v]);
        __syncthreads();
        if (v < 128) nn[v] = fd * nn[v] + iw * k[v];
        float num = 0.f;
#pragma unroll
        for (int d = 0; d < 128; ++d) { C[d] = fd * C[d] + iw * k[d] * vv; num += q[d] * C[d]; }
        __syncthreads();
        float den = 0.f;
#pragma unroll 16
        for (int d = 0; d < 128; ++d) den += q[d] * nn[d];
        const float hv = num / fmaxf(fabsf(den), expf(-m));
        float s = wave_sum(hv); if (lane == 0) red[wv] = s;
        __syncthreads();
        const float mu = (red[0] + red[1] + red[2] + red[3]) * (1.f / 256.f);
        const float dv = hv - mu; float s2 = wave_sum(dv * dv); if (lane == 0) red2[wv] = s2;
        __syncthreads();
        const float var = (red2[0] + red2[1] + red2[2] + red2[3]) * (1.f / 256.f);
        unsigned short* op = MIX + (size_t)t * 2048 + h * 256 + v;
        const float mo = bf2f(*op);
        *op = (unsigned short)f2bf(dv * rsqrtf(var + LN_EPS) * nw * sigmoid_f(mo));
    }
}
__global__ void __launch_bounds__(256) dbg_cmp_u32(const unsigned* a, const unsigned* b, size_t n, unsigned* cnt) {
    unsigned c = 0;
    for (size_t i = blockIdx.x * 256ull + threadIdx.x; i < n; i += gridDim.x * 256ull) c += (a[i] != b[i]) ? 1u : 0u;
    if (c) atomicAdd(cnt, c);
}
__global__ void __launch_bounds__(512) dbg_check_own(unsigned char* ws, unsigned* cnt) {
    __shared__ float qf_s[8][128];
    __shared__ float pb_s[8][256];
    const int wave = threadIdx.x >> 6, lane = threadIdx.x & 63;
    const int gw = blockIdx.x * 8 + wave; const int p = gw >> 3, h = gw & 7;
    const unsigned short* MIX = (const unsigned short*)(ws + WS_MIX);
    const unsigned short* KB = (const unsigned short*)(ws + WS_KB); const unsigned short* VB = (const unsigned short*)(ws + WS_VB);
    float* qf = qf_s[wave]; float* pb = pb_s[wave];
    const unsigned short* qp = MIX + (size_t)p * 2048 + 1024 + h * 128;
    qf[lane * 2] = bf2f(qp[lane * 2]); qf[lane * 2 + 1] = bf2f(qp[lane * 2 + 1]);
    __syncthreads();
    const int b = p >> 8; float s[4], mx = -INFINITY;
#pragma unroll
    for (int kk = 0; kk < 4; ++kk) { const int key = b * 256 + kk * 64 + lane; const unsigned short* kr = KB + (size_t)key * 1024 + h * 128; float a = 0.f; for (int d = 0; d < 128; ++d) a += qf[d] * bf2f(kr[d]); a *= K_SCALE; if (key > p) a = -INFINITY; s[kk] = a; mx = fmaxf(mx, a); }
    for (int o = 1; o < 64; o <<= 1) mx = fmaxf(mx, __shfl_xor(mx, o));
    float sum = 0.f;
#pragma unroll
    for (int kk = 0; kk < 4; ++kk) { const float e = (s[kk] == -INFINITY) ? 0.f : expf(s[kk] - mx); pb[kk * 64 + lane] = e; sum += e; }
    sum = wave_sum(sum);
    __syncthreads();
    float o0 = 0.f, o1 = 0.f;
    for (int kk = 0; kk < 256; ++kk) { const float pv = pb[kk]; const unsigned v = *(const unsigned*)(VB + (size_t)(b * 256 + kk) * 1024 + h * 128 + lane * 2); o0 += pv * bflo(v); o1 += pv * bfhi(v); }
    o0 /= sum; o1 /= sum;
    const unsigned short* pr = (const unsigned short*)(ws + WS_PART3) + (size_t)(p * 8 + h) * 128 + lane * 2;
    float d = fmaxf(fabsf(o0 - bf2f(pr[0])), fabsf(o1 - bf2f(pr[1])));
    for (int o = 1; o < 64; o <<= 1) d = fmaxf(d, __shfl_xor(d, o));
    const float lse_ref = mx * 1.4426950408889634f + log2f(sum); const float lse = ((const float*)(ws + WS_LSE))[(p * 8 + h) * 4 + 3];
    if (lane == 0) { if (d > 0.02f) atomicAdd(cnt, 1u); if (!(fabsf(lse - lse_ref) < 0.05f)) atomicAdd(cnt + 1, 1u); }
}
__global__ void dbg_flag(const unsigned* cnt, float* out) {
    if (threadIdx.x == 0) { if (cnt[0]) out[0] += 1000.f; if (cnt[1]) out[1] += 2000.f; if (cnt[2]) out[2] += 4000.f; if (cnt[3]) out[3] += 8000.f; }
}
#ifndef PG8_SP2
#define PG8_SP2 true
#endif
#ifndef PG8_ALIGN
#define PG8_ALIGN true
#endif
constexpr int N_PHASES = 12;
struct Args { const float* in[17]; float* out; unsigned char* ws; int ph_lo, ph_hi, li, pad; };
__global__ void __launch_bounds__(NWAVES * 64, 2) mk_fwd(Args args) {
    extern __shared__ __attribute__((aligned(16))) unsigned char lds[];
    Frame F;
    F.lds = (LAS unsigned char*)lds;
    F.MISC = (volatile LAS unsigned*)(F.lds + MISC_OFF);
    F.tid = threadIdx.x; F.lane = F.tid & 63; F.wave = __builtin_amdgcn_readfirstlane(F.tid >> 6);
    F.G = gridDim.x; F.bid = blockIdx.x; F.tp0 = 0; F.tp1 = 0;
    F.ws = args.ws; F.ctl = (gu32*)(args.ws + WS_CTL); F.out = args.out;
    F.x = args.in[0]; F.c = args.in[1]; F.w_ada = args.in[2]; F.b_ada = args.in[3]; F.w_in = args.in[4]; F.conv_w = args.in[5]; F.conv_b = args.in[6];
    F.igb = args.in[7]; F.fgb = args.in[8]; F.normw = args.in[9]; F.w_out = args.in[10]; F.ln1_w = args.in[11]; F.ln1_b = args.in[12];
    F.w_gu = args.in[13]; F.w_down = args.in[14]; F.ln2_w = args.in[15]; F.ln2_b = args.in[16];
    for (int u = F.tid; u < (LDS_BYTES - LDSCTL_OFF) / 4; u += NWAVES * 64) ((LAS unsigned*)(F.lds + LDSCTL_OFF))[u] = 0u;
    __syncthreads();
    const int lo = args.ph_lo, hi = args.ph_hi;
    XcdBarrier bar; bar.bar = (unsigned*)(F.ctl + CW_BAR) + args.li * XCD_BAR_WORDS; bar.x = 0; bar.st = nullptr;
    if (hi - lo > 1) bar = xcd_barrier_post((unsigned*)(F.ctl + CW_BAR) + args.li * XCD_BAR_WORDS, F.MISC + 8);
#ifndef PHMASK
#define PHMASK 0xFFF
#endif
#define IN(k) (((PHMASK >> (k)) & 1) && lo <= (k) && (k) < hi)
#if defined(TIME_PHASE)
    unsigned long long tp0 = 0, tp1 = 0;
#define TSTAMP(k) do { if ((k) + 1 == TIME_PHASE) tp0 = __builtin_amdgcn_s_memrealtime(); if ((k) == TIME_PHASE) tp1 = __builtin_amdgcn_s_memrealtime(); } while (0)
#else
#define TSTAMP(k) do { } while (0)
#endif
#define SEAM(k) do { if (IN(k) && IN((k) + 1)) xcd_barrier(bar); TSTAMP(k); } while (0)
    float* ada = SMALLF(SM_ADA);
#if defined(TIME_PHASE)
    if (TIME_PHASE == 0) tp0 = __builtin_amdgcn_s_memrealtime();
#endif
    if (IN(0)) { p0_phase(F); } SEAM(0);
    if (IN(1)) { p1_phase(F); } SEAM(1);
    if (IN(2)) {
        pg8::Gemm g{(const pg8::bf16_t*)(F.ws + WS_U), (const pg8::bf16_t*)(F.ws + WS_WIN), M_TOK, NPROJ, DM}; pg8::StaticOrder S; S.init(M_TOK, NPROJ, F.G, F.bid, WGM_P2);
        pg8::EpiProj E{(pg8::bf16_t*)(F.ws + WS_MIX), (pg8::bf16_t*)(F.ws + WS_KB), (pg8::bf16_t*)(F.ws + WS_VB), (pg8::bf16_t*)(F.ws + WS_MQK), (pg8::bf16_t*)(F.ws + WS_MV), (const float*)(F.ws + WS_ROPE), SMALLF(SM_KMEAN)};
        pg8::gemm_phase<pg8::EpiProj, pg8::StaticOrder, PG8_ALIGN, PG8_SP2>(F.lds, g, S, E);
    } SEAM(2);
    if (IN(3)) { p3_phase(F); } SEAM(3);
    TSTAMP(4);
    if (IN(5)) { x2_phase(F); } SEAM(5);
    if (IN(6)) { x3_phase(F); } SEAM(6);
    if (IN(7)) {
        pg8::Gemm g{(const pg8::bf16_t*)(F.ws + WS_MIX), (const pg8::bf16_t*)(F.ws + WS_WOUT), M_TOK, DM, DM}; pg8::StaticOrder S; S.init(M_TOK, DM, F.G, F.bid, WGM_P5);
        pg8::EpiY1 E{F.x, ada + 2 * DM, (pg8::bf16_t*)(F.ws + WS_Y1B), (unsigned long long*)SMALLF(SM_MUR)};
        pg8::gemm_phase<pg8::EpiY1, pg8::StaticOrder, PG8_ALIGN, PG8_SP2>(F.lds, g, S, E);
    } SEAM(7);
    TSTAMP(8);
    if (IN(9)) {
        pg8::Gemm g{(const pg8::bf16_t*)(F.ws + WS_Y1B), (const pg8::bf16_t*)(F.ws + WS_WGU), M_TOK, NGU, DM}; pg8::StaticOrder S; S.init(M_TOK, NGU, F.G, F.bid, WGM_P6);
        pg8::EpiSwiGLU E{(const unsigned long long*)SMALLF(SM_MUR), SMALLF(SM_C1), SMALLF(SM_C2), (pg8::bf16_t*)(F.ws + WS_H), &F.tp1};
        pg8::gemm_phase<pg8::EpiSwiGLU, pg8::StaticOrder, PG8_ALIGN, PG8_SP2>(F.lds, g, S, E);
    } SEAM(9);
    if (IN(10)) {
        pg8::Gemm g{(const pg8::bf16_t*)(F.ws + WS_H), (const pg8::bf16_t*)(F.ws + WS_WDOWN), M_TOK, DM, DFF}; pg8::StaticOrder S; S.init(M_TOK, DM, F.G, F.bid, WGM_P7);
        pg8::EpiY2 E{(const pg8::bf16_t*)(F.ws + WS_Y1B), (const unsigned long long*)SMALLF(SM_MUR), ada + 5 * DM, F.ln1_w, F.ln1_b, (pg8::bf16_t*)(F.ws + WS_Y2B)};
        TP_BEGIN(141); pg8::gemm_phase<pg8::EpiY2, pg8::StaticOrder, PG8_ALIGN, PG8_SP2>(F.lds, g, S, E); TP_END(141);
    }
    {
        const bool both = IN(10) && IN(11);
        bool fused = false;
        if (both) { TP_BEGIN(140); fused = ln2_panel_fused(F); TP_END(140); }
        if (!fused) { SEAM(10); if (IN(11)) { ln2_phase(F); } }
    }
#if defined(TIME_PHASE)
    if (TIME_PHASE == 11) tp1 = __builtin_amdgcn_s_memrealtime();
    if (TIME_PHASE >= 100) { tp0 = F.tp0; tp1 = F.tp1; }
    if ((F.bid == 0 || TIME_PHASE >= 100) && F.tid == 0 && tp1 > tp0) { const unsigned long long te = __builtin_amdgcn_s_memrealtime(); const unsigned long long want = (tp1 - tp0) * TIME_MULT;
        while (__builtin_amdgcn_s_memrealtime() - te < want) __builtin_amdgcn_s_sleep(32); }
#endif
#undef IN
#undef SEAM
}

#ifndef MK_MODE
#define MK_MODE 1
#endif
extern "C" void kernel_launch(void* const* d_in, const int* in_sizes, int n_in, void* d_out, int out_size, void* d_ws, size_t ws_size, hipStream_t stream) {
    static int grid = 0;
    if (grid == 0) {
        if (n_in != 17 || in_sizes[0] != M_TOK * DM || out_size != M_TOK * DM || ws_size < WS_END) {
            fprintf(stderr, "kernel_launch: shape mismatch: n_in %d in0 %d out %d ws %zu (need %zu)\n", n_in, n_in > 0 ? in_sizes[0] : -1, out_size, ws_size, (size_t)WS_END); grid = -1; return; }
        int dev = 0, cus = 0, per_cu = 0;
        if (hipGetDevice(&dev) != hipSuccess || hipDeviceGetAttribute(&cus, hipDeviceAttributeMultiprocessorCount, dev) != hipSuccess) { fprintf(stderr, "kernel_launch: device query failed\n"); grid = -1; return; }
        if (hipFuncSetAttribute((const void*)mk_fwd, hipFuncAttributeMaxDynamicSharedMemorySize, LDS_BYTES) != hipSuccess) { fprintf(stderr, "kernel_launch: hipFuncSetAttribute failed\n"); grid = -1; return; }
        if (hipOccupancyMaxActiveBlocksPerMultiprocessor(&per_cu, (const void*)mk_fwd, NWAVES * 64, LDS_BYTES) != hipSuccess || per_cu < 1) { fprintf(stderr, "kernel_launch: occupancy query says %d blocks per CU\n", per_cu); (void)hipGetLastError(); grid = -1; return; }
        grid = cus;
    }
    if (grid < 0) return;
    (void)hipMemsetAsync((char*)d_ws + WS_CTL, 0, CTL_ZERO_BYTES, stream);
    Args a{};
    for (int i = 0; i < 17; ++i) a.in[i] = (const float*)d_in[i];
    a.out = (float*)d_out; a.ws = (unsigned char*)d_ws;
#if MK_MODE == 0
    for (int ph = 0; ph < N_PHASES; ++ph) {
#if defined(NAIVE_MOBA)
        if (ph == 4) hipLaunchKernelGGL(naive_moba, dim3(M_TOK), dim3(512), 0, stream, (unsigned char*)d_ws);
#endif
#if defined(DBG_NAIVE_MOBA_LATE)
        if (ph == 7) hipLaunchKernelGGL(naive_moba, dim3(M_TOK), dim3(512), 0, stream, (unsigned char*)d_ws);
#endif
#if defined(NAIVE_MLSTM)
        if (ph == 4) hipLaunchKernelGGL(naive_mlstm, dim3(ML_H), dim3(256), 0, stream, (unsigned char*)d_ws, (const float*)d_in[7], (const float*)d_in[8], (const float*)d_in[9]);
#endif
        a.ph_lo = ph; a.ph_hi = ph + 1; a.li = 0;
        hipLaunchKernelGGL(mk_fwd, dim3(grid), dim3(NWAVES * 64), LDS_BYTES, stream, a);
#if defined(DBG_X2_TWICE)
        if (ph == 5) {
            unsigned* dc = (unsigned*)((char*)d_ws + WS_CTL) + 32768;
            (void)hipMemcpyAsync((char*)d_ws + WS_LOCAL, (char*)d_ws + WS_PART3, 32 * MiB, hipMemcpyDeviceToDevice, stream);
            hipLaunchKernelGGL(mk_fwd, dim3(grid), dim3(NWAVES * 64), LDS_BYTES, stream, a);
            hipLaunchKernelGGL(dbg_cmp_u32, dim3(1024), dim3(256), 0, stream, (const unsigned*)((char*)d_ws + WS_LOCAL), (const unsigned*)((char*)d_ws + WS_PART3), (size_t)(8 * MiB), dc);
            hipLaunchKernelGGL(dbg_check_own, dim3(M_TOK), dim3(512), 0, stream, (unsigned char*)d_ws, dc + 1);
        }
#endif
    }
#if defined(DBG_X2_TWICE)
    hipLaunchKernelGGL(dbg_flag, dim3(1), dim3(64), 0, stream, (const unsigned*)((char*)d_ws + WS_CTL) + 32768, (float*)d_out);
#endif
#else
    a.ph_lo = 0; a.ph_hi = N_PHASES; a.li = 0;
    hipLaunchKernelGGL(mk_fwd, dim3(grid), dim3(NWAVES * 64), LDS_BYTES, stream, a);
#endif
    const hipError_t le = hipPeekAtLastError();
    if (le != hipSuccess) fprintf(stderr, "kernel_launch: launch failed: %s\n", hipGetErrorName(le));
}
```

```cpp
#include <hip/hip_runtime.h>
#include <cstdio>
#include <cstdint>
#include <cmath>
namespace pg8 {
#define PG8_LAS __attribute__((address_space(3)))
typedef unsigned short bf16_t;
typedef short bf16x8 __attribute__((ext_vector_type(8)));
typedef float f32x4 __attribute__((ext_vector_type(4)));
typedef unsigned u32x4 __attribute__((ext_vector_type(4)));
constexpr int BM = 256, BK = 64, HALF = 128, HTB = HALF * BK * 2  , STAGE_BYTES = 8 * HTB, NXCD = 8, WGM = 4;

__host__ __device__ __forceinline__ int lds_byte(int r, int c) { const int st = (r >> 4) * 2 + (c >> 5), rr = r & 15, cc = c & 31, ob = rr * 64 + cc * 2; return st * 1024 + (ob ^ (((ob >> 9) & 1) << 5)); }
__host__ __device__ __forceinline__ void stage_rc(int b, int& R, int& C) { const int st = b / 1024, sb = b % 1024, swz = sb ^ (((sb >> 9) & 1) << 5); R = (st >> 1) * 16 + swz / 64; C = (st & 1) * 32 + (swz % 64) / 2; }
__host__ __device__ __forceinline__ int perm32(int rho) { const int n = rho >> 4, i = rho & 15; return 8 * (i >> 2) + 4 * n + (i & 3); }

struct Unit { int pm, pn; };
struct Gemm { const bf16_t* A; const bf16_t* Bt; int M, N, K; };

struct StaticOrder {
    int nM, nN, nwg, G, c, wgm;
    __host__ __device__ void init(int M, int N, int G_, int c_, int wgm_ = WGM) { nM = M / BM; nN = N / BM; nwg = nM * nN; G = G_; c = c_; wgm = wgm_; }
    __host__ __device__ bool next(int i, Unit& u) const {
        const long L = (long)i * G + c; if (L >= nwg) return false;
        int wgid = (int)L; { const int q = nwg / NXCD, r = nwg % NXCD, xcd = wgid % NXCD, off = wgid / NXCD; wgid = (xcd < r ? xcd * (q + 1) : r * (q + 1) + (xcd - r) * q) + off; }
        const int nig = wgm * nN, gid = wgid / nig, fm = gid * wgm, gsz = (nM - fm) < wgm ? (nM - fm) : wgm;
        u.pm = fm + ((wgid % nig) % gsz); u.pn = (wgid % nig) / gsz; return true;
    }
    __device__ __forceinline__ void a_ready(const Unit&) const {}
    __device__ __forceinline__ void done(const Unit&) const {}
};

typedef float cvp_f32x2_t __attribute__((ext_vector_type(2))); typedef __bf16 cvp_bf16x2_t __attribute__((ext_vector_type(2)));
__device__ __forceinline__ unsigned cvt_pk_bf16(float lo, float hi) { cvp_f32x2_t v = {lo, hi}; cvp_bf16x2_t b = __builtin_convertvector(v, cvp_bf16x2_t); return __builtin_bit_cast(unsigned, b); }
typedef float f32x2 __attribute__((ext_vector_type(2)));
__device__ __forceinline__ f32x2 gelu_pk(f32x2 v) {
    const f32x2 av = __builtin_elementwise_abs(v), d = av * 0.2316418882f + 1.0f;
    f32x2 t; t.x = __builtin_amdgcn_rcpf(d.x); t.y = __builtin_amdgcn_rcpf(d.y);
    f32x2 q = t * 0.5307027145f + (-0.7265760135f); q = q * t + 0.7107068705f; q = q * t + (-0.142248368f); q = q * t + 0.127414796f; q = q * t;
    const f32x2 s = (v * v) * (-0.72134752044f);
    f32x2 e; e.x = __builtin_amdgcn_exp2f(s.x); e.y = __builtin_amdgcn_exp2f(s.y);
    const f32x2 m = v * (q * e), r = v - m;
    f32x2 o; o.x = v.x < 0.f ? m.x : r.x; o.y = v.y < 0.f ? m.y : r.y; return o;
}

template <int ACT  > struct EpiBf16 {
    static constexpr bool PERM = true, AFTER_DRAIN = false; static_assert(ACT == 0 || ACT == 1, "EpiBf16: ACT is 0 (none) or 1 (gelu_pk)");
    bf16_t* O; int ldc; const float* bias; int split_cols; size_t split_stride; float scale0;
    __device__ __forceinline__ void operator()(const f32x4 (&acc)[2][2][4][2], const Unit& u, int wr, int wc, int fr, int fq) const {
        const int row0 = u.pm * BM + wr * 64 + fr; int colt = u.pn * BM; bf16_t* base = O;
        float sc = 1.f; if (split_cols) { const int t = colt / split_cols; base += (size_t)t * split_stride; colt -= t * split_cols; if (t == 0) sc = scale0; }
        const int col0 = colt + wc * 32 + 8 * fq, bcol0 = u.pn * BM + wc * 32 + 8 * fq;
        f32x4 bv[2][2];
#pragma unroll
        for (int bj = 0; bj < 2; ++bj)
#pragma unroll
            for (int n = 0; n < 2; ++n) bv[bj][n] = bias ? *(const f32x4*)(bias + bcol0 + bj * HALF + 4 * n) : (f32x4){0.f, 0.f, 0.f, 0.f};
#pragma unroll
        for (int ai = 0; ai < 2; ++ai)
#pragma unroll
            for (int m = 0; m < 4; ++m) { bf16_t* rowp = base + (size_t)(row0 + ai * HALF + m * 16) * ldc + col0;
#pragma unroll
                for (int bj = 0; bj < 2; ++bj) { f32x4 v0 = acc[ai][bj][m][0] + bv[bj][0], v1 = acc[ai][bj][m][1] + bv[bj][1];
                    if (ACT == 1) { f32x2 a = gelu_pk((f32x2){v0[0], v0[1]}), b = gelu_pk((f32x2){v0[2], v0[3]}), c = gelu_pk((f32x2){v1[0], v1[1]}), d = gelu_pk((f32x2){v1[2], v1[3]});
                        v0 = (f32x4){a.x, a.y, b.x, b.y}; v1 = (f32x4){c.x, c.y, d.x, d.y}; }
                    v0 = v0 * sc; v1 = v1 * sc; u32x4 w; w.x = cvt_pk_bf16(v0[0], v0[1]); w.y = cvt_pk_bf16(v0[2], v0[3]); w.z = cvt_pk_bf16(v1[0], v1[1]); w.w = cvt_pk_bf16(v1[2], v1[3]);
                    *(u32x4*)(rowp + bj * HALF) = w; } }
    }
};

struct PanelStats {
    unsigned* xbuf;
    unsigned* cnt;
    unsigned* tmo;
    int ntn; float eps;
    unsigned code;
    __device__ __forceinline__ bool run(const f32x4 (&v)[2][2][4][2], const Unit& u, int wr, int wc, int fr, int fq, PG8_LAS unsigned char* lds, int wid, int lane) const {
        typedef float f32x2v __attribute__((ext_vector_type(2)));
        PG8_LAS f32x2v* P = (PG8_LAS f32x2v*)lds;
        PG8_LAS f32x2v* S = (PG8_LAS f32x2v*)(lds + 8192);
        PG8_LAS unsigned* flag = (PG8_LAS unsigned*)(lds + 8192 + 2048);
#pragma unroll
        for (int ai = 0; ai < 2; ++ai)
#pragma unroll
            for (int m = 0; m < 4; ++m) {
                float s = 0.f;
#pragma unroll
                for (int bj = 0; bj < 2; ++bj)
#pragma unroll
                    for (int n = 0; n < 2; ++n) { const f32x4 x = v[ai][bj][m][n]; s += (x[0] + x[1]) + (x[2] + x[3]); }
                s += __shfl_xor(s, 16); s += __shfl_xor(s, 32);
                const float mw = s * (1.0f / 64.0f); float q = 0.f;
#pragma unroll
                for (int bj = 0; bj < 2; ++bj)
#pragma unroll
                    for (int n = 0; n < 2; ++n) { const f32x4 d = v[ai][bj][m][n] - mw; q += (d[0] * d[0] + d[1] * d[1]) + (d[2] * d[2] + d[3] * d[3]); }
                q += __shfl_xor(q, 16); q += __shfl_xor(q, 32);
                if (fq == 0) P[(ai * HALF + wr * 64 + m * 16 + fr) * 4 + wc] = (f32x2v){mw, q};
            }
        asm volatile("s_waitcnt lgkmcnt(0)" ::: "memory"); __builtin_amdgcn_s_barrier(); asm volatile("" ::: "memory");
#if defined(BROKEN_EXCHANGE_NO_WAIT)
#warning BROKEN CONTROL BUILD: the row-statistics exchange does not wait; results are wrong by design
        if (blockIdx.x >= 64) { const long long t0_ = clock64(); while (clock64() - t0_ < 60000) __builtin_amdgcn_s_sleep(8); }
#endif
        const int row = wid * 32 + (lane & 31);
        if (lane < 32) {
            const f32x2v a = P[row * 4 + 0], b = P[row * 4 + 1], c = P[row * 4 + 2], d = P[row * 4 + 3];
            const float mt = (a.x + b.x + c.x + d.x) * 0.25f;
            const float da = a.x - mt, db = b.x - mt, dc = c.x - mt, dd = d.x - mt;
            const float m2 = (a.y + b.y) + (c.y + d.y) + 64.0f * ((da * da + db * db) + (dc * dc + dd * dd));
            unsigned long long* slot = (unsigned long long*)xbuf + ((size_t)(u.pm * BM + row) * 4 + u.pn);
            __hip_atomic_store(slot, ((unsigned long long)__float_as_uint(m2) << 32) | __float_as_uint(mt), __ATOMIC_RELAXED, __HIP_MEMORY_SCOPE_AGENT);
        }
        asm volatile("s_waitcnt vmcnt(0)" ::: "memory");
        if (lane == 0) __hip_atomic_fetch_add(cnt + 64 * u.pm, 1u, __ATOMIC_RELAXED, __HIP_MEMORY_SCOPE_AGENT);
        if (wid == 0) {
            bool dead = false; const unsigned long long t0 = __builtin_amdgcn_s_memrealtime(); const unsigned want = 8u * (unsigned)ntn;
            for (;;) {
#if defined(BROKEN_EXCHANGE_NO_WAIT)
                break;
#endif
                if ((unsigned)__builtin_amdgcn_readfirstlane(__hip_atomic_load(cnt + 64 * u.pm, __ATOMIC_RELAXED, __HIP_MEMORY_SCOPE_AGENT)) >= want) break;
                if (__builtin_amdgcn_s_memrealtime() - t0 > 2000000ull) {
                    if (lane == 0) { unsigned expect = 0u; __hip_atomic_compare_exchange_strong(tmo + 1, &expect, code | (unsigned)(u.pm & 0xff), __ATOMIC_RELAXED, __ATOMIC_RELAXED, __HIP_MEMORY_SCOPE_AGENT);
                                     __hip_atomic_store(tmo, 1u, __ATOMIC_RELAXED, __HIP_MEMORY_SCOPE_AGENT); }
                    dead = true; break; }
                __builtin_amdgcn_s_sleep(2);
            }
            __builtin_amdgcn_fence(__ATOMIC_ACQUIRE, "agent");
            if (lane == 0) flag[0] = dead ? 1u : 0u;
        }
        asm volatile("s_waitcnt vmcnt(0) lgkmcnt(0)" ::: "memory"); __builtin_amdgcn_s_barrier(); asm volatile("" ::: "memory");
        const bool bad = flag[0] != 0u;
        if (lane < 32) {
            const unsigned long long* slot = (const unsigned long long*)xbuf + (size_t)(u.pm * BM + row) * 4; float mt[4], m2[4]; float ms = 0.f;
#pragma unroll
            for (int t = 0; t < 4; ++t) { if (t < ntn) { const unsigned long long w = __hip_atomic_load(slot + t, __ATOMIC_RELAXED, __HIP_MEMORY_SCOPE_AGENT); mt[t] = __uint_as_float((unsigned)w); m2[t] = __uint_as_float((unsigned)(w >> 32)); } else { mt[t] = 0.f; m2[t] = 0.f; } ms += mt[t]; }
            const float mean = ms / (float)ntn; float q = 0.f;
#pragma unroll
            for (int t = 0; t < 4; ++t) if (t < ntn) { const float dm = mt[t] - mean; q += m2[t] + 256.0f * dm * dm; }
            S[row] = (f32x2v){mean, 1.0f / sqrtf(q / (256.0f * (float)ntn) + eps)};
        }
        asm volatile("s_waitcnt lgkmcnt(0)" ::: "memory"); __builtin_amdgcn_s_barrier(); asm volatile("" ::: "memory");
        return bad;
    }
};
struct EpiLnRes {
    static constexpr bool PERM = false, AFTER_DRAIN = true;
    const float* base; float* out; int ldc; const float* bias; PanelStats st; unsigned poison;
    __device__ __forceinline__ void fused(f32x4 (&acc)[2][2][4][2], const Unit& u, int wr, int wc, int fr, int fq, PG8_LAS unsigned char* lds, int wid, int lane) const {
        typedef float f32x2v __attribute__((ext_vector_type(2)));
        const PG8_LAS f32x2v* S = (const PG8_LAS f32x2v*)(lds + 8192);
        const int col0 = u.pn * BM + wc * 32 + 4 * fq;
#pragma unroll
        for (int bj = 0; bj < 2; ++bj)
#pragma unroll
            for (int n = 0; n < 2; ++n) { const f32x4 bv = bias ? *(const f32x4*)(bias + col0 + bj * HALF + n * 16) : (f32x4){0.f, 0.f, 0.f, 0.f};
#pragma unroll
                for (int ai = 0; ai < 2; ++ai)
#pragma unroll
                    for (int m = 0; m < 4; ++m) acc[ai][bj][m][n] += bv; }
        f32x4 pre[4][2][2];
#pragma unroll
        for (int m = 0; m < 4; ++m) { const size_t off = (size_t)(u.pm * BM + wr * 64 + m * 16 + fr) * ldc + col0;
#pragma unroll
            for (int bj = 0; bj < 2; ++bj)
#pragma unroll
                for (int n = 0; n < 2; ++n) pre[m][bj][n] = *(const f32x4*)(base + off + bj * HALF + n * 16); }
        const bool bad = st.run(acc, u, wr, wc, fr, fq, lds, wid, lane) || poison != 0u;
        const float qnan = __builtin_nanf("");
#pragma unroll
        for (int ai = 0; ai < 2; ++ai)
#pragma unroll
            for (int m = 0; m < 4; ++m) { const int r = ai * HALF + wr * 64 + m * 16 + fr; const f32x2v sr = S[r]; const size_t off = (size_t)(u.pm * BM + r) * ldc + col0;
#pragma unroll
                for (int bj = 0; bj < 2; ++bj)
#pragma unroll
                    for (int n = 0; n < 2; ++n) { const f32x4 bs = ai == 0 ? pre[m][bj][n] : *(const f32x4*)(base + off + bj * HALF + n * 16); f32x4 o = bs + (acc[ai][bj][m][n] - sr.x) * sr.y;
                        if (bad) o = (f32x4){qnan, qnan, qnan, qnan}; *(f32x4*)(out + off + bj * HALF + n * 16) = o; }
                if (m & 1) asm volatile("" ::: "memory"); }
    }
};
struct EpiLnResLn {
    static constexpr bool PERM = false, AFTER_DRAIN = true;
    const float* base; float* out; bf16_t* xn; int ldc; const float* bias; PanelStats st1, st2; unsigned poison;
    __device__ __forceinline__ void fused(f32x4 (&acc)[2][2][4][2], const Unit& u, int wr, int wc, int fr, int fq, PG8_LAS unsigned char* lds, int wid, int lane) const {
        typedef float f32x2v __attribute__((ext_vector_type(2))); typedef unsigned u32x2v __attribute__((ext_vector_type(2)));
        const PG8_LAS f32x2v* S = (const PG8_LAS f32x2v*)(lds + 8192);
        const int col0 = u.pn * BM + wc * 32 + 4 * fq;
#pragma unroll
        for (int bj = 0; bj < 2; ++bj)
#pragma unroll
            for (int n = 0; n < 2; ++n) { const f32x4 bv = bias ? *(const f32x4*)(bias + col0 + bj * HALF + n * 16) : (f32x4){0.f, 0.f, 0.f, 0.f};
#pragma unroll
                for (int ai = 0; ai < 2; ++ai)
#pragma unroll
                    for (int m = 0; m < 4; ++m) acc[ai][bj][m][n] += bv; }
        bool bad = st1.run(acc, u, wr, wc, fr, fq, lds, wid, lane) || poison != 0u;
        const float qnan = __builtin_nanf("");
#pragma unroll
        for (int ai = 0; ai < 2; ++ai)
#pragma unroll
            for (int m = 0; m < 4; ++m) { const int r = ai * HALF + wr * 64 + m * 16 + fr; const f32x2v sr = S[r]; const size_t off = (size_t)(u.pm * BM + r) * ldc + col0;
#pragma unroll
                for (int bj = 0; bj < 2; ++bj)
#pragma unroll
                    for (int n = 0; n < 2; ++n) { const f32x4 bs = *(const f32x4*)(base + off + bj * HALF + n * 16); acc[ai][bj][m][n] = bs + (acc[ai][bj][m][n] - sr.x) * sr.y; }
                asm volatile("" : "+v"(acc[ai][0][m][0]), "+v"(acc[ai][0][m][1]), "+v"(acc[ai][1][m][0]), "+v"(acc[ai][1][m][1]));
                if (m & 1) asm volatile("" ::: "memory"); }
        const bool bad1 = bad;
        bad = st2.run(acc, u, wr, wc, fr, fq, lds, wid, lane) || bad;
#pragma unroll
        for (int ai = 0; ai < 2; ++ai)
#pragma unroll
            for (int m = 0; m < 4; ++m) { const int r = ai * HALF + wr * 64 + m * 16 + fr; const f32x2v sr = S[r]; const size_t off = (size_t)(u.pm * BM + r) * ldc + col0;
#pragma unroll
                for (int bj = 0; bj < 2; ++bj)
#pragma unroll
                    for (int n = 0; n < 2; ++n) { const f32x4 x1 = acc[ai][bj][m][n]; *(f32x4*)(out + off + bj * HALF + n * 16) = bad1 ? (f32x4){qnan, qnan, qnan, qnan} : x1;
                        const f32x4 o = (x1 - sr.x) * sr.y; u32x2v w; w.x = cvt_pk_bf16(o[0], o[1]); w.y = cvt_pk_bf16(o[2], o[3]);
                        if (bad) { w.x = 0x7fc07fc0u; w.y = 0x7fc07fc0u; } *(u32x2v*)(xn + off + bj * HALF + n * 16) = w; }
                asm volatile("" ::: "memory"); }
    }
};

template <class Epi, class Sched, bool ALIGN_EPI = false, bool SP2 = false>
__device__ __forceinline__ void gemm_phase(PG8_LAS unsigned char* lds, const Gemm g, const Sched& S, const Epi& E) {
    const int tid = threadIdx.x, wid = __builtin_amdgcn_readfirstlane(tid >> 6), lane = tid & 63, wr = wid >> 2, wc = wid & 3, fr = lane & 15, fq = lane >> 4;
    const int K = g.K, nt = K / BK;
    unsigned voffA[2], voffB[2];
#pragma unroll
    for (int i = 0; i < 2; ++i) { int R, C; stage_rc(tid * 16 + i * 8192, R, C); const int Rb = Epi::PERM ? ((R & ~31) + perm32(R & 31)) : R;
        voffA[i] = (unsigned)(R * K + C) * 2u; voffB[i] = (unsigned)(Rb * K + C) * 2u; }
    const size_t kstep = (size_t)(BK * 2);
    const size_t hstep = (size_t)HALF * K * 2;
    const size_t tstep = 2 * hstep;
    const unsigned ldsw = (unsigned)wid * 1024u;
    const int aoff = lds_byte(wr * 64 + fr, fq * 8), boff = lds_byte(wc * 32 + fr, fq * 8);
#define PG8_SA(b, h) (((b) * 2 + (h)) * HTB)
#define PG8_SB(b, h) ((4 + (b) * 2 + (h)) * HTB)
#define PG8_STAGE(bufoff, gbase, voff) do { _Pragma("unroll") for (int _i = 0; _i < 2; ++_i) \
        __builtin_amdgcn_global_load_lds((const unsigned*)((const char*)(gbase) + (voff)[_i]), (PG8_LAS unsigned*)(lds + (bufoff) + ldsw + _i * 8192), 16, 0, 0); } while (0)
#define PG8_LDA(dst, b, h) do { _Pragma("unroll") for (int m = 0; m < 4; ++m) _Pragma("unroll") for (int k = 0; k < 2; ++k) dst[m][k] = *(const PG8_LAS bf16x8*)(lds + PG8_SA(b, h) + aoff + m * 2048 + k * 1024); } while (0)
#define PG8_LDB(dst, b, h) do { _Pragma("unroll") for (int n = 0; n < 2; ++n) _Pragma("unroll") for (int k = 0; k < 2; ++k) dst[n][k] = *(const PG8_LAS bf16x8*)(lds + PG8_SB(b, h) + boff + n * 2048 + k * 1024); } while (0)
#define PG8_MMA(ai, bj, At, Bt) do { __builtin_amdgcn_s_setprio(1); _Pragma("unroll") for (int m = 0; m < 4; ++m) _Pragma("unroll") for (int n = 0; n < 2; ++n) _Pragma("unroll") for (int k = 0; k < 2; ++k) \
        acc[ai][bj][m][n] = __builtin_amdgcn_mfma_f32_16x16x32_bf16(Bt[n][k], At[m][k], acc[ai][bj][m][n], 0, 0, 0); __builtin_amdgcn_s_setprio(0); } while (0)
#define PG8_WAIT_V(n) asm volatile("s_waitcnt vmcnt(" #n ")" ::: "memory")
#define PG8_WAIT_L(n) asm volatile("s_waitcnt lgkmcnt(" #n ")" ::: "memory")
#define PG8_BAR __builtin_amdgcn_s_barrier()
#define PG8_SCHED __builtin_amdgcn_sched_barrier(0)
    Unit cur, nxt; int ui = 0;
    if (!S.next(0, cur)) return;
    f32x4 acc[2][2][4][2];
#pragma unroll
    for (int a = 0; a < 2; ++a)
#pragma unroll
        for (int b = 0; b < 2; ++b)
#pragma unroll
            for (int m = 0; m < 4; ++m)
#pragma unroll
                for (int n = 0; n < 2; ++n) acc[a][b][m][n] = (f32x4){0.f, 0.f, 0.f, 0.f};
    bf16x8 At[4][2], B0[2][2], B1[2][2];
    const char* cA = (const char*)g.A + (size_t)cur.pm * tstep; const char* cB = (const char*)g.Bt + (size_t)cur.pn * tstep;
    S.a_ready(cur);
    if constexpr (SP2) {
        PG8_STAGE(PG8_SB(0, 0), cB, voffB); PG8_STAGE(PG8_SB(0, 1), cB + hstep, voffB); PG8_STAGE(PG8_SA(0, 0), cA, voffA); PG8_STAGE(PG8_SA(0, 1), cA + hstep, voffA);
        if (wr == 1) PG8_BAR;
        PG8_WAIT_V(2); PG8_BAR;
        PG8_STAGE(PG8_SB(1, 0), cB + kstep, voffB); PG8_STAGE(PG8_SA(1, 0), cA + kstep, voffA); PG8_STAGE(PG8_SB(1, 1), cB + hstep + kstep, voffB);
        PG8_WAIT_V(6); PG8_BAR;
    } else {
        PG8_STAGE(PG8_SB(0, 0), cB, voffB); PG8_STAGE(PG8_SA(0, 0), cA, voffA); PG8_STAGE(PG8_SB(0, 1), cB + hstep, voffB); PG8_STAGE(PG8_SA(0, 1), cA + hstep, voffA);
        if (wr == 1) PG8_BAR;
        PG8_WAIT_V(4); PG8_BAR;
        PG8_STAGE(PG8_SB(1, 0), cB + kstep, voffB); PG8_STAGE(PG8_SA(1, 0), cA + kstep, voffA); PG8_STAGE(PG8_SB(1, 1), cB + hstep + kstep, voffB);
        PG8_WAIT_V(6); PG8_BAR;
    }
    for (;;) {
        const bool has_next = S.next(ui + 1, nxt);
        const char* nA = has_next ? (const char*)g.A + (size_t)nxt.pm * tstep : cA; const char* nB = has_next ? (const char*)g.Bt + (size_t)nxt.pn * tstep : cB;
        for (int t = 0; t < nt; t += 2) {
            const bool last = (t == nt - 2);
            const char* a1 = cA + (size_t)(t + 1) * kstep;
            const char* a2 = last ? nA : cA + (size_t)(t + 2) * kstep; const char* b2 = last ? nB : cB + (size_t)(t + 2) * kstep;
            const char* a3 = a2 + kstep; const char* b3 = b2 + kstep;
            if (last && has_next) S.a_ready(nxt);
            if constexpr (SP2) {
            PG8_LDB(B0, 0, 0); PG8_LDB(B1, 0, 1); PG8_SCHED; PG8_LDA(At, 0, 0); PG8_STAGE(PG8_SA(1, 1), a1 + hstep, voffA);
            PG8_WAIT_V(8); PG8_WAIT_L(0); PG8_BAR; PG8_MMA(0, 0, At, B0); PG8_MMA(0, 1, At, B1); PG8_BAR; PG8_SCHED;
            PG8_LDA(At, 0, 1); PG8_STAGE(PG8_SB(0, 0), b2, voffB); PG8_STAGE(PG8_SB(0, 1), b2 + hstep, voffB); PG8_STAGE(PG8_SA(0, 0), a2, voffA);
            PG8_WAIT_V(8); PG8_WAIT_L(0); PG8_BAR; PG8_MMA(1, 0, At, B0); PG8_MMA(1, 1, At, B1); PG8_BAR; PG8_SCHED;
            PG8_LDB(B0, 1, 0); PG8_LDB(B1, 1, 1); PG8_SCHED; PG8_LDA(At, 1, 0); PG8_STAGE(PG8_SA(0, 1), a2 + hstep, voffA);
            PG8_WAIT_V(8); PG8_WAIT_L(0); PG8_BAR; PG8_MMA(0, 0, At, B0); PG8_MMA(0, 1, At, B1); PG8_BAR; PG8_SCHED;
            PG8_LDA(At, 1, 1); PG8_STAGE(PG8_SB(1, 0), b3, voffB); PG8_STAGE(PG8_SB(1, 1), b3 + hstep, voffB); PG8_STAGE(PG8_SA(1, 0), a3, voffA);
            PG8_WAIT_V(8); PG8_WAIT_L(0); PG8_BAR; PG8_MMA(1, 0, At, B0); PG8_MMA(1, 1, At, B1); PG8_BAR; PG8_SCHED;
            } else {
            PG8_LDB(B0, 0, 0); PG8_SCHED; PG8_LDA(At, 0, 0); PG8_STAGE(PG8_SA(1, 1), a1 + hstep, voffA);
            PG8_WAIT_L(8); PG8_BAR; PG8_WAIT_L(0); PG8_MMA(0, 0, At, B0); PG8_BAR; PG8_SCHED;
            PG8_LDB(B1, 0, 1); PG8_STAGE(PG8_SB(0, 0), b2, voffB);
            PG8_BAR; PG8_WAIT_L(0); PG8_MMA(0, 1, At, B1); PG8_BAR;
            PG8_LDA(At, 0, 1); PG8_STAGE(PG8_SA(0, 0), a2, voffA);
            PG8_BAR; PG8_WAIT_L(0); PG8_MMA(1, 0, At, B0); PG8_BAR; PG8_SCHED;
            PG8_STAGE(PG8_SB(0, 1), b2 + hstep, voffB);
            PG8_WAIT_V(6); PG8_BAR; PG8_MMA(1, 1, At, B1); PG8_BAR;
            PG8_LDB(B0, 1, 0); PG8_SCHED; PG8_LDA(At, 1, 0); PG8_STAGE(PG8_SA(0, 1), a2 + hstep, voffA);
            PG8_WAIT_L(8); PG8_BAR; PG8_WAIT_L(0); PG8_MMA(0, 0, At, B0); PG8_BAR; PG8_SCHED;
            PG8_LDB(B1, 1, 1); PG8_STAGE(PG8_SB(1, 0), b3, voffB);
            PG8_BAR; PG8_WAIT_L(0); PG8_MMA(0, 1, At, B1); PG8_BAR;
            PG8_LDA(At, 1, 1); PG8_STAGE(PG8_SA(1, 0), a3, voffA);
            PG8_BAR; PG8_WAIT_L(0); PG8_MMA(1, 0, At, B0); PG8_BAR; PG8_SCHED;
            PG8_STAGE(PG8_SB(1, 1), b3 + hstep, voffB);
            PG8_WAIT_V(6); PG8_BAR; PG8_MMA(1, 1, At, B1); PG8_BAR;
            }
        }
        if constexpr (ALIGN_EPI) { if (wr == 0) PG8_BAR; }
        if constexpr (!Epi::AFTER_DRAIN) { E(acc, cur, wr, wc, fr, fq); S.done(cur); }
        if (!has_next) break;
#pragma unroll
        for (int a = 0; a < 2; ++a)
#pragma unroll
            for (int b = 0; b < 2; ++b)
#pragma unroll
                for (int m = 0; m < 4; ++m)
#pragma unroll
                    for (int n = 0; n < 2; ++n) acc[a][b][m][n] = (f32x4){0.f, 0.f, 0.f, 0.f};
        cur = nxt; cA = nA; cB = nB; ++ui;
        if constexpr (ALIGN_EPI) { if (wr == 1) PG8_BAR; }
    }
    PG8_WAIT_V(0);
    if constexpr (!ALIGN_EPI) { if (wr == 0) PG8_BAR; }
    PG8_BAR;
    if constexpr (Epi::AFTER_DRAIN) { E.fused(acc, cur, wr, wc, fr, fq, lds, wid, lane); S.done(cur); }
#undef PG8_SA
#undef PG8_SB
#undef PG8_STAGE
#undef PG8_LDA
#undef PG8_LDB
#undef PG8_MMA
#undef PG8_WAIT_V
#undef PG8_WAIT_L
#undef PG8_BAR
#undef PG8_SCHED
}
}
#define GAS __attribute__((address_space(1)))
#define LAS __attribute__((address_space(3)))
typedef unsigned short bf16;
typedef unsigned v4u __attribute__((ext_vector_type(4)));
typedef float f32x4 __attribute__((ext_vector_type(4)));
typedef short bf16x8 __attribute__((ext_vector_type(8)));
typedef GAS unsigned gu32;
typedef GAS unsigned long long gu64;
#define RLX_AGENT __ATOMIC_RELAXED, __HIP_MEMORY_SCOPE_AGENT
#define LDS_WAIT() asm volatile("s_waitcnt lgkmcnt(0)" ::: "memory")
#define VM_WAIT() asm volatile("s_waitcnt vmcnt(0)" ::: "memory")
__device__ __forceinline__ unsigned long long rt() { return __builtin_amdgcn_s_memrealtime(); }
__device__ __forceinline__ unsigned f2bf(float f) { unsigned u = __builtin_bit_cast(unsigned, f); return (u + 0x7fffu + ((u >> 16) & 1u)) >> 16; }
__device__ __forceinline__ unsigned pk2(float lo, float hi) { return f2bf(lo) | (f2bf(hi) << 16); }
#define XB_TMO      128
#define XB_XCNT(j)  (256  + 64 * (j))
#define XB_XSUB(j)  (1280 + 64 * (j))
#define XB_XGEN(j)  (2304 + 64 * (j))
#define XB_TOP      3328
#define XB_TOPGEN   3392
#define XCD_BAR_WORDS 3456
#define XB_SPIN_CAP (1u << 18)

__device__ __forceinline__ unsigned xb_ld(unsigned* p)              { return __hip_atomic_load(p, __ATOMIC_RELAXED, __HIP_MEMORY_SCOPE_AGENT); }
__device__ __forceinline__ unsigned xb_add(unsigned* p, unsigned v) { return __hip_atomic_fetch_add(p, v, __ATOMIC_RELAXED, __HIP_MEMORY_SCOPE_AGENT); }
__device__ __forceinline__ unsigned xb_xcc_id() { return (unsigned)__builtin_amdgcn_s_getreg((3 << 11) | 20) & 0xFu; }
#define XB_SPIN(cond, bar) do { unsigned _sp = 0; while (cond) { __builtin_amdgcn_s_sleep(1); \
    if ((++_sp & 255u) == 0u) { if (xb_ld(&(bar)[XB_TMO])) break; if (_sp > XB_SPIN_CAP) { atomicAdd(&(bar)[XB_TMO], 1u); break; } } } } while (0)

struct XcdBarrier {
    unsigned* bar; unsigned x;
    volatile LAS unsigned* st;
};

__device__ __forceinline__ XcdBarrier xcd_barrier_post(unsigned* bar, volatile LAS unsigned* st) {
    XcdBarrier b; b.bar = bar; b.x = xb_xcc_id(); b.st = st;
    if (threadIdx.x == 0) (void)xb_add(&bar[XB_XCNT(b.x)], 1u);
    return b;
}
__device__ __forceinline__ void xcd_barrier_complete(unsigned* bar, unsigned x, unsigned& nloc, unsigned& nx) {
    const unsigned G = gridDim.x * gridDim.y * gridDim.z;
    unsigned sum, cnt, mine, sp = 0u;
    for (;;) {
        sum = 0u; cnt = 0u; mine = 0u;
#pragma unroll
        for (unsigned j = 0; j < 16; ++j) { const unsigned c = xb_ld(&bar[XB_XCNT(j)]); sum += c; cnt += (c > 0u) ? 1u : 0u; mine = (j == x) ? c : mine; }
        if (sum == G) break;
        __builtin_amdgcn_s_sleep(1);
        if ((++sp & 255u) == 0u) { if (xb_ld(&bar[XB_TMO])) break; if (sp > XB_SPIN_CAP) { atomicAdd(&bar[XB_TMO], 1u); break; } }
    }
    nloc = mine > 0u ? mine : 1u; nx = cnt > 0u ? cnt : 1u;
}

__device__ __forceinline__ void xcd_barrier(const XcdBarrier& b) {
    asm volatile("s_waitcnt vmcnt(0)" ::: "memory");
    __syncthreads();
    if (threadIdx.x == 0) {
        unsigned* bar = b.bar;
        __builtin_amdgcn_s_waitcnt(0);
        unsigned nloc = b.st[0], nx = b.st[1];
        if (nloc == 0u) { xcd_barrier_complete(bar, b.x, nloc, nx); b.st[0] = nloc; b.st[1] = nx; }
        const unsigned old = xb_add(&bar[XB_XSUB(b.x)], 1u);
        const unsigned gen = old / nloc;
        if (old + 1u == (gen + 1u) * nloc) {
            __builtin_amdgcn_fence(__ATOMIC_RELEASE, "agent");
            asm volatile("s_waitcnt vmcnt(0)" ::: "memory");
            const unsigned og = xb_add(&bar[XB_TOP], 1u);
            const unsigned tg = og / nx;
            if (og + 1u == (tg + 1u) * nx) xb_add(&bar[XB_TOPGEN], 1u);
            else XB_SPIN(xb_ld(&bar[XB_TOPGEN]) == tg, bar);
            __builtin_amdgcn_fence(__ATOMIC_ACQUIRE, "agent");
            xb_add(&bar[XB_XGEN(b.x)], 1u);
            asm volatile("s_waitcnt vmcnt(0)" ::: "memory");
        } else {
            XB_SPIN(xb_ld(&bar[XB_XGEN(b.x)]) == gen, bar);
            __builtin_amdgcn_fence(__ATOMIC_ACQUIRE, "agent");
            asm volatile("s_waitcnt vmcnt(0)" ::: "memory");
        }
    }
    __syncthreads();
}
constexpr int NWAVES = 8;
#ifndef WGM_P2
#define WGM_P2 4
#endif
#ifndef WGM_P5
#define WGM_P5 4
#endif
#ifndef WGM_P6
#define WGM_P6 4
#endif
#ifndef WGM_P7
#define WGM_P7 1
#endif
constexpr int M_TOK = 16384, DM = 2048, NPROJ = 6144, WIN_LD = 6152, DFF = 5632, NGU = 11264, NADA = 12288;
constexpr int MB_H = 8, MB_DH = 128, MB_BLK = 256, MB_NB = 64;
constexpr int ML_H = 4, ML_DQK = 128, ML_DV = 256, ML_L = 64, ML_NC = 256;
constexpr float DN_ALPHA = 1.189207115002721f;
constexpr float LN_EPS = 1e-5f;
constexpr float K_SCALE = 0.08838834764831845f;

constexpr size_t MiB = 1u << 20;
constexpr size_t WS_CTL = 0, CTL_ZERO_BYTES = 128 * 1024;
constexpr size_t WS_SMALL = 1 * MiB;
constexpr size_t SM_ADA = 0, SM_C1 = 64 * 1024, SM_C2 = 128 * 1024, SM_KMEAN = 256 * 1024, SM_GATES = 512 * 1024, SM_TOKSC = 1 * MiB,
                 SM_CHSUM = 2 * MiB, SM_DECAY = 2 * MiB + 16 * 1024, SM_NLOC = 2 * MiB + 64 * 1024, SM_MUR = 3 * MiB;
constexpr size_t WS_WIN = 6 * MiB, WS_LISTS = 6 * MiB, WS_STATP = 6 * MiB;
constexpr size_t WS_WOUT = 30 * MiB, WS_WGU = 38 * MiB, WS_WDOWN = 82 * MiB;
constexpr size_t WS_U = 104 * MiB, WS_LOCAL = 104 * MiB, WS_Y1B = 104 * MiB;
constexpr size_t WS_MIX = 168 * MiB, WS_H = 168 * MiB;
constexpr size_t WS_KB = 232 * MiB, WS_VB = 264 * MiB, WS_MQK = 296 * MiB, WS_MV = 328 * MiB;
constexpr size_t WS_PART0 = 296 * MiB, WS_PART1 = 328 * MiB, WS_PART2 = 440 * MiB, WS_PART3 = 472 * MiB, WS_LSE = 504 * MiB;
constexpr size_t WS_QC = 360 * MiB, WS_KC = 376 * MiB, WS_KWT = 392 * MiB, WS_VT = 408 * MiB;
constexpr size_t WS_Y2B = 384 * MiB;
constexpr size_t WS_ROPE = 506 * MiB, WS_C12P = 508 * MiB, WS_ADAP = 511 * MiB;
constexpr size_t WS_Y1F = 384 * MiB, WS_END = 512 * MiB;
constexpr int CW_TMO = 0, CW_BAR = 4096, CW_CNT = 16384, CW_QUEUE = 20480, CW_PANEL = 24576;

constexpr int RING_BYTES = 131072, LDSCTL_OFF = RING_BYTES, LDS_BYTES = 163840, MISC_OFF = LDS_BYTES - 512;

typedef float f32x2 __attribute__((ext_vector_type(2)));
typedef unsigned u32x2 __attribute__((ext_vector_type(2)));

__device__ __forceinline__ float bf2f(unsigned short b) { return __builtin_bit_cast(float, (unsigned)b << 16); }
__device__ __forceinline__ float bflo(unsigned w) { return __builtin_bit_cast(float, w << 16); }
__device__ __forceinline__ float bfhi(unsigned w) { return __builtin_bit_cast(float, w & 0xffff0000u); }
__device__ __forceinline__ float sigmoid_f(float v) { return 1.f / (1.f + __expf(-v)); }
__device__ __forceinline__ float silu_f(float v) { return v / (1.f + __expf(-v)); }
__device__ __forceinline__ float logsigmoid_f(float v) { return fminf(v, 0.f) - log1pf(expf(-fabsf(v))); }

struct Frame {
    LAS unsigned char* lds;
    volatile LAS unsigned* MISC;
    gu32* ctl;
    int tid, lane, wave, G, bid;
    const float *x, *c, *w_ada, *b_ada, *w_in, *conv_w, *conv_b, *igb, *fgb, *normw, *w_out, *ln1_w, *ln1_b, *w_gu, *w_down, *ln2_w, *ln2_b;
    float* out; unsigned char* ws; unsigned long long tp0, tp1;
};
#if defined(TIME_PHASE)
#define TP_BEGIN(id) do { if (TIME_PHASE == (id)) F.tp0 = __builtin_amdgcn_s_memrealtime(); } while (0)
#define TP_END(id) do { if (TIME_PHASE == (id)) F.tp1 = __builtin_amdgcn_s_memrealtime(); } while (0)
#define TPA_BEGIN(id) unsigned long long tpa_t0_ = (TIME_PHASE == (id)) ? __builtin_amdgcn_s_memrealtime() : 0ull
#define TPA_END(id) do { if (TIME_PHASE == (id)) F.tp1 += __builtin_amdgcn_s_memrealtime() - tpa_t0_; } while (0)
#else
#define TPA_BEGIN(id) do { } while (0)
#define TPA_END(id) do { } while (0)
#define TP_BEGIN(id) do { } while (0)
#define TP_END(id) do { } while (0)
#endif
#define SMALLF(off) ((float*)(F.ws + WS_SMALL + (off)))

__device__ __forceinline__ float wave_sum(float v) {
#pragma unroll
    for (int o = 1; o < 64; o <<= 1) v += __shfl_xor(v, o);
    return v;
}

__device__ __forceinline__ void p0_transpose_item(const float* W, int K, int N, int ld, bf16* WT, LAS float* scr, int item, int lane) {
    const int nblk = N / 32, kb = item / nblk, nb = item % nblk, k0 = 64 * kb, n0 = 32 * nb;
    float ldv[32];
#pragma unroll
    for (int i = 0; i < 32; ++i) ldv[i] = W[(size_t)(k0 + 2 * i + (lane >> 5)) * ld + n0 + (lane & 31)];
#pragma unroll
    for (int i = 0; i < 32; ++i) scr[(2 * i + (lane >> 5)) * 33 + (lane & 31)] = ldv[i];
    LDS_WAIT(); asm volatile("" ::: "memory");
    const int c = lane & 7;
#pragma unroll
    for (int j = 0; j < 4; ++j) { const int n = (lane >> 3) + 8 * j; const LAS float* s = scr + (8 * c) * 33 + n;
        v4u o; o.x = pk2(s[0 * 33], s[1 * 33]); o.y = pk2(s[2 * 33], s[3 * 33]); o.z = pk2(s[4 * 33], s[5 * 33]); o.w = pk2(s[6 * 33], s[7 * 33]);
        *(GAS v4u*)(WT + (size_t)(n0 + n) * K + k0 + 8 * c) = o; }
    LDS_WAIT(); asm volatile("" ::: "memory");
}

__device__ __forceinline__ void p0_phase(Frame& F) {
    TP_BEGIN(120);
    {
        LAS float* sc = (LAS float*)(F.lds); LAS float* red = sc + 2048;
        for (int k = F.tid; k < DM; k += 512) sc[k] = silu_f(F.c[k]);
        __syncthreads();
        float* adap = (float*)(F.ws + WS_ADAP);
        for (int item = F.bid; item < 256; item += F.G) {
            const int kq = item >> 6, slab = item & 63;
            const int rg = F.tid / 48, cq = F.tid % 48;
            if (F.tid < 480) {
                f32x4 acc = {0.f, 0.f, 0.f, 0.f};
                const float* wp = F.w_ada + (size_t)(kq * 512) * NADA + slab * 192 + cq * 4;
#pragma unroll 13
                for (int k = rg; k < 512; k += 10) { const f32x4 w = *(const f32x4*)(wp + (size_t)k * NADA); acc += w * sc[kq * 512 + k]; }
                *(LAS f32x4*)(red + rg * 192 + cq * 4) = acc;
            }
            __syncthreads();
            if (F.tid < 192) { float s = 0.f;
#pragma unroll
                for (int g = 0; g < 10; ++g) s += red[g * 192 + F.tid];
                adap[(size_t)kq * NADA + slab * 192 + F.tid] = s; }
            __syncthreads();
        }
    }
    TP_END(120); TP_BEGIN(121);
    {
        LAS float* scr = (LAS float*)(F.lds + F.wave * 16384);
        const int gw = F.bid * NWAVES + F.wave, NGW = F.G * NWAVES;
        constexpr int I_IN = (DM / 64) * (NPROJ / 32), I_OUT = (DM / 64) * (DM / 32), I_DN = (DFF / 64) * (DM / 32);
        for (int it = gw; it < I_IN + I_OUT + I_DN; it += NGW) {
            int r = it;
            if (r < I_IN) { p0_transpose_item(F.w_in, DM, NPROJ, WIN_LD, (bf16*)(F.ws + WS_WIN), scr, r, F.lane); continue; } r -= I_IN;
            if (r < I_OUT) { p0_transpose_item(F.w_out, DM, DM, DM, (bf16*)(F.ws + WS_WOUT), scr, r, F.lane); continue; } r -= I_OUT;
            p0_transpose_item(F.w_down, DFF, DM, DM, (bf16*)(F.ws + WS_WDOWN), scr, r, F.lane);
        }
    }
    TP_END(121); TP_BEGIN(122);
    for (int i = F.bid * 512 + F.tid; i < MB_H * MB_NB * MB_DH; i += F.G * 512) SMALLF(SM_KMEAN)[i] = 0.f;
    for (int i = F.bid * 512 + F.tid; i < M_TOK * 2; i += F.G * 512) ((unsigned long long*)SMALLF(SM_MUR))[i] = 0ull;
    {
        const double INV[16] = {1.0, 0.44036660267178046, 0.19392274474868576, 0.08539710028576561, 0.03760603093086393, 0.016560440080994446, 0.007292664737217109, 0.003211445994752591,
                                0.001414213562373095, 0.000622772421914596, 0.0002742481756762073, 0.00012076973741146504, 5.318295896944988e-05, 2.341999896140934e-05, 1.031338537721246e-05, 4.5416704806078695e-06};
        float* rope = (float*)(F.ws + WS_ROPE);
        for (int idx = F.bid * 512 + F.tid; idx < M_TOK * 16; idx += F.G * 512) {
            const int pos = idx >> 4, i = idx & 15;
            double inv = INV[0];
#pragma unroll
            for (int j = 1; j < 16; ++j) inv = (i == j) ? INV[j] : inv;
            const double ang = (double)pos * inv;
            const double q = __builtin_floor(ang * 0.6366197723675814 + 0.5);
            double r = __builtin_fma(-q, 1.5707963267948966, ang); r = __builtin_fma(-q, 6.123233995736766e-17, r);
            const int qi = ((int)q) & 3; const double r2 = r * r;
            double cs = 1.0 + r2 * (-0.5 + r2 * (1.0 / 24 + r2 * (-1.0 / 720 + r2 * (1.0 / 40320 + r2 * (-1.0 / 3628800 + r2 * (1.0 / 479001600 + r2 * (-1.0 / 87178291200.0)))))));
            double sn = r * (1.0 + r2 * (-1.0 / 6 + r2 * (1.0 / 120 + r2 * (-1.0 / 5040 + r2 * (1.0 / 362880 + r2 * (-1.0 / 39916800 + r2 * (1.0 / 6227020800.0 + r2 * (-1.0 / 1307674368000.0))))))));
            double co, si;
            if (qi == 0) { co = cs; si = sn; } else if (qi == 1) { co = -sn; si = cs; } else if (qi == 2) { co = -cs; si = -sn; } else { co = sn; si = -cs; }
            rope[pos * 32 + i] = (float)co; rope[pos * 32 + 16 + i] = (float)si;
        }
    }
    TP_END(122);
}

__device__ __forceinline__ float ada_val(const Frame& F, int n) {
    const float* p = (const float*)(F.ws + WS_ADAP) + n;
    return ((p[0] + p[NADA]) + (p[2 * NADA] + p[3 * NADA])) + F.b_ada[n];
}
__device__ __forceinline__ void p1_wgu_item(Frame& F, LAS float* scr, int item) {
    const int lane = F.lane;
    constexpr int nblk = NGU / 32; const int kb = item / nblk, nb = item % nblk, k0 = 64 * kb, n0 = 32 * nb;
    const int pn = n0 >> 8, bj = (n0 >> 7) & 1, idx0 = n0 & 127;
    const int src0 = (bj ? DFF : 0) + pn * 128 + idx0;
    LAS float* wv = scr + 64 * 33; LAS float* bv = wv + 64;
    {   const int k = k0 + lane;
        const float s2 = 1.f + ada_val(F, 4 * DM + k); wv[lane] = F.ln1_w[k] * s2; bv[lane] = F.ln1_b[k] * s2 + ada_val(F, 3 * DM + k); }
    float ldv[32];
#pragma unroll
    for (int i = 0; i < 32; ++i) ldv[i] = F.w_gu[(size_t)(k0 + 2 * i + (lane >> 5)) * NGU + src0 + (lane & 31)];
#pragma unroll
    for (int i = 0; i < 32; ++i) scr[(2 * i + (lane >> 5)) * 33 + (lane & 31)] = ldv[i];
    LDS_WAIT(); asm volatile("" ::: "memory");
    const int c = lane & 7; bf16* WT = (bf16*)(F.ws + WS_WGU);
    float* c1p = (float*)(F.ws + WS_C12P) + (size_t)kb * NGU; float* c2p = (float*)(F.ws + WS_C12P) + (size_t)(32 + kb) * NGU;
#pragma unroll
    for (int j = 0; j < 4; ++j) { const int n = (lane >> 3) + 8 * j; const LAS float* s = scr + (8 * c) * 33 + n;
        float v[8], s1 = 0.f, s2 = 0.f; unsigned short b[8];
#pragma unroll
        for (int e = 0; e < 8; ++e) { const float raw = s[e * 33]; v[e] = raw * wv[8 * c + e]; b[e] = (unsigned short)f2bf(v[e]); s1 += bf2f(b[e]); s2 += raw * bv[8 * c + e]; }
        v4u o; o.x = b[0] | ((unsigned)b[1] << 16); o.y = b[2] | ((unsigned)b[3] << 16); o.z = b[4] | ((unsigned)b[5] << 16); o.w = b[6] | ((unsigned)b[7] << 16);
        *(GAS v4u*)(WT + (size_t)(n0 + n) * DM + k0 + 8 * c) = o;
        s1 += __shfl_xor(s1, 1); s1 += __shfl_xor(s1, 2); s1 += __shfl_xor(s1, 4);
        s2 += __shfl_xor(s2, 1); s2 += __shfl_xor(s2, 2); s2 += __shfl_xor(s2, 4);
        if (c == 0) { c1p[n0 + n] = s1; c2p[n0 + n] = s2; } }
    LDS_WAIT(); asm volatile("" ::: "memory");
}

__device__ __forceinline__ void p1_phase(Frame& F) {
    {   float* ada = SMALLF(SM_ADA);
        for (int n = F.bid * 512 + F.tid; n < NADA; n += F.G * 512) ada[n] = ada_val(F, n); }
    TP_BEGIN(110);
    {
        LAS float* sc1 = (LAS float*)(F.lds);
        LAS float* sh1 = sc1 + 2048;
        LAS float* wgT = sh1 + 2048;
        for (int k = F.tid; k < DM; k += 512) { sc1[k] = 1.f + ada_val(F, DM + k); sh1[k] = ada_val(F, k); }
        for (int i = F.tid; i < DM * 2; i += 512) { const int k = i >> 1, hf = i & 1; const f32x4 v = *(const f32x4*)(F.w_in + (size_t)k * WIN_LD + NPROJ + hf * 4);
            wgT[(hf * 4 + 0) * DM + k] = v.x; wgT[(hf * 4 + 1) * DM + k] = v.y; wgT[(hf * 4 + 2) * DM + k] = v.z; wgT[(hf * 4 + 3) * DM + k] = v.w; }
        __syncthreads();
        bf16* U = (bf16*)(F.ws + WS_U); float* gates = SMALLF(SM_GATES);
        const int rstep = F.G * NWAVES;
#define XROW_LOAD(X, row_) do { const GAS f32x4* xr_ = (const GAS f32x4*)(F.x + (size_t)(row_) * DM) + F.lane; _Pragma("unroll") for (int j = 0; j < 8; ++j) X[j] = xr_[64 * j]; } while (0)
#define XROW_DO(X, row_) do { float g[8]; _Pragma("unroll") for (int e = 0; e < 8; ++e) g[e] = 0.f; \
            GAS unsigned long long* o8 = (GAS unsigned long long*)(U + (size_t)(row_) * DM) + F.lane; \
            _Pragma("unroll") for (int j = 0; j < 8; ++j) { asm volatile("" ::: "memory"); const int k = F.lane * 4 + 256 * j; \
                const f32x4 s = *(LAS f32x4*)(sc1 + k), h = *(LAS f32x4*)(sh1 + k); const f32x4 u = X[j] * s + h; \
                o8[64 * j] = (unsigned long long)pk2(u.x, u.y) | ((unsigned long long)pk2(u.z, u.w) << 32); \
                _Pragma("unroll") for (int e = 0; e < 8; ++e) { const f32x4 w = *(LAS f32x4*)(wgT + e * DM + k); g[e] += (u.x * w.x + u.y * w.y) + (u.z * w.z + u.w * w.w); } } \
            _Pragma("unroll") for (int e = 0; e < 8; ++e) { float t = g[e]; \
                t += __builtin_bit_cast(float, __builtin_amdgcn_update_dpp(0, __builtin_bit_cast(int, t), 0xB1, 0xF, 0xF, true)); \
                t += __builtin_bit_cast(float, __builtin_amdgcn_update_dpp(0, __builtin_bit_cast(int, t), 0x4E, 0xF, 0xF, true)); \
                t += __builtin_bit_cast(float, __builtin_amdgcn_update_dpp(0, __builtin_bit_cast(int, t), 0x141, 0xF, 0xF, true)); \
                t += __builtin_bit_cast(float, __builtin_amdgcn_update_dpp(0, __builtin_bit_cast(int, t), 0x140, 0xF, 0xF, true)); \
                t += __shfl_xor(t, 16); t += __shfl_xor(t, 32); g[e] = t; } \
            if (F.lane == 0) { *(f32x4*)(gates + (row_) * 8) = (f32x4){g[0], g[1], g[2], g[3]}; *(f32x4*)(gates + (row_) * 8 + 4) = (f32x4){g[4], g[5], g[6], g[7]}; } } while (0)
        f32x4 xa[8], xb[8];
        int row = F.bid * NWAVES + F.wave;
        if (row < M_TOK) XROW_LOAD(xa, row);
        while (row < M_TOK) {
            if (row + rstep < M_TOK) XROW_LOAD(xb, row + rstep);
            XROW_DO(xa, row);
            row += rstep; if (row >= M_TOK) break;
            if (row + rstep < M_TOK) XROW_LOAD(xa, row + rstep);
            XROW_DO(xb, row);
            row += rstep;
        }
#undef XROW_LOAD
#undef XROW_DO
        __syncthreads();
    }
    TP_END(110); TP_BEGIN(111);
    {
        LAS float* scr = (LAS float*)(F.lds + F.wave * 16384);
        const int gw = F.bid * NWAVES + F.wave, NGW = F.G * NWAVES;
        constexpr int I_GU = (DM / 64) * (NGU / 32);
        for (int it = gw; it < I_GU; it += NGW) p1_wgu_item(F, scr, it);
    }
    TP_END(111);
}

namespace pg8 {
struct EpiProj {
    static constexpr bool PERM = true, AFTER_DRAIN = false;
    bf16_t *mix, *kb, *vb, *mqk, *mv; const float* rope; float* kmean;
    __device__ __forceinline__ void operator()(const f32x4 (&acc)[2][2][4][2], const Unit& u, int wr, int wc, int fr, int fq) const {
        const int row0 = u.pm * BM + wr * 64 + fr; const int colt = u.pn * BM; const int t = colt >> 10, cl = colt & 1023;
        bf16_t* base; int ldc;
        if (t == 0) { base = mix + 1024; ldc = 2048; } else if (t == 1) { base = kb; ldc = 1024; } else if (t == 2) { base = vb; ldc = 1024; }
        else if (t == 3) { base = mqk; ldc = 1024; } else if (t == 4) { base = mv; ldc = 1024; } else { base = mix; ldc = 2048; }
        const int col0 = cl + wc * 32 + 8 * fq;
        const bool dorope = (t < 2) && (wc == 0);
        const float sgn = (fq < 2) ? -1.f : 1.f;
        f32x4 ks0[2] = {{0.f, 0.f, 0.f, 0.f}, {0.f, 0.f, 0.f, 0.f}}, ks1[2] = {{0.f, 0.f, 0.f, 0.f}, {0.f, 0.f, 0.f, 0.f}};
#pragma unroll
        for (int ai = 0; ai < 2; ++ai) {
            f32x4 rc0[4], rc1[4], rs0[4], rs1[4];
            if (dorope) {
#pragma unroll
                for (int m = 0; m < 4; ++m) { const float* rp = rope + (size_t)(row0 + ai * HALF + m * 16) * 32 + 8 * (fq & 1);
                    rc0[m] = *(const f32x4*)(rp); rc1[m] = *(const f32x4*)(rp + 4); rs0[m] = *(const f32x4*)(rp + 16); rs1[m] = *(const f32x4*)(rp + 20); }
            }
#pragma unroll
            for (int m = 0; m < 4; ++m) {
                const int row = row0 + ai * HALF + m * 16;
                bf16_t* rowp = base + (size_t)row * ldc + col0;
#pragma unroll
                for (int bj = 0; bj < 2; ++bj) {
                    f32x4 v0 = acc[ai][bj][m][0], v1 = acc[ai][bj][m][1];
                    if (dorope) {
                        f32x4 p0, p1;
#pragma unroll
                        for (int i = 0; i < 4; ++i) { p0[i] = __shfl_xor(v0[i], 32); p1[i] = __shfl_xor(v1[i], 32); }
                        v0 = v0 * rc0[m] + p0 * rs0[m] * sgn; v1 = v1 * rc1[m] + p1 * rs1[m] * sgn;
                    }
                    u32x4 w; w.x = cvt_pk_bf16(v0[0], v0[1]); w.y = cvt_pk_bf16(v0[2], v0[3]); w.z = cvt_pk_bf16(v1[0], v1[1]); w.w = cvt_pk_bf16(v1[2], v1[3]);
                    *(u32x4*)(rowp + bj * HALF) = w;
                    if (t == 1) { ks0[bj] += v0; ks1[bj] += v1; }
                }
            }
        }
        if (t == 1) {
#pragma unroll
            for (int bj = 0; bj < 2; ++bj) {
                float s8[8] = {ks0[bj][0], ks0[bj][1], ks0[bj][2], ks0[bj][3], ks1[bj][0], ks1[bj][1], ks1[bj][2], ks1[bj][3]};
#pragma unroll
                for (int e = 0; e < 8; ++e) {
                    float x = s8[e];
                    x += __builtin_bit_cast(float, __builtin_amdgcn_update_dpp(0, __builtin_bit_cast(int, x), 0xB1, 0xF, 0xF, true));
                    x += __builtin_bit_cast(float, __builtin_amdgcn_update_dpp(0, __builtin_bit_cast(int, x), 0x4E, 0xF, 0xF, true));
                    x += __builtin_bit_cast(float, __builtin_amdgcn_update_dpp(0, __builtin_bit_cast(int, x), 0x141, 0xF, 0xF, true));
                    x += __builtin_bit_cast(float, __builtin_amdgcn_update_dpp(0, __builtin_bit_cast(int, x), 0x140, 0xF, 0xF, true));
                    s8[e] = x;
                }
                if (fr == 0) { const int col = cl + bj * HALF + wc * 32 + 8 * fq; float* kp = kmean + ((size_t)(col >> 7) * 64 + u.pm) * 128 + (col & 127);
#pragma unroll
                    for (int e = 0; e < 8; ++e) atomicAdd(kp + e, s8[e] * (1.f / 256.f)); }
            }
        }
    }
};
struct EpiY1 {
    static constexpr bool PERM = false, AFTER_DRAIN = false;
    const float* x; const float* gate1; bf16_t* y1b; unsigned long long* stat;
    __device__ __forceinline__ void operator()(const f32x4 (&acc)[2][2][4][2], const Unit& u, int wr, int wc, int fr, int fq) const {
        const int row0 = u.pm * BM + wr * 64 + fr, col0 = u.pn * BM + wc * 32 + 4 * fq;
        float s[8], ss[8];
#pragma unroll
        for (int i = 0; i < 8; ++i) { s[i] = 0.f; ss[i] = 0.f; }
#pragma unroll
        for (int bj = 0; bj < 2; ++bj)
#pragma unroll
            for (int n = 0; n < 2; ++n) {
                const int c = col0 + bj * HALF + n * 16;
                const f32x4 g1 = *(const f32x4*)(gate1 + c) + 1.0f;
                f32x4 xv[8];
#pragma unroll
                for (int i = 0; i < 8; ++i) xv[i] = *(const f32x4*)(x + (size_t)(row0 + (i >> 2) * HALF + (i & 3) * 16) * 2048 + c);
                asm volatile("" ::: "memory");
#pragma unroll
                for (int i = 0; i < 8; ++i) {
                    const size_t off = (size_t)(row0 + (i >> 2) * HALF + (i & 3) * 16) * 2048 + c;
                    const f32x4 y = xv[i] * 1.189207115002721f + g1 * acc[i >> 2][bj][i & 3][n];
                    typedef unsigned u32x2v __attribute__((ext_vector_type(2)));
                    u32x2v w; w.x = cvt_pk_bf16(y[0], y[1]); w.y = cvt_pk_bf16(y[2], y[3]);
                    *(u32x2v*)(y1b + off) = w;
                    s[i] += (y[0] + y[1]) + (y[2] + y[3]); ss[i] += (y[0] * y[0] + y[1] * y[1]) + (y[2] * y[2] + y[3] * y[3]);
                }
                asm volatile("" ::: "memory");
            }
#pragma unroll
        for (int i = 0; i < 8; ++i) {
            float a = s[i], a2 = ss[i];
            a += __shfl_xor(a, 16); a += __shfl_xor(a, 32); a2 += __shfl_xor(a2, 16); a2 += __shfl_xor(a2, 32);
            if (fq == 0) { unsigned long long* sp = stat + (size_t)(row0 + (i >> 2) * HALF + (i & 3) * 16) * 2;
                atomicAdd(sp, (unsigned long long)(long long)(a * 16777216.f)); atomicAdd(sp + 1, (unsigned long long)(long long)(a2 * 16777216.f)); }
        }
    }
};
__device__ __forceinline__ f32x2 ln_stats_from_fixed(const unsigned long long* sp) {
    typedef unsigned long long u64x2 __attribute__((ext_vector_type(2)));
    const u64x2 v = *(const u64x2*)sp;
    const float s = (float)((double)(long long)v.x * (1.0 / (16777216.0 * 2048.0))), q = (float)((double)(long long)v.y * (1.0 / (16777216.0 * 2048.0)));
    const float var = fmaxf(q - s * s, 0.f);
    return (f32x2){s, rsqrtf(var + 1e-5f)};
}
struct EpiSwiGLU {
    static constexpr bool PERM = true, AFTER_DRAIN = false;
    const unsigned long long* stat; const float* c1; const float* c2; bf16_t* H; unsigned long long* tacc;
    __device__ __forceinline__ void operator()(const f32x4 (&acc)[2][2][4][2], const Unit& u, int wr, int wc, int fr, int fq) const {
#if defined(TIME_PHASE)
        const unsigned long long te0_ = (TIME_PHASE == 170) ? __builtin_amdgcn_s_memrealtime() : 0ull;
#endif
        const int row0 = u.pm * BM + wr * 64 + fr; const int cl = wc * 32 + 8 * fq; const int cg = u.pn * BM + cl;
        f32x4 c1g[2], c2g[2], c1u[2], c2u[2];
#pragma unroll
        for (int n = 0; n < 2; ++n) { c1g[n] = *(const f32x4*)(c1 + cg + 4 * n); c2g[n] = *(const f32x4*)(c2 + cg + 4 * n); c1u[n] = *(const f32x4*)(c1 + cg + HALF + 4 * n); c2u[n] = *(const f32x4*)(c2 + cg + HALF + 4 * n); }
        typedef float f32x2v __attribute__((ext_vector_type(2)));
        f32x2v mrs[8];
#pragma unroll
        for (int i = 0; i < 8; ++i) { const f32x2 t_ = ln_stats_from_fixed(stat + (size_t)(row0 + (i >> 2) * HALF + (i & 3) * 16) * 2); mrs[i] = (f32x2v){t_.x, t_.y}; }
#pragma unroll
        for (int ai = 0; ai < 2; ++ai)
#pragma unroll
            for (int m = 0; m < 4; ++m) {
                const int row = row0 + ai * HALF + m * 16;
                const f32x2v mr = mrs[ai * 4 + m];
                f32x4 hv[2];
#pragma unroll
                for (int n = 0; n < 2; ++n) {
                    const f32x4 g = (acc[ai][0][m][n] - c1g[n] * mr.x) * mr.y + c2g[n];
                    const f32x4 up = (acc[ai][1][m][n] - c1u[n] * mr.x) * mr.y + c2u[n];
#pragma unroll
                    for (int i = 0; i < 4; ++i) { const float e = __builtin_amdgcn_exp2f(g[i] * -1.4426950408889634f); hv[n][i] = g[i] * __builtin_amdgcn_rcpf(1.f + e) * up[i]; }
                }
                u32x4 w; w.x = cvt_pk_bf16(hv[0][0], hv[0][1]); w.y = cvt_pk_bf16(hv[0][2], hv[0][3]); w.z = cvt_pk_bf16(hv[1][0], hv[1][1]); w.w = cvt_pk_bf16(hv[1][2], hv[1][3]);
                *(u32x4*)(H + (size_t)row * 5632 + u.pn * HALF + cl) = w;
            }
#if defined(TIME_PHASE)
        if (TIME_PHASE == 170) *tacc += __builtin_amdgcn_s_memrealtime() - te0_;
#endif
    }
};
struct EpiY2 {
    static constexpr bool PERM = false, AFTER_DRAIN = false;
    const bf16_t* y1b; const unsigned long long* stat; const float* gate2; const float* lw; const float* lb; bf16_t* y2b;
    __device__ __forceinline__ void operator()(const f32x4 (&acc)[2][2][4][2], const Unit& u, int wr, int wc, int fr, int fq) const {
        const int row0 = u.pm * BM + wr * 64 + fr, col0 = u.pn * BM + wc * 32 + 4 * fq;
        typedef float f32x2v __attribute__((ext_vector_type(2)));
        f32x2v mrs[8];
#pragma unroll
        for (int i = 0; i < 8; ++i) { const f32x2 t_ = ln_stats_from_fixed(stat + (size_t)(row0 + (i >> 2) * HALF + (i & 3) * 16) * 2); mrs[i] = (f32x2v){t_.x, t_.y}; }
#pragma unroll
        for (int bj = 0; bj < 2; ++bj)
#pragma unroll
            for (int n = 0; n < 2; ++n) {
                const int c = col0 + bj * HALF + n * 16;
                const f32x4 g2 = *(const f32x4*)(gate2 + c) + 1.0f, w = *(const f32x4*)(lw + c), b = *(const f32x4*)(lb + c);
                f32x4 yv[8];
                {   typedef unsigned u32x2v __attribute__((ext_vector_type(2))); u32x2v yr[8];
#pragma unroll
                    for (int i = 0; i < 8; ++i) yr[i] = *(const u32x2v*)(y1b + (size_t)(row0 + (i >> 2) * HALF + (i & 3) * 16) * 2048 + c);
                    asm volatile("" ::: "memory");
#pragma unroll
                    for (int i = 0; i < 8; ++i) yv[i] = (f32x4){__builtin_bit_cast(float, yr[i].x << 16), __builtin_bit_cast(float, yr[i].x & 0xffff0000u), __builtin_bit_cast(float, yr[i].y << 16), __builtin_bit_cast(float, yr[i].y & 0xffff0000u)}; }
#pragma unroll
                for (int i = 0; i < 8; ++i) {
                    const size_t off = (size_t)(row0 + (i >> 2) * HALF + (i & 3) * 16) * 2048 + c;
                    const f32x4 x1 = (yv[i] - mrs[i].x) * mrs[i].y * w + b;
                    const f32x4 y2 = x1 * 1.189207115002721f + g2 * acc[i >> 2][bj][i & 3][n];
                    typedef unsigned u32x2w __attribute__((ext_vector_type(2))); u32x2w pk; pk.x = cvt_pk_bf16(y2[0], y2[1]); pk.y = cvt_pk_bf16(y2[2], y2[3]);
                    *(u32x2w*)(y2b + off) = pk;
                }
                asm volatile("" ::: "memory");
            }
    }
};
}

__device__ __forceinline__ float wave_incl_scan_add(float v, int lane) {
#pragma unroll
    for (int o = 1; o < 64; o <<= 1) { const float t = __shfl_up(v, o); if (lane >= o) v += t; }
    return v;
}
__device__ __forceinline__ float wave_incl_scan_max(float v, int lane) {
#pragma unroll
    for (int o = 1; o < 64; o <<= 1) { const float t = __shfl_up(v, o); if (lane >= o) v = fmaxf(v, t); }
    return v;
}
__device__ __forceinline__ void p3_chunk_item(Frame& F, int c) {
    const int t0 = c * ML_L, tid = F.tid, lane = F.lane;
    LAS float* wgt = (LAS float*)F.lds;
    LAS unsigned short* KT = (LAS unsigned short*)(F.lds + 1024);
    LAS unsigned short* VTh = (LAS unsigned short*)(F.lds + 1024 + 512 * 72 * 2);
    const float* gates = SMALLF(SM_GATES);
    if (F.wave < 4) {
        const int h = F.wave, t = t0 + lane;
        const float ig = gates[t * 8 + h] + F.igb[h], fg = gates[t * 8 + 4 + h] + F.fgb[h];
        const float lf = logsigmoid_f(fg);
        const float b = wave_incl_scan_add(lf, lane), u = ig - b, m1 = wave_incl_scan_max(u, lane);
        const float m1l = __shfl(m1, 63), bl = __shfl(b, 63);
        *(f32x4*)(SMALLF(SM_TOKSC) + (size_t)(t * 4 + h) * 4) = (f32x4){b, u, m1, 0.f};
        if (lane == 63) { SMALLF(SM_CHSUM)[(c * 4 + h) * 2] = bl; SMALLF(SM_CHSUM)[(c * 4 + h) * 2 + 1] = m1l; }
        wgt[h * 64 + lane] = expf(u - m1l);
    }
    {
        const int cgp = tid & 127, rq = tid >> 7, ch0 = cgp * 8, r0 = 16 * rq;
        const v4u* MQK = (const v4u*)(F.ws + WS_MQK);
        float w[4][8], bs[8];
#pragma unroll
        for (int j = 0; j < 4; ++j) { const f32x4 a = *(const f32x4*)(F.conv_w + j * 1024 + ch0), b = *(const f32x4*)(F.conv_w + j * 1024 + ch0 + 4);
            w[j][0] = a.x; w[j][1] = a.y; w[j][2] = a.z; w[j][3] = a.w; w[j][4] = b.x; w[j][5] = b.y; w[j][6] = b.z; w[j][7] = b.w; }
        { const f32x4 a = *(const f32x4*)(F.conv_b + ch0), b = *(const f32x4*)(F.conv_b + ch0 + 4); bs[0] = a.x; bs[1] = a.y; bs[2] = a.z; bs[3] = a.w; bs[4] = b.x; bs[5] = b.y; bs[6] = b.z; bs[7] = b.w; }
        __syncthreads();
        const bool isq = ch0 < 512; const int hh = (ch0 - 512) >> 7;
        v4u* QC = (v4u*)(F.ws + WS_QC); v4u* KC = (v4u*)(F.ws + WS_KC);
#pragma unroll 1
        for (int hf = 0; hf < 2; ++hf) {
        v4u xin[11];
#pragma unroll
        for (int i = 0; i < 11; ++i) { const int t = t0 + r0 + 8 * hf - 3 + i; xin[i] = (t >= 0) ? MQK[(size_t)t * 128 + cgp] : (v4u){0u, 0u, 0u, 0u}; }
#pragma unroll
        for (int r = 0; r < 8; ++r) {
            float y[8];
#pragma unroll
            for (int e = 0; e < 8; ++e) y[e] = bs[e];
#pragma unroll
            for (int j = 0; j < 4; ++j) { const v4u x = xin[r + j];
                y[0] += w[j][0] * bflo(x.x); y[1] += w[j][1] * bfhi(x.x); y[2] += w[j][2] * bflo(x.y); y[3] += w[j][3] * bfhi(x.y);
                y[4] += w[j][4] * bflo(x.z); y[5] += w[j][5] * bfhi(x.z); y[6] += w[j][6] * bflo(x.w); y[7] += w[j][7] * bfhi(x.w); }
#pragma unroll
            for (int e = 0; e < 8; ++e) y[e] = silu_f(y[e]);
            const int s = r0 + 8 * hf + r;
            if (isq) { v4u o; o.x = pk2(y[0], y[1]); o.y = pk2(y[2], y[3]); o.z = pk2(y[4], y[5]); o.w = pk2(y[6], y[7]); QC[(size_t)(t0 + s) * 64 + cgp] = o; }
            else {
#pragma unroll
                for (int e = 0; e < 8; ++e) y[e] *= K_SCALE;
                v4u o; o.x = pk2(y[0], y[1]); o.y = pk2(y[2], y[3]); o.z = pk2(y[4], y[5]); o.w = pk2(y[6], y[7]); KC[(size_t)(t0 + s) * 64 + (cgp - 64)] = o;
                const float wg_ = wgt[hh * 64 + s];
#pragma unroll
                for (int e = 0; e < 8; ++e) KT[(ch0 - 512 + e) * 72 + s] = (unsigned short)f2bf(y[e] * wg_);
            }
        }
        }
    }
    __syncthreads();
    {
        float sm = 0.f;
#pragma unroll
        for (int i = 0; i < 8; ++i) { const v4u v = *(LAS v4u*)(KT + tid * 72 + i * 8); sm += bflo(v.x) + bfhi(v.x) + bflo(v.y) + bfhi(v.y) + bflo(v.z) + bfhi(v.z) + bflo(v.w) + bfhi(v.w); }
        SMALLF(SM_NLOC)[(size_t)c * 512 + tid] = sm;
    }
    const v4u* MV = (const v4u*)(F.ws + WS_MV);
    const int r = lane & 31, hh2 = lane >> 5, w = F.wave;
    const int vg = tid & 31, sq = tid >> 5;
    v4u vin[4];
#pragma unroll
    for (int i = 0; i < 4; ++i) vin[i] = MV[(size_t)(t0 + 4 * sq + i) * 128 + vg];
#pragma unroll 1
    for (int h = 0; h < 4; ++h) {
#pragma unroll
        for (int i = 0; i < 4; ++i) { const int s = 4 * sq + i; LAS unsigned short* p = VTh + (8 * vg) * 72 + s;
            p[0] = (unsigned short)vin[i].x; p[72] = (unsigned short)(vin[i].x >> 16); p[144] = (unsigned short)vin[i].y; p[216] = (unsigned short)(vin[i].y >> 16);
            p[288] = (unsigned short)vin[i].z; p[360] = (unsigned short)(vin[i].z >> 16); p[432] = (unsigned short)vin[i].w; p[504] = (unsigned short)(vin[i].w >> 16); }
        __syncthreads();
        if (h < 3) {
#pragma unroll
            for (int i = 0; i < 4; ++i) vin[i] = MV[(size_t)(t0 + 4 * sq + i) * 128 + (h + 1) * 32 + vg];
        }
        {
            unsigned long long* VT8 = (unsigned long long*)(F.ws + WS_VT) + (size_t)(c * 4 + h) * 4096;
#pragma unroll
            for (int p = 0; p < 8; ++p) { const int idx = p * 512 + tid, sb = idx >> 8, v = idx & 255;
                VT8[idx] = *(LAS unsigned long long*)(VTh + v * 72 + sb * 4); } }
        {
            pg8::bf16x8 bfr[4];
#pragma unroll
            for (int ks = 0; ks < 4; ++ks) bfr[ks] = *(LAS pg8::bf16x8*)(VTh + (32 * w + r) * 72 + 16 * ks + 8 * hh2);
            unsigned short* LOC = (unsigned short*)(F.ws + WS_LOCAL) + (size_t)(c * 4 + h) * 256 * 128 + (size_t)(32 * w + r) * 8 + 4 * hh2;
#pragma unroll
            for (int dt = 0; dt < 4; ++dt) {
                __attribute__((ext_vector_type(16))) float acc = {};
#pragma unroll
                for (int ks = 0; ks < 4; ++ks) { const pg8::bf16x8 af = *(LAS pg8::bf16x8*)(KT + (h * 128 + 32 * dt + r) * 72 + 16 * ks + 8 * hh2);
                    acc = __builtin_amdgcn_mfma_f32_32x32x16_bf16(af, bfr[ks], acc, 0, 0, 0); }
#pragma unroll
                for (int g = 0; g < 4; ++g) { u32x2 o; o.x = pk2(acc[4 * g], acc[4 * g + 1]); o.y = pk2(acc[4 * g + 2], acc[4 * g + 3]);
                    *(u32x2*)(LOC + (size_t)(4 * dt + g) * 2048) = o; }
            }
        }
        __syncthreads();
    }
}
__device__ __forceinline__ void p3_kmean_item(Frame& F, int j) {
    const v4u* KB = (const v4u*)(F.ws + WS_KB);
    const int cg = F.tid & 127, rg = F.tid >> 7;
    float s[8];
#pragma unroll
    for (int e = 0; e < 8; ++e) s[e] = 0.f;
#pragma unroll 16
    for (int r = 0; r < 64; ++r) { const v4u v = KB[(size_t)(j * MB_BLK + rg * 64 + r) * 128 + cg];
        s[0] += bflo(v.x); s[1] += bfhi(v.x); s[2] += bflo(v.y); s[3] += bfhi(v.y); s[4] += bflo(v.z); s[5] += bfhi(v.z); s[6] += bflo(v.w); s[7] += bfhi(v.w); }
    LAS float* red = (LAS float*)F.lds;
#pragma unroll
    for (int e = 0; e < 8; ++e) red[rg * 1024 + cg * 8 + e] = s[e];
    __syncthreads();
#pragma unroll
    for (int e = 0; e < 2; ++e) { const int col = F.tid * 2 + e; const float t = (red[col] + red[1024 + col]) + (red[2048 + col] + red[3072 + col]);
        SMALLF(SM_KMEAN)[(size_t)((col >> 7) * 64 + j) * 128 + (col & 127)] = t * (1.f / 256.f); }
    __syncthreads();
}
__device__ __forceinline__ void p3_c12_item(Frame& F, int it) {
    const int n = it * 512 + F.tid; if (n >= NGU) return;
    const float* p = (const float*)(F.ws + WS_C12P);
    float a = 0.f, b = 0.f;
    for (int k = 0; k < 32; ++k) { a += p[(size_t)k * NGU + n]; b += p[(size_t)(32 + k) * NGU + n]; }
    SMALLF(SM_C1)[n] = a; SMALLF(SM_C2)[n] = b;
}
__device__ __forceinline__ void moba_select_item(Frame& F, int b, int h);
__device__ __forceinline__ void p3_phase(Frame& F) {
    constexpr int N_CH = ML_NC, N_SEL = MB_NB * MB_H, N_C12 = NGU / 512;
    for (int it = F.bid; it < N_CH + N_SEL + N_C12; it += F.G) {
        if (it < N_CH) { TP_BEGIN(160); p3_chunk_item(F, it); TP_END(160); }
        else if (it < N_CH + N_SEL) {
#if !defined(NAIVE_MOBA)
            const int i = it - N_CH, b = 63 - (i >> 3), h = i & 7; if (b > 0) moba_select_item(F, b, h);
#endif
        }
        else p3_c12_item(F, it - N_CH - N_SEL);
    }
}

__device__ __forceinline__ void stat_phase(Frame& F) {
    const float* sp = (const float*)(F.ws + WS_STATP); float* mur = SMALLF(SM_MUR);
    for (int row = F.bid * 512 + F.tid; row < M_TOK; row += F.G * 512) {
        float s = 0.f, ss = 0.f;
#pragma unroll
        for (int i = 0; i < 16; ++i) { const f32x4 v = *(const f32x4*)(sp + (size_t)row * 64 + i * 4); s += v.x + v.z; ss += v.y + v.w; }
        const float mean = s * (1.f / DM); const float var = fmaxf(ss * (1.f / DM) - mean * mean, 0.f);
        mur[row * 2] = mean; mur[row * 2 + 1] = rsqrtf(var + LN_EPS);
    }
}
__device__ __forceinline__ void ln2_rows(Frame& F, int row0, int nrows) {
    const v4u* Y2 = (const v4u*)(F.ws + WS_Y2B);
#define LN2_LOAD(V, row_) do { const v4u* xr_ = Y2 + (size_t)(row_) * 256 + F.lane; _Pragma("unroll") for (int j = 0; j < 4; ++j) V[j] = xr_[64 * j]; } while (0)
#define LN2_DO(V, row_) do { GAS f32x4* xw_ = (GAS f32x4*)(F.out + (size_t)(row_) * DM); float s = 0.f; f32x4 f[8]; \
        _Pragma("unroll") for (int j = 0; j < 4; ++j) { f[2 * j] = (f32x4){bflo(V[j].x), bfhi(V[j].x), bflo(V[j].y), bfhi(V[j].y)}; f[2 * j + 1] = (f32x4){bflo(V[j].z), bfhi(V[j].z), bflo(V[j].w), bfhi(V[j].w)}; } \
        _Pragma("unroll") for (int j = 0; j < 8; ++j) s += (f[j].x + f[j].y) + (f[j].z + f[j].w); \
        const float mean = wave_sum(s) * (1.f / DM); float s2 = 0.f; \
        _Pragma("unroll") for (int j = 0; j < 8; ++j) { f[j] = f[j] - mean; s2 += (f[j].x * f[j].x + f[j].y * f[j].y) + (f[j].z * f[j].z + f[j].w * f[j].w); } \
        const float rstd = rsqrtf(wave_sum(s2) * (1.f / DM) + LN_EPS); \
        _Pragma("unroll") for (int j = 0; j < 8; ++j) { const int k = (F.lane + 64 * (j >> 1)) * 8 + 4 * (j & 1); const f32x4 w = *(const f32x4*)(F.ln2_w + k), b = *(const f32x4*)(F.ln2_b + k); *(GAS f32x4*)((GAS float*)xw_ + k) = f[j] * rstd * w + b; } } while (0)
    v4u va[4], vb[4];
    int rr = F.wave;
    if (rr < nrows) LN2_LOAD(va, row0 + rr);
    while (rr < nrows) {
        if (rr + NWAVES < nrows) LN2_LOAD(vb, row0 + rr + NWAVES);
        LN2_DO(va, row0 + rr);
        rr += NWAVES; if (rr >= nrows) break;
        if (rr + NWAVES < nrows) LN2_LOAD(va, row0 + rr + NWAVES);
        LN2_DO(vb, row0 + rr);
        rr += NWAVES;
    }
#undef LN2_LOAD
#undef LN2_DO
}
__device__ __forceinline__ bool ln2_panel_fused(Frame& F) {
    pg8::StaticOrder S; S.init(M_TOK, DM, F.G, F.bid, WGM_P7); pg8::Unit u0, u1, u2;
    if (F.G != 256 || !S.next(0, u0) || !S.next(1, u1) || S.next(2, u2)) return false;
    gu32* c0 = F.ctl + CW_PANEL + 64 * u0.pm; gu32* c1 = F.ctl + CW_PANEL + 64 * u1.pm;
    asm volatile("s_waitcnt vmcnt(0)" ::: "memory");
    __syncthreads();
    if (F.tid == 0) {
        __builtin_amdgcn_fence(__ATOMIC_RELEASE, "agent"); asm volatile("s_waitcnt vmcnt(0)" ::: "memory");
        __hip_atomic_fetch_add(c0, 1u, __ATOMIC_RELAXED, __HIP_MEMORY_SCOPE_AGENT);
        __hip_atomic_fetch_add(c1, 1u, __ATOMIC_RELAXED, __HIP_MEMORY_SCOPE_AGENT);
        unsigned sp = 0;
        while (__hip_atomic_load(c0, __ATOMIC_RELAXED, __HIP_MEMORY_SCOPE_AGENT) < 8u || __hip_atomic_load(c1, __ATOMIC_RELAXED, __HIP_MEMORY_SCOPE_AGENT) < 8u) { __builtin_amdgcn_s_sleep(2); if (++sp > (1u << 22)) break; }
        __builtin_amdgcn_fence(__ATOMIC_ACQUIRE, "agent"); asm volatile("s_waitcnt vmcnt(0)" ::: "memory");
    }
    __syncthreads();
    ln2_rows(F, u0.pm * 256 + 32 * u0.pn, 32);
    ln2_rows(F, u1.pm * 256 + 32 * u1.pn, 32);
    return true;
}
__device__ __forceinline__ void ln2_phase(Frame& F) {
    for (int r0 = F.bid * NWAVES; r0 < M_TOK; r0 += F.G * NWAVES) ln2_rows(F, r0, NWAVES);
}
typedef short s16x4 __attribute__((ext_vector_type(4)));
typedef float f32x16 __attribute__((ext_vector_type(16)));
typedef unsigned u32x4v __attribute__((ext_vector_type(4)));
#define MFMA32(a, b, c) __builtin_amdgcn_mfma_f32_32x32x16_bf16((a), (b), (c), 0, 0, 0)
#define SBAR() __builtin_amdgcn_sched_barrier(0)
__device__ __forceinline__ int crow(int r, int hi) { return (r & 3) + 8 * (r >> 2) + 4 * hi; }
typedef float cv_f32x2_t __attribute__((ext_vector_type(2))); typedef __bf16 cv_bf16x2_t __attribute__((ext_vector_type(2)));
__device__ __forceinline__ unsigned cvtpk(float lo, float hi) { cv_f32x2_t v = {lo, hi}; cv_bf16x2_t b = __builtin_convertvector(v, cv_bf16x2_t); return __builtin_bit_cast(unsigned, b); }

constexpr int LIST_HSTRIDE = 256 * 2016;
__device__ __forceinline__ int list_off(int h, int j) { return h * LIST_HSTRIDE + 256 * (63 * j - (j * (j - 1)) / 2); }
__device__ __forceinline__ unsigned short* part_ptr(unsigned char* ws, int slot) {
    return (unsigned short*)(ws + (slot == 0 ? WS_PART0 : slot == 1 ? WS_PART1 : slot == 2 ? WS_PART2 : WS_PART3));
}

#define TOP3_INS(S_, J_) do { const float s__ = (S_); const int j__ = (J_); \
    if (s__ > v0 || (s__ == v0 && j__ < i0)) { v2 = v1; i2 = i1; v1 = v0; i1 = i0; v0 = s__; i0 = j__; } \
    else if (s__ > v1 || (s__ == v1 && j__ < i1)) { v2 = v1; i2 = i1; v1 = s__; i1 = j__; } \
    else if (s__ > v2 || (s__ == v2 && j__ < i2)) { v2 = s__; i2 = j__; } } while (0)
__device__ __forceinline__ void moba_select_item(Frame& F, int b, int h) {
    const int tid = F.tid, lane = F.lane, r32 = lane & 31, hi = lane >> 5, w = F.wave;
    constexpr int KS = 136;
    LAS unsigned short* kmh = (LAS unsigned short*)F.lds;
    LAS unsigned short* kml = kmh + 64 * KS;
    LAS int* hist = (LAS int*)(F.lds + 2 * 64 * KS * 2);
    LAS int* base = hist + 64;
    {   const float* src = SMALLF(SM_KMEAN) + (size_t)h * 64 * 128;
        for (int i = tid; i < 64 * 32; i += 512) { const int j = i >> 5, c4 = (i & 31) * 4; f32x4 f = {0.f, 0.f, 0.f, 0.f}; if (j < b) f = *(const f32x4*)(src + j * 128 + c4);
            const unsigned h0 = f2bf(f.x), h1 = f2bf(f.y), h2 = f2bf(f.z), h3 = f2bf(f.w);
            const float l0 = f.x - bf2f((unsigned short)h0), l1 = f.y - bf2f((unsigned short)h1), l2 = f.z - bf2f((unsigned short)h2), l3 = f.w - bf2f((unsigned short)h3);
            *(LAS u32x2*)(kmh + j * KS + c4) = (u32x2){h0 | (h1 << 16), h2 | (h3 << 16)};
            *(LAS u32x2*)(kml + j * KS + c4) = (u32x2){pk2(l0, l1), pk2(l2, l3)}; }
        if (tid < 64) hist[tid] = 0; }
    __syncthreads();
    const int p = b * 256 + 32 * w + r32;
    bf16x8 qf[8];
    {   const unsigned short* qp = (const unsigned short*)(F.ws + WS_MIX) + (size_t)p * 2048 + 1024 + h * 128 + 8 * hi;
#pragma unroll
        for (int kd = 0; kd < 8; ++kd) qf[kd] = *(const bf16x8*)(qp + 16 * kd); }
    float v0 = -INFINITY, v1 = -INFINITY, v2 = -INFINITY; int i0 = 64, i1 = 64, i2 = 64;
    const int ntile = (b + 31) >> 5;
#pragma unroll 1
    for (int tile = 0; tile < ntile; ++tile) {
        f32x16 acc = {};
#pragma unroll
        for (int kd = 0; kd < 8; ++kd) {
            const bf16x8 ah = *(const LAS bf16x8*)(kmh + (32 * tile + r32) * KS + 16 * kd + 8 * hi), al = *(const LAS bf16x8*)(kml + (32 * tile + r32) * KS + 16 * kd + 8 * hi);
            acc = MFMA32(ah, qf[kd], acc); acc = MFMA32(al, qf[kd], acc);
        }
#pragma unroll
        for (int r = 0; r < 16; ++r) { const int j = 32 * tile + crow(r, hi); const float s = (j < b) ? acc[r] : -INFINITY; TOP3_INS(s, j); }
    }
    {
        const float u0 = __shfl_xor(v0, 32), u1 = __shfl_xor(v1, 32), u2 = __shfl_xor(v2, 32); const int k0 = __shfl_xor(i0, 32), k1 = __shfl_xor(i1, 32), k2 = __shfl_xor(i2, 32);
        TOP3_INS(u0, k0); TOP3_INS(u1, k1); TOP3_INS(u2, k2); }
    const int nsel = b < 3 ? b : 3; int sel[3] = {i0, i1, i2}, rank[3] = {0, 0, 0};
    if (hi == 0) {
#pragma unroll
        for (int k = 0; k < 3; ++k) if (k < nsel) rank[k] = atomicAdd((int*)&hist[sel[k]], 1);
    }
    __syncthreads();
    if (tid < 64) { const int n = hist[tid]; base[tid] = n ? (int)atomicAdd((unsigned*)(F.ctl + CW_CNT + h * 64 + tid), (unsigned)n) : 0; }
    __syncthreads();
    if (hi == 0) { unsigned* lists = (unsigned*)(F.ws + WS_LISTS);
#pragma unroll
        for (int k = 0; k < 3; ++k) if (k < nsel) lists[list_off(h, sel[k]) + base[sel[k]] + rank[k]] = ((unsigned)p << 2) | (unsigned)k; }
    __syncthreads();
}
#undef TOP3_INS

namespace moba {
constexpr int D = 128, NW = 8, QBLK = 32, KVBLK = 64, LDK = 1024;
constexpr float SCALE = 0.088388347648318440f, THR = 8.f;
constexpr size_t SHM_V = KVBLK * D * 2, SHM_K = KVBLK * D * 2, SHM_ATTN = 2 * SHM_V + 2 * SHM_K + NW * 128 * 4;
#define KSWZ(row, colB) ((row) * 256 + ((colB) ^ (((row) & 7) << 4)))
__device__ __forceinline__ void partialSM(f32x16& p0, f32x16& p1, float& m_reg, float& mn, float& alpha) {
  constexpr float C = SCALE * 1.4426950408889634f;
  float pmax = p0[0]; for (int r = 1; r < 16; ++r) pmax = fmaxf(pmax, p0[r]); for (int r = 0; r < 16; ++r) pmax = fmaxf(pmax, p1[r]);
  { auto rr = __builtin_amdgcn_permlane32_swap(__float_as_uint(pmax), __float_as_uint(pmax), false, false);
    pmax = fmaxf(__uint_as_float(rr[0]), __uint_as_float(rr[1])); }
  if (__builtin_expect(__all(pmax - m_reg <= THR / SCALE), 1)) { mn = m_reg; alpha = 1.f; }
  else { mn = fmaxf(m_reg, pmax); alpha = __builtin_amdgcn_exp2f((m_reg - mn) * C); m_reg = mn; }
  float mnC = -mn * C;
  for (int r = 0; r < 16; ++r) p0[r] = fmaf(p0[r], C, mnC); for (int r = 0; r < 16; ++r) p1[r] = fmaf(p1[r], C, mnC);
  for (int r = 0; r < 16; ++r) p0[r] = __builtin_amdgcn_exp2f(p0[r]);
}
__device__ __forceinline__ void finishSM(f32x16& p0, f32x16& p1, float alpha, float& l_reg, bf16x8& pa0, bf16x8& pa1, bf16x8& pa2, bf16x8& pa3) {
  for (int r = 0; r < 16; ++r) p1[r] = __builtin_amdgcn_exp2f(p1[r]);
  float ps = 0; for (int r = 0; r < 16; ++r) ps += p0[r]; for (int r = 0; r < 16; ++r) ps += p1[r];
  { auto rr = __builtin_amdgcn_permlane32_swap(__float_as_uint(ps), __float_as_uint(ps), false, false);
    ps = __uint_as_float(rr[0]) + __uint_as_float(rr[1]); }
  l_reg = l_reg * alpha + ps;
#define PK4(P, BASE, OUT) do { unsigned a0 = cvtpk(P[BASE + 0], P[BASE + 1]), a1 = cvtpk(P[BASE + 2], P[BASE + 3]);   \
    unsigned b0 = cvtpk(P[BASE + 4], P[BASE + 5]), b1 = cvtpk(P[BASE + 6], P[BASE + 7]);                              \
    auto r0 = __builtin_amdgcn_permlane32_swap(a0, b0, false, false); auto r1 = __builtin_amdgcn_permlane32_swap(a1, b1, false, false); \
    u32x4v w = {r0[0], r1[0], r0[1], r1[1]}; OUT = *reinterpret_cast<bf16x8*>(&w); } while (0)
  PK4(p0, 0, pa0); PK4(p0, 8, pa1); PK4(p1, 0, pa2); PK4(p1, 8, pa3);
#undef PK4
}
__device__ __forceinline__ void qkt(f32x16& p0, f32x16& p1, const char* Ks, const bf16x8* qr, int r32, int hi) {
  const f32x16 z = {};
  bf16x8 a0 = *reinterpret_cast<const bf16x8*>(Ks + KSWZ(r32, (hi * 8) * 2)), a1 = *reinterpret_cast<const bf16x8*>(Ks + KSWZ(32 + r32, (hi * 8) * 2));
#pragma unroll
  for (int d0 = 0; d0 < 8; ++d0) {
    bf16x8 n0 = a0, n1 = a1;
    if (d0 < 7) { const int cb = ((d0 + 1) * 16 + hi * 8) * 2; n0 = *reinterpret_cast<const bf16x8*>(Ks + KSWZ(r32, cb)); n1 = *reinterpret_cast<const bf16x8*>(Ks + KSWZ(32 + r32, cb)); }
    p0 = MFMA32(a0, qr[d0], d0 == 0 ? z : p0);
    p1 = MFMA32(a1, qr[d0], d0 == 0 ? z : p1);
    a0 = n0; a1 = n1;
  }
}
__device__ __forceinline__ int v_st(int k, int c) { const int kk = (k & ~0xC) | ((k & 4) << 1) | ((k & 8) >> 1); return ((kk >> 3) * 4 + (c >> 5)) * 512 + ((kk & 7) * 32 + (c & 31)) * 2; }
__device__ __forceinline__ int v_rd_base(int lane) { return ((lane & 3) << 3) | (((lane >> 2) & 3) << 6) | (((lane >> 4) & 1) << 5) | (((lane >> 5) & 1) << 8); }
constexpr int v_rd_off(int d0, int ks, int half) { return d0 * 512 + ks * 4096 + half * 2048; }
template <int OFF> __device__ __forceinline__ s16x4 tr_read(int vb) {
  s16x4 r; asm volatile("ds_read_b64_tr_b16 %0, %1 offset:%2" : "=&v"(r) : "v"(vb), "i"(OFF) : "memory"); return r;
}
template <int D0> __device__ __forceinline__ void pv_one(f32x16& od, int vb, bf16x8 pa0, bf16x8 pa1, bf16x8 pa2, bf16x8 pa3) {
  const s16x4 l0 = tr_read<v_rd_off(D0, 0, 0)>(vb), h0 = tr_read<v_rd_off(D0, 0, 1)>(vb), l1 = tr_read<v_rd_off(D0, 1, 0)>(vb), h1 = tr_read<v_rd_off(D0, 1, 1)>(vb);
  const s16x4 l2 = tr_read<v_rd_off(D0, 2, 0)>(vb), h2 = tr_read<v_rd_off(D0, 2, 1)>(vb), l3 = tr_read<v_rd_off(D0, 3, 0)>(vb), h3 = tr_read<v_rd_off(D0, 3, 1)>(vb);
  asm volatile("s_waitcnt lgkmcnt(0)" ::: "memory"); SBAR();
#define PK(L, H) (bf16x8){L[0], L[1], L[2], L[3], H[0], H[1], H[2], H[3]}
  od = MFMA32(pa0, PK(l0, h0), od);
  od = MFMA32(pa1, PK(l1, h1), od);
  od = MFMA32(pa2, PK(l2, h2), od);
  od = MFMA32(pa3, PK(l3, h3), od);
#undef PK
}
__device__ __forceinline__ void pv_d0(f32x16* o, int vb, bf16x8 pa0, bf16x8 pa1, bf16x8 pa2, bf16x8 pa3) {
  pv_one<0>(o[0], vb, pa0, pa1, pa2, pa3); pv_one<1>(o[1], vb, pa0, pa1, pa2, pa3); pv_one<2>(o[2], vb, pa0, pa1, pa2, pa3); pv_one<3>(o[3], vb, pa0, pa1, pa2, pa3);
}
__device__ __forceinline__ void cmask(f32x16& p0, f32x16& p1, int tile, int qloc, int hi) {
#pragma unroll
  for (int r = 0; r < 16; ++r) { const int key = 64 * tile + crow(r, hi); if (key > qloc) p0[r] = -1e30f; if (key + 32 > qloc) p1[r] = -1e30f; }
}
#ifndef MOBA_STAGGER
#define MOBA_STAGGER 24
#endif
constexpr int MAXWC = 24;
constexpr int TILE_B = 16384;
__device__ __forceinline__ void wave_chunk(const bf16x8 (&qr)[8], int nt, bool causal, int qloc, const char* K_lds, int vb0, float* ws, unsigned rowoff, unsigned lseoff, unsigned char* wsb, int r32, int hi) {
  float* li_l = ws; float* al_l = ws + 32; unsigned* id_l = (unsigned*)(ws + 64);
  float m_reg = -1e30f, l_reg = 0; f32x16 o[4] = {};
#pragma unroll 1
  for (int t = 0; t < nt; ++t) {
    f32x16 p0, p1; float mn, alpha; bf16x8 pa0, pa1, pa2, pa3;
    __builtin_amdgcn_s_setprio(1); qkt(p0, p1, K_lds + t * TILE_B, qr, r32, hi); __builtin_amdgcn_s_setprio(0);
    if (causal && t == nt - 1) cmask(p0, p1, t, qloc, hi);
    partialSM(p0, p1, m_reg, mn, alpha);
    finishSM(p0, p1, alpha, l_reg, pa0, pa1, pa2, pa3);
    if (__any(alpha < 1.f)) { if (hi == 0) al_l[r32] = alpha; asm volatile("s_waitcnt lgkmcnt(0)" ::: "memory");
#pragma unroll
      for (int d = 0; d < 4; ++d)
#pragma unroll
        for (int r = 0; r < 16; ++r) o[d][r] *= al_l[crow(r, hi)]; }
    SBAR();
    __builtin_amdgcn_s_setprio(1); pv_d0(o, vb0 + t * TILE_B, pa0, pa1, pa2, pa3); __builtin_amdgcn_s_setprio(0);
  }
  if (hi == 0) { li_l[r32] = l_reg; id_l[r32] = rowoff; *(float*)(wsb + lseoff) = m_reg * (SCALE * 1.4426950408889634f) + __builtin_amdgcn_logf(l_reg); }
  asm volatile("s_waitcnt lgkmcnt(0)" ::: "memory");
#pragma unroll
  for (int r = 0; r < 16; ++r) { const int orow = crow(r, hi); const unsigned off = id_l[orow]; const float rl = __builtin_amdgcn_rcpf(li_l[orow]);
    unsigned short* dst = (unsigned short*)(wsb + off) + r32;
#pragma unroll
    for (int d0 = 0; d0 < 4; ++d0) dst[d0 * 32] = (unsigned short)(cvtpk(o[d0][r] * rl, 0.f)); }
  asm volatile("s_waitcnt lgkmcnt(0)" ::: "memory");
}
#undef KSWZ
}

__device__ __forceinline__ void moba_attn_phase(Frame& F) {
    constexpr int SCR_OFF = LDSCTL_OFF + 1024, PREF_OFF = SCR_OFF + 4096;
    LAS int* prefF = (LAS int*)(F.lds + PREF_OFF);
    LAS int* prefP = prefF + 520;
    LAS int* wsum = prefP + 520;
    LAS int* tk = wsum + 16;
    const int tid = F.tid;
    {   const unsigned n = __hip_atomic_load(F.ctl + CW_CNT + tid, __ATOMIC_RELAXED, __HIP_MEMORY_SCOPE_AGENT);
        const int wc = 8 + (int)((n + 31u) >> 5); const int nf = wc / moba::MAXWC, np = (wc % moba::MAXWC) ? 1 : 0;
        int v = nf, u = np;
#pragma unroll
        for (int o = 1; o < 64; o <<= 1) { const int t = __shfl_up(v, o), t2 = __shfl_up(u, o); if (F.lane >= o) { v += t; u += t2; } }
        if (F.lane == 63) { wsum[F.wave] = v; wsum[8 + F.wave] = u; }
        __syncthreads();
        int add = 0, add2 = 0;
#pragma unroll
        for (int w = 0; w < 8; ++w) { add += (w < F.wave) ? wsum[w] : 0; add2 += (w < F.wave) ? wsum[8 + w] : 0; }
        prefF[tid] = v - nf + add; prefP[tid] = u - np + add2;
        if (tid == 511) { prefF[512] = v + add; prefP[512] = u + add2; }
        if (tid == 0) tk[0] = (int)atomicAdd((unsigned*)(F.ctl + CW_QUEUE), 1u);
        __syncthreads();
    }
    const int totalF = prefF[512], total = totalF + prefP[512];
    const unsigned short* MIXq = (const unsigned short*)(F.ws + WS_MIX) + 1024;
    const unsigned short* KB = (const unsigned short*)(F.ws + WS_KB); const unsigned short* VB = (const unsigned short*)(F.ws + WS_VB);
    const unsigned* lists = (const unsigned*)(F.ws + WS_LISTS);
    const int r32 = F.lane & 31, hi = F.lane >> 5, w = F.wave;
    char* K_lds = (char*)F.lds; char* V_lds = (char*)F.lds + 4 * moba::TILE_B;
    float* scr = (float*)((char*)F.lds + SCR_OFF) + w * 128;
    const int vb0 = (int)(uintptr_t)V_lds + moba::v_rd_base(F.lane);
    const int sr = tid >> 4, sc = (tid & 15) * 8, vst0 = moba::v_st(sr, sc), vst1 = moba::v_st(32 + sr, sc);
    int it = tk[0];
    while (it < total) {
        const bool isfull = it < totalF; const int r_ = isfull ? it : it - totalF; LAS int* pref = isfull ? prefF : prefP;
        int lo = 0, hi_ = 512;
        while (hi_ - lo > 1) { const int mid = (lo + hi_) >> 1; if (pref[mid] <= r_) lo = mid; else hi_ = mid; }
        const int e = lo, h = e >> 6, j = e & 63;
        const int n = (int)__hip_atomic_load(F.ctl + CW_CNT + e, __ATOMIC_RELAXED, __HIP_MEMORY_SCOPE_AGENT);
        const int wc_e = 8 + ((n + 31) >> 5); const int sub = isfull ? (r_ - pref[e]) : (wc_e / moba::MAXWC);
        const int q_lo = sub * moba::MAXWC, q_hi = (q_lo + moba::MAXWC < wc_e) ? q_lo + moba::MAXWC : wc_e;
        const unsigned short* Kh = KB + (size_t)(j * 256) * 1024 + h * 128; const unsigned short* Vh = VB + (size_t)(j * 256) * 1024 + h * 128;
        { TPA_BEGIN(130);
        __syncthreads();
        if (tid == 0) tk[0] = (int)atomicAdd((unsigned*)(F.ctl + CW_QUEUE), 1u);
        {   bf16x8 kv[16];
#pragma unroll
            for (int tt = 0; tt < 4; ++tt) { const int k0 = tt * 64;
                kv[4 * tt + 0] = *(const bf16x8*)(Vh + (size_t)(k0 + sr) * 1024 + sc); kv[4 * tt + 1] = *(const bf16x8*)(Vh + (size_t)(k0 + 32 + sr) * 1024 + sc);
                kv[4 * tt + 2] = *(const bf16x8*)(Kh + (size_t)(k0 + sr) * 1024 + sc); kv[4 * tt + 3] = *(const bf16x8*)(Kh + (size_t)(k0 + 32 + sr) * 1024 + sc); }
#pragma unroll
            for (int tt = 0; tt < 4; ++tt) { const int tb = tt * moba::TILE_B, kc = sc * 2;
                *(bf16x8*)(V_lds + tb + vst0) = kv[4 * tt + 0]; *(bf16x8*)(V_lds + tb + vst1) = kv[4 * tt + 1];
                *(bf16x8*)(K_lds + tb + ((sr) * 256 + ((kc) ^ (((sr) & 7) << 4)))) = kv[4 * tt + 2];
                *(bf16x8*)(K_lds + tb + ((32 + sr) * 256 + ((kc) ^ (((32 + sr) & 7) << 4)))) = kv[4 * tt + 3]; }
        }
        __syncthreads();
        TPA_END(130); }
        it = tk[0];
        TPA_BEGIN(131);
        if (w >= 4) __builtin_amdgcn_s_sleep(MOBA_STAGGER);
        bf16x8 qa[8], qb[8]; unsigned ida = 0, idb = 0, lsa = 0, lsb = 0; int nta = 4, ntb = 4, qla = 0, qlb = 0; bool ca = false, cb = false;
        const unsigned dump = (unsigned)WS_KWT + (unsigned)((F.bid * 8 + w) * 512);
#define PART_OFF(slot_) ((unsigned)(((slot_) & 2) ? WS_PART2 : WS_PART0) + (unsigned)((slot_) & 1) * (unsigned)(32 * MiB))
#define WC_SETUP(Q_, QF, ID, LS, NT, QL, CZ) do { const int q__ = (Q_); const unsigned short* qp__; \
        if (q__ < 8) { const int p__ = j * 256 + 32 * q__ + r32; qp__ = MIXq + (size_t)p__ * 2048 + h * 128 + hi * 8; ID = PART_OFF(3) + (unsigned)(p__ * 8 + h) * 256u; LS = (unsigned)WS_LSE + (unsigned)((p__ * 8 + h) * 4 + 3) * 4u; NT = (q__ >> 1) + 1; QL = 32 * q__ + r32; CZ = true; } \
        else { const int idx__ = 32 * (q__ - 8) + r32; const bool v__ = idx__ < n; const unsigned ent__ = lists[list_off(h, j) + (v__ ? idx__ : 0)]; const int p__ = (int)(ent__ >> 2); const int sl__ = (int)(ent__ & 3u); \
               qp__ = MIXq + (size_t)p__ * 2048 + h * 128 + hi * 8; ID = v__ ? PART_OFF(sl__) + (unsigned)(p__ * 8 + h) * 256u : dump; LS = v__ ? (unsigned)WS_LSE + (unsigned)((p__ * 8 + h) * 4 + sl__) * 4u : dump + 256u; NT = 4; QL = 0; CZ = false; } \
        _Pragma("unroll") for (int d0 = 0; d0 < 8; ++d0) QF[d0] = *reinterpret_cast<const bf16x8*>(qp__ + d0 * 16); } while (0)
        int q = q_lo + w;
        if (q < q_hi) WC_SETUP(q, qa, ida, lsa, nta, qla, ca);
        while (q < q_hi) {
            if (q + 8 < q_hi) WC_SETUP(q + 8, qb, idb, lsb, ntb, qlb, cb);
            moba::wave_chunk(qa, nta, ca, qla, K_lds, vb0, scr, ida, lsa, F.ws, r32, hi);
            q += 8; if (q >= q_hi) break;
            if (q + 8 < q_hi) WC_SETUP(q + 8, qa, ida, lsa, nta, qla, ca);
            moba::wave_chunk(qb, ntb, cb, qlb, K_lds, vb0, scr, idb, lsb, F.ws, r32, hi);
            q += 8;
        }
#undef PART_OFF
#undef WC_SETUP
        TPA_END(131);
    }
}

__device__ __forceinline__ void moba_merge_phase(Frame& F, int wg, int nwg) {
    const float* lse = (const float*)(F.ws + WS_LSE);
    const u32x4v* P0 = (const u32x4v*)(F.ws + WS_PART0); const u32x4v* P1 = (const u32x4v*)(F.ws + WS_PART1);
    const u32x4v* P2 = (const u32x4v*)(F.ws + WS_PART2); const u32x4v* P3 = (const u32x4v*)(F.ws + WS_PART3);
    for (int g = wg * 512 + F.tid; g < M_TOK * MB_H * 16; g += nwg * 512) {
        const int ph = g >> 4, dg = g & 15, p = ph >> 3;
#if defined(DBG_OWN_ONLY)
        const int nsel = 0;
#else
        const int nsel = (p >> 8) < 3 ? (p >> 8) : 3;
#endif
        const f32x4 l4 = *(const f32x4*)(lse + (size_t)ph * 4);
        const size_t po = (size_t)ph * 16 + dg;
        const u32x4v v0 = P0[po], v1 = P1[po], v2 = P2[po], v3 = P3[po];
        const float l0 = nsel > 0 ? l4[0] : -INFINITY, l1 = nsel > 1 ? l4[1] : -INFINITY, l2 = nsel > 2 ? l4[2] : -INFINITY, l3 = l4[3];
        const float mx = fmaxf(fmaxf(l0, l1), fmaxf(l2, l3));
        const float w0 = nsel > 0 ? __builtin_amdgcn_exp2f(l0 - mx) : 0.f, w1 = nsel > 1 ? __builtin_amdgcn_exp2f(l1 - mx) : 0.f, w2 = nsel > 2 ? __builtin_amdgcn_exp2f(l2 - mx) : 0.f, w3 = __builtin_amdgcn_exp2f(l3 - mx);
        const u32x4v z = {0u, 0u, 0u, 0u};
        const u32x4v a0 = nsel > 0 ? v0 : z, a1 = nsel > 1 ? v1 : z, a2 = nsel > 2 ? v2 : z;
        const float inv = 1.f / ((w0 + w1) + (w2 + w3));
        float acc[8];
#define MRG(E, F_) acc[E] = (w0 * F_(a0[E >> 1]) + w1 * F_(a1[E >> 1])) + (w2 * F_(a2[E >> 1]) + w3 * F_(v3[E >> 1]))
        MRG(0, bflo); MRG(1, bfhi); MRG(2, bflo); MRG(3, bfhi); MRG(4, bflo); MRG(5, bfhi); MRG(6, bflo); MRG(7, bfhi);
#undef MRG
        u32x4v o; o.x = pk2(acc[0] * inv, acc[1] * inv); o.y = pk2(acc[2] * inv, acc[3] * inv); o.z = pk2(acc[4] * inv, acc[5] * inv); o.w = pk2(acc[6] * inv, acc[7] * inv);
        *(u32x4v*)((unsigned short*)(F.ws + WS_MIX) + (size_t)p * 2048 + 1024 + (ph & 7) * 128 + dg * 8) = o;
    }
}

__device__ __forceinline__ void ml_mscan(const float* chsum, int h, int c, int lane, float& m_c, float& m_c1) {
    float a[4], g[4]; float A = 0.f, G = -INFINITY;
#pragma unroll
    for (int i = 0; i < 4; ++i) { const int cc = 4 * lane + i; const float bl = chsum[(cc * 4 + h) * 2], m1 = chsum[(cc * 4 + h) * 2 + 1]; a[i] = bl; g[i] = bl + m1; G = fmaxf(G + a[i], g[i]); A += a[i]; }
#pragma unroll
    for (int o = 1; o < 64; o <<= 1) { const float Ao = __shfl_up(A, o), Go = __shfl_up(G, o); if (lane >= o) { G = fmaxf(Go + A, G); A = Ao + A; } }
    float Ae = __shfl_up(A, 1), Ge = __shfl_up(G, 1); if (lane == 0) { Ae = 0.f; Ge = -INFINITY; }
    float m = fmaxf(Ae, Ge), mc = 0.f, mc1 = 0.f;
#pragma unroll
    for (int i = 0; i < 4; ++i) { if (i == (c & 3)) mc = m; m = fmaxf(m + a[i], g[i]); if (i == (c & 3)) mc1 = m; }
    m_c = __shfl(mc, c >> 2); m_c1 = __shfl(mc1, c >> 2);
}
__device__ __forceinline__ void ml_tables(const float* chsum, int h, int lane, LAS float* dec, LAS float* scl) {
    float a[4], g[4]; float A = 0.f, G = -INFINITY;
#pragma unroll
    for (int i = 0; i < 4; ++i) { const int cc = 4 * lane + i; const float bl = chsum[(cc * 4 + h) * 2], m1 = chsum[(cc * 4 + h) * 2 + 1]; a[i] = bl; g[i] = bl + m1; G = fmaxf(G + a[i], g[i]); A += a[i]; }
#pragma unroll
    for (int o = 1; o < 64; o <<= 1) { const float Ao = __shfl_up(A, o), Go = __shfl_up(G, o); if (lane >= o) { G = fmaxf(Go + A, G); A = Ao + A; } }
    float Ae = __shfl_up(A, 1), Ge = __shfl_up(G, 1); if (lane == 0) { Ae = 0.f; Ge = -INFINITY; }
    float m = fmaxf(Ae, Ge);
#pragma unroll
    for (int i = 0; i < 4; ++i) { const float mn = fmaxf(m + a[i], g[i]); dec[4 * lane + i] = expf(a[i] + m - mn); scl[4 * lane + i] = expf(g[i] - mn); m = mn; }
}
__device__ __forceinline__ void ml_scan_item(Frame& F, int item) {
    LAS float* dec = (LAS float*)F.lds; LAS float* scl = dec + 1024;
    if (item < 32) {
        const int gid = item * 512 + F.tid, h = gid >> 12, rem = gid & 4095;
        if (F.wave == 0) ml_tables(SMALLF(SM_CHSUM), h, F.lane, dec, scl);
        __syncthreads();
        u32x4v* base = (u32x4v*)((unsigned short*)(F.ws + WS_LOCAL) + (size_t)h * 256 * 128) + rem;
        constexpr size_t CST = (size_t)4 * 256 * 128 / 8;
        float C[8];
#pragma unroll
        for (int e = 0; e < 8; ++e) C[e] = 0.f;
        u32x4v la[16], lb[16];
#define SC_LOAD(L, c0_) do { _Pragma("unroll") for (int i = 0; i < 16; ++i) L[i] = base[(size_t)((c0_) + i) * CST]; } while (0)
#define SC_STEP(L, c0_) do { _Pragma("unroll") for (int i = 0; i < 16; ++i) { \
            u32x4v st; st.x = cvtpk(C[0], C[1]); st.y = cvtpk(C[2], C[3]); st.z = cvtpk(C[4], C[5]); st.w = cvtpk(C[6], C[7]); \
            base[(size_t)((c0_) + i) * CST] = st; \
            const u32x4v v = L[i]; const float d = dec[(c0_) + i], s = scl[(c0_) + i]; \
            C[0] = d * C[0] + s * bflo(v.x); C[1] = d * C[1] + s * bfhi(v.x); C[2] = d * C[2] + s * bflo(v.y); C[3] = d * C[3] + s * bfhi(v.y); \
            C[4] = d * C[4] + s * bflo(v.z); C[5] = d * C[5] + s * bfhi(v.z); C[6] = d * C[6] + s * bflo(v.w); C[7] = d * C[7] + s * bfhi(v.w); } } while (0)
        SC_LOAD(la, 0);
#pragma unroll 1
        for (int c0 = 0; c0 < ML_NC; c0 += 32) {
            SC_LOAD(lb, c0 + 16);
            SC_STEP(la, c0);
            if (c0 + 32 < ML_NC) SC_LOAD(la, c0 + 32);
            SC_STEP(lb, c0 + 16);
        }
#undef SC_LOAD
#undef SC_STEP
        __syncthreads();
    } else {
        if (F.wave < 4) ml_tables(SMALLF(SM_CHSUM), F.wave, F.lane, dec + F.wave * 256, scl + F.wave * 256);
        __syncthreads();
        const int h = F.tid >> 7, d = F.tid & 127; float* nl = SMALLF(SM_NLOC) + h * 128 + d; float n = 0.f;
#pragma unroll 1
        for (int c0 = 0; c0 < ML_NC; c0 += 32) {
            float lv[32];
#pragma unroll
            for (int i = 0; i < 32; ++i) lv[i] = nl[(size_t)(c0 + i) * 512];
#pragma unroll
            for (int i = 0; i < 32; ++i) { nl[(size_t)(c0 + i) * 512] = n; n = dec[h * 256 + c0 + i] * n + scl[h * 256 + c0 + i] * lv[i]; }
        }
        __syncthreads();
    }
}
__device__ __forceinline__ float dpp_row_sum(float x) {
    x += __builtin_bit_cast(float, __builtin_amdgcn_update_dpp(0, __builtin_bit_cast(int, x), 0xB1, 0xF, 0xF, true));
    x += __builtin_bit_cast(float, __builtin_amdgcn_update_dpp(0, __builtin_bit_cast(int, x), 0x4E, 0xF, 0xF, true));
    x += __builtin_bit_cast(float, __builtin_amdgcn_update_dpp(0, __builtin_bit_cast(int, x), 0x141, 0xF, 0xF, true));
    x += __builtin_bit_cast(float, __builtin_amdgcn_update_dpp(0, __builtin_bit_cast(int, x), 0x140, 0xF, 0xF, true));
    return x;
}
struct MlRegs { v4u gq[2], gk[2], gm[4]; bf16x8 cf[8]; u32x2 vlo[4], vhi[4]; };
__device__ __forceinline__ void ml_load_tiles(Frame& F, int c, int h, MlRegs& R) {
    const int tid = F.tid, t0 = c * ML_L;
    const v4u* QC = (const v4u*)(F.ws + WS_QC); const v4u* KC = (const v4u*)(F.ws + WS_KC); const v4u* MX = (const v4u*)(F.ws + WS_MIX);
#pragma unroll
    for (int i = 0; i < 2; ++i) { const int idx = tid + 512 * i, row = idx >> 4, ch = idx & 15; R.gq[i] = QC[(size_t)(t0 + row) * 64 + h * 16 + ch]; R.gk[i] = KC[(size_t)(t0 + row) * 64 + h * 16 + ch]; }
    (void)MX;
}
__device__ __forceinline__ void ml_load_state(Frame& F, int c, int h, MlRegs& R) {
    const int hh = F.lane >> 5, vcol = 32 * F.wave + (F.lane & 31);
    const unsigned short* ST = (const unsigned short*)(F.ws + WS_LOCAL) + (size_t)(c * 4 + h) * 256 * 128 + (size_t)vcol * 8;
#pragma unroll
    for (int kd = 0; kd < 8; ++kd) R.cf[kd] = *(const bf16x8*)(ST + (2 * kd + hh) * 2048);
}
__device__ __forceinline__ void ml_load_vt(Frame& F, int c, int h, MlRegs& R) {
    const int hh = F.lane >> 5, vcol = 32 * F.wave + (F.lane & 31);
    const unsigned short* VTv = (const unsigned short*)(F.ws + WS_VT) + (size_t)(c * 4 + h) * 256 * 64 + (size_t)vcol * 4;
#pragma unroll
    for (int i = 0; i < 4; ++i) { R.vlo[i] = *(const u32x2*)(VTv + (4 * i + hh) * 1024); R.vhi[i] = *(const u32x2*)(VTv + (4 * i + 2 + hh) * 1024); }
}
__device__ __forceinline__ void ml_out_item(Frame& F, int c, int h, MlRegs& R, bool has_next, int cn, int hn) {
    const int lane = F.lane, r = lane & 31, hh = lane >> 5, w = F.wave, tid = F.tid, t0 = c * ML_L;
    constexpr int QS = 136, MS = 264;
    LAS float* tb_u = (LAS float*)F.lds;
    LAS float* tb_mt = tb_u + 64;
    LAS float* tb_wi = tb_mt + 64;
    LAS float* tb_em = tb_wi + 64;
    LAS float* tb_n = tb_em + 64;
    LAS float* tb_den = tb_n + 128;
    LAS float* tb_ln = tb_den + 512;
    LAS float* tb_mr = tb_ln + 1024;
    LAS unsigned short* Ql = (LAS unsigned short*)(F.lds + 8192);
    LAS unsigned short* Kl = Ql + 64 * QS;
    LAS unsigned short* Ml = Kl + 64 * QS;
    const int vcol = 32 * w + r;
    ml_load_tiles(F, c, h, R);
    {   const v4u* MX = (const v4u*)(F.ws + WS_MIX);
#pragma unroll
        for (int i = 0; i < 4; ++i) { const int idx = tid + 512 * i, row = idx >> 5, ch = idx & 31; R.gm[i] = MX[(size_t)(t0 + row) * 256 + h * 32 + ch]; } }
    float m_c, m_c1; ml_mscan(SMALLF(SM_CHSUM), h, c, lane, m_c, m_c1);
    if (tid < 64) { const f32x4 ts = *(const f32x4*)(SMALLF(SM_TOKSC) + (size_t)((t0 + tid) * 4 + h) * 4);
        const float mt = fmaxf(m_c, ts.z); tb_u[tid] = ts.y; tb_mt[tid] = mt; tb_wi[tid] = expf(m_c - mt); tb_em[tid] = expf(-(ts.x + mt)); }
    if (tid >= 64 && tid < 192) tb_n[tid - 64] = SMALLF(SM_NLOC)[(c * 4 + h) * 128 + tid - 64];
#pragma unroll
    for (int i = 0; i < 2; ++i) { const int idx = tid + 512 * i, row = idx >> 4, ch = idx & 15; *(LAS v4u*)(Ql + row * QS + ch * 8) = R.gq[i]; *(LAS v4u*)(Kl + row * QS + ch * 8) = R.gk[i]; }
#pragma unroll
    for (int i = 0; i < 4; ++i) { const int idx = tid + 512 * i, row = idx >> 5, ch = idx & 31; *(LAS v4u*)(Ml + row * MS + ch * 8) = R.gm[i]; }
    __syncthreads();
    f32x16 s00 = {}, s01 = {}, s11 = {};
    float qn0 = 0.f, qn1 = 0.f;
#pragma unroll 1
    for (int kd = 0; kd < 8; ++kd) {
        const bf16x8 q0 = *(const LAS bf16x8*)(Ql + r * QS + 16 * kd + 8 * hh), q1 = *(const LAS bf16x8*)(Ql + (32 + r) * QS + 16 * kd + 8 * hh);
        const bf16x8 k0 = *(const LAS bf16x8*)(Kl + r * QS + 16 * kd + 8 * hh), k1 = *(const LAS bf16x8*)(Kl + (32 + r) * QS + 16 * kd + 8 * hh);
        s00 = MFMA32(k0, q0, s00); s01 = MFMA32(k0, q1, s01); s11 = MFMA32(k1, q1, s11);
        const f32x4 n0 = *(const LAS f32x4*)(tb_n + 16 * kd + 8 * hh), n1 = *(const LAS f32x4*)(tb_n + 16 * kd + 8 * hh + 4);
        const u32x4v a = __builtin_bit_cast(u32x4v, q0), b = __builtin_bit_cast(u32x4v, q1);
        qn0 += bflo(a.x) * n0.x + bfhi(a.x) * n0.y + bflo(a.y) * n0.z + bfhi(a.y) * n0.w + bflo(a.z) * n1.x + bfhi(a.z) * n1.y + bflo(a.w) * n1.z + bfhi(a.w) * n1.w;
        qn1 += bflo(b.x) * n0.x + bfhi(b.x) * n0.y + bflo(b.y) * n0.z + bfhi(b.y) * n0.w + bflo(b.z) * n1.x + bfhi(b.z) * n1.y + bflo(b.w) * n1.z + bfhi(b.w) * n1.w;
    }
    const float mt0 = tb_mt[r], mt1 = tb_mt[32 + r];
    float rs0 = 0.f, rs1 = 0.f;
#pragma unroll
    for (int q = 0; q < 16; ++q) {
        const int s = crow(q, hh); const float u0 = tb_u[s], u1 = tb_u[32 + s];
        s00[q] = (s <= r) ? s00[q] * __expf(u0 - mt0) : 0.f;
        s01[q] = s01[q] * __expf(u0 - mt1);
        s11[q] = (s <= r) ? s11[q] * __expf(u1 - mt1) : 0.f;
        rs0 += s00[q]; rs1 += s01[q] + s11[q];
    }
    rs0 += __shfl_xor(rs0, 32); rs1 += __shfl_xor(rs1, 32); qn0 += __shfl_xor(qn0, 32); qn1 += __shfl_xor(qn1, 32);
    {   const float den0 = tb_wi[r] * qn0 + rs0, den1 = tb_wi[32 + r] * qn1 + rs1;
        if (hh == 0) { tb_den[w * 64 + r] = 1.f / fmaxf(fabsf(den0), tb_em[r]); tb_den[w * 64 + 32 + r] = 1.f / fmaxf(fabsf(den1), tb_em[32 + r]); } }
    bf16x8 p00[2], p01[2], p11[2];
#pragma unroll
    for (int ks = 0; ks < 2; ++ks) {
        u32x4v x; x.x = cvtpk(s00[8 * ks], s00[8 * ks + 1]); x.y = cvtpk(s00[8 * ks + 2], s00[8 * ks + 3]); x.z = cvtpk(s00[8 * ks + 4], s00[8 * ks + 5]); x.w = cvtpk(s00[8 * ks + 6], s00[8 * ks + 7]); p00[ks] = __builtin_bit_cast(bf16x8, x);
        x.x = cvtpk(s01[8 * ks], s01[8 * ks + 1]); x.y = cvtpk(s01[8 * ks + 2], s01[8 * ks + 3]); x.z = cvtpk(s01[8 * ks + 4], s01[8 * ks + 5]); x.w = cvtpk(s01[8 * ks + 6], s01[8 * ks + 7]); p01[ks] = __builtin_bit_cast(bf16x8, x);
        x.x = cvtpk(s11[8 * ks], s11[8 * ks + 1]); x.y = cvtpk(s11[8 * ks + 2], s11[8 * ks + 3]); x.z = cvtpk(s11[8 * ks + 4], s11[8 * ks + 5]); x.w = cvtpk(s11[8 * ks + 6], s11[8 * ks + 7]); p11[ks] = __builtin_bit_cast(bf16x8, x);
    }
    f32x16 o0 = {}, o1 = {};
#pragma unroll
    for (int kd = 0; kd < 8; ++kd) {
        const bf16x8 q0 = *(const LAS bf16x8*)(Ql + r * QS + 16 * kd + 8 * hh), q1 = *(const LAS bf16x8*)(Ql + (32 + r) * QS + 16 * kd + 8 * hh);
        o0 = MFMA32(q0, R.cf[kd], o0); o1 = MFMA32(q1, R.cf[kd], o1); }
    asm volatile("" ::: "memory");
    if (has_next) ml_load_state(F, cn, hn, R);
#pragma unroll
    for (int q = 0; q < 16; ++q) { o0[q] *= tb_wi[crow(q, hh)]; o1[q] *= tb_wi[32 + crow(q, hh)]; }
#pragma unroll
    for (int st = 0; st < 2; ++st)
#pragma unroll
        for (int ks = 0; ks < 2; ++ks) {
            u32x4v bb; bb.x = R.vlo[2 * st + ks].x; bb.y = R.vlo[2 * st + ks].y; bb.z = R.vhi[2 * st + ks].x; bb.w = R.vhi[2 * st + ks].y; const bf16x8 vf = __builtin_bit_cast(bf16x8, bb);
            if (st == 0) { o0 = MFMA32(p00[ks], vf, o0); o1 = MFMA32(p01[ks], vf, o1); } else { o1 = MFMA32(p11[ks], vf, o1); }
        }
    asm volatile("" ::: "memory");
    if (has_next) ml_load_vt(F, cn, hn, R);
#pragma unroll
    for (int q = 0; q < 16; ++q) { o0[q] *= tb_den[w * 64 + crow(q, hh)]; o1[q] *= tb_den[w * 64 + 32 + crow(q, hh)]; }
#pragma unroll
    for (int q = 0; q < 16; ++q) {
        float a = dpp_row_sum(o0[q]), a2 = dpp_row_sum(o0[q] * o0[q]), b = dpp_row_sum(o1[q]), b2 = dpp_row_sum(o1[q] * o1[q]);
        a += __shfl_xor(a, 16); a2 += __shfl_xor(a2, 16); b += __shfl_xor(b, 16); b2 += __shfl_xor(b2, 16);
        if (r == 0) { const int t = crow(q, hh); tb_ln[(w * 64 + t) * 2] = a; tb_ln[(w * 64 + t) * 2 + 1] = a2; tb_ln[(w * 64 + 32 + t) * 2] = b; tb_ln[(w * 64 + 32 + t) * 2 + 1] = b2; }
    }
    __syncthreads();
    if (tid < 64) { float s = 0.f, s2 = 0.f;
#pragma unroll
        for (int ww = 0; ww < 8; ++ww) { s += tb_ln[(ww * 64 + tid) * 2]; s2 += tb_ln[(ww * 64 + tid) * 2 + 1]; }
        const float mu = s * (1.f / 256.f), var = fmaxf(s2 * (1.f / 256.f) - mu * mu, 0.f); tb_mr[tid * 2] = mu; tb_mr[tid * 2 + 1] = rsqrtf(var + LN_EPS); }
    __syncthreads();
    const float nw = F.normw[h * 256 + vcol];
#pragma unroll
    for (int tt = 0; tt < 2; ++tt)
#pragma unroll
        for (int q = 0; q < 16; ++q) {
            const int t = 32 * tt + crow(q, hh); const float mu = tb_mr[t * 2], rstd = tb_mr[t * 2 + 1];
            const float hv = tt ? o1[q] : o0[q];
            LAS unsigned short* op = Ml + t * MS + vcol; const float mo = bf2f(*op);
            *op = (unsigned short)f2bf((hv - mu) * rstd * nw * sigmoid_f(mo));
        }
    __syncthreads();
    {   v4u* MX = (v4u*)(F.ws + WS_MIX);
#pragma unroll
        for (int i = 0; i < 4; ++i) { const int idx = tid + 512 * i, row = idx >> 5, ch = idx & 31; MX[(size_t)(t0 + row) * 256 + h * 32 + ch] = *(LAS v4u*)(Ml + row * MS + ch * 8); } }
    __syncthreads();
}

constexpr int ML_BLK = 73728;
struct MlRegs2 { bf16x8 cf[8]; u32x2 vlo[4], vhi[4]; };
__device__ __forceinline__ void ml2_load_state(Frame& F, int c, int h, int vcol, int hh, bf16x8 (&cf)[8]) {
    const GAS char* sb = (const GAS char*)(F.ws + WS_LOCAL) + (size_t)__builtin_amdgcn_readfirstlane((c * 4 + h) * 65536);
    unsigned vo = (unsigned)(vcol * 16 + hh * 4096); asm volatile("" : "+v"(vo));
#pragma unroll
    for (int kd = 0; kd < 8; ++kd) cf[kd] = *(const GAS bf16x8*)(sb + vo + kd * 8192);
}
__device__ __forceinline__ void ml2_load_vt(Frame& F, int c, int h, int vcol, int hh, u32x2 (&vlo)[4], u32x2 (&vhi)[4]) {
    const GAS char* sb = (const GAS char*)(F.ws + WS_VT) + (size_t)__builtin_amdgcn_readfirstlane((c * 4 + h) * 32768);
    unsigned vo = (unsigned)(vcol * 8 + hh * 2048); asm volatile("" : "+v"(vo));
#pragma unroll
    for (int i = 0; i < 4; ++i) { vlo[i] = *(const GAS u32x2*)(sb + vo + i * 8192); vhi[i] = *(const GAS u32x2*)(sb + vo + i * 8192 + 4096); }
}
__device__ __forceinline__ void ml_out_item2(Frame& F, int c, int h, MlRegs2& R, bool has_next, int cn, int hn) {
    const int lane = F.lane, r = lane & 31, hh = lane >> 5, w = F.wave, half = w >> 2, w4 = w & 3, ltid = F.tid & 255, t0 = c * ML_L;
    constexpr int QS = 136, MS = 264;
    const int lbase = half * ML_BLK;
    LAS float* tb_u = (LAS float*)(F.lds + lbase);
    LAS float* tb_mt = tb_u + 64;
    LAS float* tb_wi = tb_mt + 64;
    LAS float* tb_em = tb_wi + 64;
    LAS float* tb_n = tb_em + 64;
    LAS float* tb_den = tb_n + 128;
    LAS float* tb_ln = tb_den + 256;
    LAS float* tb_mr = tb_ln + 512;
    LAS unsigned short* Ql = (LAS unsigned short*)(F.lds + lbase + 5120);
    LAS unsigned short* Kl = Ql + 64 * QS;
    LAS unsigned short* Ml = Kl + 64 * QS;
    const int vcA = 64 * w4 + r, vcB = vcA + 32;
#define CR(q) (((q) & 3) + 8 * ((q) >> 2))
    LAS float* ub = tb_u + 4 * hh; LAS float* wib = tb_wi + 4 * hh; LAS float* denb = tb_den + w4 * 64 + 4 * hh; LAS float* lnb = tb_ln + (w4 * 64 + 4 * hh) * 2; LAS float* mrb = tb_mr + 8 * hh;
    LAS unsigned short* mlb = Ml + 4 * hh * MS + vcA;
    LAS unsigned short* qb0 = Ql + r * QS + 8 * hh; LAS unsigned short* kb0 = Kl + r * QS + 8 * hh; LAS float* nb = tb_n + 8 * hh;
    asm volatile("" : "+v"(ub), "+v"(wib), "+v"(denb), "+v"(lnb), "+v"(mrb), "+v"(mlb), "+v"(qb0), "+v"(kb0), "+v"(nb));
    const int r4 = r - 4 * hh;
    const int rowq = ltid >> 4, chq = ltid & 15, rowm = ltid >> 5, chm = ltid & 31;
    LAS unsigned short* qld = Ql + rowq * QS + chq * 8; LAS unsigned short* kld = Kl + rowq * QS + chq * 8; LAS unsigned short* mld = Ml + rowm * MS + chm * 8;
    {
        const v4u* qsrc = (const v4u*)(F.ws + WS_QC) + (size_t)(t0 + rowq) * 64 + h * 16 + chq; const v4u* ksrc = (const v4u*)(F.ws + WS_KC) + (size_t)(t0 + rowq) * 64 + h * 16 + chq;
        const v4u* msrc = (const v4u*)(F.ws + WS_MIX) + (size_t)(t0 + rowm) * 256 + h * 32 + chm;
        v4u gq[4], gk[4];
#pragma unroll
        for (int i = 0; i < 4; ++i) { gq[i] = qsrc[i * 16 * 64]; gk[i] = ksrc[i * 16 * 64]; }
        float m_c, m_c1; ml_mscan(SMALLF(SM_CHSUM), h, c, lane, m_c, m_c1);
        if (ltid < 64) { const f32x4 ts = *(const f32x4*)(SMALLF(SM_TOKSC) + (size_t)((t0 + ltid) * 4 + h) * 4);
            const float mt = fmaxf(m_c, ts.z); tb_u[ltid] = ts.y; tb_mt[ltid] = mt; tb_wi[ltid] = expf(m_c - mt); tb_em[ltid] = expf(-(ts.x + mt)); }
        if (ltid >= 64 && ltid < 192) tb_n[ltid - 64] = SMALLF(SM_NLOC)[(c * 4 + h) * 128 + ltid - 64];
#pragma unroll
        for (int i = 0; i < 4; ++i) { *(LAS v4u*)(qld + i * 16 * QS) = gq[i]; *(LAS v4u*)(kld + i * 16 * QS) = gk[i]; }
        asm volatile("" ::: "memory");
        v4u gm[8];
#pragma unroll
        for (int i = 0; i < 8; ++i) gm[i] = msrc[i * 8 * 256];
#pragma unroll
        for (int i = 0; i < 8; ++i) *(LAS v4u*)(mld + i * 8 * MS) = gm[i];
    }
    __syncthreads();
    f32x16 s00 = {}, s01 = {}, s11 = {};
    float qn0 = 0.f, qn1 = 0.f;
#pragma unroll 1
    for (int kd = 0; kd < 8; ++kd) {
        const bf16x8 q0 = *(const LAS bf16x8*)(qb0 + 16 * kd), q1 = *(const LAS bf16x8*)(qb0 + 32 * QS + 16 * kd);
        const bf16x8 k0 = *(const LAS bf16x8*)(kb0 + 16 * kd), k1 = *(const LAS bf16x8*)(kb0 + 32 * QS + 16 * kd);
        s00 = MFMA32(k0, q0, s00); s01 = MFMA32(k0, q1, s01); s11 = MFMA32(k1, q1, s11);
        const f32x4 n0 = *(const LAS f32x4*)(nb + 16 * kd), n1 = *(const LAS f32x4*)(nb + 16 * kd + 4);
        const u32x4v a = __builtin_bit_cast(u32x4v, q0), b = __builtin_bit_cast(u32x4v, q1);
        qn0 += bflo(a.x) * n0.x + bfhi(a.x) * n0.y + bflo(a.y) * n0.z + bfhi(a.y) * n0.w + bflo(a.z) * n1.x + bfhi(a.z) * n1.y + bflo(a.w) * n1.z + bfhi(a.w) * n1.w;
        qn1 += bflo(b.x) * n0.x + bfhi(b.x) * n0.y + bflo(b.y) * n0.z + bfhi(b.y) * n0.w + bflo(b.z) * n1.x + bfhi(b.z) * n1.y + bflo(b.w) * n1.z + bfhi(b.w) * n1.w;
    }
    const float mt0 = tb_mt[r], mt1 = tb_mt[32 + r];
    float rs0 = 0.f, rs1 = 0.f;
#pragma unroll
    for (int q = 0; q < 16; ++q) {
        const float u0 = ub[CR(q)], u1 = ub[32 + CR(q)];
        s00[q] = (CR(q) <= r4) ? s00[q] * __expf(u0 - mt0) : 0.f;
        s01[q] = s01[q] * __expf(u0 - mt1);
        s11[q] = (CR(q) <= r4) ? s11[q] * __expf(u1 - mt1) : 0.f;
        rs0 += s00[q]; rs1 += s01[q] + s11[q];
    }
    rs0 += __shfl_xor(rs0, 32); rs1 += __shfl_xor(rs1, 32); qn0 += __shfl_xor(qn0, 32); qn1 += __shfl_xor(qn1, 32);
    {   const float den0 = tb_wi[r] * qn0 + rs0, den1 = tb_wi[32 + r] * qn1 + rs1;
        if (hh == 0) { tb_den[w4 * 64 + r] = 1.f / fmaxf(fabsf(den0), tb_em[r]); tb_den[w4 * 64 + 32 + r] = 1.f / fmaxf(fabsf(den1), tb_em[32 + r]); } }
    bf16x8 p00[2], p01[2], p11[2];
#pragma unroll
    for (int ks = 0; ks < 2; ++ks) {
        u32x4v x; x.x = cvtpk(s00[8 * ks], s00[8 * ks + 1]); x.y = cvtpk(s00[8 * ks + 2], s00[8 * ks + 3]); x.z = cvtpk(s00[8 * ks + 4], s00[8 * ks + 5]); x.w = cvtpk(s00[8 * ks + 6], s00[8 * ks + 7]); p00[ks] = __builtin_bit_cast(bf16x8, x);
        x.x = cvtpk(s01[8 * ks], s01[8 * ks + 1]); x.y = cvtpk(s01[8 * ks + 2], s01[8 * ks + 3]); x.z = cvtpk(s01[8 * ks + 4], s01[8 * ks + 5]); x.w = cvtpk(s01[8 * ks + 6], s01[8 * ks + 7]); p01[ks] = __builtin_bit_cast(bf16x8, x);
        x.x = cvtpk(s11[8 * ks], s11[8 * ks + 1]); x.y = cvtpk(s11[8 * ks + 2], s11[8 * ks + 3]); x.z = cvtpk(s11[8 * ks + 4], s11[8 * ks + 5]); x.w = cvtpk(s11[8 * ks + 6], s11[8 * ks + 7]); p11[ks] = __builtin_bit_cast(bf16x8, x);
    }
    f32x16 oa0 = {}, oa1 = {}, ob0 = {}, ob1 = {};
#define ML2_TILE(O0, O1, FIRST, AFTER_INTER, AFTER_INTRA) do { \
    _Pragma("unroll") for (int kd = 0; kd < 8; ++kd) { if ((kd & 1) == 0) asm volatile("" ::: "memory"); \
        const bf16x8 q0 = *(const LAS bf16x8*)(qb0 + 16 * kd), q1 = *(const LAS bf16x8*)(qb0 + 32 * QS + 16 * kd); \
        O0 = MFMA32(q0, R.cf[kd], O0); O1 = MFMA32(q1, R.cf[kd], O1); } \
    bf16x8 vf_[4]; \
    _Pragma("unroll") for (int i = 0; i < 4; ++i) { u32x4v bb; bb.x = R.vlo[i].x; bb.y = R.vlo[i].y; bb.z = R.vhi[i].x; bb.w = R.vhi[i].y; vf_[i] = __builtin_bit_cast(bf16x8, bb); } \
    asm volatile("" ::: "memory"); \
    AFTER_INTER; \
    _Pragma("unroll") for (int q = 0; q < 16; ++q) { O0[q] *= wib[CR(q)]; O1[q] *= wib[32 + CR(q)]; } \
    O0 = MFMA32(p00[0], vf_[0], O0); O1 = MFMA32(p01[0], vf_[0], O1); O0 = MFMA32(p00[1], vf_[1], O0); O1 = MFMA32(p01[1], vf_[1], O1); \
    O1 = MFMA32(p11[0], vf_[2], O1); O1 = MFMA32(p11[1], vf_[3], O1); \
    AFTER_INTRA; \
    _Pragma("unroll") for (int q = 0; q < 16; ++q) { O0[q] *= denb[CR(q)]; O1[q] *= denb[32 + CR(q)]; } \
    _Pragma("unroll") for (int q = 0; q < 16; ++q) { \
        float a = dpp_row_sum(O0[q]), a2 = dpp_row_sum(O0[q] * O0[q]), b = dpp_row_sum(O1[q]), b2 = dpp_row_sum(O1[q] * O1[q]); \
        a += __shfl_xor(a, 16); a2 += __shfl_xor(a2, 16); b += __shfl_xor(b, 16); b2 += __shfl_xor(b2, 16); \
        if (r == 0) { LAS float* p0_ = lnb + CR(q) * 2; LAS float* p1_ = lnb + (32 + CR(q)) * 2; \
            if (FIRST) { p0_[0] = a; p0_[1] = a2; p1_[0] = b; p1_[1] = b2; } else { p0_[0] += a; p0_[1] += a2; p1_[0] += b; p1_[1] += b2; } } } } while (0)
    ML2_TILE(oa0, oa1, true, ml2_load_state(F, c, h, vcB, hh, R.cf), ml2_load_vt(F, c, h, vcB, hh, R.vlo, R.vhi));
    ML2_TILE(ob0, ob1, false, { if (has_next) ml2_load_state(F, cn, hn, vcA, hh, R.cf); }, { if (has_next) ml2_load_vt(F, cn, hn, vcA, hh, R.vlo, R.vhi); });
#undef ML2_TILE
    __syncthreads();
    if (ltid < 64) { float s = 0.f, s2 = 0.f;
#pragma unroll
        for (int ww = 0; ww < 4; ++ww) { s += tb_ln[(ww * 64 + ltid) * 2]; s2 += tb_ln[(ww * 64 + ltid) * 2 + 1]; }
        const float mu = s * (1.f / 256.f), var = fmaxf(s2 * (1.f / 256.f) - mu * mu, 0.f); tb_mr[ltid * 2] = mu; tb_mr[ltid * 2 + 1] = rsqrtf(var + LN_EPS); }
    __syncthreads();
    {   const float nwA = F.normw[h * 256 + vcA], nwB = F.normw[h * 256 + vcB];
#pragma unroll
        for (int tt = 0; tt < 2; ++tt)
#pragma unroll
            for (int q = 0; q < 16; ++q) {
                if ((q & 3) == 0) asm volatile("" ::: "memory");
                const float mu = mrb[(32 * tt + CR(q)) * 2], rstd = mrb[(32 * tt + CR(q)) * 2 + 1];
                const float ha = tt ? oa1[q] : oa0[q], hb = tt ? ob1[q] : ob0[q];
                LAS unsigned short* opa = mlb + (32 * tt + CR(q)) * MS; LAS unsigned short* opb = opa + 32;
                const float moa = bf2f(*opa), mob = bf2f(*opb);
                *opa = (unsigned short)f2bf((ha - mu) * rstd * nwA * sigmoid_f(moa));
                *opb = (unsigned short)f2bf((hb - mu) * rstd * nwB * sigmoid_f(mob));
            } }
    __syncthreads();
    {   v4u* mdst = (v4u*)(F.ws + WS_MIX) + (size_t)(t0 + rowm) * 256 + h * 32 + chm;
#pragma unroll
        for (int i = 0; i < 8; ++i) mdst[i * 8 * 256] = *(LAS v4u*)(mld + i * 8 * MS); }
    __syncthreads();
#undef CR
}

__device__ __forceinline__ void x2_phase(Frame& F) {
    constexpr int NSCAN = 33;
#if defined(NAIVE_MOBA)
    for (int i = F.bid; i < NSCAN; i += F.G) ml_scan_item(F, i);
#elif defined(NAIVE_MLSTM)
    moba_attn_phase(F);
#else
    for (int i = F.bid; i < NSCAN; i += F.G) { TP_BEGIN(100); ml_scan_item(F, i); TP_END(100); }
    __syncthreads();
    TP_BEGIN(101); moba_attn_phase(F); TP_END(101);
#endif
}
__device__ __forceinline__ void x3_phase(Frame& F) {
#if !defined(NAIVE_MLSTM)
    TP_BEGIN(150);
    if ((ML_NC * ML_H) % (2 * F.G) == 0) {
        MlRegs2 R2; const int half = F.wave >> 2, hh_ = F.lane >> 5, vcA_ = 64 * (F.wave & 3) + (F.lane & 31);
        int it = F.bid + half * F.G;
        ml2_load_state(F, it >> 2, it & 3, vcA_, hh_, R2.cf); ml2_load_vt(F, it >> 2, it & 3, vcA_, hh_, R2.vlo, R2.vhi);
        for (; it < ML_NC * ML_H; it += 2 * F.G) { const int nx = it + 2 * F.G; const bool hn = nx < ML_NC * ML_H; ml_out_item2(F, it >> 2, it & 3, R2, hn, nx >> 2, nx & 3); }
    } else
    {   MlRegs R; int it = F.bid;
        if (it < ML_NC * ML_H) { ml_load_state(F, it >> 2, it & 3, R); ml_load_vt(F, it >> 2, it & 3, R); }
        for (; it < ML_NC * ML_H; it += F.G) { const int nx = it + F.G; const bool hn = nx < ML_NC * ML_H; ml_out_item(F, it >> 2, it & 3, R, hn, nx >> 2, nx & 3); } }
#endif
#if !defined(NAIVE_MOBA) && !defined(DBG_SKIP_MERGE)
    TP_BEGIN(151); moba_merge_phase(F, F.bid, F.G); TP_END(151);
#endif
}
__global__ void __launch_bounds__(512) naive_moba(unsigned char* ws) {
    __shared__ float qf_s[8][128];
    __shared__ float pb_s[8][1024];
    const int wave = threadIdx.x >> 6, lane = threadIdx.x & 63;
    const int gw = blockIdx.x * 8 + wave; const int p = gw >> 3, h = gw & 7;
    unsigned short* MIX = (unsigned short*)(ws + WS_MIX);
    const unsigned short* KB = (const unsigned short*)(ws + WS_KB); const unsigned short* VB = (const unsigned short*)(ws + WS_VB);
    const float* kmean = (const float*)(ws + WS_SMALL + SM_KMEAN);
    float* qf = qf_s[wave]; float* pb = pb_s[wave];
    unsigned short* qp = MIX + (size_t)p * 2048 + 1024 + h * 128;
    qf[lane * 2] = bf2f(qp[lane * 2]); qf[lane * 2 + 1] = bf2f(qp[lane * 2 + 1]);
    __syncthreads();
    const int b = p >> 8;
    float sc = -INFINITY;
    if (lane < b) { const float* km = kmean + (size_t)(h * 64 + lane) * 128; float s = 0.f; for (int d = 0; d < 128; ++d) s += qf[d] * km[d]; sc = s; }
    int sel[3]; const int nsel = b < 3 ? b : 3;
#pragma unroll
    for (int k = 0; k < 3; ++k) {
        float bv = sc; int bi = lane;
        for (int o = 1; o < 64; o <<= 1) { const float ov = __shfl_xor(bv, o); const int oi = __shfl_xor(bi, o); if (ov > bv || (ov == bv && oi < bi)) { bv = ov; bi = oi; } }
        sel[k] = bi; if (lane == bi) sc = -INFINITY;
    }
    float s[16]; float mx = -INFINITY;
#pragma unroll
    for (int bi = 0; bi < 4; ++bi) {
        const bool valid = (bi < nsel) || (bi == 3); const int blk = (bi == 3) ? b : sel[bi < 3 ? bi : 0];
#pragma unroll
        for (int kk = 0; kk < 4; ++kk) {
            float v = -INFINITY;
            if (valid) { const int key = blk * 256 + kk * 64 + lane; const unsigned short* kr = KB + (size_t)key * 1024 + h * 128; float a = 0.f; for (int d = 0; d < 128; ++d) a += qf[d] * bf2f(kr[d]); a *= K_SCALE; if (bi == 3 && key > p) a = -INFINITY; v = a; }
            s[bi * 4 + kk] = v; mx = fmaxf(mx, v);
        }
    }
    for (int o = 1; o < 64; o <<= 1) mx = fmaxf(mx, __shfl_xor(mx, o));
    float sum = 0.f;
#pragma unroll
    for (int i = 0; i < 16; ++i) { const float e = (s[i] == -INFINITY) ? 0.f : expf(s[i] - mx); pb[i * 64 + lane] = e; sum += e; }
    sum = wave_sum(sum);
    __syncthreads();
    float o0 = 0.f, o1 = 0.f;
#pragma unroll
    for (int bi = 0; bi < 4; ++bi) {
        const bool valid = (bi < nsel) || (bi == 3); if (!valid) continue; const int blk = (bi == 3) ? b : sel[bi];
        for (int kk = 0; kk < 256; ++kk) { const float pv = pb[bi * 256 + kk]; const unsigned v = *(const unsigned*)(VB + (size_t)(blk * 256 + kk) * 1024 + h * 128 + lane * 2); o0 += pv * bflo(v); o1 += pv * bfhi(v); }
    }
    const float inv = 1.f / sum;
    *(unsigned*)(qp + lane * 2) = pk2(o0 * inv, o1 * inv);
}
__global__ void __launch_bounds__(256) naive_mlstm(unsigned char* ws, const float* igb, const float* fgb, const float* normw) {
    __shared__ float q[128], k[128], nn[128], red[4], red2[4];
    const int h = blockIdx.x, v = threadIdx.x, lane = v & 63, wv = v >> 6;
    const unsigned short* QC = (const unsigned short*)(ws + WS_QC); const unsigned short* KC = (const unsigned short*)(ws + WS_KC); const unsigned short* MV = (const unsigned short*)(ws + WS_MV);
    const float* gates = (const float*)(ws + WS_SMALL + SM_GATES); unsigned short* MIX = (unsigned short*)(ws + WS_MIX);
    float C[128];
#pragma unroll
    for (int d = 0; d < 128; ++d) C[d] = 0.f;
    float m = 0.f; if (v < 128) nn[v] = 0.f;
    const float ib = igb[h], fb = fgb[h], nw = normw[h * 256 + v];
    for (int t = 0; t < M_TOK; ++t) {
        if (v < 128) q[v] = bf2f(QC[(size_t)t * 512 + h * 128 + v]); else k[v - 128] = bf2f(KC[(size_t)t * 512 + h * 128 + v - 128]);
        const float ig = gates[t * 8 + h] + ib, lf = logsigmoid_f(gates[t * 8 + 4 + h] + fb);
        const float mn = fmaxf(lf + m, ig), fd = expf(lf + m - mn), iw = expf(ig - mn); m = mn;
        const float vv = bf2f(MV[(size_t)t * 1024 + h * 256 + v]);
        __syncthreads();
        if (v < 128) nn[v] = fd * nn[v] + iw * k[v];
        float num = 0.f;
#pragma unroll
        for (int d = 0; d < 128; ++d) { C[d] = fd * C[d] + iw * k[d] * vv; num += q[d] * C[d]; }
        __syncthreads();
        float den = 0.f;
#pragma unroll 16
        for (int d = 0; d < 128; ++d) den += q[d] * nn[d];
        const float hv = num / fmaxf(fabsf(den), expf(-m));
        float s = wave_sum(hv); if (lane == 0) red[wv] = s;
        __syncthreads();
        const float mu = (red[0] + red[1] + red[2] + red[3]) * (1.f / 256.f);
        const float dv = hv - mu; float s2 = wave_sum(dv * dv); if (lane == 0) red2[wv] = s2;
        __syncthreads();
        const float var = (red2[0] + red2[1] + red2[2] + red2[3]) * (1.f / 256.f);
        unsigned short* op = MIX + (size_t)t * 2048 + h * 256 + v;
        const float mo = bf2f(*op);
        *op = (unsigned short)f2bf(dv * rsqrtf(var + LN_EPS) * nw * sigmoid_f(mo));
    }
}
__global__ void __launch_bounds__(256) dbg_cmp_u32(const unsigned* a, const unsigned* b, size_t n, unsigned* cnt) {
    unsigned c = 0;
    for (size_t i = blockIdx.x * 256ull + threadIdx.x; i < n; i += gridDim.x * 256ull) c += (a[i] != b[i]) ? 1u : 0u;
    if (c) atomicAdd(cnt, c);
}
__global__ void __launch_bounds__(512) dbg_check_own(unsigned char* ws, unsigned* cnt) {
    __shared__ float qf_s[8][128];
    __shared__ float pb_s[8][256];
    const int wave = threadIdx.x >> 6, lane = threadIdx.x & 63;
    const int gw = blockIdx.x * 8 + wave; const int p = gw >> 3, h = gw & 7;
    const unsigned short* MIX = (const unsigned short*)(ws + WS_MIX);
    const unsigned short* KB = (const unsigned short*)(ws + WS_KB); const unsigned short* VB = (const unsigned short*)(ws + WS_VB);
    float* qf = qf_s[wave]; float* pb = pb_s[wave];
    const unsigned short* qp = MIX + (size_t)p * 2048 + 1024 + h * 128;
    qf[lane * 2] = bf2f(qp[lane * 2]); qf[lane * 2 + 1] = bf2f(qp[lane * 2 + 1]);
    __syncthreads();
    const int b = p >> 8; float s[4], mx = -INFINITY;
#pragma unroll
    for (int kk = 0; kk < 4; ++kk) { const int key = b * 256 + kk * 64 + lane; const unsigned short* kr = KB + (size_t)key * 1024 + h * 128; float a = 0.f; for (int d = 0; d < 128; ++d) a += qf[d] * bf2f(kr[d]); a *= K_SCALE; if (key > p) a = -INFINITY; s[kk] = a; mx = fmaxf(mx, a); }
    for (int o = 1; o < 64; o <<= 1) mx = fmaxf(mx, __shfl_xor(mx, o));
    float sum = 0.f;
#pragma unroll
    for (int kk = 0; kk < 4; ++kk) { const float e = (s[kk] == -INFINITY) ? 0.f : expf(s[kk] - mx); pb[kk * 64 + lane] = e; sum += e; }
    sum = wave_sum(sum);
    __syncthreads();
    float o0 = 0.f, o1 = 0.f;
    for (int kk = 0; kk < 256; ++kk) { const float pv = pb[kk]; const unsigned v = *(const unsigned*)(VB + (size_t)(b * 256 + kk) * 1024 + h * 128 + lane * 2); o0 += pv * bflo(v); o1 += pv * bfhi(v); }
    o0 /= sum; o1 /= sum;
    const unsigned short* pr = (const unsigned short*)(ws + WS_PART3) + (size_t)(p * 8 + h) * 128 + lane * 2;
    float d = fmaxf(fabsf(o0 - bf2f(pr[0])), fabsf(o1 - bf2f(pr[1])));
    for (int o = 1; o < 64; o <<= 1) d = fmaxf(d, __shfl_xor(d, o));
    const float lse_ref = mx * 1.4426950408889634f + log2f(sum); const float lse = ((const float*)(ws + WS_LSE))[(p * 8 + h) * 4 + 3];
    if (lane == 0) { if (d > 0.02f) atomicAdd(cnt, 1u); if (!(fabsf(lse - lse_ref) < 0.05f)) atomicAdd(cnt + 1, 1u); }
}
__global__ void dbg_flag(const unsigned* cnt, float* out) {
    if (threadIdx.x == 0) { if (cnt[0]) out[0] += 1000.f; if (cnt[1]) out[1] += 2000.f; if (cnt[2]) out[2] += 4000.f; if (cnt[3]) out[3] += 8000.f; }
}
#ifndef PG8_SP2
#define PG8_SP2 true
#endif
#ifndef PG8_ALIGN
#define PG8_ALIGN true
#endif
constexpr int N_PHASES = 12;
struct Args { const float* in[17]; float* out; unsigned char* ws; int ph_lo, ph_hi, li, pad; };
__global__ void __launch_bounds__(NWAVES * 64, 2) mk_fwd(Args args) {
    extern __shared__ __attribute__((aligned(16))) unsigned char lds[];
    Frame F;
    F.lds = (LAS unsigned char*)lds;
    F.MISC = (volatile LAS unsigned*)(F.lds + MISC_OFF);
    F.tid = threadIdx.x; F.lane = F.tid & 63; F.wave = __builtin_amdgcn_readfirstlane(F.tid >> 6);
    F.G = gridDim.x; F.bid = blockIdx.x; F.tp0 = 0; F.tp1 = 0;
    F.ws = args.ws; F.ctl = (gu32*)(args.ws + WS_CTL); F.out = args.out;
    F.x = args.in[0]; F.c = args.in[1]; F.w_ada = args.in[2]; F.b_ada = args.in[3]; F.w_in = args.in[4]; F.conv_w = args.in[5]; F.conv_b = args.in[6];
    F.igb = args.in[7]; F.fgb = args.in[8]; F.normw = args.in[9]; F.w_out = args.in[10]; F.ln1_w = args.in[11]; F.ln1_b = args.in[12];
    F.w_gu = args.in[13]; F.w_down = args.in[14]; F.ln2_w = args.in[15]; F.ln2_b = args.in[16];
    for (int u = F.tid; u < (LDS_BYTES - LDSCTL_OFF) / 4; u += NWAVES * 64) ((LAS unsigned*)(F.lds + LDSCTL_OFF))[u] = 0u;
    __syncthreads();
    const int lo = args.ph_lo, hi = args.ph_hi;
    XcdBarrier bar; bar.bar = (unsigned*)(F.ctl + CW_BAR) + args.li * XCD_BAR_WORDS; bar.x = 0; bar.st = nullptr;
    if (hi - lo > 1) bar = xcd_barrier_post((unsigned*)(F.ctl + CW_BAR) + args.li * XCD_BAR_WORDS, F.MISC + 8);
#ifndef PHMASK
#define PHMASK 0xFFF
#endif
#define IN(k) (((PHMASK >> (k)) & 1) && lo <= (k) && (k) < hi)
#if defined(TIME_PHASE)
    unsigned long long tp0 = 0, tp1 = 0;
#define TSTAMP(k) do { if ((k) + 1 == TIME_PHASE) tp0 = __builtin_amdgcn_s_memrealtime(); if ((k) == TIME_PHASE) tp1 = __builtin_amdgcn_s_memrealtime(); } while (0)
#else
#define TSTAMP(k) do { } while (0)
#endif
#define SEAM(k) do { if (IN(k) && IN((k) + 1)) xcd_barrier(bar); TSTAMP(k); } while (0)
    float* ada = SMALLF(SM_ADA);
#if defined(TIME_PHASE)
    if (TIME_PHASE == 0) tp0 = __builtin_amdgcn_s_memrealtime();
#endif
    if (IN(0)) { p0_phase(F); } SEAM(0);
    if (IN(1)) { p1_phase(F); } SEAM(1);
    if (IN(2)) {
        pg8::Gemm g{(const pg8::bf16_t*)(F.ws + WS_U), (const pg8::bf16_t*)(F.ws + WS_WIN), M_TOK, NPROJ, DM}; pg8::StaticOrder S; S.init(M_TOK, NPROJ, F.G, F.bid, WGM_P2);
        pg8::EpiProj E{(pg8::bf16_t*)(F.ws + WS_MIX), (pg8::bf16_t*)(F.ws + WS_KB), (pg8::bf16_t*)(F.ws + WS_VB), (pg8::bf16_t*)(F.ws + WS_MQK), (pg8::bf16_t*)(F.ws + WS_MV), (const float*)(F.ws + WS_ROPE), SMALLF(SM_KMEAN)};
        pg8::gemm_phase<pg8::EpiProj, pg8::StaticOrder, PG8_ALIGN, PG8_SP2>(F.lds, g, S, E);
    } SEAM(2);
    if (IN(3)) { p3_phase(F); } SEAM(3);
    TSTAMP(4);
    if (IN(5)) { x2_phase(F); } SEAM(5);
    if (IN(6)) { x3_phase(F); } SEAM(6);
    if (IN(7)) {
        pg8::Gemm g{(const pg8::bf16_t*)(F.ws + WS_MIX), (const pg8::bf16_t*)(F.ws + WS_WOUT), M_TOK, DM, DM}; pg8::StaticOrder S; S.init(M_TOK, DM, F.G, F.bid, WGM_P5);
        pg8::EpiY1 E{F.x, ada + 2 * DM, (pg8::bf16_t*)(F.ws + WS_Y1B), (unsigned long long*)SMALLF(SM_MUR)};
        pg8::gemm_phase<pg8::EpiY1, pg8::StaticOrder, PG8_ALIGN, PG8_SP2>(F.lds, g, S, E);
    } SEAM(7);
    TSTAMP(8);
    if (IN(9)) {
        pg8::Gemm g{(const pg8::bf16_t*)(F.ws + WS_Y1B), (const pg8::bf16_t*)(F.ws + WS_WGU), M_TOK, NGU, DM}; pg8::StaticOrder S; S.init(M_TOK, NGU, F.G, F.bid, WGM_P6);
        pg8::EpiSwiGLU E{(const unsigned long long*)SMALLF(SM_MUR), SMALLF(SM_C1), SMALLF(SM_C2), (pg8::bf16_t*)(F.ws + WS_H), &F.tp1};
        pg8::gemm_phase<pg8::EpiSwiGLU, pg8::StaticOrder, PG8_ALIGN, PG8_SP2>(F.lds, g, S, E);
    } SEAM(9);
    if (IN(10)) {
        pg8::Gemm g{(const pg8::bf16_t*)(F.ws + WS_H), (const pg8::bf16_t*)(F.ws + WS_WDOWN), M_TOK, DM, DFF}; pg8::StaticOrder S; S.init(M_TOK, DM, F.G, F.bid, WGM_P7);
        pg8::EpiY2 E{(const pg8::bf16_t*)(F.ws + WS_Y1B), (const unsigned long long*)SMALLF(SM_MUR), ada + 5 * DM, F.ln1_w, F.ln1_b, (pg8::bf16_t*)(F.ws + WS_Y2B)};
        TP_BEGIN(141); pg8::gemm_phase<pg8::EpiY2, pg8::StaticOrder, PG8_ALIGN, PG8_SP2>(F.lds, g, S, E); TP_END(141);
    }
    {
        const bool both = IN(10) && IN(11);
        bool fused = false;
        if (both) { TP_BEGIN(140); fused = ln2_panel_fused(F); TP_END(140); }
        if (!fused) { SEAM(10); if (IN(11)) { ln2_phase(F); } }
    }
#if defined(TIME_PHASE)
    if (TIME_PHASE == 11) tp1 = __builtin_amdgcn_s_memrealtime();
    if (TIME_PHASE >= 100) { tp0 = F.tp0; tp1 = F.tp1; }
    if ((F.bid == 0 || TIME_PHASE >= 100) && F.tid == 0 && tp1 > tp0) { const unsigned long long te = __builtin_amdgcn_s_memrealtime(); const unsigned long long want = (tp1 - tp0) * TIME_MULT;
        while (__builtin_amdgcn_s_memrealtime() - te < want) __builtin_amdgcn_s_sleep(32); }
#endif
#undef IN
#undef SEAM
}

#ifndef MK_MODE
#define MK_MODE 1
#endif
extern "C" void kernel_launch(void* const* d_in, const int* in_sizes, int n_in, void* d_out, int out_size, void* d_ws, size_t ws_size, hipStream_t stream) {
    static int grid = 0;
    if (grid == 0) {
        if (n_in != 17 || in_sizes[0] != M_TOK * DM || out_size != M_TOK * DM || ws_size < WS_END) {
            fprintf(stderr, "kernel_launch: shape mismatch: n_in %d in0 %d out %d ws %zu (need %zu)\n", n_in, n_in > 0 ? in_sizes[0] : -1, out_size, ws_size, (size_t)WS_END); grid = -1; return; }
        int dev = 0, cus = 0, per_cu = 0;
        if (hipGetDevice(&dev) != hipSuccess || hipDeviceGetAttribute(&cus, hipDeviceAttributeMultiprocessorCount, dev) != hipSuccess) { fprintf(stderr, "kernel_launch: device query failed\n"); grid = -1; return; }
        if (hipFuncSetAttribute((const void*)mk_fwd, hipFuncAttributeMaxDynamicSharedMemorySize, LDS_BYTES) != hipSuccess) { fprintf(stderr, "kernel_launch: hipFuncSetAttribute failed\n"); grid = -1; return; }
        if (hipOccupancyMaxActiveBlocksPerMultiprocessor(&per_cu, (const void*)mk_fwd, NWAVES * 64, LDS_BYTES) != hipSuccess || per_cu < 1) { fprintf(stderr, "kernel_launch: occupancy query says %d blocks per CU\n", per_cu); (void)hipGetLastError(); grid = -1; return; }
        grid = cus;
    }
    if (grid < 0) return;
    (void)hipMemsetAsync((char*)d_ws + WS_CTL, 0, CTL_ZERO_BYTES, stream);
    Args a{};
    for (int i = 0; i < 17; ++i) a.in[i] = (const float*)d_in[i];
    a.out = (float*)d_out; a.ws = (unsigned char*)d_ws;
#if MK_MODE == 0
    for (int ph = 0; ph < N_PHASES; ++ph) {
#if defined(NAIVE_MOBA)
        if (ph == 4) hipLaunchKernelGGL(naive_moba, dim3(M_TOK), dim3(512), 0, stream, (unsigned char*)d_ws);
#endif
#if defined(DBG_NAIVE_MOBA_LATE)
        if (ph == 7) hipLaunchKernelGGL(naive_moba, dim3(M_TOK), dim3(512), 0, stream, (unsigned char*)d_ws);
#endif
#if defined(NAIVE_MLSTM)
        if (ph == 4) hipLaunchKernelGGL(naive_mlstm, dim3(ML_H), dim3(256), 0, stream, (unsigned char*)d_ws, (const float*)d_in[7], (const float*)d_in[8], (const float*)d_in[9]);
#endif
        a.ph_lo = ph; a.ph_hi = ph + 1; a.li = 0;
        hipLaunchKernelGGL(mk_fwd, dim3(grid), dim3(NWAVES * 64), LDS_BYTES, stream, a);
#if defined(DBG_X2_TWICE)
        if (ph == 5) {
            unsigned* dc = (unsigned*)((char*)d_ws + WS_CTL) + 32768;
            (void)hipMemcpyAsync((char*)d_ws + WS_LOCAL, (char*)d_ws + WS_PART3, 32 * MiB, hipMemcpyDeviceToDevice, stream);
            hipLaunchKernelGGL(mk_fwd, dim3(grid), dim3(NWAVES * 64), LDS_BYTES, stream, a);
            hipLaunchKernelGGL(dbg_cmp_u32, dim3(1024), dim3(256), 0, stream, (const unsigned*)((char*)d_ws + WS_LOCAL), (const unsigned*)((char*)d_ws + WS_PART3), (size_t)(8 * MiB), dc);
            hipLaunchKernelGGL(dbg_check_own, dim3(M_TOK), dim3(512), 0, stream, (unsigned char*)d_ws, dc + 1);
        }
#endif
    }
#if defined(DBG_X2_TWICE)
    hipLaunchKernelGGL(dbg_flag, dim3(1), dim3(64), 0, stream, (const unsigned*)((char*)d_ws + WS_CTL) + 32768, (float*)d_out);
#endif
#else
    a.ph_lo = 0; a.ph_hi = N_PHASES; a.li = 0;
    hipLaunchKernelGGL(mk_fwd, dim3(grid), dim3(NWAVES * 64), LDS_BYTES, stream, a);
#endif
    const hipError_t le = hipPeekAtLastError();
    if (le != hipSuccess) fprintf(stderr, "kernel_launch: launch failed: %s\n", hipGetErrorName(le));
}
```

```cpp
#include <hip/hip_runtime.h>
#include <cstdio>
#include <cstdint>
#include <cmath>
namespace pg8 {
#define PG8_LAS __attribute__((address_space(3)))
typedef unsigned short bf16_t;
typedef short bf16x8 __attribute__((ext_vector_type(8)));
typedef float f32x4 __attribute__((ext_vector_type(4)));
typedef unsigned u32x4 __attribute__((ext_vector_type(4)));
constexpr int BM = 256, BK = 64, HALF = 128, HTB = HALF * BK * 2  , STAGE_BYTES = 8 * HTB, NXCD = 8, WGM = 4;

__host__ __device__ __forceinline__ int lds_byte(int r, int c) { const int st = (r >> 4) * 2 + (c >> 5), rr = r & 15, cc = c & 31, ob = rr * 64 + cc * 2; return st * 1024 + (ob ^ (((ob >> 9) & 1) << 5)); }
__host__ __device__ __forceinline__ void stage_rc(int b, int& R, int& C) { const int st = b / 1024, sb = b % 1024, swz = sb ^ (((sb >> 9) & 1) << 5); R = (st >> 1) * 16 + swz / 64; C = (st & 1) * 32 + (swz % 64) / 2; }
__host__ __device__ __forceinline__ int perm32(int rho) { const int n = rho >> 4, i = rho & 15; return 8 * (i >> 2) + 4 * n + (i & 3); }

struct Unit { int pm, pn; };
struct Gemm { const bf16_t* A; const bf16_t* Bt; int M, N, K; };

struct StaticOrder {
    int nM, nN, nwg, G, c, wgm;
    __host__ __device__ void init(int M, int N, int G_, int c_, int wgm_ = WGM) { nM = M / BM; nN = N / BM; nwg = nM * nN; G = G_; c = c_; wgm = wgm_; }
    __host__ __device__ bool next(int i, Unit& u) const {
        const long L = (long)i * G + c; if (L >= nwg) return false;
        int wgid = (int)L; { const int q = nwg / NXCD, r = nwg % NXCD, xcd = wgid % NXCD, off = wgid / NXCD; wgid = (xcd < r ? xcd * (q + 1) : r * (q + 1) + (xcd - r) * q) + off; }
        const int nig = wgm * nN, gid = wgid / nig, fm = gid * wgm, gsz = (nM - fm) < wgm ? (nM - fm) : wgm;
        u.pm = fm + ((wgid % nig) % gsz); u.pn = (wgid % nig) / gsz; return true;
    }
    __device__ __forceinline__ void a_ready(const Unit&) const {}
    __device__ __forceinline__ void done(const Unit&) const {}
};

typedef float cvp_f32x2_t __attribute__((ext_vector_type(2))); typedef __bf16 cvp_bf16x2_t __attribute__((ext_vector_type(2)));
__device__ __forceinline__ unsigned cvt_pk_bf16(float lo, float hi) { cvp_f32x2_t v = {lo, hi}; cvp_bf16x2_t b = __builtin_convertvector(v, cvp_bf16x2_t); return __builtin_bit_cast(unsigned, b); }
typedef float f32x2 __attribute__((ext_vector_type(2)));
__device__ __forceinline__ f32x2 gelu_pk(f32x2 v) {
    const f32x2 av = __builtin_elementwise_abs(v), d = av * 0.2316418882f + 1.0f;
    f32x2 t; t.x = __builtin_amdgcn_rcpf(d.x); t.y = __builtin_amdgcn_rcpf(d.y);
    f32x2 q = t * 0.5307027145f + (-0.7265760135f); q = q * t + 0.7107068705f; q = q * t + (-0.142248368f); q = q * t + 0.127414796f; q = q * t;
    const f32x2 s = (v * v) * (-0.72134752044f);
    f32x2 e; e.x = __builtin_amdgcn_exp2f(s.x); e.y = __builtin_amdgcn_exp2f(s.y);
    const f32x2 m = v * (q * e), r = v - m;
    f32x2 o; o.x = v.x < 0.f ? m.x : r.x; o.y = v.y < 0.f ? m.y : r.y; return o;
}

template <int ACT  > struct EpiBf16 {
    static constexpr bool PERM = true, AFTER_DRAIN = false; static constexpr int PF_LEAD = 0; static_assert(ACT == 0 || ACT == 1, "EpiBf16: ACT is 0 (none) or 1 (gelu_pk)");
    bf16_t* O; int ldc; const float* bias; int split_cols; size_t split_stride; float scale0;
    __device__ __forceinline__ void operator()(const f32x4 (&acc)[2][2][4][2], const Unit& u, int wr, int wc, int fr, int fq) const {
        const int row0 = u.pm * BM + wr * 64 + fr; int colt = u.pn * BM; bf16_t* base = O;
        float sc = 1.f; if (split_cols) { const int t = colt / split_cols; base += (size_t)t * split_stride; colt -= t * split_cols; if (t == 0) sc = scale0; }
        const int col0 = colt + wc * 32 + 8 * fq, bcol0 = u.pn * BM + wc * 32 + 8 * fq;
        f32x4 bv[2][2];
#pragma unroll
        for (int bj = 0; bj < 2; ++bj)
#pragma unroll
            for (int n = 0; n < 2; ++n) bv[bj][n] = bias ? *(const f32x4*)(bias + bcol0 + bj * HALF + 4 * n) : (f32x4){0.f, 0.f, 0.f, 0.f};
#pragma unroll
        for (int ai = 0; ai < 2; ++ai)
#pragma unroll
            for (int m = 0; m < 4; ++m) { bf16_t* rowp = base + (size_t)(row0 + ai * HALF + m * 16) * ldc + col0;
#pragma unroll
                for (int bj = 0; bj < 2; ++bj) { f32x4 v0 = acc[ai][bj][m][0] + bv[bj][0], v1 = acc[ai][bj][m][1] + bv[bj][1];
                    if (ACT == 1) { f32x2 a = gelu_pk((f32x2){v0[0], v0[1]}), b = gelu_pk((f32x2){v0[2], v0[3]}), c = gelu_pk((f32x2){v1[0], v1[1]}), d = gelu_pk((f32x2){v1[2], v1[3]});
                        v0 = (f32x4){a.x, a.y, b.x, b.y}; v1 = (f32x4){c.x, c.y, d.x, d.y}; }
                    v0 = v0 * sc; v1 = v1 * sc; u32x4 w; w.x = cvt_pk_bf16(v0[0], v0[1]); w.y = cvt_pk_bf16(v0[2], v0[3]); w.z = cvt_pk_bf16(v1[0], v1[1]); w.w = cvt_pk_bf16(v1[2], v1[3]);
                    *(u32x4*)(rowp + bj * HALF) = w; } }
    }
};

struct PanelStats {
    unsigned* xbuf;
    unsigned* cnt;
    unsigned* tmo;
    int ntn; float eps;
    unsigned code;
    __device__ __forceinline__ bool run(const f32x4 (&v)[2][2][4][2], const Unit& u, int wr, int wc, int fr, int fq, PG8_LAS unsigned char* lds, int wid, int lane) const {
        typedef float f32x2v __attribute__((ext_vector_type(2)));
        PG8_LAS f32x2v* P = (PG8_LAS f32x2v*)lds;
        PG8_LAS f32x2v* S = (PG8_LAS f32x2v*)(lds + 8192);
        PG8_LAS unsigned* flag = (PG8_LAS unsigned*)(lds + 8192 + 2048);
#pragma unroll
        for (int ai = 0; ai < 2; ++ai)
#pragma unroll
            for (int m = 0; m < 4; ++m) {
                float s = 0.f;
#pragma unroll
                for (int bj = 0; bj < 2; ++bj)
#pragma unroll
                    for (int n = 0; n < 2; ++n) { const f32x4 x = v[ai][bj][m][n]; s += (x[0] + x[1]) + (x[2] + x[3]); }
                s += __shfl_xor(s, 16); s += __shfl_xor(s, 32);
                const float mw = s * (1.0f / 64.0f); float q = 0.f;
#pragma unroll
                for (int bj = 0; bj < 2; ++bj)
#pragma unroll
                    for (int n = 0; n < 2; ++n) { const f32x4 d = v[ai][bj][m][n] - mw; q += (d[0] * d[0] + d[1] * d[1]) + (d[2] * d[2] + d[3] * d[3]); }
                q += __shfl_xor(q, 16); q += __shfl_xor(q, 32);
                if (fq == 0) P[(ai * HALF + wr * 64 + m * 16 + fr) * 4 + wc] = (f32x2v){mw, q};
            }
        asm volatile("s_waitcnt lgkmcnt(0)" ::: "memory"); __builtin_amdgcn_s_barrier(); asm volatile("" ::: "memory");
#if defined(BROKEN_EXCHANGE_NO_WAIT)
#warning BROKEN CONTROL BUILD: the row-statistics exchange does not wait; results are wrong by design
        if (blockIdx.x >= 64) { const long long t0_ = clock64(); while (clock64() - t0_ < 60000) __builtin_amdgcn_s_sleep(8); }
#endif
        const int row = wid * 32 + (lane & 31);
        if (lane < 32) {
            const f32x2v a = P[row * 4 + 0], b = P[row * 4 + 1], c = P[row * 4 + 2], d = P[row * 4 + 3];
            const float mt = (a.x + b.x + c.x + d.x) * 0.25f;
            const float da = a.x - mt, db = b.x - mt, dc = c.x - mt, dd = d.x - mt;
            const float m2 = (a.y + b.y) + (c.y + d.y) + 64.0f * ((da * da + db * db) + (dc * dc + dd * dd));
            unsigned long long* slot = (unsigned long long*)xbuf + ((size_t)(u.pm * BM + row) * 4 + u.pn);
            __hip_atomic_store(slot, ((unsigned long long)__float_as_uint(m2) << 32) | __float_as_uint(mt), __ATOMIC_RELAXED, __HIP_MEMORY_SCOPE_AGENT);
        }
        asm volatile("s_waitcnt vmcnt(0)" ::: "memory");
        if (lane == 0) __hip_atomic_fetch_add(cnt + 64 * u.pm, 1u, __ATOMIC_RELAXED, __HIP_MEMORY_SCOPE_AGENT);
        if (wid == 0) {
            bool dead = false; const unsigned long long t0 = __builtin_amdgcn_s_memrealtime(); const unsigned want = 8u * (unsigned)ntn;
            for (;;) {
#if defined(BROKEN_EXCHANGE_NO_WAIT)
                break;
#endif
                if ((unsigned)__builtin_amdgcn_readfirstlane(__hip_atomic_load(cnt + 64 * u.pm, __ATOMIC_RELAXED, __HIP_MEMORY_SCOPE_AGENT)) >= want) break;
                if (__builtin_amdgcn_s_memrealtime() - t0 > 2000000ull) {
                    if (lane == 0) { unsigned expect = 0u; __hip_atomic_compare_exchange_strong(tmo + 1, &expect, code | (unsigned)(u.pm & 0xff), __ATOMIC_RELAXED, __ATOMIC_RELAXED, __HIP_MEMORY_SCOPE_AGENT);
                                     __hip_atomic_store(tmo, 1u, __ATOMIC_RELAXED, __HIP_MEMORY_SCOPE_AGENT); }
                    dead = true; break; }
                __builtin_amdgcn_s_sleep(2);
            }
            __builtin_amdgcn_fence(__ATOMIC_ACQUIRE, "agent");
            if (lane == 0) flag[0] = dead ? 1u : 0u;
        }
        asm volatile("s_waitcnt vmcnt(0) lgkmcnt(0)" ::: "memory"); __builtin_amdgcn_s_barrier(); asm volatile("" ::: "memory");
        const bool bad = flag[0] != 0u;
        if (lane < 32) {
            const unsigned long long* slot = (const unsigned long long*)xbuf + (size_t)(u.pm * BM + row) * 4; float mt[4], m2[4]; float ms = 0.f;
#pragma unroll
            for (int t = 0; t < 4; ++t) { if (t < ntn) { const unsigned long long w = __hip_atomic_load(slot + t, __ATOMIC_RELAXED, __HIP_MEMORY_SCOPE_AGENT); mt[t] = __uint_as_float((unsigned)w); m2[t] = __uint_as_float((unsigned)(w >> 32)); } else { mt[t] = 0.f; m2[t] = 0.f; } ms += mt[t]; }
            const float mean = ms / (float)ntn; float q = 0.f;
#pragma unroll
            for (int t = 0; t < 4; ++t) if (t < ntn) { const float dm = mt[t] - mean; q += m2[t] + 256.0f * dm * dm; }
            S[row] = (f32x2v){mean, 1.0f / sqrtf(q / (256.0f * (float)ntn) + eps)};
        }
        asm volatile("s_waitcnt lgkmcnt(0)" ::: "memory"); __builtin_amdgcn_s_barrier(); asm volatile("" ::: "memory");
        return bad;
    }
};
struct EpiLnRes {
    static constexpr bool PERM = false, AFTER_DRAIN = true; static constexpr int PF_LEAD = 0;
    const float* base; float* out; int ldc; const float* bias; PanelStats st; unsigned poison;
    __device__ __forceinline__ void fused(f32x4 (&acc)[2][2][4][2], const Unit& u, int wr, int wc, int fr, int fq, PG8_LAS unsigned char* lds, int wid, int lane) const {
        typedef float f32x2v __attribute__((ext_vector_type(2)));
        const PG8_LAS f32x2v* S = (const PG8_LAS f32x2v*)(lds + 8192);
        const int col0 = u.pn * BM + wc * 32 + 4 * fq;
#pragma unroll
        for (int bj = 0; bj < 2; ++bj)
#pragma unroll
            for (int n = 0; n < 2; ++n) { const f32x4 bv = bias ? *(const f32x4*)(bias + col0 + bj * HALF + n * 16) : (f32x4){0.f, 0.f, 0.f, 0.f};
#pragma unroll
                for (int ai = 0; ai < 2; ++ai)
#pragma unroll
                    for (int m = 0; m < 4; ++m) acc[ai][bj][m][n] += bv; }
        f32x4 pre[4][2][2];
#pragma unroll
        for (int m = 0; m < 4; ++m) { const size_t off = (size_t)(u.pm * BM + wr * 64 + m * 16 + fr) * ldc + col0;
#pragma unroll
            for (int bj = 0; bj < 2; ++bj)
#pragma unroll
                for (int n = 0; n < 2; ++n) pre[m][bj][n] = *(const f32x4*)(base + off + bj * HALF + n * 16); }
        const bool bad = st.run(acc, u, wr, wc, fr, fq, lds, wid, lane) || poison != 0u;
        const float qnan = __builtin_nanf("");
#pragma unroll
        for (int ai = 0; ai < 2; ++ai)
#pragma unroll
            for (int m = 0; m < 4; ++m) { const int r = ai * HALF + wr * 64 + m * 16 + fr; const f32x2v sr = S[r]; const size_t off = (size_t)(u.pm * BM + r) * ldc + col0;
#pragma unroll
                for (int bj = 0; bj < 2; ++bj)
#pragma unroll
                    for (int n = 0; n < 2; ++n) { const f32x4 bs = ai == 0 ? pre[m][bj][n] : *(const f32x4*)(base + off + bj * HALF + n * 16); f32x4 o = bs + (acc[ai][bj][m][n] - sr.x) * sr.y;
                        if (bad) o = (f32x4){qnan, qnan, qnan, qnan}; *(f32x4*)(out + off + bj * HALF + n * 16) = o; }
                if (m & 1) asm volatile("" ::: "memory"); }
    }
};
struct EpiLnResLn {
    static constexpr bool PERM = false, AFTER_DRAIN = true; static constexpr int PF_LEAD = 0;
    const float* base; float* out; bf16_t* xn; int ldc; const float* bias; PanelStats st1, st2; unsigned poison;
    __device__ __forceinline__ void fused(f32x4 (&acc)[2][2][4][2], const Unit& u, int wr, int wc, int fr, int fq, PG8_LAS unsigned char* lds, int wid, int lane) const {
        typedef float f32x2v __attribute__((ext_vector_type(2))); typedef unsigned u32x2v __attribute__((ext_vector_type(2)));
        const PG8_LAS f32x2v* S = (const PG8_LAS f32x2v*)(lds + 8192);
        const int col0 = u.pn * BM + wc * 32 + 4 * fq;
#pragma unroll
        for (int bj = 0; bj < 2; ++bj)
#pragma unroll
            for (int n = 0; n < 2; ++n) { const f32x4 bv = bias ? *(const f32x4*)(bias + col0 + bj * HALF + n * 16) : (f32x4){0.f, 0.f, 0.f, 0.f};
#pragma unroll
                for (int ai = 0; ai < 2; ++ai)
#pragma unroll
                    for (int m = 0; m < 4; ++m) acc[ai][bj][m][n] += bv; }
        bool bad = st1.run(acc, u, wr, wc, fr, fq, lds, wid, lane) || poison != 0u;
        const float qnan = __builtin_nanf("");
#pragma unroll
        for (int ai = 0; ai < 2; ++ai)
#pragma unroll
            for (int m = 0; m < 4; ++m) { const int r = ai * HALF + wr * 64 + m * 16 + fr; const f32x2v sr = S[r]; const size_t off = (size_t)(u.pm * BM + r) * ldc + col0;
#pragma unroll
                for (int bj = 0; bj < 2; ++bj)
#pragma unroll
                    for (int n = 0; n < 2; ++n) { const f32x4 bs = *(const f32x4*)(base + off + bj * HALF + n * 16); acc[ai][bj][m][n] = bs + (acc[ai][bj][m][n] - sr.x) * sr.y; }
                asm volatile("" : "+v"(acc[ai][0][m][0]), "+v"(acc[ai][0][m][1]), "+v"(acc[ai][1][m][0]), "+v"(acc[ai][1][m][1]));
                if (m & 1) asm volatile("" ::: "memory"); }
        const bool bad1 = bad;
        bad = st2.run(acc, u, wr, wc, fr, fq, lds, wid, lane) || bad;
#pragma unroll
        for (int ai = 0; ai < 2; ++ai)
#pragma unroll
            for (int m = 0; m < 4; ++m) { const int r = ai * HALF + wr * 64 + m * 16 + fr; const f32x2v sr = S[r]; const size_t off = (size_t)(u.pm * BM + r) * ldc + col0;
#pragma unroll
                for (int bj = 0; bj < 2; ++bj)
#pragma unroll
                    for (int n = 0; n < 2; ++n) { const f32x4 x1 = acc[ai][bj][m][n]; *(f32x4*)(out + off + bj * HALF + n * 16) = bad1 ? (f32x4){qnan, qnan, qnan, qnan} : x1;
                        const f32x4 o = (x1 - sr.x) * sr.y; u32x2v w; w.x = cvt_pk_bf16(o[0], o[1]); w.y = cvt_pk_bf16(o[2], o[3]);
                        if (bad) { w.x = 0x7fc07fc0u; w.y = 0x7fc07fc0u; } *(u32x2v*)(xn + off + bj * HALF + n * 16) = w; }
                asm volatile("" ::: "memory"); }
    }
};

template <class Epi, class Sched, bool ALIGN_EPI = false, bool SP2 = false>
__device__ __forceinline__ void gemm_phase(PG8_LAS unsigned char* lds, const Gemm g, const Sched& S, const Epi& E) {
    const int tid = threadIdx.x, wid = __builtin_amdgcn_readfirstlane(tid >> 6), lane = tid & 63, wr = wid >> 2, wc = wid & 3, fr = lane & 15, fq = lane >> 4;
    const int K = g.K, nt = K / BK;
    unsigned voffA[2], voffB[2];
#pragma unroll
    for (int i = 0; i < 2; ++i) { int R, C; stage_rc(tid * 16 + i * 8192, R, C); const int Rb = Epi::PERM ? ((R & ~31) + perm32(R & 31)) : R;
        voffA[i] = (unsigned)(R * K + C) * 2u; voffB[i] = (unsigned)(Rb * K + C) * 2u; }
    const size_t kstep = (size_t)(BK * 2);
    const size_t hstep = (size_t)HALF * K * 2;
    const size_t tstep = 2 * hstep;
    const unsigned ldsw = (unsigned)wid * 1024u;
    const int aoff = lds_byte(wr * 64 + fr, fq * 8), boff = lds_byte(wc * 32 + fr, fq * 8);
#define PG8_SA(b, h) (((b) * 2 + (h)) * HTB)
#define PG8_SB(b, h) ((4 + (b) * 2 + (h)) * HTB)
#define PG8_STAGE(bufoff, gbase, voff) do { _Pragma("unroll") for (int _i = 0; _i < 2; ++_i) \
        __builtin_amdgcn_global_load_lds((const unsigned*)((const char*)(gbase) + (voff)[_i]), (PG8_LAS unsigned*)(lds + (bufoff) + ldsw + _i * 8192), 16, 0, 0); } while (0)
#define PG8_LDA(dst, b, h) do { _Pragma("unroll") for (int m = 0; m < 4; ++m) _Pragma("unroll") for (int k = 0; k < 2; ++k) dst[m][k] = *(const PG8_LAS bf16x8*)(lds + PG8_SA(b, h) + aoff + m * 2048 + k * 1024); } while (0)
#define PG8_LDB(dst, b, h) do { _Pragma("unroll") for (int n = 0; n < 2; ++n) _Pragma("unroll") for (int k = 0; k < 2; ++k) dst[n][k] = *(const PG8_LAS bf16x8*)(lds + PG8_SB(b, h) + boff + n * 2048 + k * 1024); } while (0)
#define PG8_MMA(ai, bj, At, Bt) do { __builtin_amdgcn_s_setprio(1); _Pragma("unroll") for (int m = 0; m < 4; ++m) _Pragma("unroll") for (int n = 0; n < 2; ++n) _Pragma("unroll") for (int k = 0; k < 2; ++k) \
        acc[ai][bj][m][n] = __builtin_amdgcn_mfma_f32_16x16x32_bf16(Bt[n][k], At[m][k], acc[ai][bj][m][n], 0, 0, 0); __builtin_amdgcn_s_setprio(0); } while (0)
#define PG8_WAIT_V(n) asm volatile("s_waitcnt vmcnt(" #n ")" ::: "memory")
#define PG8_WAIT_L(n) asm volatile("s_waitcnt lgkmcnt(" #n ")" ::: "memory")
#define PG8_BAR __builtin_amdgcn_s_barrier()
#define PG8_SCHED __builtin_amdgcn_sched_barrier(0)
    const int pf_t = Epi::PF_LEAD > 0 ? 2 * (1 + (int)((blockIdx.x * 5u) % (unsigned)(nt / 2 - 2))) : -1;
    Unit cur, nxt; int ui = 0;
    if (!S.next(0, cur)) return;
    f32x4 acc[2][2][4][2];
#pragma unroll
    for (int a = 0; a < 2; ++a)
#pragma unroll
        for (int b = 0; b < 2; ++b)
#pragma unroll
            for (int m = 0; m < 4; ++m)
#pragma unroll
                for (int n = 0; n < 2; ++n) acc[a][b][m][n] = (f32x4){0.f, 0.f, 0.f, 0.f};
    bf16x8 At[4][2], B0[2][2], B1[2][2];
    const char* cA = (const char*)g.A + (size_t)cur.pm * tstep; const char* cB = (const char*)g.Bt + (size_t)cur.pn * tstep;
    S.a_ready(cur);
    if constexpr (SP2) {
        PG8_STAGE(PG8_SB(0, 0), cB, voffB); PG8_STAGE(PG8_SB(0, 1), cB + hstep, voffB); PG8_STAGE(PG8_SA(0, 0), cA, voffA); PG8_STAGE(PG8_SA(0, 1), cA + hstep, voffA);
        if (wr == 1) PG8_BAR;
        PG8_WAIT_V(2); PG8_BAR;
        PG8_STAGE(PG8_SB(1, 0), cB + kstep, voffB); PG8_STAGE(PG8_SA(1, 0), cA + kstep, voffA); PG8_STAGE(PG8_SB(1, 1), cB + hstep + kstep, voffB);
        PG8_WAIT_V(6); PG8_BAR;
    } else {
        PG8_STAGE(PG8_SB(0, 0), cB, voffB); PG8_STAGE(PG8_SA(0, 0), cA, voffA); PG8_STAGE(PG8_SB(0, 1), cB + hstep, voffB); PG8_STAGE(PG8_SA(0, 1), cA + hstep, voffA);
        if (wr == 1) PG8_BAR;
        PG8_WAIT_V(4); PG8_BAR;
        PG8_STAGE(PG8_SB(1, 0), cB + kstep, voffB); PG8_STAGE(PG8_SA(1, 0), cA + kstep, voffA); PG8_STAGE(PG8_SB(1, 1), cB + hstep + kstep, voffB);
        PG8_WAIT_V(6); PG8_BAR;
    }
    for (;;) {
        const bool has_next = S.next(ui + 1, nxt);
        const char* nA = has_next ? (const char*)g.A + (size_t)nxt.pm * tstep : cA; const char* nB = has_next ? (const char*)g.Bt + (size_t)nxt.pn * tstep : cB;
        for (int t = 0; t < nt; t += 2) {
            const bool last = (t == nt - 2);
            const char* a1 = cA + (size_t)(t + 1) * kstep;
            const char* a2 = last ? nA : cA + (size_t)(t + 2) * kstep; const char* b2 = last ? nB : cB + (size_t)(t + 2) * kstep;
            const char* a3 = a2 + kstep; const char* b3 = b2 + kstep;
            if (last && has_next) S.a_ready(nxt);
            if constexpr (Epi::PF_LEAD > 0) { if (t == pf_t) E.prefetch(cur, wr, wc, lane, lds + 131072 + wid * 256); }
            if constexpr (SP2) {
            PG8_LDB(B0, 0, 0); PG8_LDB(B1, 0, 1); PG8_SCHED; PG8_LDA(At, 0, 0); PG8_STAGE(PG8_SA(1, 1), a1 + hstep, voffA);
            PG8_WAIT_V(8); PG8_WAIT_L(0); PG8_BAR; PG8_MMA(0, 0, At, B0); PG8_MMA(0, 1, At, B1); PG8_BAR; PG8_SCHED;
            PG8_LDA(At, 0, 1); PG8_STAGE(PG8_SB(0, 0), b2, voffB); PG8_STAGE(PG8_SB(0, 1), b2 + hstep, voffB); PG8_STAGE(PG8_SA(0, 0), a2, voffA);
            PG8_WAIT_V(8); PG8_WAIT_L(0); PG8_BAR; PG8_MMA(1, 0, At, B0); PG8_MMA(1, 1, At, B1); PG8_BAR; PG8_SCHED;
            PG8_LDB(B0, 1, 0); PG8_LDB(B1, 1, 1); PG8_SCHED; PG8_LDA(At, 1, 0); PG8_STAGE(PG8_SA(0, 1), a2 + hstep, voffA);
            PG8_WAIT_V(8); PG8_WAIT_L(0); PG8_BAR; PG8_MMA(0, 0, At, B0); PG8_MMA(0, 1, At, B1); PG8_BAR; PG8_SCHED;
            PG8_LDA(At, 1, 1); PG8_STAGE(PG8_SB(1, 0), b3, voffB); PG8_STAGE(PG8_SB(1, 1), b3 + hstep, voffB); PG8_STAGE(PG8_SA(1, 0), a3, voffA);
            PG8_WAIT_V(8); PG8_WAIT_L(0); PG8_BAR; PG8_MMA(1, 0, At, B0); PG8_MMA(1, 1, At, B1); PG8_BAR; PG8_SCHED;
            } else {
            PG8_LDB(B0, 0, 0); PG8_SCHED; PG8_LDA(At, 0, 0); PG8_STAGE(PG8_SA(1, 1), a1 + hstep, voffA);
            PG8_WAIT_L(8); PG8_BAR; PG8_WAIT_L(0); PG8_MMA(0, 0, At, B0); PG8_BAR; PG8_SCHED;
            PG8_LDB(B1, 0, 1); PG8_STAGE(PG8_SB(0, 0), b2, voffB);
            PG8_BAR; PG8_WAIT_L(0); PG8_MMA(0, 1, At, B1); PG8_BAR;
            PG8_LDA(At, 0, 1); PG8_STAGE(PG8_SA(0, 0), a2, voffA);
            PG8_BAR; PG8_WAIT_L(0); PG8_MMA(1, 0, At, B0); PG8_BAR; PG8_SCHED;
            PG8_STAGE(PG8_SB(0, 1), b2 + hstep, voffB);
            PG8_WAIT_V(6); PG8_BAR; PG8_MMA(1, 1, At, B1); PG8_BAR;
            PG8_LDB(B0, 1, 0); PG8_SCHED; PG8_LDA(At, 1, 0); PG8_STAGE(PG8_SA(0, 1), a2 + hstep, voffA);
            PG8_WAIT_L(8); PG8_BAR; PG8_WAIT_L(0); PG8_MMA(0, 0, At, B0); PG8_BAR; PG8_SCHED;
            PG8_LDB(B1, 1, 1); PG8_STAGE(PG8_SB(1, 0), b3, voffB);
            PG8_BAR; PG8_WAIT_L(0); PG8_MMA(0, 1, At, B1); PG8_BAR;
            PG8_LDA(At, 1, 1); PG8_STAGE(PG8_SA(1, 0), a3, voffA);
            PG8_BAR; PG8_WAIT_L(0); PG8_MMA(1, 0, At, B0); PG8_BAR; PG8_SCHED;
            PG8_STAGE(PG8_SB(1, 1), b3 + hstep, voffB);
            PG8_WAIT_V(6); PG8_BAR; PG8_MMA(1, 1, At, B1); PG8_BAR;
            }
        }
        if constexpr (ALIGN_EPI) { if (wr == 0) PG8_BAR; }
        if constexpr (!Epi::AFTER_DRAIN) { E(acc, cur, wr, wc, fr, fq); S.done(cur); }
        if (!has_next) break;
#pragma unroll
        for (int a = 0; a < 2; ++a)
#pragma unroll
            for (int b = 0; b < 2; ++b)
#pragma unroll
                for (int m = 0; m < 4; ++m)
#pragma unroll
                    for (int n = 0; n < 2; ++n) acc[a][b][m][n] = (f32x4){0.f, 0.f, 0.f, 0.f};
        cur = nxt; cA = nA; cB = nB; ++ui;
        if constexpr (ALIGN_EPI) { if (wr == 1) PG8_BAR; }
    }
    PG8_WAIT_V(0);
    if constexpr (!ALIGN_EPI) { if (wr == 0) PG8_BAR; }
    PG8_BAR;
    if constexpr (Epi::AFTER_DRAIN) { E.fused(acc, cur, wr, wc, fr, fq, lds, wid, lane); S.done(cur); }
#undef PG8_SA
#undef PG8_SB
#undef PG8_STAGE
#undef PG8_LDA
#undef PG8_LDB
#undef PG8_MMA
#undef PG8_WAIT_V
#undef PG8_WAIT_L
#undef PG8_BAR
#undef PG8_SCHED
}
}
#define GAS __attribute__((address_space(1)))
#define LAS __attribute__((address_space(3)))
typedef unsigned short bf16;
typedef unsigned v4u __attribute__((ext_vector_type(4)));
typedef float f32x4 __attribute__((ext_vector_type(4)));
typedef short bf16x8 __attribute__((ext_vector_type(8)));
typedef GAS unsigned gu32;
typedef GAS unsigned long long gu64;
#define RLX_AGENT __ATOMIC_RELAXED, __HIP_MEMORY_SCOPE_AGENT
#define LDS_WAIT() asm volatile("s_waitcnt lgkmcnt(0)" ::: "memory")
#define VM_WAIT() asm volatile("s_waitcnt vmcnt(0)" ::: "memory")
__device__ __forceinline__ unsigned long long rt() { return __builtin_amdgcn_s_memrealtime(); }
__device__ __forceinline__ unsigned f2bf(float f) { unsigned u = __builtin_bit_cast(unsigned, f); return (u + 0x7fffu + ((u >> 16) & 1u)) >> 16; }
__device__ __forceinline__ unsigned pk2(float lo, float hi) { return f2bf(lo) | (f2bf(hi) << 16); }
#define XB_TMO      128
#define XB_XCNT(j)  (256  + 64 * (j))
#define XB_XSUB(j)  (1280 + 64 * (j))
#define XB_XGEN(j)  (2304 + 64 * (j))
#define XB_TOP      3328
#define XB_TOPGEN   3392
#define XCD_BAR_WORDS 3456
#define XB_SPIN_CAP (1u << 18)

__device__ __forceinline__ unsigned xb_ld(unsigned* p)              { return __hip_atomic_load(p, __ATOMIC_RELAXED, __HIP_MEMORY_SCOPE_AGENT); }
__device__ __forceinline__ unsigned xb_add(unsigned* p, unsigned v) { return __hip_atomic_fetch_add(p, v, __ATOMIC_RELAXED, __HIP_MEMORY_SCOPE_AGENT); }
__device__ __forceinline__ unsigned xb_xcc_id() { return (unsigned)__builtin_amdgcn_s_getreg((3 << 11) | 20) & 0xFu; }
#define XB_SPIN(cond, bar) do { unsigned _sp = 0; while (cond) { __builtin_amdgcn_s_sleep(1); \
    if ((++_sp & 255u) == 0u) { if (xb_ld(&(bar)[XB_TMO])) break; if (_sp > XB_SPIN_CAP) { atomicAdd(&(bar)[XB_TMO], 1u); break; } } } } while (0)

struct XcdBarrier {
    unsigned* bar; unsigned x;
    volatile LAS unsigned* st;
};

__device__ __forceinline__ XcdBarrier xcd_barrier_post(unsigned* bar, volatile LAS unsigned* st) {
    XcdBarrier b; b.bar = bar; b.x = xb_xcc_id(); b.st = st;
    if (threadIdx.x == 0) (void)xb_add(&bar[XB_XCNT(b.x)], 1u);
    return b;
}
__device__ __forceinline__ void xcd_barrier_complete(unsigned* bar, unsigned x, unsigned& nloc, unsigned& nx) {
    const unsigned G = gridDim.x * gridDim.y * gridDim.z;
    unsigned sum, cnt, mine, sp = 0u;
    for (;;) {
        sum = 0u; cnt = 0u; mine = 0u;
#pragma unroll
        for (unsigned j = 0; j < 16; ++j) { const unsigned c = xb_ld(&bar[XB_XCNT(j)]); sum += c; cnt += (c > 0u) ? 1u : 0u; mine = (j == x) ? c : mine; }
        if (sum == G) break;
        __builtin_amdgcn_s_sleep(1);
        if ((++sp & 255u) == 0u) { if (xb_ld(&bar[XB_TMO])) break; if (sp > XB_SPIN_CAP) { atomicAdd(&bar[XB_TMO], 1u); break; } }
    }
    nloc = mine > 0u ? mine : 1u; nx = cnt > 0u ? cnt : 1u;
}

__device__ __forceinline__ void xcd_barrier(const XcdBarrier& b) {
    asm volatile("s_waitcnt vmcnt(0)" ::: "memory");
    __syncthreads();
    if (threadIdx.x == 0) {
        unsigned* bar = b.bar;
        __builtin_amdgcn_s_waitcnt(0);
        unsigned nloc = b.st[0], nx = b.st[1];
        if (nloc == 0u) { xcd_barrier_complete(bar, b.x, nloc, nx); b.st[0] = nloc; b.st[1] = nx; }
        const unsigned old = xb_add(&bar[XB_XSUB(b.x)], 1u);
        const unsigned gen = old / nloc;
        if (old + 1u == (gen + 1u) * nloc) {
            __builtin_amdgcn_fence(__ATOMIC_RELEASE, "agent");
            asm volatile("s_waitcnt vmcnt(0)" ::: "memory");
            const unsigned og = xb_add(&bar[XB_TOP], 1u);
            const unsigned tg = og / nx;
            if (og + 1u == (tg + 1u) * nx) xb_add(&bar[XB_TOPGEN], 1u);
            else XB_SPIN(xb_ld(&bar[XB_TOPGEN]) == tg, bar);
            __builtin_amdgcn_fence(__ATOMIC_ACQUIRE, "agent");
            xb_add(&bar[XB_XGEN(b.x)], 1u);
            asm volatile("s_waitcnt vmcnt(0)" ::: "memory");
        } else {
            XB_SPIN(xb_ld(&bar[XB_XGEN(b.x)]) == gen, bar);
            __builtin_amdgcn_fence(__ATOMIC_ACQUIRE, "agent");
            asm volatile("s_waitcnt vmcnt(0)" ::: "memory");
        }
    }
    __syncthreads();
}
constexpr int NWAVES = 8;
#ifndef WGM_P2
#define WGM_P2 4
#endif
#ifndef WGM_P5
#define WGM_P5 4
#endif
#ifndef WGM_P6
#define WGM_P6 4
#endif
#ifndef WGM_P7
#define WGM_P7 1
#endif
constexpr int M_TOK = 16384, DM = 2048, NPROJ = 6144, WIN_LD = 6152, DFF = 5632, NGU = 11264, NADA = 12288;
constexpr int MB_H = 8, MB_DH = 128, MB_BLK = 256, MB_NB = 64;
constexpr int ML_H = 4, ML_DQK = 128, ML_DV = 256, ML_L = 64, ML_NC = 256;
constexpr float DN_ALPHA = 1.189207115002721f;
constexpr float LN_EPS = 1e-5f;
constexpr float K_SCALE = 0.08838834764831845f;

constexpr size_t MiB = 1u << 20;
constexpr size_t WS_CTL = 0, CTL_ZERO_BYTES = 128 * 1024;
constexpr size_t WS_SMALL = 1 * MiB;
constexpr size_t SM_ADA = 0, SM_C1 = 64 * 1024, SM_C2 = 128 * 1024, SM_KMEAN = 256 * 1024, SM_GATES = 512 * 1024, SM_TOKSC = 1 * MiB,
                 SM_CHSUM = 2 * MiB, SM_DECAY = 2 * MiB + 16 * 1024, SM_NLOC = 2 * MiB + 64 * 1024, SM_MUR = 3 * MiB;
constexpr size_t WS_WIN = 6 * MiB, WS_LISTS = 6 * MiB, WS_STATP = 6 * MiB;
constexpr size_t WS_WOUT = 30 * MiB, WS_WGU = 38 * MiB, WS_WDOWN = 82 * MiB;
constexpr size_t WS_U = 104 * MiB, WS_LOCAL = 104 * MiB, WS_Y1B = 104 * MiB;
constexpr size_t WS_MIX = 168 * MiB, WS_H = 168 * MiB;
constexpr size_t WS_KB = 232 * MiB, WS_VB = 264 * MiB, WS_MQK = 296 * MiB, WS_MV = 328 * MiB;
constexpr size_t WS_PART0 = 296 * MiB, WS_PART1 = 328 * MiB, WS_PART2 = 440 * MiB, WS_PART3 = 472 * MiB, WS_LSE = 504 * MiB;
constexpr size_t WS_QC = 360 * MiB, WS_KC = 376 * MiB, WS_KWT = 392 * MiB, WS_VT = 408 * MiB;
constexpr size_t WS_Y2B = 384 * MiB;
constexpr size_t WS_ROPE = 506 * MiB, WS_C12P = 508 * MiB, WS_ADAP = 511 * MiB;
constexpr size_t WS_Y1F = 384 * MiB, WS_END = 512 * MiB;
constexpr int CW_TMO = 0, CW_BAR = 4096, CW_CNT = 16384, CW_QUEUE = 20480, CW_PANEL = 24576;

constexpr int RING_BYTES = 131072, LDSCTL_OFF = RING_BYTES, LDS_BYTES = 163840, MISC_OFF = LDS_BYTES - 512;

typedef float f32x2 __attribute__((ext_vector_type(2)));
typedef unsigned u32x2 __attribute__((ext_vector_type(2)));

__device__ __forceinline__ float bf2f(unsigned short b) { return __builtin_bit_cast(float, (unsigned)b << 16); }
__device__ __forceinline__ float bflo(unsigned w) { return __builtin_bit_cast(float, w << 16); }
__device__ __forceinline__ float bfhi(unsigned w) { return __builtin_bit_cast(float, w & 0xffff0000u); }
__device__ __forceinline__ float sigmoid_f(float v) { return 1.f / (1.f + __expf(-v)); }
__device__ __forceinline__ float silu_f(float v) { return v / (1.f + __expf(-v)); }
__device__ __forceinline__ float logsigmoid_f(float v) { return fminf(v, 0.f) - log1pf(expf(-fabsf(v))); }

struct Frame {
    LAS unsigned char* lds;
    volatile LAS unsigned* MISC;
    gu32* ctl;
    int tid, lane, wave, G, bid;
    const float *x, *c, *w_ada, *b_ada, *w_in, *conv_w, *conv_b, *igb, *fgb, *normw, *w_out, *ln1_w, *ln1_b, *w_gu, *w_down, *ln2_w, *ln2_b;
    float* out; unsigned char* ws; unsigned long long tp0, tp1;
};
#if defined(TIME_PHASE)
#define TP_BEGIN(id) do { if (TIME_PHASE == (id)) F.tp0 = __builtin_amdgcn_s_memrealtime(); } while (0)
#define TP_END(id) do { if (TIME_PHASE == (id)) F.tp1 = __builtin_amdgcn_s_memrealtime(); } while (0)
#define TPA_BEGIN(id) unsigned long long tpa_t0_ = (TIME_PHASE == (id)) ? __builtin_amdgcn_s_memrealtime() : 0ull
#define TPA_END(id) do { if (TIME_PHASE == (id)) F.tp1 += __builtin_amdgcn_s_memrealtime() - tpa_t0_; } while (0)
#else
#define TPA_BEGIN(id) do { } while (0)
#define TPA_END(id) do { } while (0)
#define TP_BEGIN(id) do { } while (0)
#define TP_END(id) do { } while (0)
#endif
#define SMALLF(off) ((float*)(F.ws + WS_SMALL + (off)))

__device__ __forceinline__ float wave_sum(float v) {
#pragma unroll
    for (int o = 1; o < 64; o <<= 1) v += __shfl_xor(v, o);
    return v;
}

__device__ __forceinline__ void p0_transpose_item(const float* W, int K, int N, int ld, bf16* WT, LAS float* scr, int item, int lane) {
    const int nblk = N / 32, kb = item / nblk, nb = item % nblk, k0 = 64 * kb, n0 = 32 * nb;
    float ldv[32];
#pragma unroll
    for (int i = 0; i < 32; ++i) ldv[i] = W[(size_t)(k0 + 2 * i + (lane >> 5)) * ld + n0 + (lane & 31)];
#pragma unroll
    for (int i = 0; i < 32; ++i) scr[(2 * i + (lane >> 5)) * 33 + (lane & 31)] = ldv[i];
    LDS_WAIT(); asm volatile("" ::: "memory");
    const int c = lane & 7;
#pragma unroll
    for (int j = 0; j < 4; ++j) { const int n = (lane >> 3) + 8 * j; const LAS float* s = scr + (8 * c) * 33 + n;
        v4u o; o.x = pk2(s[0 * 33], s[1 * 33]); o.y = pk2(s[2 * 33], s[3 * 33]); o.z = pk2(s[4 * 33], s[5 * 33]); o.w = pk2(s[6 * 33], s[7 * 33]);
        *(GAS v4u*)(WT + (size_t)(n0 + n) * K + k0 + 8 * c) = o; }
    LDS_WAIT(); asm volatile("" ::: "memory");
}

__device__ __forceinline__ void p0_phase(Frame& F) {
    TP_BEGIN(120);
    {
        LAS float* sc = (LAS float*)(F.lds); LAS float* red = sc + 2048;
        for (int k = F.tid; k < DM; k += 512) sc[k] = silu_f(F.c[k]);
        __syncthreads();
        float* adap = (float*)(F.ws + WS_ADAP);
        for (int item = F.bid; item < 256; item += F.G) {
            const int kq = item >> 6, slab = item & 63;
            const int rg = F.tid / 48, cq = F.tid % 48;
            if (F.tid < 480) {
                f32x4 acc = {0.f, 0.f, 0.f, 0.f};
                const float* wp = F.w_ada + (size_t)(kq * 512) * NADA + slab * 192 + cq * 4;
#pragma unroll 13
                for (int k = rg; k < 512; k += 10) { const f32x4 w = *(const f32x4*)(wp + (size_t)k * NADA); acc += w * sc[kq * 512 + k]; }
                *(LAS f32x4*)(red + rg * 192 + cq * 4) = acc;
            }
            __syncthreads();
            if (F.tid < 192) { float s = 0.f;
#pragma unroll
                for (int g = 0; g < 10; ++g) s += red[g * 192 + F.tid];
                adap[(size_t)kq * NADA + slab * 192 + F.tid] = s; }
            __syncthreads();
        }
    }
    TP_END(120); TP_BEGIN(121);
    {
        LAS float* scr = (LAS float*)(F.lds + F.wave * 16384);
        const int gw = F.bid * NWAVES + F.wave, NGW = F.G * NWAVES;
        constexpr int I_IN = (DM / 64) * (NPROJ / 32), I_OUT = (DM / 64) * (DM / 32), I_DN = (DFF / 64) * (DM / 32);
        for (int it = gw; it < I_IN + I_OUT + I_DN; it += NGW) {
            int r = it;
            if (r < I_IN) { p0_transpose_item(F.w_in, DM, NPROJ, WIN_LD, (bf16*)(F.ws + WS_WIN), scr, r, F.lane); continue; } r -= I_IN;
            if (r < I_OUT) { p0_transpose_item(F.w_out, DM, DM, DM, (bf16*)(F.ws + WS_WOUT), scr, r, F.lane); continue; } r -= I_OUT;
            p0_transpose_item(F.w_down, DFF, DM, DM, (bf16*)(F.ws + WS_WDOWN), scr, r, F.lane);
        }
    }
    TP_END(121); TP_BEGIN(122);
    for (int i = F.bid * 512 + F.tid; i < MB_H * MB_NB * MB_DH; i += F.G * 512) SMALLF(SM_KMEAN)[i] = 0.f;
    for (int i = F.bid * 512 + F.tid; i < M_TOK * 2; i += F.G * 512) ((unsigned long long*)SMALLF(SM_MUR))[i] = 0ull;
    {
        const double INV[16] = {1.0, 0.44036660267178046, 0.19392274474868576, 0.08539710028576561, 0.03760603093086393, 0.016560440080994446, 0.007292664737217109, 0.003211445994752591,
                                0.001414213562373095, 0.000622772421914596, 0.0002742481756762073, 0.00012076973741146504, 5.318295896944988e-05, 2.341999896140934e-05, 1.031338537721246e-05, 4.5416704806078695e-06};
        float* rope = (float*)(F.ws + WS_ROPE);
        for (int idx = F.bid * 512 + F.tid; idx < M_TOK * 16; idx += F.G * 512) {
            const int pos = idx >> 4, i = idx & 15;
            double inv = INV[0];
#pragma unroll
            for (int j = 1; j < 16; ++j) inv = (i == j) ? INV[j] : inv;
            const double ang = (double)pos * inv;
            const double q = __builtin_floor(ang * 0.6366197723675814 + 0.5);
            double r = __builtin_fma(-q, 1.5707963267948966, ang); r = __builtin_fma(-q, 6.123233995736766e-17, r);
            const int qi = ((int)q) & 3; const double r2 = r * r;
            double cs = 1.0 + r2 * (-0.5 + r2 * (1.0 / 24 + r2 * (-1.0 / 720 + r2 * (1.0 / 40320 + r2 * (-1.0 / 3628800 + r2 * (1.0 / 479001600 + r2 * (-1.0 / 87178291200.0)))))));
            double sn = r * (1.0 + r2 * (-1.0 / 6 + r2 * (1.0 / 120 + r2 * (-1.0 / 5040 + r2 * (1.0 / 362880 + r2 * (-1.0 / 39916800 + r2 * (1.0 / 6227020800.0 + r2 * (-1.0 / 1307674368000.0))))))));
            double co, si;
            if (qi == 0) { co = cs; si = sn; } else if (qi == 1) { co = -sn; si = cs; } else if (qi == 2) { co = -cs; si = -sn; } else { co = sn; si = -cs; }
            rope[pos * 32 + i] = (float)co; rope[pos * 32 + 16 + i] = (float)si;
        }
    }
    TP_END(122);
}

__device__ __forceinline__ float ada_val(const Frame& F, int n) {
    const float* p = (const float*)(F.ws + WS_ADAP) + n;
    return ((p[0] + p[NADA]) + (p[2 * NADA] + p[3 * NADA])) + F.b_ada[n];
}
__device__ __forceinline__ void p1_wgu_item(Frame& F, LAS float* scr, int item) {
    const int lane = F.lane;
    constexpr int nblk = NGU / 32; const int kb = item / nblk, nb = item % nblk, k0 = 64 * kb, n0 = 32 * nb;
    const int pn = n0 >> 8, bj = (n0 >> 7) & 1, idx0 = n0 & 127;
    const int src0 = (bj ? DFF : 0) + pn * 128 + idx0;
    LAS float* wv = scr + 64 * 33; LAS float* bv = wv + 64;
    {   const int k = k0 + lane;
        const float s2 = 1.f + ada_val(F, 4 * DM + k); wv[lane] = F.ln1_w[k] * s2; bv[lane] = F.ln1_b[k] * s2 + ada_val(F, 3 * DM + k); }
    float ldv[32];
#pragma unroll
    for (int i = 0; i < 32; ++i) ldv[i] = F.w_gu[(size_t)(k0 + 2 * i + (lane >> 5)) * NGU + src0 + (lane & 31)];
#pragma unroll
    for (int i = 0; i < 32; ++i) scr[(2 * i + (lane >> 5)) * 33 + (lane & 31)] = ldv[i];
    LDS_WAIT(); asm volatile("" ::: "memory");
    const int c = lane & 7; bf16* WT = (bf16*)(F.ws + WS_WGU);
    float* c1p = (float*)(F.ws + WS_C12P) + (size_t)kb * NGU; float* c2p = (float*)(F.ws + WS_C12P) + (size_t)(32 + kb) * NGU;
#pragma unroll
    for (int j = 0; j < 4; ++j) { const int n = (lane >> 3) + 8 * j; const LAS float* s = scr + (8 * c) * 33 + n;
        float v[8], s1 = 0.f, s2 = 0.f; unsigned short b[8];
#pragma unroll
        for (int e = 0; e < 8; ++e) { const float raw = s[e * 33]; v[e] = raw * wv[8 * c + e]; b[e] = (unsigned short)f2bf(v[e]); s1 += bf2f(b[e]); s2 += raw * bv[8 * c + e]; }
        v4u o; o.x = b[0] | ((unsigned)b[1] << 16); o.y = b[2] | ((unsigned)b[3] << 16); o.z = b[4] | ((unsigned)b[5] << 16); o.w = b[6] | ((unsigned)b[7] << 16);
        *(GAS v4u*)(WT + (size_t)(n0 + n) * DM + k0 + 8 * c) = o;
        s1 += __shfl_xor(s1, 1); s1 += __shfl_xor(s1, 2); s1 += __shfl_xor(s1, 4);
        s2 += __shfl_xor(s2, 1); s2 += __shfl_xor(s2, 2); s2 += __shfl_xor(s2, 4);
        if (c == 0) { c1p[n0 + n] = s1; c2p[n0 + n] = s2; } }
    LDS_WAIT(); asm volatile("" ::: "memory");
}

__device__ __forceinline__ void p1_phase(Frame& F) {
    {   float* ada = SMALLF(SM_ADA);
        for (int n = F.bid * 512 + F.tid; n < NADA; n += F.G * 512) ada[n] = ada_val(F, n); }
    TP_BEGIN(110);
    {
        LAS float* sc1 = (LAS float*)(F.lds);
        LAS float* sh1 = sc1 + 2048;
        LAS float* wgT = sh1 + 2048;
        for (int k = F.tid; k < DM; k += 512) { sc1[k] = 1.f + ada_val(F, DM + k); sh1[k] = ada_val(F, k); }
        for (int i = F.tid; i < DM * 2; i += 512) { const int k = i >> 1, hf = i & 1; const f32x4 v = *(const f32x4*)(F.w_in + (size_t)k * WIN_LD + NPROJ + hf * 4);
            wgT[(hf * 4 + 0) * DM + k] = v.x; wgT[(hf * 4 + 1) * DM + k] = v.y; wgT[(hf * 4 + 2) * DM + k] = v.z; wgT[(hf * 4 + 3) * DM + k] = v.w; }
        __syncthreads();
        bf16* U = (bf16*)(F.ws + WS_U); float* gates = SMALLF(SM_GATES);
        const int rstep = F.G * NWAVES;
#define XROW_LOAD(X, row_) do { const GAS f32x4* xr_ = (const GAS f32x4*)(F.x + (size_t)(row_) * DM) + F.lane; _Pragma("unroll") for (int j = 0; j < 8; ++j) X[j] = xr_[64 * j]; } while (0)
#define XROW_DO(X, row_) do { float g[8]; _Pragma("unroll") for (int e = 0; e < 8; ++e) g[e] = 0.f; \
            GAS unsigned long long* o8 = (GAS unsigned long long*)(U + (size_t)(row_) * DM) + F.lane; \
            _Pragma("unroll") for (int j = 0; j < 8; ++j) { asm volatile("" ::: "memory"); const int k = F.lane * 4 + 256 * j; \
                const f32x4 s = *(LAS f32x4*)(sc1 + k), h = *(LAS f32x4*)(sh1 + k); const f32x4 u = X[j] * s + h; \
                o8[64 * j] = (unsigned long long)pk2(u.x, u.y) | ((unsigned long long)pk2(u.z, u.w) << 32); \
                _Pragma("unroll") for (int e = 0; e < 8; ++e) { const f32x4 w = *(LAS f32x4*)(wgT + e * DM + k); g[e] += (u.x * w.x + u.y * w.y) + (u.z * w.z + u.w * w.w); } } \
            _Pragma("unroll") for (int e = 0; e < 8; ++e) { float t = g[e]; \
                t += __builtin_bit_cast(float, __builtin_amdgcn_update_dpp(0, __builtin_bit_cast(int, t), 0xB1, 0xF, 0xF, true)); \
                t += __builtin_bit_cast(float, __builtin_amdgcn_update_dpp(0, __builtin_bit_cast(int, t), 0x4E, 0xF, 0xF, true)); \
                t += __builtin_bit_cast(float, __builtin_amdgcn_update_dpp(0, __builtin_bit_cast(int, t), 0x141, 0xF, 0xF, true)); \
                t += __builtin_bit_cast(float, __builtin_amdgcn_update_dpp(0, __builtin_bit_cast(int, t), 0x140, 0xF, 0xF, true)); \
                t += __shfl_xor(t, 16); t += __shfl_xor(t, 32); g[e] = t; } \
            if (F.lane == 0) { *(f32x4*)(gates + (row_) * 8) = (f32x4){g[0], g[1], g[2], g[3]}; *(f32x4*)(gates + (row_) * 8 + 4) = (f32x4){g[4], g[5], g[6], g[7]}; } } while (0)
        f32x4 xa[8], xb[8];
        int row = F.bid * NWAVES + F.wave;
        if (row < M_TOK) XROW_LOAD(xa, row);
        while (row < M_TOK) {
            if (row + rstep < M_TOK) XROW_LOAD(xb, row + rstep);
            XROW_DO(xa, row);
            row += rstep; if (row >= M_TOK) break;
            if (row + rstep < M_TOK) XROW_LOAD(xa, row + rstep);
            XROW_DO(xb, row);
            row += rstep;
        }
#undef XROW_LOAD
#undef XROW_DO
        __syncthreads();
    }
    TP_END(110); TP_BEGIN(111);
    {
        LAS float* scr = (LAS float*)(F.lds + F.wave * 16384);
        const int gw = F.bid * NWAVES + F.wave, NGW = F.G * NWAVES;
        constexpr int I_GU = (DM / 64) * (NGU / 32);
        for (int it = gw; it < I_GU; it += NGW) p1_wgu_item(F, scr, it);
    }
    TP_END(111);
}

namespace pg8 {
struct EpiProj {
    static constexpr bool PERM = true, AFTER_DRAIN = false; static constexpr int PF_LEAD = 0;
    bf16_t *mix, *kb, *vb, *mqk, *mv; const float* rope; float* kmean;
    __device__ __forceinline__ void operator()(const f32x4 (&acc)[2][2][4][2], const Unit& u, int wr, int wc, int fr, int fq) const {
        const int row0 = u.pm * BM + wr * 64 + fr; const int colt = u.pn * BM; const int t = colt >> 10, cl = colt & 1023;
        bf16_t* base; int ldc;
        if (t == 0) { base = mix + 1024; ldc = 2048; } else if (t == 1) { base = kb; ldc = 1024; } else if (t == 2) { base = vb; ldc = 1024; }
        else if (t == 3) { base = mqk; ldc = 1024; } else if (t == 4) { base = mv; ldc = 1024; } else { base = mix; ldc = 2048; }
        const int col0 = cl + wc * 32 + 8 * fq;
        const bool dorope = (t < 2) && (wc == 0);
        const float sgn = (fq < 2) ? -1.f : 1.f;
        f32x4 ks0[2] = {{0.f, 0.f, 0.f, 0.f}, {0.f, 0.f, 0.f, 0.f}}, ks1[2] = {{0.f, 0.f, 0.f, 0.f}, {0.f, 0.f, 0.f, 0.f}};
#pragma unroll
        for (int ai = 0; ai < 2; ++ai) {
            f32x4 rc0[4], rc1[4], rs0[4], rs1[4];
            if (dorope) {
#pragma unroll
                for (int m = 0; m < 4; ++m) { const float* rp = rope + (size_t)(row0 + ai * HALF + m * 16) * 32 + 8 * (fq & 1);
                    rc0[m] = *(const f32x4*)(rp); rc1[m] = *(const f32x4*)(rp + 4); rs0[m] = *(const f32x4*)(rp + 16); rs1[m] = *(const f32x4*)(rp + 20); }
            }
#pragma unroll
            for (int m = 0; m < 4; ++m) {
                const int row = row0 + ai * HALF + m * 16;
                bf16_t* rowp = base + (size_t)row * ldc + col0;
#pragma unroll
                for (int bj = 0; bj < 2; ++bj) {
                    f32x4 v0 = acc[ai][bj][m][0], v1 = acc[ai][bj][m][1];
                    if (dorope) {
                        f32x4 p0, p1;
#pragma unroll
                        for (int i = 0; i < 4; ++i) { p0[i] = __shfl_xor(v0[i], 32); p1[i] = __shfl_xor(v1[i], 32); }
                        v0 = v0 * rc0[m] + p0 * rs0[m] * sgn; v1 = v1 * rc1[m] + p1 * rs1[m] * sgn;
                    }
                    u32x4 w; w.x = cvt_pk_bf16(v0[0], v0[1]); w.y = cvt_pk_bf16(v0[2], v0[3]); w.z = cvt_pk_bf16(v1[0], v1[1]); w.w = cvt_pk_bf16(v1[2], v1[3]);
                    *(u32x4*)(rowp + bj * HALF) = w;
                    if (t == 1) { ks0[bj] += v0; ks1[bj] += v1; }
                }
            }
        }
        if (t == 1) {
#pragma unroll
            for (int bj = 0; bj < 2; ++bj) {
                float s8[8] = {ks0[bj][0], ks0[bj][1], ks0[bj][2], ks0[bj][3], ks1[bj][0], ks1[bj][1], ks1[bj][2], ks1[bj][3]};
#pragma unroll
                for (int e = 0; e < 8; ++e) {
                    float x = s8[e];
                    x += __builtin_bit_cast(float, __builtin_amdgcn_update_dpp(0, __builtin_bit_cast(int, x), 0xB1, 0xF, 0xF, true));
                    x += __builtin_bit_cast(float, __builtin_amdgcn_update_dpp(0, __builtin_bit_cast(int, x), 0x4E, 0xF, 0xF, true));
                    x += __builtin_bit_cast(float, __builtin_amdgcn_update_dpp(0, __builtin_bit_cast(int, x), 0x141, 0xF, 0xF, true));
                    x += __builtin_bit_cast(float, __builtin_amdgcn_update_dpp(0, __builtin_bit_cast(int, x), 0x140, 0xF, 0xF, true));
                    s8[e] = x;
                }
                if (fr == 0) { const int col = cl + bj * HALF + wc * 32 + 8 * fq; float* kp = kmean + ((size_t)(col >> 7) * 64 + u.pm) * 128 + (col & 127);
#pragma unroll
                    for (int e = 0; e < 8; ++e) atomicAdd(kp + e, s8[e] * (1.f / 256.f)); }
            }
        }
    }
};
#ifndef PF_Y1
#define PF_Y1 0
#endif
template <int MODE> struct EpiY1T {
    static constexpr bool PERM = false, AFTER_DRAIN = false; static constexpr int PF_LEAD = PF_Y1;
    __device__ __forceinline__ void prefetch(const Unit& u, int wr, int wc, int lane, PG8_LAS unsigned char* dummy) const {
#pragma unroll
        for (int j = 0; j < 8; ++j) { const int s = j * 64 + lane, r = s >> 2, bj = (s >> 1) & 1, hf = s & 1;
            const float* p = x + (size_t)(u.pm * BM + wr * 64 + (r & 63) + (r >> 6) * HALF) * 2048 + u.pn * BM + wc * 32 + bj * HALF + hf * 16;
            __builtin_amdgcn_global_load_lds((const unsigned*)p, (PG8_LAS unsigned*)dummy, 4, 0, 0); }
    }
    const float* x; const float* gate1; bf16_t* y1b; unsigned long long* stat;
    __device__ __forceinline__ void operator()(const f32x4 (&acc)[2][2][4][2], const Unit& u, int wr, int wc, int fr, int fq) const {
        const int row0 = u.pm * BM + wr * 64 + fr, col0 = u.pn * BM + wc * 32 + 4 * fq;
        float s[8], ss[8];
#pragma unroll
        for (int i = 0; i < 8; ++i) { s[i] = 0.f; ss[i] = 0.f; }
#pragma unroll
        for (int bj = 0; bj < 2; ++bj)
#pragma unroll
            for (int n = 0; n < 2; ++n) {
                const int c = col0 + bj * HALF + n * 16;
                const f32x4 g1 = *(const f32x4*)(gate1 + c) + 1.0f;
                f32x4 xv[8];
#pragma unroll
                for (int i = 0; i < 8; ++i) { if (MODE & 1) xv[i] = (f32x4){1.f, 2.f, 3.f, 4.f}; else if (MODE & 4) xv[i] = *(const f32x4*)(x + (size_t)((row0 + (i >> 2) * HALF + (i & 3) * 16) & 255) * 2048 + c); else xv[i] = *(const f32x4*)(x + (size_t)(row0 + (i >> 2) * HALF + (i & 3) * 16) * 2048 + c); }
                asm volatile("" ::: "memory");
#pragma unroll
                for (int i = 0; i < 8; ++i) {
                    const size_t off = (size_t)(row0 + (i >> 2) * HALF + (i & 3) * 16) * 2048 + c;
                    const f32x4 y = xv[i] * 1.189207115002721f + g1 * acc[i >> 2][bj][i & 3][n];
                    typedef unsigned u32x2v __attribute__((ext_vector_type(2)));
                    u32x2v w; w.x = cvt_pk_bf16(y[0], y[1]); w.y = cvt_pk_bf16(y[2], y[3]);
                    *(u32x2v*)(y1b + off) = w;
                    s[i] += (y[0] + y[1]) + (y[2] + y[3]); ss[i] += (y[0] * y[0] + y[1] * y[1]) + (y[2] * y[2] + y[3] * y[3]);
                }
                asm volatile("" ::: "memory");
            }
#pragma unroll
        for (int i = 0; i < 8; ++i) {
            float a = s[i], a2 = ss[i];
            a += __shfl_xor(a, 16); a += __shfl_xor(a, 32); a2 += __shfl_xor(a2, 16); a2 += __shfl_xor(a2, 32);
            if (MODE & 2) { if (fq == 0 && a == 123.456f) stat[0] = 1; }
            else if (fq == 0) { unsigned long long* sp = stat + (size_t)(row0 + (i >> 2) * HALF + (i & 3) * 16) * 2;
                atomicAdd(sp, (unsigned long long)(long long)(a * 16777216.f)); atomicAdd(sp + 1, (unsigned long long)(long long)(a2 * 16777216.f)); }
        }
    }
};
using EpiY1 = EpiY1T<0>;
__device__ __forceinline__ f32x2 ln_stats_from_fixed(const unsigned long long* sp) {
    typedef unsigned long long u64x2 __attribute__((ext_vector_type(2)));
    const u64x2 v = *(const u64x2*)sp;
    const float s = (float)((double)(long long)v.x * (1.0 / (16777216.0 * 2048.0))), q = (float)((double)(long long)v.y * (1.0 / (16777216.0 * 2048.0)));
    const float var = fmaxf(q - s * s, 0.f);
    return (f32x2){s, rsqrtf(var + 1e-5f)};
}
struct EpiSwiGLU {
    static constexpr bool PERM = true, AFTER_DRAIN = false; static constexpr int PF_LEAD = 0;
    const unsigned long long* stat; const float* c1; const float* c2; bf16_t* H; unsigned long long* tacc;
    __device__ __forceinline__ void operator()(const f32x4 (&acc)[2][2][4][2], const Unit& u, int wr, int wc, int fr, int fq) const {
#if defined(TIME_PHASE)
        const unsigned long long te0_ = (TIME_PHASE == 170) ? __builtin_amdgcn_s_memrealtime() : 0ull;
#endif
        const int row0 = u.pm * BM + wr * 64 + fr; const int cl = wc * 32 + 8 * fq; const int cg = u.pn * BM + cl;
        f32x4 c1g[2], c2g[2], c1u[2], c2u[2];
#pragma unroll
        for (int n = 0; n < 2; ++n) { c1g[n] = *(const f32x4*)(c1 + cg + 4 * n); c2g[n] = *(const f32x4*)(c2 + cg + 4 * n); c1u[n] = *(const f32x4*)(c1 + cg + HALF + 4 * n); c2u[n] = *(const f32x4*)(c2 + cg + HALF + 4 * n); }
        typedef float f32x2v __attribute__((ext_vector_type(2)));
        f32x2v mrs[8];
#pragma unroll
        for (int i = 0; i < 8; ++i) { const f32x2 t_ = ln_stats_from_fixed(stat + (size_t)(row0 + (i >> 2) * HALF + (i & 3) * 16) * 2); mrs[i] = (f32x2v){t_.x, t_.y}; }
#pragma unroll
        for (int ai = 0; ai < 2; ++ai)
#pragma unroll
            for (int m = 0; m < 4; ++m) {
                const int row = row0 + ai * HALF + m * 16;
                const f32x2v mr = mrs[ai * 4 + m];
                f32x4 hv[2];
#pragma unroll
                for (int n = 0; n < 2; ++n) {
                    const f32x4 g = (acc[ai][0][m][n] - c1g[n] * mr.x) * mr.y + c2g[n];
                    const f32x4 up = (acc[ai][1][m][n] - c1u[n] * mr.x) * mr.y + c2u[n];
#pragma unroll
                    for (int i = 0; i < 4; ++i) { const float e = __builtin_amdgcn_exp2f(g[i] * -1.4426950408889634f); hv[n][i] = g[i] * __builtin_amdgcn_rcpf(1.f + e) * up[i]; }
                }
                u32x4 w; w.x = cvt_pk_bf16(hv[0][0], hv[0][1]); w.y = cvt_pk_bf16(hv[0][2], hv[0][3]); w.z = cvt_pk_bf16(hv[1][0], hv[1][1]); w.w = cvt_pk_bf16(hv[1][2], hv[1][3]);
                *(u32x4*)(H + (size_t)row * 5632 + u.pn * HALF + cl) = w;
            }
#if defined(TIME_PHASE)
        if (TIME_PHASE == 170) *tacc += __builtin_amdgcn_s_memrealtime() - te0_;
#endif
    }
};
struct EpiY2 {
    static constexpr bool PERM = false, AFTER_DRAIN = false; static constexpr int PF_LEAD = 0;
    const bf16_t* y1b; const unsigned long long* stat; const float* gate2; const float* lw; const float* lb; bf16_t* y2b;
    __device__ __forceinline__ void operator()(const f32x4 (&acc)[2][2][4][2], const Unit& u, int wr, int wc, int fr, int fq) const {
        const int row0 = u.pm * BM + wr * 64 + fr, col0 = u.pn * BM + wc * 32 + 4 * fq;
        typedef float f32x2v __attribute__((ext_vector_type(2)));
        f32x2v mrs[8];
#pragma unroll
        for (int i = 0; i < 8; ++i) { const f32x2 t_ = ln_stats_from_fixed(stat + (size_t)(row0 + (i >> 2) * HALF + (i & 3) * 16) * 2); mrs[i] = (f32x2v){t_.x, t_.y}; }
#pragma unroll
        for (int bj = 0; bj < 2; ++bj)
#pragma unroll
            for (int n = 0; n < 2; ++n) {
                const int c = col0 + bj * HALF + n * 16;
                const f32x4 g2 = *(const f32x4*)(gate2 + c) + 1.0f, w = *(const f32x4*)(lw + c), b = *(const f32x4*)(lb + c);
                f32x4 yv[8];
                {   typedef unsigned u32x2v __attribute__((ext_vector_type(2))); u32x2v yr[8];
#pragma unroll
                    for (int i = 0; i < 8; ++i) yr[i] = *(const u32x2v*)(y1b + (size_t)(row0 + (i >> 2) * HALF + (i & 3) * 16) * 2048 + c);
                    asm volatile("" ::: "memory");
#pragma unroll
                    for (int i = 0; i < 8; ++i) yv[i] = (f32x4){__builtin_bit_cast(float, yr[i].x << 16), __builtin_bit_cast(float, yr[i].x & 0xffff0000u), __builtin_bit_cast(float, yr[i].y << 16), __builtin_bit_cast(float, yr[i].y & 0xffff0000u)}; }
#pragma unroll
                for (int i = 0; i < 8; ++i) {
                    const size_t off = (size_t)(row0 + (i >> 2) * HALF + (i & 3) * 16) * 2048 + c;
                    const f32x4 x1 = (yv[i] - mrs[i].x) * mrs[i].y * w + b;
                    const f32x4 y2 = x1 * 1.189207115002721f + g2 * acc[i >> 2][bj][i & 3][n];
                    typedef unsigned u32x2w __attribute__((ext_vector_type(2))); u32x2w pk; pk.x = cvt_pk_bf16(y2[0], y2[1]); pk.y = cvt_pk_bf16(y2[2], y2[3]);
                    *(u32x2w*)(y2b + off) = pk;
                }
                asm volatile("" ::: "memory");
            }
    }
};
}

__device__ __forceinline__ float wave_incl_scan_add(float v, int lane) {
#pragma unroll
    for (int o = 1; o < 64; o <<= 1) { const float t = __shfl_up(v, o); if (lane >= o) v += t; }
    return v;
}
__device__ __forceinline__ float wave_incl_scan_max(float v, int lane) {
#pragma unroll
    for (int o = 1; o < 64; o <<= 1) { const float t = __shfl_up(v, o); if (lane >= o) v = fmaxf(v, t); }
    return v;
}
__device__ __forceinline__ void p3_chunk_item(Frame& F, int c) {
    const int t0 = c * ML_L, tid = F.tid, lane = F.lane;
    LAS float* wgt = (LAS float*)F.lds;
    LAS unsigned short* KT = (LAS unsigned short*)(F.lds + 1024);
    LAS unsigned short* VTh = (LAS unsigned short*)(F.lds + 1024 + 512 * 72 * 2);
    const float* gates = SMALLF(SM_GATES);
    if (F.wave < 4) {
        const int h = F.wave, t = t0 + lane;
        const float ig = gates[t * 8 + h] + F.igb[h], fg = gates[t * 8 + 4 + h] + F.fgb[h];
        const float lf = logsigmoid_f(fg);
        const float b = wave_incl_scan_add(lf, lane), u = ig - b, m1 = wave_incl_scan_max(u, lane);
        const float m1l = __shfl(m1, 63), bl = __shfl(b, 63);
        *(f32x4*)(SMALLF(SM_TOKSC) + (size_t)(t * 4 + h) * 4) = (f32x4){b, u, m1, 0.f};
        if (lane == 63) { SMALLF(SM_CHSUM)[(c * 4 + h) * 2] = bl; SMALLF(SM_CHSUM)[(c * 4 + h) * 2 + 1] = m1l; }
        wgt[h * 64 + lane] = expf(u - m1l);
    }
    {
        const int cgp = tid & 127, rq = tid >> 7, ch0 = cgp * 8, r0 = 16 * rq;
        const v4u* MQK = (const v4u*)(F.ws + WS_MQK);
        float w[4][8], bs[8];
#pragma unroll
        for (int j = 0; j < 4; ++j) { const f32x4 a = *(const f32x4*)(F.conv_w + j * 1024 + ch0), b = *(const f32x4*)(F.conv_w + j * 1024 + ch0 + 4);
            w[j][0] = a.x; w[j][1] = a.y; w[j][2] = a.z; w[j][3] = a.w; w[j][4] = b.x; w[j][5] = b.y; w[j][6] = b.z; w[j][7] = b.w; }
        { const f32x4 a = *(const f32x4*)(F.conv_b + ch0), b = *(const f32x4*)(F.conv_b + ch0 + 4); bs[0] = a.x; bs[1] = a.y; bs[2] = a.z; bs[3] = a.w; bs[4] = b.x; bs[5] = b.y; bs[6] = b.z; bs[7] = b.w; }
        __syncthreads();
        const bool isq = ch0 < 512; const int hh = (ch0 - 512) >> 7;
        v4u* QC = (v4u*)(F.ws + WS_QC); v4u* KC = (v4u*)(F.ws + WS_KC);
#pragma unroll 1
        for (int hf = 0; hf < 2; ++hf) {
        v4u xin[11];
#pragma unroll
        for (int i = 0; i < 11; ++i) { const int t = t0 + r0 + 8 * hf - 3 + i; xin[i] = (t >= 0) ? MQK[(size_t)t * 128 + cgp] : (v4u){0u, 0u, 0u, 0u}; }
#pragma unroll
        for (int r = 0; r < 8; ++r) {
            float y[8];
#pragma unroll
            for (int e = 0; e < 8; ++e) y[e] = bs[e];
#pragma unroll
            for (int j = 0; j < 4; ++j) { const v4u x = xin[r + j];
                y[0] += w[j][0] * bflo(x.x); y[1] += w[j][1] * bfhi(x.x); y[2] += w[j][2] * bflo(x.y); y[3] += w[j][3] * bfhi(x.y);
                y[4] += w[j][4] * bflo(x.z); y[5] += w[j][5] * bfhi(x.z); y[6] += w[j][6] * bflo(x.w); y[7] += w[j][7] * bfhi(x.w); }
#pragma unroll
            for (int e = 0; e < 8; ++e) y[e] = silu_f(y[e]);
            const int s = r0 + 8 * hf + r;
            if (isq) { v4u o; o.x = pk2(y[0], y[1]); o.y = pk2(y[2], y[3]); o.z = pk2(y[4], y[5]); o.w = pk2(y[6], y[7]); QC[(size_t)(t0 + s) * 64 + cgp] = o; }
            else {
#pragma unroll
                for (int e = 0; e < 8; ++e) y[e] *= K_SCALE;
                v4u o; o.x = pk2(y[0], y[1]); o.y = pk2(y[2], y[3]); o.z = pk2(y[4], y[5]); o.w = pk2(y[6], y[7]); KC[(size_t)(t0 + s) * 64 + (cgp - 64)] = o;
                const float wg_ = wgt[hh * 64 + s];
#pragma unroll
                for (int e = 0; e < 8; ++e) KT[(ch0 - 512 + e) * 72 + s] = (unsigned short)f2bf(y[e] * wg_);
            }
        }
        }
    }
    __syncthreads();
    {
        float sm = 0.f;
#pragma unroll
        for (int i = 0; i < 8; ++i) { const v4u v = *(LAS v4u*)(KT + tid * 72 + i * 8); sm += bflo(v.x) + bfhi(v.x) + bflo(v.y) + bfhi(v.y) + bflo(v.z) + bfhi(v.z) + bflo(v.w) + bfhi(v.w); }
        SMALLF(SM_NLOC)[(size_t)c * 512 + tid] = sm;
    }
    const v4u* MV = (const v4u*)(F.ws + WS_MV);
    const int r = lane & 31, hh2 = lane >> 5, w = F.wave;
    const int vg = tid & 31, sq = tid >> 5;
    v4u vin[4];
#pragma unroll
    for (int i = 0; i < 4; ++i) vin[i] = MV[(size_t)(t0 + 4 * sq + i) * 128 + vg];
#pragma unroll 1
    for (int h = 0; h < 4; ++h) {
#pragma unroll
        for (int i = 0; i < 4; ++i) { const int s = 4 * sq + i; LAS unsigned short* p = VTh + (8 * vg) * 72 + s;
            p[0] = (unsigned short)vin[i].x; p[72] = (unsigned short)(vin[i].x >> 16); p[144] = (unsigned short)vin[i].y; p[216] = (unsigned short)(vin[i].y >> 16);
            p[288] = (unsigned short)vin[i].z; p[360] = (unsigned short)(vin[i].z >> 16); p[432] = (unsigned short)vin[i].w; p[504] = (unsigned short)(vin[i].w >> 16); }
        __syncthreads();
        if (h < 3) {
#pragma unroll
            for (int i = 0; i < 4; ++i) vin[i] = MV[(size_t)(t0 + 4 * sq + i) * 128 + (h + 1) * 32 + vg];
        }
        {
            unsigned long long* VT8 = (unsigned long long*)(F.ws + WS_VT) + (size_t)(c * 4 + h) * 4096;
#pragma unroll
            for (int p = 0; p < 8; ++p) { const int idx = p * 512 + tid, sb = idx >> 8, v = idx & 255;
                VT8[idx] = *(LAS unsigned long long*)(VTh + v * 72 + sb * 4); } }
        {
            pg8::bf16x8 bfr[4];
#pragma unroll
            for (int ks = 0; ks < 4; ++ks) bfr[ks] = *(LAS pg8::bf16x8*)(VTh + (32 * w + r) * 72 + 16 * ks + 8 * hh2);
            unsigned short* LOC = (unsigned short*)(F.ws + WS_LOCAL) + (size_t)(c * 4 + h) * 256 * 128 + (size_t)(32 * w + r) * 8 + 4 * hh2;
#pragma unroll
            for (int dt = 0; dt < 4; ++dt) {
                __attribute__((ext_vector_type(16))) float acc = {};
#pragma unroll
                for (int ks = 0; ks < 4; ++ks) { const pg8::bf16x8 af = *(LAS pg8::bf16x8*)(KT + (h * 128 + 32 * dt + r) * 72 + 16 * ks + 8 * hh2);
                    acc = __builtin_amdgcn_mfma_f32_32x32x16_bf16(af, bfr[ks], acc, 0, 0, 0); }
#pragma unroll
                for (int g = 0; g < 4; ++g) { u32x2 o; o.x = pk2(acc[4 * g], acc[4 * g + 1]); o.y = pk2(acc[4 * g + 2], acc[4 * g + 3]);
                    *(u32x2*)(LOC + (size_t)(4 * dt + g) * 2048) = o; }
            }
        }
        __syncthreads();
    }
}
__device__ __forceinline__ void p3_kmean_item(Frame& F, int j) {
    const v4u* KB = (const v4u*)(F.ws + WS_KB);
    const int cg = F.tid & 127, rg = F.tid >> 7;
    float s[8];
#pragma unroll
    for (int e = 0; e < 8; ++e) s[e] = 0.f;
#pragma unroll 16
    for (int r = 0; r < 64; ++r) { const v4u v = KB[(size_t)(j * MB_BLK + rg * 64 + r) * 128 + cg];
        s[0] += bflo(v.x); s[1] += bfhi(v.x); s[2] += bflo(v.y); s[3] += bfhi(v.y); s[4] += bflo(v.z); s[5] += bfhi(v.z); s[6] += bflo(v.w); s[7] += bfhi(v.w); }
    LAS float* red = (LAS float*)F.lds;
#pragma unroll
    for (int e = 0; e < 8; ++e) red[rg * 1024 + cg * 8 + e] = s[e];
    __syncthreads();
#pragma unroll
    for (int e = 0; e < 2; ++e) { const int col = F.tid * 2 + e; const float t = (red[col] + red[1024 + col]) + (red[2048 + col] + red[3072 + col]);
        SMALLF(SM_KMEAN)[(size_t)((col >> 7) * 64 + j) * 128 + (col & 127)] = t * (1.f / 256.f); }
    __syncthreads();
}
__device__ __forceinline__ void p3_c12_item(Frame& F, int it) {
    const int n = it * 512 + F.tid; if (n >= NGU) return;
    const float* p = (const float*)(F.ws + WS_C12P);
    float a = 0.f, b = 0.f;
    for (int k = 0; k < 32; ++k) { a += p[(size_t)k * NGU + n]; b += p[(size_t)(32 + k) * NGU + n]; }
    SMALLF(SM_C1)[n] = a; SMALLF(SM_C2)[n] = b;
}
__device__ __forceinline__ void moba_select_item(Frame& F, int b, int h);
__device__ __forceinline__ void p3_phase(Frame& F) {
    constexpr int N_CH = ML_NC, N_SEL = MB_NB * MB_H, N_C12 = NGU / 512;
    for (int it = F.bid; it < N_CH + N_SEL + N_C12; it += F.G) {
        if (it < N_CH) { TP_BEGIN(160); p3_chunk_item(F, it); TP_END(160); }
        else if (it < N_CH + N_SEL) {
#if !defined(NAIVE_MOBA)
            const int i = it - N_CH, b = 63 - (i >> 3), h = i & 7; if (b > 0) moba_select_item(F, b, h);
#endif
        }
        else p3_c12_item(F, it - N_CH - N_SEL);
    }
}

__device__ __forceinline__ void stat_phase(Frame& F) {
    const float* sp = (const float*)(F.ws + WS_STATP); float* mur = SMALLF(SM_MUR);
    for (int row = F.bid * 512 + F.tid; row < M_TOK; row += F.G * 512) {
        float s = 0.f, ss = 0.f;
#pragma unroll
        for (int i = 0; i < 16; ++i) { const f32x4 v = *(const f32x4*)(sp + (size_t)row * 64 + i * 4); s += v.x + v.z; ss += v.y + v.w; }
        const float mean = s * (1.f / DM); const float var = fmaxf(ss * (1.f / DM) - mean * mean, 0.f);
        mur[row * 2] = mean; mur[row * 2 + 1] = rsqrtf(var + LN_EPS);
    }
}
__device__ __forceinline__ void ln2_rows(Frame& F, int row0, int nrows) {
    const v4u* Y2 = (const v4u*)(F.ws + WS_Y2B);
#define LN2_LOAD(V, row_) do { const v4u* xr_ = Y2 + (size_t)(row_) * 256 + F.lane; _Pragma("unroll") for (int j = 0; j < 4; ++j) V[j] = xr_[64 * j]; } while (0)
#define LN2_DO(V, row_) do { GAS f32x4* xw_ = (GAS f32x4*)(F.out + (size_t)(row_) * DM); float s = 0.f; f32x4 f[8]; \
        _Pragma("unroll") for (int j = 0; j < 4; ++j) { f[2 * j] = (f32x4){bflo(V[j].x), bfhi(V[j].x), bflo(V[j].y), bfhi(V[j].y)}; f[2 * j + 1] = (f32x4){bflo(V[j].z), bfhi(V[j].z), bflo(V[j].w), bfhi(V[j].w)}; } \
        _Pragma("unroll") for (int j = 0; j < 8; ++j) s += (f[j].x + f[j].y) + (f[j].z + f[j].w); \
        const float mean = wave_sum(s) * (1.f / DM); float s2 = 0.f; \
        _Pragma("unroll") for (int j = 0; j < 8; ++j) { f[j] = f[j] - mean; s2 += (f[j].x * f[j].x + f[j].y * f[j].y) + (f[j].z * f[j].z + f[j].w * f[j].w); } \
        const float rstd = rsqrtf(wave_sum(s2) * (1.f / DM) + LN_EPS); \
        _Pragma("unroll") for (int j = 0; j < 8; ++j) { const int k = (F.lane + 64 * (j >> 1)) * 8 + 4 * (j & 1); const f32x4 w = *(const f32x4*)(F.ln2_w + k), b = *(const f32x4*)(F.ln2_b + k); *(GAS f32x4*)((GAS float*)xw_ + k) = f[j] * rstd * w + b; } } while (0)
    v4u va[4], vb[4];
    int rr = F.wave;
    if (rr < nrows) LN2_LOAD(va, row0 + rr);
    while (rr < nrows) {
        if (rr + NWAVES < nrows) LN2_LOAD(vb, row0 + rr + NWAVES);
        LN2_DO(va, row0 + rr);
        rr += NWAVES; if (rr >= nrows) break;
        if (rr + NWAVES < nrows) LN2_LOAD(va, row0 + rr + NWAVES);
        LN2_DO(vb, row0 + rr);
        rr += NWAVES;
    }
#undef LN2_LOAD
#undef LN2_DO
}
__device__ __forceinline__ bool ln2_panel_fused(Frame& F) {
    pg8::StaticOrder S; S.init(M_TOK, DM, F.G, F.bid, WGM_P7); pg8::Unit u0, u1, u2;
    if (F.G != 256 || !S.next(0, u0) || !S.next(1, u1) || S.next(2, u2)) return false;
    gu32* c0 = F.ctl + CW_PANEL + 64 * u0.pm; gu32* c1 = F.ctl + CW_PANEL + 64 * u1.pm;
    asm volatile("s_waitcnt vmcnt(0)" ::: "memory");
    __syncthreads();
    if (F.tid == 0) {
        __builtin_amdgcn_fence(__ATOMIC_RELEASE, "agent"); asm volatile("s_waitcnt vmcnt(0)" ::: "memory");
        __hip_atomic_fetch_add(c0, 1u, __ATOMIC_RELAXED, __HIP_MEMORY_SCOPE_AGENT);
        __hip_atomic_fetch_add(c1, 1u, __ATOMIC_RELAXED, __HIP_MEMORY_SCOPE_AGENT);
        unsigned sp = 0;
        while (__hip_atomic_load(c0, __ATOMIC_RELAXED, __HIP_MEMORY_SCOPE_AGENT) < 8u || __hip_atomic_load(c1, __ATOMIC_RELAXED, __HIP_MEMORY_SCOPE_AGENT) < 8u) { __builtin_amdgcn_s_sleep(2); if (++sp > (1u << 22)) break; }
        __builtin_amdgcn_fence(__ATOMIC_ACQUIRE, "agent"); asm volatile("s_waitcnt vmcnt(0)" ::: "memory");
    }
    __syncthreads();
    ln2_rows(F, u0.pm * 256 + 32 * u0.pn, 32);
    ln2_rows(F, u1.pm * 256 + 32 * u1.pn, 32);
    return true;
}
__device__ __forceinline__ void ln2_phase(Frame& F) {
    for (int r0 = F.bid * NWAVES; r0 < M_TOK; r0 += F.G * NWAVES) ln2_rows(F, r0, NWAVES);
}
typedef short s16x4 __attribute__((ext_vector_type(4)));
typedef float f32x16 __attribute__((ext_vector_type(16)));
typedef unsigned u32x4v __attribute__((ext_vector_type(4)));
#define MFMA32(a, b, c) __builtin_amdgcn_mfma_f32_32x32x16_bf16((a), (b), (c), 0, 0, 0)
#define SBAR() __builtin_amdgcn_sched_barrier(0)
__device__ __forceinline__ int crow(int r, int hi) { return (r & 3) + 8 * (r >> 2) + 4 * hi; }
typedef float cv_f32x2_t __attribute__((ext_vector_type(2))); typedef __bf16 cv_bf16x2_t __attribute__((ext_vector_type(2)));
__device__ __forceinline__ unsigned cvtpk(float lo, float hi) { cv_f32x2_t v = {lo, hi}; cv_bf16x2_t b = __builtin_convertvector(v, cv_bf16x2_t); return __builtin_bit_cast(unsigned, b); }

constexpr int LIST_HSTRIDE = 256 * 2016;
__device__ __forceinline__ int list_off(int h, int j) { return h * LIST_HSTRIDE + 256 * (63 * j - (j * (j - 1)) / 2); }
__device__ __forceinline__ unsigned short* part_ptr(unsigned char* ws, int slot) {
    return (unsigned short*)(ws + (slot == 0 ? WS_PART0 : slot == 1 ? WS_PART1 : slot == 2 ? WS_PART2 : WS_PART3));
}

#define TOP3_INS(S_, J_) do { const float s__ = (S_); const int j__ = (J_); \
    if (s__ > v0 || (s__ == v0 && j__ < i0)) { v2 = v1; i2 = i1; v1 = v0; i1 = i0; v0 = s__; i0 = j__; } \
    else if (s__ > v1 || (s__ == v1 && j__ < i1)) { v2 = v1; i2 = i1; v1 = s__; i1 = j__; } \
    else if (s__ > v2 || (s__ == v2 && j__ < i2)) { v2 = s__; i2 = j__; } } while (0)
__device__ __forceinline__ void moba_select_item(Frame& F, int b, int h) {
    const int tid = F.tid, lane = F.lane, r32 = lane & 31, hi = lane >> 5, w = F.wave;
    constexpr int KS = 136;
    LAS unsigned short* kmh = (LAS unsigned short*)F.lds;
    LAS unsigned short* kml = kmh + 64 * KS;
    LAS int* hist = (LAS int*)(F.lds + 2 * 64 * KS * 2);
    LAS int* base = hist + 64;
    {   const float* src = SMALLF(SM_KMEAN) + (size_t)h * 64 * 128;
        for (int i = tid; i < 64 * 32; i += 512) { const int j = i >> 5, c4 = (i & 31) * 4; f32x4 f = {0.f, 0.f, 0.f, 0.f}; if (j < b) f = *(const f32x4*)(src + j * 128 + c4);
            const unsigned h0 = f2bf(f.x), h1 = f2bf(f.y), h2 = f2bf(f.z), h3 = f2bf(f.w);
            const float l0 = f.x - bf2f((unsigned short)h0), l1 = f.y - bf2f((unsigned short)h1), l2 = f.z - bf2f((unsigned short)h2), l3 = f.w - bf2f((unsigned short)h3);
            *(LAS u32x2*)(kmh + j * KS + c4) = (u32x2){h0 | (h1 << 16), h2 | (h3 << 16)};
            *(LAS u32x2*)(kml + j * KS + c4) = (u32x2){pk2(l0, l1), pk2(l2, l3)}; }
        if (tid < 64) hist[tid] = 0; }
    __syncthreads();
    const int p = b * 256 + 32 * w + r32;
    bf16x8 qf[8];
    {   const unsigned short* qp = (const unsigned short*)(F.ws + WS_MIX) + (size_t)p * 2048 + 1024 + h * 128 + 8 * hi;
#pragma unroll
        for (int kd = 0; kd < 8; ++kd) qf[kd] = *(const bf16x8*)(qp + 16 * kd); }
    float v0 = -INFINITY, v1 = -INFINITY, v2 = -INFINITY; int i0 = 64, i1 = 64, i2 = 64;
    const int ntile = (b + 31) >> 5;
#pragma unroll 1
    for (int tile = 0; tile < ntile; ++tile) {
        f32x16 acc = {};
#pragma unroll
        for (int kd = 0; kd < 8; ++kd) {
            const bf16x8 ah = *(const LAS bf16x8*)(kmh + (32 * tile + r32) * KS + 16 * kd + 8 * hi), al = *(const LAS bf16x8*)(kml + (32 * tile + r32) * KS + 16 * kd + 8 * hi);
            acc = MFMA32(ah, qf[kd], acc); acc = MFMA32(al, qf[kd], acc);
        }
#pragma unroll
        for (int r = 0; r < 16; ++r) { const int j = 32 * tile + crow(r, hi); const float s = (j < b) ? acc[r] : -INFINITY; TOP3_INS(s, j); }
    }
    {
        const float u0 = __shfl_xor(v0, 32), u1 = __shfl_xor(v1, 32), u2 = __shfl_xor(v2, 32); const int k0 = __shfl_xor(i0, 32), k1 = __shfl_xor(i1, 32), k2 = __shfl_xor(i2, 32);
        TOP3_INS(u0, k0); TOP3_INS(u1, k1); TOP3_INS(u2, k2); }
    const int nsel = b < 3 ? b : 3; int sel[3] = {i0, i1, i2}, rank[3] = {0, 0, 0};
    if (hi == 0) {
#pragma unroll
        for (int k = 0; k < 3; ++k) if (k < nsel) rank[k] = atomicAdd((int*)&hist[sel[k]], 1);
    }
    __syncthreads();
    if (tid < 64) { const int n = hist[tid]; base[tid] = n ? (int)atomicAdd((unsigned*)(F.ctl + CW_CNT + h * 64 + tid), (unsigned)n) : 0; }
    __syncthreads();
    if (hi == 0) { unsigned* lists = (unsigned*)(F.ws + WS_LISTS);
#pragma unroll
        for (int k = 0; k < 3; ++k) if (k < nsel) lists[list_off(h, sel[k]) + base[sel[k]] + rank[k]] = ((unsigned)p << 2) | (unsigned)k; }
    __syncthreads();
}
#undef TOP3_INS

namespace moba {
constexpr int D = 128, NW = 8, QBLK = 32, KVBLK = 64, LDK = 1024;
constexpr float SCALE = 0.088388347648318440f, THR = 8.f;
constexpr size_t SHM_V = KVBLK * D * 2, SHM_K = KVBLK * D * 2, SHM_ATTN = 2 * SHM_V + 2 * SHM_K + NW * 128 * 4;
#define KSWZ(row, colB) ((row) * 256 + ((colB) ^ (((row) & 7) << 4)))
__device__ __forceinline__ void partialSM(f32x16& p0, f32x16& p1, float& m_reg, float& mn, float& alpha) {
  constexpr float C = SCALE * 1.4426950408889634f;
  float pmax = p0[0]; for (int r = 1; r < 16; ++r) pmax = fmaxf(pmax, p0[r]); for (int r = 0; r < 16; ++r) pmax = fmaxf(pmax, p1[r]);
  { auto rr = __builtin_amdgcn_permlane32_swap(__float_as_uint(pmax), __float_as_uint(pmax), false, false);
    pmax = fmaxf(__uint_as_float(rr[0]), __uint_as_float(rr[1])); }
  if (__builtin_expect(__all(pmax - m_reg <= THR / SCALE), 1)) { mn = m_reg; alpha = 1.f; }
  else { mn = fmaxf(m_reg, pmax); alpha = __builtin_amdgcn_exp2f((m_reg - mn) * C); m_reg = mn; }
  float mnC = -mn * C;
  for (int r = 0; r < 16; ++r) p0[r] = fmaf(p0[r], C, mnC); for (int r = 0; r < 16; ++r) p1[r] = fmaf(p1[r], C, mnC);
  for (int r = 0; r < 16; ++r) p0[r] = __builtin_amdgcn_exp2f(p0[r]);
}
__device__ __forceinline__ void finishSM(f32x16& p0, f32x16& p1, float alpha, float& l_reg, bf16x8& pa0, bf16x8& pa1, bf16x8& pa2, bf16x8& pa3) {
  for (int r = 0; r < 16; ++r) p1[r] = __builtin_amdgcn_exp2f(p1[r]);
  float ps = 0; for (int r = 0; r < 16; ++r) ps += p0[r]; for (int r = 0; r < 16; ++r) ps += p1[r];
  { auto rr = __builtin_amdgcn_permlane32_swap(__float_as_uint(ps), __float_as_uint(ps), false, false);
    ps = __uint_as_float(rr[0]) + __uint_as_float(rr[1]); }
  l_reg = l_reg * alpha + ps;
#define PK4(P, BASE, OUT) do { unsigned a0 = cvtpk(P[BASE + 0], P[BASE + 1]), a1 = cvtpk(P[BASE + 2], P[BASE + 3]);   \
    unsigned b0 = cvtpk(P[BASE + 4], P[BASE + 5]), b1 = cvtpk(P[BASE + 6], P[BASE + 7]);                              \
    auto r0 = __builtin_amdgcn_permlane32_swap(a0, b0, false, false); auto r1 = __builtin_amdgcn_permlane32_swap(a1, b1, false, false); \
    u32x4v w = {r0[0], r1[0], r0[1], r1[1]}; OUT = *reinterpret_cast<bf16x8*>(&w); } while (0)
  PK4(p0, 0, pa0); PK4(p0, 8, pa1); PK4(p1, 0, pa2); PK4(p1, 8, pa3);
#undef PK4
}
__device__ __forceinline__ void qkt(f32x16& p0, f32x16& p1, const char* Ks, const bf16x8* qr, int r32, int hi) {
  const f32x16 z = {};
  bf16x8 a0 = *reinterpret_cast<const bf16x8*>(Ks + KSWZ(r32, (hi * 8) * 2)), a1 = *reinterpret_cast<const bf16x8*>(Ks + KSWZ(32 + r32, (hi * 8) * 2));
#pragma unroll
  for (int d0 = 0; d0 < 8; ++d0) {
    bf16x8 n0 = a0, n1 = a1;
    if (d0 < 7) { const int cb = ((d0 + 1) * 16 + hi * 8) * 2; n0 = *reinterpret_cast<const bf16x8*>(Ks + KSWZ(r32, cb)); n1 = *reinterpret_cast<const bf16x8*>(Ks + KSWZ(32 + r32, cb)); }
    p0 = MFMA32(a0, qr[d0], d0 == 0 ? z : p0);
    p1 = MFMA32(a1, qr[d0], d0 == 0 ? z : p1);
    a0 = n0; a1 = n1;
  }
}
__device__ __forceinline__ int v_st(int k, int c) { const int kk = (k & ~0xC) | ((k & 4) << 1) | ((k & 8) >> 1); return ((kk >> 3) * 4 + (c >> 5)) * 512 + ((kk & 7) * 32 + (c & 31)) * 2; }
__device__ __forceinline__ int v_rd_base(int lane) { return ((lane & 3) << 3) | (((lane >> 2) & 3) << 6) | (((lane >> 4) & 1) << 5) | (((lane >> 5) & 1) << 8); }
constexpr int v_rd_off(int d0, int ks, int half) { return d0 * 512 + ks * 4096 + half * 2048; }
template <int OFF> __device__ __forceinline__ s16x4 tr_read(int vb) {
  s16x4 r; asm volatile("ds_read_b64_tr_b16 %0, %1 offset:%2" : "=&v"(r) : "v"(vb), "i"(OFF) : "memory"); return r;
}
template <int D0> __device__ __forceinline__ void pv_one(f32x16& od, int vb, bf16x8 pa0, bf16x8 pa1, bf16x8 pa2, bf16x8 pa3) {
  const s16x4 l0 = tr_read<v_rd_off(D0, 0, 0)>(vb), h0 = tr_read<v_rd_off(D0, 0, 1)>(vb), l1 = tr_read<v_rd_off(D0, 1, 0)>(vb), h1 = tr_read<v_rd_off(D0, 1, 1)>(vb);
  const s16x4 l2 = tr_read<v_rd_off(D0, 2, 0)>(vb), h2 = tr_read<v_rd_off(D0, 2, 1)>(vb), l3 = tr_read<v_rd_off(D0, 3, 0)>(vb), h3 = tr_read<v_rd_off(D0, 3, 1)>(vb);
  asm volatile("s_waitcnt lgkmcnt(0)" ::: "memory"); SBAR();
#define PK(L, H) (bf16x8){L[0], L[1], L[2], L[3], H[0], H[1], H[2], H[3]}
  od = MFMA32(pa0, PK(l0, h0), od);
  od = MFMA32(pa1, PK(l1, h1), od);
  od = MFMA32(pa2, PK(l2, h2), od);
  od = MFMA32(pa3, PK(l3, h3), od);
#undef PK
}
__device__ __forceinline__ void pv_d0(f32x16* o, int vb, bf16x8 pa0, bf16x8 pa1, bf16x8 pa2, bf16x8 pa3) {
  pv_one<0>(o[0], vb, pa0, pa1, pa2, pa3); pv_one<1>(o[1], vb, pa0, pa1, pa2, pa3); pv_one<2>(o[2], vb, pa0, pa1, pa2, pa3); pv_one<3>(o[3], vb, pa0, pa1, pa2, pa3);
}
__device__ __forceinline__ void cmask(f32x16& p0, f32x16& p1, int tile, int qloc, int hi) {
#pragma unroll
  for (int r = 0; r < 16; ++r) { const int key = 64 * tile + crow(r, hi); if (key > qloc) p0[r] = -1e30f; if (key + 32 > qloc) p1[r] = -1e30f; }
}
#ifndef MOBA_STAGGER
#define MOBA_STAGGER 24
#endif
constexpr int MAXWC = 24;
constexpr int TILE_B = 16384;
__device__ __forceinline__ void wave_chunk(const bf16x8 (&qr)[8], int nt, bool causal, int qloc, const char* K_lds, int vb0, float* ws, unsigned rowoff, unsigned lseoff, unsigned char* wsb, int r32, int hi) {
  float* li_l = ws; float* al_l = ws + 32; unsigned* id_l = (unsigned*)(ws + 64);
  float m_reg = -1e30f, l_reg = 0; f32x16 o[4] = {};
#pragma unroll 1
  for (int t = 0; t < nt; ++t) {
    f32x16 p0, p1; float mn, alpha; bf16x8 pa0, pa1, pa2, pa3;
    __builtin_amdgcn_s_setprio(1); qkt(p0, p1, K_lds + t * TILE_B, qr, r32, hi); __builtin_amdgcn_s_setprio(0);
    if (causal && t == nt - 1) cmask(p0, p1, t, qloc, hi);
    partialSM(p0, p1, m_reg, mn, alpha);
    finishSM(p0, p1, alpha, l_reg, pa0, pa1, pa2, pa3);
    if (__any(alpha < 1.f)) { if (hi == 0) al_l[r32] = alpha; asm volatile("s_waitcnt lgkmcnt(0)" ::: "memory");
#pragma unroll
      for (int d = 0; d < 4; ++d)
#pragma unroll
        for (int r = 0; r < 16; ++r) o[d][r] *= al_l[crow(r, hi)]; }
    SBAR();
    __builtin_amdgcn_s_setprio(1); pv_d0(o, vb0 + t * TILE_B, pa0, pa1, pa2, pa3); __builtin_amdgcn_s_setprio(0);
  }
  if (hi == 0) { li_l[r32] = l_reg; id_l[r32] = rowoff; *(float*)(wsb + lseoff) = m_reg * (SCALE * 1.4426950408889634f) + __builtin_amdgcn_logf(l_reg); }
  asm volatile("s_waitcnt lgkmcnt(0)" ::: "memory");
#pragma unroll
  for (int r = 0; r < 16; ++r) { const int orow = crow(r, hi); const unsigned off = id_l[orow]; const float rl = __builtin_amdgcn_rcpf(li_l[orow]);
    unsigned short* dst = (unsigned short*)(wsb + off) + r32;
#pragma unroll
    for (int d0 = 0; d0 < 4; ++d0) dst[d0 * 32] = (unsigned short)(cvtpk(o[d0][r] * rl, 0.f)); }
  asm volatile("s_waitcnt lgkmcnt(0)" ::: "memory");
}
#undef KSWZ
}

__device__ __forceinline__ void moba_attn_phase(Frame& F) {
    constexpr int SCR_OFF = LDSCTL_OFF + 1024, PREF_OFF = SCR_OFF + 4096;
    LAS int* prefF = (LAS int*)(F.lds + PREF_OFF);
    LAS int* prefP = prefF + 520;
    LAS int* wsum = prefP + 520;
    LAS int* tk = wsum + 16;
    const int tid = F.tid;
    {   const unsigned n = __hip_atomic_load(F.ctl + CW_CNT + tid, __ATOMIC_RELAXED, __HIP_MEMORY_SCOPE_AGENT);
        const int wc = 8 + (int)((n + 31u) >> 5); const int nf = wc / moba::MAXWC, np = (wc % moba::MAXWC) ? 1 : 0;
        int v = nf, u = np;
#pragma unroll
        for (int o = 1; o < 64; o <<= 1) { const int t = __shfl_up(v, o), t2 = __shfl_up(u, o); if (F.lane >= o) { v += t; u += t2; } }
        if (F.lane == 63) { wsum[F.wave] = v; wsum[8 + F.wave] = u; }
        __syncthreads();
        int add = 0, add2 = 0;
#pragma unroll
        for (int w = 0; w < 8; ++w) { add += (w < F.wave) ? wsum[w] : 0; add2 += (w < F.wave) ? wsum[8 + w] : 0; }
        prefF[tid] = v - nf + add; prefP[tid] = u - np + add2;
        if (tid == 511) { prefF[512] = v + add; prefP[512] = u + add2; }
        if (tid == 0) tk[0] = (int)atomicAdd((unsigned*)(F.ctl + CW_QUEUE), 1u);
        __syncthreads();
    }
    const int totalF = prefF[512], total = totalF + prefP[512];
    const unsigned short* MIXq = (const unsigned short*)(F.ws + WS_MIX) + 1024;
    const unsigned short* KB = (const unsigned short*)(F.ws + WS_KB); const unsigned short* VB = (const unsigned short*)(F.ws + WS_VB);
    const unsigned* lists = (const unsigned*)(F.ws + WS_LISTS);
    const int r32 = F.lane & 31, hi = F.lane >> 5, w = F.wave;
    char* K_lds = (char*)F.lds; char* V_lds = (char*)F.lds + 4 * moba::TILE_B;
    float* scr = (float*)((char*)F.lds + SCR_OFF) + w * 128;
    const int vb0 = (int)(uintptr_t)V_lds + moba::v_rd_base(F.lane);
    const int sr = tid >> 4, sc = (tid & 15) * 8, vst0 = moba::v_st(sr, sc), vst1 = moba::v_st(32 + sr, sc);
    int it = tk[0];
    while (it < total) {
        const bool isfull = it < totalF; const int r_ = isfull ? it : it - totalF; LAS int* pref = isfull ? prefF : prefP;
        int lo = 0, hi_ = 512;
        while (hi_ - lo > 1) { const int mid = (lo + hi_) >> 1; if (pref[mid] <= r_) lo = mid; else hi_ = mid; }
        const int e = lo, h = e >> 6, j = e & 63;
        const int n = (int)__hip_atomic_load(F.ctl + CW_CNT + e, __ATOMIC_RELAXED, __HIP_MEMORY_SCOPE_AGENT);
        const int wc_e = 8 + ((n + 31) >> 5); const int sub = isfull ? (r_ - pref[e]) : (wc_e / moba::MAXWC);
        const int q_lo = sub * moba::MAXWC, q_hi = (q_lo + moba::MAXWC < wc_e) ? q_lo + moba::MAXWC : wc_e;
        const unsigned short* Kh = KB + (size_t)(j * 256) * 1024 + h * 128; const unsigned short* Vh = VB + (size_t)(j * 256) * 1024 + h * 128;
        { TPA_BEGIN(130);
        __syncthreads();
        if (tid == 0) tk[0] = (int)atomicAdd((unsigned*)(F.ctl + CW_QUEUE), 1u);
        {   bf16x8 kv[16];
#pragma unroll
            for (int tt = 0; tt < 4; ++tt) { const int k0 = tt * 64;
                kv[4 * tt + 0] = *(const bf16x8*)(Vh + (size_t)(k0 + sr) * 1024 + sc); kv[4 * tt + 1] = *(const bf16x8*)(Vh + (size_t)(k0 + 32 + sr) * 1024 + sc);
                kv[4 * tt + 2] = *(const bf16x8*)(Kh + (size_t)(k0 + sr) * 1024 + sc); kv[4 * tt + 3] = *(const bf16x8*)(Kh + (size_t)(k0 + 32 + sr) * 1024 + sc); }
#pragma unroll
            for (int tt = 0; tt < 4; ++tt) { const int tb = tt * moba::TILE_B, kc = sc * 2;
                *(bf16x8*)(V_lds + tb + vst0) = kv[4 * tt + 0]; *(bf16x8*)(V_lds + tb + vst1) = kv[4 * tt + 1];
                *(bf16x8*)(K_lds + tb + ((sr) * 256 + ((kc) ^ (((sr) & 7) << 4)))) = kv[4 * tt + 2];
                *(bf16x8*)(K_lds + tb + ((32 + sr) * 256 + ((kc) ^ (((32 + sr) & 7) << 4)))) = kv[4 * tt + 3]; }
        }
        __syncthreads();
        TPA_END(130); }
        it = tk[0];
        TPA_BEGIN(131);
        if (w >= 4) __builtin_amdgcn_s_sleep(MOBA_STAGGER);
        bf16x8 qa[8], qb[8]; unsigned ida = 0, idb = 0, lsa = 0, lsb = 0; int nta = 4, ntb = 4, qla = 0, qlb = 0; bool ca = false, cb = false;
        const unsigned dump = (unsigned)WS_KWT + (unsigned)((F.bid * 8 + w) * 512);
#define PART_OFF(slot_) ((unsigned)(((slot_) & 2) ? WS_PART2 : WS_PART0) + (unsigned)((slot_) & 1) * (unsigned)(32 * MiB))
#define WC_SETUP(Q_, QF, ID, LS, NT, QL, CZ) do { const int q__ = (Q_); const unsigned short* qp__; \
        if (q__ < 8) { const int p__ = j * 256 + 32 * q__ + r32; qp__ = MIXq + (size_t)p__ * 2048 + h * 128 + hi * 8; ID = PART_OFF(3) + (unsigned)(p__ * 8 + h) * 256u; LS = (unsigned)WS_LSE + (unsigned)((p__ * 8 + h) * 4 + 3) * 4u; NT = (q__ >> 1) + 1; QL = 32 * q__ + r32; CZ = true; } \
        else { const int idx__ = 32 * (q__ - 8) + r32; const bool v__ = idx__ < n; const unsigned ent__ = lists[list_off(h, j) + (v__ ? idx__ : 0)]; const int p__ = (int)(ent__ >> 2); const int sl__ = (int)(ent__ & 3u); \
               qp__ = MIXq + (size_t)p__ * 2048 + h * 128 + hi * 8; ID = v__ ? PART_OFF(sl__) + (unsigned)(p__ * 8 + h) * 256u : dump; LS = v__ ? (unsigned)WS_LSE + (unsigned)((p__ * 8 + h) * 4 + sl__) * 4u : dump + 256u; NT = 4; QL = 0; CZ = false; } \
        _Pragma("unroll") for (int d0 = 0; d0 < 8; ++d0) QF[d0] = *reinterpret_cast<const bf16x8*>(qp__ + d0 * 16); } while (0)
        int q = q_lo + w;
        if (q < q_hi) WC_SETUP(q, qa, ida, lsa, nta, qla, ca);
        while (q < q_hi) {
            if (q + 8 < q_hi) WC_SETUP(q + 8, qb, idb, lsb, ntb, qlb, cb);
            moba::wave_chunk(qa, nta, ca, qla, K_lds, vb0, scr, ida, lsa, F.ws, r32, hi);
            q += 8; if (q >= q_hi) break;
            if (q + 8 < q_hi) WC_SETUP(q + 8, qa, ida, lsa, nta, qla, ca);
            moba::wave_chunk(qb, ntb, cb, qlb, K_lds, vb0, scr, idb, lsb, F.ws, r32, hi);
            q += 8;
        }
#undef PART_OFF
#undef WC_SETUP
        TPA_END(131);
    }
}

__device__ __forceinline__ void moba_merge_phase(Frame& F, int wg, int nwg) {
    const float* lse = (const float*)(F.ws + WS_LSE);
    const u32x4v* P0 = (const u32x4v*)(F.ws + WS_PART0); const u32x4v* P1 = (const u32x4v*)(F.ws + WS_PART1);
    const u32x4v* P2 = (const u32x4v*)(F.ws + WS_PART2); const u32x4v* P3 = (const u32x4v*)(F.ws + WS_PART3);
    for (int g = wg * 512 + F.tid; g < M_TOK * MB_H * 16; g += nwg * 512) {
        const int ph = g >> 4, dg = g & 15, p = ph >> 3;
#if defined(DBG_OWN_ONLY)
        const int nsel = 0;
#else
        const int nsel = (p >> 8) < 3 ? (p >> 8) : 3;
#endif
        const f32x4 l4 = *(const f32x4*)(lse + (size_t)ph * 4);
        const size_t po = (size_t)ph * 16 + dg;
        const u32x4v v0 = P0[po], v1 = P1[po], v2 = P2[po], v3 = P3[po];
        const float l0 = nsel > 0 ? l4[0] : -INFINITY, l1 = nsel > 1 ? l4[1] : -INFINITY, l2 = nsel > 2 ? l4[2] : -INFINITY, l3 = l4[3];
        const float mx = fmaxf(fmaxf(l0, l1), fmaxf(l2, l3));
        const float w0 = nsel > 0 ? __builtin_amdgcn_exp2f(l0 - mx) : 0.f, w1 = nsel > 1 ? __builtin_amdgcn_exp2f(l1 - mx) : 0.f, w2 = nsel > 2 ? __builtin_amdgcn_exp2f(l2 - mx) : 0.f, w3 = __builtin_amdgcn_exp2f(l3 - mx);
        const u32x4v z = {0u, 0u, 0u, 0u};
        const u32x4v a0 = nsel > 0 ? v0 : z, a1 = nsel > 1 ? v1 : z, a2 = nsel > 2 ? v2 : z;
        const float inv = 1.f / ((w0 + w1) + (w2 + w3));
        float acc[8];
#define MRG(E, F_) acc[E] = (w0 * F_(a0[E >> 1]) + w1 * F_(a1[E >> 1])) + (w2 * F_(a2[E >> 1]) + w3 * F_(v3[E >> 1]))
        MRG(0, bflo); MRG(1, bfhi); MRG(2, bflo); MRG(3, bfhi); MRG(4, bflo); MRG(5, bfhi); MRG(6, bflo); MRG(7, bfhi);
#undef MRG
        u32x4v o; o.x = pk2(acc[0] * inv, acc[1] * inv); o.y = pk2(acc[2] * inv, acc[3] * inv); o.z = pk2(acc[4] * inv, acc[5] * inv); o.w = pk2(acc[6] * inv, acc[7] * inv);
        *(u32x4v*)((unsigned short*)(F.ws + WS_MIX) + (size_t)p * 2048 + 1024 + (ph & 7) * 128 + dg * 8) = o;
    }
}

__device__ __forceinline__ void ml_mscan(const float* chsum, int h, int c, int lane, float& m_c, float& m_c1) {
    float a[4], g[4]; float A = 0.f, G = -INFINITY;
#pragma unroll
    for (int i = 0; i < 4; ++i) { const int cc = 4 * lane + i; const float bl = chsum[(cc * 4 + h) * 2], m1 = chsum[(cc * 4 + h) * 2 + 1]; a[i] = bl; g[i] = bl + m1; G = fmaxf(G + a[i], g[i]); A += a[i]; }
#pragma unroll
    for (int o = 1; o < 64; o <<= 1) { const float Ao = __shfl_up(A, o), Go = __shfl_up(G, o); if (lane >= o) { G = fmaxf(Go + A, G); A = Ao + A; } }
    float Ae = __shfl_up(A, 1), Ge = __shfl_up(G, 1); if (lane == 0) { Ae = 0.f; Ge = -INFINITY; }
    float m = fmaxf(Ae, Ge), mc = 0.f, mc1 = 0.f;
#pragma unroll
    for (int i = 0; i < 4; ++i) { if (i == (c & 3)) mc = m; m = fmaxf(m + a[i], g[i]); if (i == (c & 3)) mc1 = m; }
    m_c = __shfl(mc, c >> 2); m_c1 = __shfl(mc1, c >> 2);
}
__device__ __forceinline__ void ml_tables(const float* chsum, int h, int lane, LAS float* dec, LAS float* scl) {
    float a[4], g[4]; float A = 0.f, G = -INFINITY;
#pragma unroll
    for (int i = 0; i < 4; ++i) { const int cc = 4 * lane + i; const float bl = chsum[(cc * 4 + h) * 2], m1 = chsum[(cc * 4 + h) * 2 + 1]; a[i] = bl; g[i] = bl + m1; G = fmaxf(G + a[i], g[i]); A += a[i]; }
#pragma unroll
    for (int o = 1; o < 64; o <<= 1) { const float Ao = __shfl_up(A, o), Go = __shfl_up(G, o); if (lane >= o) { G = fmaxf(Go + A, G); A = Ao + A; } }
    float Ae = __shfl_up(A, 1), Ge = __shfl_up(G, 1); if (lane == 0) { Ae = 0.f; Ge = -INFINITY; }
    float m = fmaxf(Ae, Ge);
#pragma unroll
    for (int i = 0; i < 4; ++i) { const float mn = fmaxf(m + a[i], g[i]); dec[4 * lane + i] = expf(a[i] + m - mn); scl[4 * lane + i] = expf(g[i] - mn); m = mn; }
}
__device__ __forceinline__ void ml_scan_item(Frame& F, int item) {
    LAS float* dec = (LAS float*)F.lds; LAS float* scl = dec + 1024;
    if (item < 32) {
        const int gid = item * 512 + F.tid, h = gid >> 12, rem = gid & 4095;
        if (F.wave == 0) ml_tables(SMALLF(SM_CHSUM), h, F.lane, dec, scl);
        __syncthreads();
        u32x4v* base = (u32x4v*)((unsigned short*)(F.ws + WS_LOCAL) + (size_t)h * 256 * 128) + rem;
        constexpr size_t CST = (size_t)4 * 256 * 128 / 8;
        float C[8];
#pragma unroll
        for (int e = 0; e < 8; ++e) C[e] = 0.f;
        u32x4v la[16], lb[16];
#define SC_LOAD(L, c0_) do { _Pragma("unroll") for (int i = 0; i < 16; ++i) L[i] = base[(size_t)((c0_) + i) * CST]; } while (0)
#define SC_STEP(L, c0_) do { _Pragma("unroll") for (int i = 0; i < 16; ++i) { \
            u32x4v st; st.x = cvtpk(C[0], C[1]); st.y = cvtpk(C[2], C[3]); st.z = cvtpk(C[4], C[5]); st.w = cvtpk(C[6], C[7]); \
            base[(size_t)((c0_) + i) * CST] = st; \
            const u32x4v v = L[i]; const float d = dec[(c0_) + i], s = scl[(c0_) + i]; \
            C[0] = d * C[0] + s * bflo(v.x); C[1] = d * C[1] + s * bfhi(v.x); C[2] = d * C[2] + s * bflo(v.y); C[3] = d * C[3] + s * bfhi(v.y); \
            C[4] = d * C[4] + s * bflo(v.z); C[5] = d * C[5] + s * bfhi(v.z); C[6] = d * C[6] + s * bflo(v.w); C[7] = d * C[7] + s * bfhi(v.w); } } while (0)
        SC_LOAD(la, 0);
#pragma unroll 1
        for (int c0 = 0; c0 < ML_NC; c0 += 32) {
            SC_LOAD(lb, c0 + 16);
            SC_STEP(la, c0);
            if (c0 + 32 < ML_NC) SC_LOAD(la, c0 + 32);
            SC_STEP(lb, c0 + 16);
        }
#undef SC_LOAD
#undef SC_STEP
        __syncthreads();
    } else {
        if (F.wave < 4) ml_tables(SMALLF(SM_CHSUM), F.wave, F.lane, dec + F.wave * 256, scl + F.wave * 256);
        __syncthreads();
        const int h = F.tid >> 7, d = F.tid & 127; float* nl = SMALLF(SM_NLOC) + h * 128 + d; float n = 0.f;
#pragma unroll 1
        for (int c0 = 0; c0 < ML_NC; c0 += 32) {
            float lv[32];
#pragma unroll
            for (int i = 0; i < 32; ++i) lv[i] = nl[(size_t)(c0 + i) * 512];
#pragma unroll
            for (int i = 0; i < 32; ++i) { nl[(size_t)(c0 + i) * 512] = n; n = dec[h * 256 + c0 + i] * n + scl[h * 256 + c0 + i] * lv[i]; }
        }
        __syncthreads();
    }
}
__device__ __forceinline__ float dpp_row_sum(float x) {
    x += __builtin_bit_cast(float, __builtin_amdgcn_update_dpp(0, __builtin_bit_cast(int, x), 0xB1, 0xF, 0xF, true));
    x += __builtin_bit_cast(float, __builtin_amdgcn_update_dpp(0, __builtin_bit_cast(int, x), 0x4E, 0xF, 0xF, true));
    x += __builtin_bit_cast(float, __builtin_amdgcn_update_dpp(0, __builtin_bit_cast(int, x), 0x141, 0xF, 0xF, true));
    x += __builtin_bit_cast(float, __builtin_amdgcn_update_dpp(0, __builtin_bit_cast(int, x), 0x140, 0xF, 0xF, true));
    return x;
}
struct MlRegs { v4u gq[2], gk[2], gm[4]; bf16x8 cf[8]; u32x2 vlo[4], vhi[4]; };
__device__ __forceinline__ void ml_load_tiles(Frame& F, int c, int h, MlRegs& R) {
    const int tid = F.tid, t0 = c * ML_L;
    const v4u* QC = (const v4u*)(F.ws + WS_QC); const v4u* KC = (const v4u*)(F.ws + WS_KC); const v4u* MX = (const v4u*)(F.ws + WS_MIX);
#pragma unroll
    for (int i = 0; i < 2; ++i) { const int idx = tid + 512 * i, row = idx >> 4, ch = idx & 15; R.gq[i] = QC[(size_t)(t0 + row) * 64 + h * 16 + ch]; R.gk[i] = KC[(size_t)(t0 + row) * 64 + h * 16 + ch]; }
    (void)MX;
}
__device__ __forceinline__ void ml_load_state(Frame& F, int c, int h, MlRegs& R) {
    const int hh = F.lane >> 5, vcol = 32 * F.wave + (F.lane & 31);
    const unsigned short* ST = (const unsigned short*)(F.ws + WS_LOCAL) + (size_t)(c * 4 + h) * 256 * 128 + (size_t)vcol * 8;
#pragma unroll
    for (int kd = 0; kd < 8; ++kd) R.cf[kd] = *(const bf16x8*)(ST + (2 * kd + hh) * 2048);
}
__device__ __forceinline__ void ml_load_vt(Frame& F, int c, int h, MlRegs& R) {
    const int hh = F.lane >> 5, vcol = 32 * F.wave + (F.lane & 31);
    const unsigned short* VTv = (const unsigned short*)(F.ws + WS_VT) + (size_t)(c * 4 + h) * 256 * 64 + (size_t)vcol * 4;
#pragma unroll
    for (int i = 0; i < 4; ++i) { R.vlo[i] = *(const u32x2*)(VTv + (4 * i + hh) * 1024); R.vhi[i] = *(const u32x2*)(VTv + (4 * i + 2 + hh) * 1024); }
}
__device__ __forceinline__ void ml_out_item(Frame& F, int c, int h, MlRegs& R, bool has_next, int cn, int hn) {
    const int lane = F.lane, r = lane & 31, hh = lane >> 5, w = F.wave, tid = F.tid, t0 = c * ML_L;
    constexpr int QS = 136, MS = 264;
    LAS float* tb_u = (LAS float*)F.lds;
    LAS float* tb_mt = tb_u + 64;
    LAS float* tb_wi = tb_mt + 64;
    LAS float* tb_em = tb_wi + 64;
    LAS float* tb_n = tb_em + 64;
    LAS float* tb_den = tb_n + 128;
    LAS float* tb_ln = tb_den + 512;
    LAS float* tb_mr = tb_ln + 1024;
    LAS unsigned short* Ql = (LAS unsigned short*)(F.lds + 8192);
    LAS unsigned short* Kl = Ql + 64 * QS;
    LAS unsigned short* Ml = Kl + 64 * QS;
    const int vcol = 32 * w + r;
    ml_load_tiles(F, c, h, R);
    {   const v4u* MX = (const v4u*)(F.ws + WS_MIX);
#pragma unroll
        for (int i = 0; i < 4; ++i) { const int idx = tid + 512 * i, row = idx >> 5, ch = idx & 31; R.gm[i] = MX[(size_t)(t0 + row) * 256 + h * 32 + ch]; } }
    float m_c, m_c1; ml_mscan(SMALLF(SM_CHSUM), h, c, lane, m_c, m_c1);
    if (tid < 64) { const f32x4 ts = *(const f32x4*)(SMALLF(SM_TOKSC) + (size_t)((t0 + tid) * 4 + h) * 4);
        const float mt = fmaxf(m_c, ts.z); tb_u[tid] = ts.y; tb_mt[tid] = mt; tb_wi[tid] = expf(m_c - mt); tb_em[tid] = expf(-(ts.x + mt)); }
    if (tid >= 64 && tid < 192) tb_n[tid - 64] = SMALLF(SM_NLOC)[(c * 4 + h) * 128 + tid - 64];
#pragma unroll
    for (int i = 0; i < 2; ++i) { const int idx = tid + 512 * i, row = idx >> 4, ch = idx & 15; *(LAS v4u*)(Ql + row * QS + ch * 8) = R.gq[i]; *(LAS v4u*)(Kl + row * QS + ch * 8) = R.gk[i]; }
#pragma unroll
    for (int i = 0; i < 4; ++i) { const int idx = tid + 512 * i, row = idx >> 5, ch = idx & 31; *(LAS v4u*)(Ml + row * MS + ch * 8) = R.gm[i]; }
    __syncthreads();
    f32x16 s00 = {}, s01 = {}, s11 = {};
    float qn0 = 0.f, qn1 = 0.f;
#pragma unroll 1
    for (int kd = 0; kd < 8; ++kd) {
        const bf16x8 q0 = *(const LAS bf16x8*)(Ql + r * QS + 16 * kd + 8 * hh), q1 = *(const LAS bf16x8*)(Ql + (32 + r) * QS + 16 * kd + 8 * hh);
        const bf16x8 k0 = *(const LAS bf16x8*)(Kl + r * QS + 16 * kd + 8 * hh), k1 = *(const LAS bf16x8*)(Kl + (32 + r) * QS + 16 * kd + 8 * hh);
        s00 = MFMA32(k0, q0, s00); s01 = MFMA32(k0, q1, s01); s11 = MFMA32(k1, q1, s11);
        const f32x4 n0 = *(const LAS f32x4*)(tb_n + 16 * kd + 8 * hh), n1 = *(const LAS f32x4*)(tb_n + 16 * kd + 8 * hh + 4);
        const u32x4v a = __builtin_bit_cast(u32x4v, q0), b = __builtin_bit_cast(u32x4v, q1);
        qn0 += bflo(a.x) * n0.x + bfhi(a.x) * n0.y + bflo(a.y) * n0.z + bfhi(a.y) * n0.w + bflo(a.z) * n1.x + bfhi(a.z) * n1.y + bflo(a.w) * n1.z + bfhi(a.w) * n1.w;
        qn1 += bflo(b.x) * n0.x + bfhi(b.x) * n0.y + bflo(b.y) * n0.z + bfhi(b.y) * n0.w + bflo(b.z) * n1.x + bfhi(b.z) * n1.y + bflo(b.w) * n1.z + bfhi(b.w) * n1.w;
    }
    const float mt0 = tb_mt[r], mt1 = tb_mt[32 + r];
    float rs0 = 0.f, rs1 = 0.f;
#pragma unroll
    for (int q = 0; q < 16; ++q) {
        const int s = crow(q, hh); const float u0 = tb_u[s], u1 = tb_u[32 + s];
        s00[q] = (s <= r) ? s00[q] * __expf(u0 - mt0) : 0.f;
        s01[q] = s01[q] * __expf(u0 - mt1);
        s11[q] = (s <= r) ? s11[q] * __expf(u1 - mt1) : 0.f;
        rs0 += s00[q]; rs1 += s01[q] + s11[q];
    }
    rs0 += __shfl_xor(rs0, 32); rs1 += __shfl_xor(rs1, 32); qn0 += __shfl_xor(qn0, 32); qn1 += __shfl_xor(qn1, 32);
    {   const float den0 = tb_wi[r] * qn0 + rs0, den1 = tb_wi[32 + r] * qn1 + rs1;
        if (hh == 0) { tb_den[w * 64 + r] = 1.f / fmaxf(fabsf(den0), tb_em[r]); tb_den[w * 64 + 32 + r] = 1.f / fmaxf(fabsf(den1), tb_em[32 + r]); } }
    bf16x8 p00[2], p01[2], p11[2];
#pragma unroll
    for (int ks = 0; ks < 2; ++ks) {
        u32x4v x; x.x = cvtpk(s00[8 * ks], s00[8 * ks + 1]); x.y = cvtpk(s00[8 * ks + 2], s00[8 * ks + 3]); x.z = cvtpk(s00[8 * ks + 4], s00[8 * ks + 5]); x.w = cvtpk(s00[8 * ks + 6], s00[8 * ks + 7]); p00[ks] = __builtin_bit_cast(bf16x8, x);
        x.x = cvtpk(s01[8 * ks], s01[8 * ks + 1]); x.y = cvtpk(s01[8 * ks + 2], s01[8 * ks + 3]); x.z = cvtpk(s01[8 * ks + 4], s01[8 * ks + 5]); x.w = cvtpk(s01[8 * ks + 6], s01[8 * ks + 7]); p01[ks] = __builtin_bit_cast(bf16x8, x);
        x.x = cvtpk(s11[8 * ks], s11[8 * ks + 1]); x.y = cvtpk(s11[8 * ks + 2], s11[8 * ks + 3]); x.z = cvtpk(s11[8 * ks + 4], s11[8 * ks + 5]); x.w = cvtpk(s11[8 * ks + 6], s11[8 * ks + 7]); p11[ks] = __builtin_bit_cast(bf16x8, x);
    }
    f32x16 o0 = {}, o1 = {};
#pragma unroll
    for (int kd = 0; kd < 8; ++kd) {
        const bf16x8 q0 = *(const LAS bf16x8*)(Ql + r * QS + 16 * kd + 8 * hh), q1 = *(const LAS bf16x8*)(Ql + (32 + r) * QS + 16 * kd + 8 * hh);
        o0 = MFMA32(q0, R.cf[kd], o0); o1 = MFMA32(q1, R.cf[kd], o1); }
    asm volatile("" ::: "memory");
    if (has_next) ml_load_state(F, cn, hn, R);
#pragma unroll
    for (int q = 0; q < 16; ++q) { o0[q] *= tb_wi[crow(q, hh)]; o1[q] *= tb_wi[32 + crow(q, hh)]; }
#pragma unroll
    for (int st = 0; st < 2; ++st)
#pragma unroll
        for (int ks = 0; ks < 2; ++ks) {
            u32x4v bb; bb.x = R.vlo[2 * st + ks].x; bb.y = R.vlo[2 * st + ks].y; bb.z = R.vhi[2 * st + ks].x; bb.w = R.vhi[2 * st + ks].y; const bf16x8 vf = __builtin_bit_cast(bf16x8, bb);
            if (st == 0) { o0 = MFMA32(p00[ks], vf, o0); o1 = MFMA32(p01[ks], vf, o1); } else { o1 = MFMA32(p11[ks], vf, o1); }
        }
    asm volatile("" ::: "memory");
    if (has_next) ml_load_vt(F, cn, hn, R);
#pragma unroll
    for (int q = 0; q < 16; ++q) { o0[q] *= tb_den[w * 64 + crow(q, hh)]; o1[q] *= tb_den[w * 64 + 32 + crow(q, hh)]; }
#pragma unroll
    for (int q = 0; q < 16; ++q) {
        float a = dpp_row_sum(o0[q]), a2 = dpp_row_sum(o0[q] * o0[q]), b = dpp_row_sum(o1[q]), b2 = dpp_row_sum(o1[q] * o1[q]);
        a += __shfl_xor(a, 16); a2 += __shfl_xor(a2, 16); b += __shfl_xor(b, 16); b2 += __shfl_xor(b2, 16);
        if (r == 0) { const int t = crow(q, hh); tb_ln[(w * 64 + t) * 2] = a; tb_ln[(w * 64 + t) * 2 + 1] = a2; tb_ln[(w * 64 + 32 + t) * 2] = b; tb_ln[(w * 64 + 32 + t) * 2 + 1] = b2; }
    }
    __syncthreads();
    if (tid < 64) { float s = 0.f, s2 = 0.f;
#pragma unroll
        for (int ww = 0; ww < 8; ++ww) { s += tb_ln[(ww * 64 + tid) * 2]; s2 += tb_ln[(ww * 64 + tid) * 2 + 1]; }
        const float mu = s * (1.f / 256.f), var = fmaxf(s2 * (1.f / 256.f) - mu * mu, 0.f); tb_mr[tid * 2] = mu; tb_mr[tid * 2 + 1] = rsqrtf(var + LN_EPS); }
    __syncthreads();
    const float nw = F.normw[h * 256 + vcol];
#pragma unroll
    for (int tt = 0; tt < 2; ++tt)
#pragma unroll
        for (int q = 0; q < 16; ++q) {
            const int t = 32 * tt + crow(q, hh); const float mu = tb_mr[t * 2], rstd = tb_mr[t * 2 + 1];
            const float hv = tt ? o1[q] : o0[q];
            LAS unsigned short* op = Ml + t * MS + vcol; const float mo = bf2f(*op);
            *op = (unsigned short)f2bf((hv - mu) * rstd * nw * sigmoid_f(mo));
        }
    __syncthreads();
    {   v4u* MX = (v4u*)(F.ws + WS_MIX);
#pragma unroll
        for (int i = 0; i < 4; ++i) { const int idx = tid + 512 * i, row = idx >> 5, ch = idx & 31; MX[(size_t)(t0 + row) * 256 + h * 32 + ch] = *(LAS v4u*)(Ml + row * MS + ch * 8); } }
    __syncthreads();
}

constexpr int ML_BLK = 73728;
struct MlRegs2 { bf16x8 cf[8]; u32x2 vlo[4], vhi[4]; };
__device__ __forceinline__ void ml2_load_state(Frame& F, int c, int h, int vcol, int hh, bf16x8 (&cf)[8]) {
    const GAS char* sb = (const GAS char*)(F.ws + WS_LOCAL) + (size_t)__builtin_amdgcn_readfirstlane((c * 4 + h) * 65536);
    unsigned vo = (unsigned)(vcol * 16 + hh * 4096); asm volatile("" : "+v"(vo));
#pragma unroll
    for (int kd = 0; kd < 8; ++kd) cf[kd] = *(const GAS bf16x8*)(sb + vo + kd * 8192);
}
__device__ __forceinline__ void ml2_load_vt(Frame& F, int c, int h, int vcol, int hh, u32x2 (&vlo)[4], u32x2 (&vhi)[4]) {
    const GAS char* sb = (const GAS char*)(F.ws + WS_VT) + (size_t)__builtin_amdgcn_readfirstlane((c * 4 + h) * 32768);
    unsigned vo = (unsigned)(vcol * 8 + hh * 2048); asm volatile("" : "+v"(vo));
#pragma unroll
    for (int i = 0; i < 4; ++i) { vlo[i] = *(const GAS u32x2*)(sb + vo + i * 8192); vhi[i] = *(const GAS u32x2*)(sb + vo + i * 8192 + 4096); }
}
__device__ __forceinline__ void ml_out_item2(Frame& F, int c, int h, MlRegs2& R, bool has_next, int cn, int hn) {
    const int lane = F.lane, r = lane & 31, hh = lane >> 5, w = F.wave, half = w >> 2, w4 = w & 3, ltid = F.tid & 255, t0 = c * ML_L;
    constexpr int QS = 136, MS = 264;
    const int lbase = half * ML_BLK;
    LAS float* tb_u = (LAS float*)(F.lds + lbase);
    LAS float* tb_mt = tb_u + 64;
    LAS float* tb_wi = tb_mt + 64;
    LAS float* tb_em = tb_wi + 64;
    LAS float* tb_n = tb_em + 64;
    LAS float* tb_den = tb_n + 128;
    LAS float* tb_ln = tb_den + 256;
    LAS float* tb_mr = tb_ln + 512;
    LAS unsigned short* Ql = (LAS unsigned short*)(F.lds + lbase + 5120);
    LAS unsigned short* Kl = Ql + 64 * QS;
    LAS unsigned short* Ml = Kl + 64 * QS;
    const int vcA = 64 * w4 + r, vcB = vcA + 32;
#define CR(q) (((q) & 3) + 8 * ((q) >> 2))
    LAS float* ub = tb_u + 4 * hh; LAS float* wib = tb_wi + 4 * hh; LAS float* denb = tb_den + w4 * 64 + 4 * hh; LAS float* lnb = tb_ln + (w4 * 64 + 4 * hh) * 2; LAS float* mrb = tb_mr + 8 * hh;
    LAS unsigned short* mlb = Ml + 4 * hh * MS + vcA;
    LAS unsigned short* qb0 = Ql + r * QS + 8 * hh; LAS unsigned short* kb0 = Kl + r * QS + 8 * hh; LAS float* nb = tb_n + 8 * hh;
    asm volatile("" : "+v"(ub), "+v"(wib), "+v"(denb), "+v"(lnb), "+v"(mrb), "+v"(mlb), "+v"(qb0), "+v"(kb0), "+v"(nb));
    const int r4 = r - 4 * hh;
    const int rowq = ltid >> 4, chq = ltid & 15, rowm = ltid >> 5, chm = ltid & 31;
    LAS unsigned short* qld = Ql + rowq * QS + chq * 8; LAS unsigned short* kld = Kl + rowq * QS + chq * 8; LAS unsigned short* mld = Ml + rowm * MS + chm * 8;
    {
        const v4u* qsrc = (const v4u*)(F.ws + WS_QC) + (size_t)(t0 + rowq) * 64 + h * 16 + chq; const v4u* ksrc = (const v4u*)(F.ws + WS_KC) + (size_t)(t0 + rowq) * 64 + h * 16 + chq;
        const v4u* msrc = (const v4u*)(F.ws + WS_MIX) + (size_t)(t0 + rowm) * 256 + h * 32 + chm;
        v4u gq[4], gk[4];
#pragma unroll
        for (int i = 0; i < 4; ++i) { gq[i] = qsrc[i * 16 * 64]; gk[i] = ksrc[i * 16 * 64]; }
        float m_c, m_c1; ml_mscan(SMALLF(SM_CHSUM), h, c, lane, m_c, m_c1);
        if (ltid < 64) { const f32x4 ts = *(const f32x4*)(SMALLF(SM_TOKSC) + (size_t)((t0 + ltid) * 4 + h) * 4);
            const float mt = fmaxf(m_c, ts.z); tb_u[ltid] = ts.y; tb_mt[ltid] = mt; tb_wi[ltid] = expf(m_c - mt); tb_em[ltid] = expf(-(ts.x + mt)); }
        if (ltid >= 64 && ltid < 192) tb_n[ltid - 64] = SMALLF(SM_NLOC)[(c * 4 + h) * 128 + ltid - 64];
#pragma unroll
        for (int i = 0; i < 4; ++i) { *(LAS v4u*)(qld + i * 16 * QS) = gq[i]; *(LAS v4u*)(kld + i * 16 * QS) = gk[i]; }
        asm volatile("" ::: "memory");
        v4u gm[8];
#pragma unroll
        for (int i = 0; i < 8; ++i) gm[i] = msrc[i * 8 * 256];
#pragma unroll
        for (int i = 0; i < 8; ++i) *(LAS v4u*)(mld + i * 8 * MS) = gm[i];
    }
    __syncthreads();
    f32x16 s00 = {}, s01 = {}, s11 = {};
    float qn0 = 0.f, qn1 = 0.f;
#pragma unroll 1
    for (int kd = 0; kd < 8; ++kd) {
        const bf16x8 q0 = *(const LAS bf16x8*)(qb0 + 16 * kd), q1 = *(const LAS bf16x8*)(qb0 + 32 * QS + 16 * kd);
        const bf16x8 k0 = *(const LAS bf16x8*)(kb0 + 16 * kd), k1 = *(const LAS bf16x8*)(kb0 + 32 * QS + 16 * kd);
        s00 = MFMA32(k0, q0, s00); s01 = MFMA32(k0, q1, s01); s11 = MFMA32(k1, q1, s11);
        const f32x4 n0 = *(const LAS f32x4*)(nb + 16 * kd), n1 = *(const LAS f32x4*)(nb + 16 * kd + 4);
        const u32x4v a = __builtin_bit_cast(u32x4v, q0), b = __builtin_bit_cast(u32x4v, q1);
        qn0 += bflo(a.x) * n0.x + bfhi(a.x) * n0.y + bflo(a.y) * n0.z + bfhi(a.y) * n0.w + bflo(a.z) * n1.x + bfhi(a.z) * n1.y + bflo(a.w) * n1.z + bfhi(a.w) * n1.w;
        qn1 += bflo(b.x) * n0.x + bfhi(b.x) * n0.y + bflo(b.y) * n0.z + bfhi(b.y) * n0.w + bflo(b.z) * n1.x + bfhi(b.z) * n1.y + bflo(b.w) * n1.z + bfhi(b.w) * n1.w;
    }
    const float mt0 = tb_mt[r], mt1 = tb_mt[32 + r];
    float rs0 = 0.f, rs1 = 0.f;
#pragma unroll
    for (int q = 0; q < 16; ++q) {
        const float u0 = ub[CR(q)], u1 = ub[32 + CR(q)];
        s00[q] = (CR(q) <= r4) ? s00[q] * __expf(u0 - mt0) : 0.f;
        s01[q] = s01[q] * __expf(u0 - mt1);
        s11[q] = (CR(q) <= r4) ? s11[q] * __expf(u1 - mt1) : 0.f;
        rs0 += s00[q]; rs1 += s01[q] + s11[q];
    }
    rs0 += __shfl_xor(rs0, 32); rs1 += __shfl_xor(rs1, 32); qn0 += __shfl_xor(qn0, 32); qn1 += __shfl_xor(qn1, 32);
    {   const float den0 = tb_wi[r] * qn0 + rs0, den1 = tb_wi[32 + r] * qn1 + rs1;
        if (hh == 0) { tb_den[w4 * 64 + r] = 1.f / fmaxf(fabsf(den0), tb_em[r]); tb_den[w4 * 64 + 32 + r] = 1.f / fmaxf(fabsf(den1), tb_em[32 + r]); } }
    bf16x8 p00[2], p01[2], p11[2];
#pragma unroll
    for (int ks = 0; ks < 2; ++ks) {
        u32x4v x; x.x = cvtpk(s00[8 * ks], s00[8 * ks + 1]); x.y = cvtpk(s00[8 * ks + 2], s00[8 * ks + 3]); x.z = cvtpk(s00[8 * ks + 4], s00[8 * ks + 5]); x.w = cvtpk(s00[8 * ks + 6], s00[8 * ks + 7]); p00[ks] = __builtin_bit_cast(bf16x8, x);
        x.x = cvtpk(s01[8 * ks], s01[8 * ks + 1]); x.y = cvtpk(s01[8 * ks + 2], s01[8 * ks + 3]); x.z = cvtpk(s01[8 * ks + 4], s01[8 * ks + 5]); x.w = cvtpk(s01[8 * ks + 6], s01[8 * ks + 7]); p01[ks] = __builtin_bit_cast(bf16x8, x);
        x.x = cvtpk(s11[8 * ks], s11[8 * ks + 1]); x.y = cvtpk(s11[8 * ks + 2], s11[8 * ks + 3]); x.z = cvtpk(s11[8 * ks + 4], s11[8 * ks + 5]); x.w = cvtpk(s11[8 * ks + 6], s11[8 * ks + 7]); p11[ks] = __builtin_bit_cast(bf16x8, x);
    }
    f32x16 oa0 = {}, oa1 = {}, ob0 = {}, ob1 = {};
#define ML2_TILE(O0, O1, FIRST, AFTER_INTER, AFTER_INTRA) do { \
    _Pragma("unroll") for (int kd = 0; kd < 8; ++kd) { if ((kd & 1) == 0) asm volatile("" ::: "memory"); \
        const bf16x8 q0 = *(const LAS bf16x8*)(qb0 + 16 * kd), q1 = *(const LAS bf16x8*)(qb0 + 32 * QS + 16 * kd); \
        O0 = MFMA32(q0, R.cf[kd], O0); O1 = MFMA32(q1, R.cf[kd], O1); } \
    bf16x8 vf_[4]; \
    _Pragma("unroll") for (int i = 0; i < 4; ++i) { u32x4v bb; bb.x = R.vlo[i].x; bb.y = R.vlo[i].y; bb.z = R.vhi[i].x; bb.w = R.vhi[i].y; vf_[i] = __builtin_bit_cast(bf16x8, bb); } \
    asm volatile("" ::: "memory"); \
    AFTER_INTER; \
    _Pragma("unroll") for (int q = 0; q < 16; ++q) { O0[q] *= wib[CR(q)]; O1[q] *= wib[32 + CR(q)]; } \
    O0 = MFMA32(p00[0], vf_[0], O0); O1 = MFMA32(p01[0], vf_[0], O1); O0 = MFMA32(p00[1], vf_[1], O0); O1 = MFMA32(p01[1], vf_[1], O1); \
    O1 = MFMA32(p11[0], vf_[2], O1); O1 = MFMA32(p11[1], vf_[3], O1); \
    AFTER_INTRA; \
    _Pragma("unroll") for (int q = 0; q < 16; ++q) { O0[q] *= denb[CR(q)]; O1[q] *= denb[32 + CR(q)]; } \
    _Pragma("unroll") for (int q = 0; q < 16; ++q) { \
        float a = dpp_row_sum(O0[q]), a2 = dpp_row_sum(O0[q] * O0[q]), b = dpp_row_sum(O1[q]), b2 = dpp_row_sum(O1[q] * O1[q]); \
        a += __shfl_xor(a, 16); a2 += __shfl_xor(a2, 16); b += __shfl_xor(b, 16); b2 += __shfl_xor(b2, 16); \
        if (r == 0) { LAS float* p0_ = lnb + CR(q) * 2; LAS float* p1_ = lnb + (32 + CR(q)) * 2; \
            if (FIRST) { p0_[0] = a; p0_[1] = a2; p1_[0] = b; p1_[1] = b2; } else { p0_[0] += a; p0_[1] += a2; p1_[0] += b; p1_[1] += b2; } } } } while (0)
    ML2_TILE(oa0, oa1, true, ml2_load_state(F, c, h, vcB, hh, R.cf), ml2_load_vt(F, c, h, vcB, hh, R.vlo, R.vhi));
    ML2_TILE(ob0, ob1, false, { if (has_next) ml2_load_state(F, cn, hn, vcA, hh, R.cf); }, { if (has_next) ml2_load_vt(F, cn, hn, vcA, hh, R.vlo, R.vhi); });
#undef ML2_TILE
    __syncthreads();
    if (ltid < 64) { float s = 0.f, s2 = 0.f;
#pragma unroll
        for (int ww = 0; ww < 4; ++ww) { s += tb_ln[(ww * 64 + ltid) * 2]; s2 += tb_ln[(ww * 64 + ltid) * 2 + 1]; }
        const float mu = s * (1.f / 256.f), var = fmaxf(s2 * (1.f / 256.f) - mu * mu, 0.f); tb_mr[ltid * 2] = mu; tb_mr[ltid * 2 + 1] = rsqrtf(var + LN_EPS); }
    __syncthreads();
    {   const float nwA = F.normw[h * 256 + vcA], nwB = F.normw[h * 256 + vcB];
#pragma unroll
        for (int tt = 0; tt < 2; ++tt)
#pragma unroll
            for (int q = 0; q < 16; ++q) {
                if ((q & 3) == 0) asm volatile("" ::: "memory");
                const float mu = mrb[(32 * tt + CR(q)) * 2], rstd = mrb[(32 * tt + CR(q)) * 2 + 1];
                const float ha = tt ? oa1[q] : oa0[q], hb = tt ? ob1[q] : ob0[q];
                LAS unsigned short* opa = mlb + (32 * tt + CR(q)) * MS; LAS unsigned short* opb = opa + 32;
                const float moa = bf2f(*opa), mob = bf2f(*opb);
                *opa = (unsigned short)f2bf((ha - mu) * rstd * nwA * sigmoid_f(moa));
                *opb = (unsigned short)f2bf((hb - mu) * rstd * nwB * sigmoid_f(mob));
            } }
    __syncthreads();
    {   v4u* mdst = (v4u*)(F.ws + WS_MIX) + (size_t)(t0 + rowm) * 256 + h * 32 + chm;
#pragma unroll
        for (int i = 0; i < 8; ++i) mdst[i * 8 * 256] = *(LAS v4u*)(mld + i * 8 * MS); }
    __syncthreads();
#undef CR
}

__device__ __forceinline__ void x2_phase(Frame& F) {
    constexpr int NSCAN = 33;
#if defined(NAIVE_MOBA)
    for (int i = F.bid; i < NSCAN; i += F.G) ml_scan_item(F, i);
#elif defined(NAIVE_MLSTM)
    moba_attn_phase(F);
#else
    for (int i = F.bid; i < NSCAN; i += F.G) { TP_BEGIN(100); ml_scan_item(F, i); TP_END(100); }
    __syncthreads();
    TP_BEGIN(101); moba_attn_phase(F); TP_END(101);
#endif
}
__device__ __forceinline__ void x3_phase(Frame& F) {
    bool merged = false;
#if !defined(NAIVE_MLSTM)
    TP_BEGIN(150);
    if ((ML_NC * ML_H) % (2 * F.G) == 0) {
        MlRegs2 R2; const int half = F.wave >> 2, hh_ = F.lane >> 5, vcA_ = 64 * (F.wave & 3) + (F.lane & 31);
        int it = F.bid + half * F.G;
        ml2_load_state(F, it >> 2, it & 3, vcA_, hh_, R2.cf); ml2_load_vt(F, it >> 2, it & 3, vcA_, hh_, R2.vlo, R2.vhi);
        const int n_it = (ML_NC * ML_H) / (2 * F.G), slot = F.bid % (n_it + 1);
#pragma unroll 1
        for (int s = 0; s <= n_it; ++s) {
#if !defined(NAIVE_MOBA) && !defined(DBG_SKIP_MERGE)
            if (s == slot) { moba_merge_phase(F, F.bid, F.G); merged = true; }
#endif
            if (s < n_it) { const int nx = it + 2 * F.G; const bool hn = nx < ML_NC * ML_H; ml_out_item2(F, it >> 2, it & 3, R2, hn, nx >> 2, nx & 3); it = nx; }
        }
    } else
    {   MlRegs R; int it = F.bid;
        if (it < ML_NC * ML_H) { ml_load_state(F, it >> 2, it & 3, R); ml_load_vt(F, it >> 2, it & 3, R); }
        for (; it < ML_NC * ML_H; it += F.G) { const int nx = it + F.G; const bool hn = nx < ML_NC * ML_H; ml_out_item(F, it >> 2, it & 3, R, hn, nx >> 2, nx & 3); } }
#endif
#if !defined(NAIVE_MOBA) && !defined(DBG_SKIP_MERGE)
    if (!merged) { TP_BEGIN(151); moba_merge_phase(F, F.bid, F.G); TP_END(151); }
#endif
}
__global__ void __launch_bounds__(512) naive_moba(unsigned char* ws) {
    __shared__ float qf_s[8][128];
    __shared__ float pb_s[8][1024];
    const int wave = threadIdx.x >> 6, lane = threadIdx.x & 63;
    const int gw = blockIdx.x * 8 + wave; const int p = gw >> 3, h = gw & 7;
    unsigned short* MIX = (unsigned short*)(ws + WS_MIX);
    const unsigned short* KB = (const unsigned short*)(ws + WS_KB); const unsigned short* VB = (const unsigned short*)(ws + WS_VB);
    const float* kmean = (const float*)(ws + WS_SMALL + SM_KMEAN);
    float* qf = qf_s[wave]; float* pb = pb_s[wave];
    unsigned short* qp = MIX + (size_t)p * 2048 + 1024 + h * 128;
    qf[lane * 2] = bf2f(qp[lane * 2]); qf[lane * 2 + 1] = bf2f(qp[lane * 2 + 1]);
    __syncthreads();
    const int b = p >> 8;
    float sc = -INFINITY;
    if (lane < b) { const float* km = kmean + (size_t)(h * 64 + lane) * 128; float s = 0.f; for (int d = 0; d < 128; ++d) s += qf[d] * km[d]; sc = s; }
    int sel[3]; const int nsel = b < 3 ? b : 3;
#pragma unroll
    for (int k = 0; k < 3; ++k) {
        float bv = sc; int bi = lane;
        for (int o = 1; o < 64; o <<= 1) { const float ov = __shfl_xor(bv, o); const int oi = __shfl_xor(bi, o); if (ov > bv || (ov == bv && oi < bi)) { bv = ov; bi = oi; } }
        sel[k] = bi; if (lane == bi) sc = -INFINITY;
    }
    float s[16]; float mx = -INFINITY;
#pragma unroll
    for (int bi = 0; bi < 4; ++bi) {
        const bool valid = (bi < nsel) || (bi == 3); const int blk = (bi == 3) ? b : sel[bi < 3 ? bi : 0];
#pragma unroll
        for (int kk = 0; kk < 4; ++kk) {
            float v = -INFINITY;
            if (valid) { const int key = blk * 256 + kk * 64 + lane; const unsigned short* kr = KB + (size_t)key * 1024 + h * 128; float a = 0.f; for (int d = 0; d < 128; ++d) a += qf[d] * bf2f(kr[d]); a *= K_SCALE; if (bi == 3 && key > p) a = -INFINITY; v = a; }
            s[bi * 4 + kk] = v; mx = fmaxf(mx, v);
        }
    }
    for (int o = 1; o < 64; o <<= 1) mx = fmaxf(mx, __shfl_xor(mx, o));
    float sum = 0.f;
#pragma unroll
    for (int i = 0; i < 16; ++i) { const float e = (s[i] == -INFINITY) ? 0.f : expf(s[i] - mx); pb[i * 64 + lane] = e; sum += e; }
    sum = wave_sum(sum);
    __syncthreads();
    float o0 = 0.f, o1 = 0.f;
#pragma unroll
    for (int bi = 0; bi < 4; ++bi) {
        const bool valid = (bi < nsel) || (bi == 3); if (!valid) continue; const int blk = (bi == 3) ? b : sel[bi];
        for (int kk = 0; kk < 256; ++kk) { const float pv = pb[bi * 256 + kk]; const unsigned v = *(const unsigned*)(VB + (size_t)(blk * 256 + kk) * 1024 + h * 128 + lane * 2); o0 += pv * bflo(v); o1 += pv * bfhi(v); }
    }
    const float inv = 1.f / sum;
    *(unsigned*)(qp + lane * 2) = pk2(o0 * inv, o1 * inv);
}
__global__ void __launch_bounds__(256) naive_mlstm(unsigned char* ws, const float* igb, const float* fgb, const float* normw) {
    __shared__ float q[128], k[128], nn[128], red[4], red2[4];
    const int h = blockIdx.x, v = threadIdx.x, lane = v & 63, wv = v >> 6;
    const unsigned short* QC = (const unsigned short*)(ws + WS_QC); const unsigned short* KC = (const unsigned short*)(ws + WS_KC); const unsigned short* MV = (const unsigned short*)(ws + WS_MV);
    const float* gates = (const float*)(ws + WS_SMALL + SM_GATES); unsigned short* MIX = (unsigned short*)(ws + WS_MIX);
    float C[128];
#pragma unroll
    for (int d = 0; d < 128; ++d) C[d] = 0.f;
    float m = 0.f; if (v < 128) nn[v] = 0.f;
    const float ib = igb[h], fb = fgb[h], nw = normw[h * 256 + v];
    for (int t = 0; t < M_TOK; ++t) {
        if (v < 128) q[v] = bf2f(QC[(size_t)t * 512 + h * 128 + v]); else k[v - 128] = bf2f(KC[(size_t)t * 512 + h * 128 + v - 128]);
        const float ig = gates[t * 8 + h] + ib, lf = logsigmoid_f(gates[t * 8 + 4 + h] + fb);
        const float mn = fmaxf(lf + m, ig), fd = expf(lf + m - mn), iw = expf(ig - mn); m = mn;
        const float vv = bf2f(MV[(size_t)t * 1024 + h * 256 + v]);
        __syncthreads();
        if (v < 128) nn[v] = fd * nn[v] + iw * k[v];
        float num = 0.f;
#pragma unroll
        for (int d = 0; d < 128; ++d) { C[d] = fd * C[d] + iw * k[d] * vv; num += q[d] * C[d]; }
        __syncthreads();
        float den = 0.f;
#pragma unroll 16
        for (int d = 0; d < 128; ++d) den += q[d] * nn[d];
        const float hv = num / fmaxf(fabsf(den), expf(-m));
        float s = wave_sum(hv); if (lane == 0) red[wv] = s;
        __syncthreads();
        const float mu = (red[0] + red[1] + red[2] + red[3]) * (1.f / 256.f);
        const float dv = hv - mu; float s2 = wave_sum(dv * dv); if (lane == 0) red2[wv] = s2;
        __syncthreads();
        const float var = (red2[0] + red2[1] + red2[2] + red2[3]) * (1.f / 256.f);
        unsigned short* op = MIX + (size_t)t * 2048 + h * 256 + v;
        const float mo = bf2f(*op);
        *op = (unsigned short)f2bf(dv * rsqrtf(var + LN_EPS) * nw * sigmoid_f(mo));
    }
}
__global__ void __launch_bounds__(256) dbg_cmp_u32(const unsigned* a, const unsigned* b, size_t n, unsigned* cnt) {
    unsigned c = 0;
    for (size_t i = blockIdx.x * 256ull + threadIdx.x; i < n; i += gridDim.x * 256ull) c += (a[i] != b[i]) ? 1u : 0u;
    if (c) atomicAdd(cnt, c);
}
__global__ void __launch_bounds__(512) dbg_check_own(unsigned char* ws, unsigned* cnt) {
    __shared__ float qf_s[8][128];
    __shared__ float pb_s[8][256];
    const int wave = threadIdx.x >> 6, lane = threadIdx.x & 63;
    const int gw = blockIdx.x * 8 + wave; const int p = gw >> 3, h = gw & 7;
    const unsigned short* MIX = (const unsigned short*)(ws + WS_MIX);
    const unsigned short* KB = (const unsigned short*)(ws + WS_KB); const unsigned short* VB = (const unsigned short*)(ws + WS_VB);
    float* qf = qf_s[wave]; float* pb = pb_s[wave];
    const unsigned short* qp = MIX + (size_t)p * 2048 + 1024 + h * 128;
    qf[lane * 2] = bf2f(qp[lane * 2]); qf[lane * 2 + 1] = bf2f(qp[lane * 2 + 1]);
    __syncthreads();
    const int b = p >> 8; float s[4], mx = -INFINITY;
#pragma unroll
    for (int kk = 0; kk < 4; ++kk) { const int key = b * 256 + kk * 64 + lane; const unsigned short* kr = KB + (size_t)key * 1024 + h * 128; float a = 0.f; for (int d = 0; d < 128; ++d) a += qf[d] * bf2f(kr[d]); a *= K_SCALE; if (key > p) a = -INFINITY; s[kk] = a; mx = fmaxf(mx, a); }
    for (int o = 1; o < 64; o <<= 1) mx = fmaxf(mx, __shfl_xor(mx, o));
    float sum = 0.f;
#pragma unroll
    for (int kk = 0; kk < 4; ++kk) { const float e = (s[kk] == -INFINITY) ? 0.f : expf(s[kk] - mx); pb[kk * 64 + lane] = e; sum += e; }
    sum = wave_sum(sum);
    __syncthreads();
    float o0 = 0.f, o1 = 0.f;
    for (int kk = 0; kk < 256; ++kk) { const float pv = pb[kk]; const unsigned v = *(const unsigned*)(VB + (size_t)(b * 256 + kk) * 1024 + h * 128 + lane * 2); o0 += pv * bflo(v); o1 += pv * bfhi(v); }
    o0 /= sum; o1 /= sum;
    const unsigned short* pr = (const unsigned short*)(ws + WS_PART3) + (size_t)(p * 8 + h) * 128 + lane * 2;
    float d = fmaxf(fabsf(o0 - bf2f(pr[0])), fabsf(o1 - bf2f(pr[1])));
    for (int o = 1; o < 64; o <<= 1) d = fmaxf(d, __shfl_xor(d, o));
    const float lse_ref = mx * 1.4426950408889634f + log2f(sum); const float lse = ((const float*)(ws + WS_LSE))[(p * 8 + h) * 4 + 3];
    if (lane == 0) { if (d > 0.02f) atomicAdd(cnt, 1u); if (!(fabsf(lse - lse_ref) < 0.05f)) atomicAdd(cnt + 1, 1u); }
}
__global__ void dbg_flag(const unsigned* cnt, float* out) {
    if (threadIdx.x == 0) { if (cnt[0]) out[0] += 1000.f; if (cnt[1]) out[1] += 2000.f; if (cnt[2]) out[2] += 4000.f; if (cnt[3]) out[3] += 8000.f; }
}
#ifndef PG8_SP2
#define PG8_SP2 true
#endif
#ifndef PG8_ALIGN
#define PG8_ALIGN true
#endif
constexpr int N_PHASES = 12;
struct Args { const float* in[17]; float* out; unsigned char* ws; int ph_lo, ph_hi, li, pad; };
__global__ void __launch_bounds__(NWAVES * 64, 2) mk_fwd(Args args) {
    extern __shared__ __attribute__((aligned(16))) unsigned char lds[];
    Frame F;
    F.lds = (LAS unsigned char*)lds;
    F.MISC = (volatile LAS unsigned*)(F.lds + MISC_OFF);
    F.tid = threadIdx.x; F.lane = F.tid & 63; F.wave = __builtin_amdgcn_readfirstlane(F.tid >> 6);
    F.G = gridDim.x; F.bid = blockIdx.x; F.tp0 = 0; F.tp1 = 0;
    F.ws = args.ws; F.ctl = (gu32*)(args.ws + WS_CTL); F.out = args.out;
    F.x = args.in[0]; F.c = args.in[1]; F.w_ada = args.in[2]; F.b_ada = args.in[3]; F.w_in = args.in[4]; F.conv_w = args.in[5]; F.conv_b = args.in[6];
    F.igb = args.in[7]; F.fgb = args.in[8]; F.normw = args.in[9]; F.w_out = args.in[10]; F.ln1_w = args.in[11]; F.ln1_b = args.in[12];
    F.w_gu = args.in[13]; F.w_down = args.in[14]; F.ln2_w = args.in[15]; F.ln2_b = args.in[16];
    for (int u = F.tid; u < (LDS_BYTES - LDSCTL_OFF) / 4; u += NWAVES * 64) ((LAS unsigned*)(F.lds + LDSCTL_OFF))[u] = 0u;
    __syncthreads();
    const int lo = args.ph_lo, hi = args.ph_hi;
    XcdBarrier bar; bar.bar = (unsigned*)(F.ctl + CW_BAR) + args.li * XCD_BAR_WORDS; bar.x = 0; bar.st = nullptr;
    if (hi - lo > 1) bar = xcd_barrier_post((unsigned*)(F.ctl + CW_BAR) + args.li * XCD_BAR_WORDS, F.MISC + 8);
#ifndef PHMASK
#define PHMASK 0xFFF
#endif
#define IN(k) (((PHMASK >> (k)) & 1) && lo <= (k) && (k) < hi)
#if defined(TIME_PHASE)
    unsigned long long tp0 = 0, tp1 = 0;
#define TSTAMP(k) do { if ((k) + 1 == TIME_PHASE) tp0 = __builtin_amdgcn_s_memrealtime(); if ((k) == TIME_PHASE) tp1 = __builtin_amdgcn_s_memrealtime(); } while (0)
#else
#define TSTAMP(k) do { } while (0)
#endif
#define SEAM(k) do { if (IN(k) && IN((k) + 1)) xcd_barrier(bar); TSTAMP(k); } while (0)
    float* ada = SMALLF(SM_ADA);
#if defined(TIME_PHASE)
    if (TIME_PHASE == 0) tp0 = __builtin_amdgcn_s_memrealtime();
#endif
    if (IN(0)) { p0_phase(F); } SEAM(0);
    if (IN(1)) { p1_phase(F); } SEAM(1);
    if (IN(2)) {
        pg8::Gemm g{(const pg8::bf16_t*)(F.ws + WS_U), (const pg8::bf16_t*)(F.ws + WS_WIN), M_TOK, NPROJ, DM}; pg8::StaticOrder S; S.init(M_TOK, NPROJ, F.G, F.bid, WGM_P2);
        pg8::EpiProj E{(pg8::bf16_t*)(F.ws + WS_MIX), (pg8::bf16_t*)(F.ws + WS_KB), (pg8::bf16_t*)(F.ws + WS_VB), (pg8::bf16_t*)(F.ws + WS_MQK), (pg8::bf16_t*)(F.ws + WS_MV), (const float*)(F.ws + WS_ROPE), SMALLF(SM_KMEAN)};
        pg8::gemm_phase<pg8::EpiProj, pg8::StaticOrder, PG8_ALIGN, PG8_SP2>(F.lds, g, S, E);
    } SEAM(2);
    if (IN(3)) { p3_phase(F); } SEAM(3);
    TSTAMP(4);
    if (IN(5)) { x2_phase(F); } SEAM(5);
    if (IN(6)) { x3_phase(F); } SEAM(6);
    if (IN(7)) {
        pg8::Gemm g{(const pg8::bf16_t*)(F.ws + WS_MIX), (const pg8::bf16_t*)(F.ws + WS_WOUT), M_TOK, DM, DM}; pg8::StaticOrder S; S.init(M_TOK, DM, F.G, F.bid, WGM_P5);
#if defined(EXP_P5_EXTRA)
        { pg8::StaticOrder S2; S2.init(M_TOK, DM, F.G, F.bid, WGM_P5); pg8::EpiY1T<(EXP_P5_EXTRA) & 7> E2{F.x, ada + 2 * DM, (pg8::bf16_t*)(F.ws + WS_Y1B), (unsigned long long*)(F.ws + WS_KWT)};
          pg8::gemm_phase<pg8::EpiY1T<(EXP_P5_EXTRA) & 7>, pg8::StaticOrder, PG8_ALIGN, PG8_SP2>(F.lds, g, S2, E2); }
#endif
        pg8::EpiY1 E{F.x, ada + 2 * DM, (pg8::bf16_t*)(F.ws + WS_Y1B), (unsigned long long*)SMALLF(SM_MUR)};
        pg8::gemm_phase<pg8::EpiY1, pg8::StaticOrder, PG8_ALIGN, PG8_SP2>(F.lds, g, S, E);
    } SEAM(7);
    TSTAMP(8);
    if (IN(9)) {
        pg8::Gemm g{(const pg8::bf16_t*)(F.ws + WS_Y1B), (const pg8::bf16_t*)(F.ws + WS_WGU), M_TOK, NGU, DM}; pg8::StaticOrder S; S.init(M_TOK, NGU, F.G, F.bid, WGM_P6);
        pg8::EpiSwiGLU E{(const unsigned long long*)SMALLF(SM_MUR), SMALLF(SM_C1), SMALLF(SM_C2), (pg8::bf16_t*)(F.ws + WS_H), &F.tp1};
        pg8::gemm_phase<pg8::EpiSwiGLU, pg8::StaticOrder, PG8_ALIGN, PG8_SP2>(F.lds, g, S, E);
    } SEAM(9);
    if (IN(10)) {
        pg8::Gemm g{(const pg8::bf16_t*)(F.ws + WS_H), (const pg8::bf16_t*)(F.ws + WS_WDOWN), M_TOK, DM, DFF}; pg8::StaticOrder S; S.init(M_TOK, DM, F.G, F.bid, WGM_P7);
        pg8::EpiY2 E{(const pg8::bf16_t*)(F.ws + WS_Y1B), (const unsigned long long*)SMALLF(SM_MUR), ada + 5 * DM, F.ln1_w, F.ln1_b, (pg8::bf16_t*)(F.ws + WS_Y2B)};
#if defined(EXP_P7_EXTRA)
        { pg8::StaticOrder S2; S2.init(M_TOK, DM, F.G, F.bid, WGM_P7); pg8::gemm_phase<pg8::EpiY2, pg8::StaticOrder, PG8_ALIGN, PG8_SP2>(F.lds, g, S2, E); }
#endif
        TP_BEGIN(141); pg8::gemm_phase<pg8::EpiY2, pg8::StaticOrder, PG8_ALIGN, PG8_SP2>(F.lds, g, S, E); TP_END(141);
    }
    {
        const bool both = IN(10) && IN(11);
        bool fused = false;
        if (both) { TP_BEGIN(140); fused = ln2_panel_fused(F); TP_END(140); }
        if (!fused) { SEAM(10); if (IN(11)) { ln2_phase(F); } }
    }
#if defined(TIME_PHASE)
    if (TIME_PHASE == 11) tp1 = __builtin_amdgcn_s_memrealtime();
    if (TIME_PHASE >= 100) { tp0 = F.tp0; tp1 = F.tp1; }
    if ((F.bid == 0 || TIME_PHASE >= 100) && F.tid == 0 && tp1 > tp0) { const unsigned long long te = __builtin_amdgcn_s_memrealtime(); const unsigned long long want = (tp1 - tp0) * TIME_MULT;
        while (__builtin_amdgcn_s_memrealtime() - te < want) __builtin_amdgcn_s_sleep(32); }
#endif
#undef IN
#undef SEAM
}

#ifndef MK_MODE
#define MK_MODE 1
#endif
extern "C" void kernel_launch(void* const* d_in, const int* in_sizes, int n_in, void* d_out, int out_size, void* d_ws, size_t ws_size, hipStream_t stream) {
    static int grid = 0;
    if (grid == 0) {
        if (n_in != 17 || in_sizes[0] != M_TOK * DM || out_size != M_TOK * DM || ws_size < WS_END) {
            fprintf(stderr, "kernel_launch: shape mismatch: n_in %d in0 %d out %d ws %zu (need %zu)\n", n_in, n_in > 0 ? in_sizes[0] : -1, out_size, ws_size, (size_t)WS_END); grid = -1; return; }
        int dev = 0, cus = 0, per_cu = 0;
        if (hipGetDevice(&dev) != hipSuccess || hipDeviceGetAttribute(&cus, hipDeviceAttributeMultiprocessorCount, dev) != hipSuccess) { fprintf(stderr, "kernel_launch: device query failed\n"); grid = -1; return; }
        if (hipFuncSetAttribute((const void*)mk_fwd, hipFuncAttributeMaxDynamicSharedMemorySize, LDS_BYTES) != hipSuccess) { fprintf(stderr, "kernel_launch: hipFuncSetAttribute failed\n"); grid = -1; return; }
        if (hipOccupancyMaxActiveBlocksPerMultiprocessor(&per_cu, (const void*)mk_fwd, NWAVES * 64, LDS_BYTES) != hipSuccess || per_cu < 1) { fprintf(stderr, "kernel_launch: occupancy query says %d blocks per CU\n", per_cu); (void)hipGetLastError(); grid = -1; return; }
        grid = cus;
    }
    if (grid < 0) return;
    (void)hipMemsetAsync((char*)d_ws + WS_CTL, 0, CTL_ZERO_BYTES, stream);
    Args a{};
    for (int i = 0; i < 17; ++i) a.in[i] = (const float*)d_in[i];
    a.out = (float*)d_out; a.ws = (unsigned char*)d_ws;
#if MK_MODE == 0
    for (int ph = 0; ph < N_PHASES; ++ph) {
#if defined(NAIVE_MOBA)
        if (ph == 4) hipLaunchKernelGGL(naive_moba, dim3(M_TOK), dim3(512), 0, stream, (unsigned char*)d_ws);
#endif
#if defined(DBG_NAIVE_MOBA_LATE)
        if (ph == 7) hipLaunchKernelGGL(naive_moba, dim3(M_TOK), dim3(512), 0, stream, (unsigned char*)d_ws);
#endif
#if defined(NAIVE_MLSTM)
        if (ph == 4) hipLaunchKernelGGL(naive_mlstm, dim3(ML_H), dim3(256), 0, stream, (unsigned char*)d_ws, (const float*)d_in[7], (const float*)d_in[8], (const float*)d_in[9]);
#endif
        a.ph_lo = ph; a.ph_hi = ph + 1; a.li = 0;
        hipLaunchKernelGGL(mk_fwd, dim3(grid), dim3(NWAVES * 64), LDS_BYTES, stream, a);
#if defined(DBG_X2_TWICE)
        if (ph == 5) {
            unsigned* dc = (unsigned*)((char*)d_ws + WS_CTL) + 32768;
            (void)hipMemcpyAsync((char*)d_ws + WS_LOCAL, (char*)d_ws + WS_PART3, 32 * MiB, hipMemcpyDeviceToDevice, stream);
            hipLaunchKernelGGL(mk_fwd, dim3(grid), dim3(NWAVES * 64), LDS_BYTES, stream, a);
            hipLaunchKernelGGL(dbg_cmp_u32, dim3(1024), dim3(256), 0, stream, (const unsigned*)((char*)d_ws + WS_LOCAL), (const unsigned*)((char*)d_ws + WS_PART3), (size_t)(8 * MiB), dc);
            hipLaunchKernelGGL(dbg_check_own, dim3(M_TOK), dim3(512), 0, stream, (unsigned char*)d_ws, dc + 1);
        }
#endif
    }
#if defined(DBG_X2_TWICE)
    hipLaunchKernelGGL(dbg_flag, dim3(1), dim3(64), 0, stream, (const unsigned*)((char*)d_ws + WS_CTL) + 32768, (float*)d_out);
#endif
#else
    a.ph_lo = 0; a.ph_hi = N_PHASES; a.li = 0;
    hipLaunchKernelGGL(mk_fwd, dim3(grid), dim3(NWAVES * 64), LDS_BYTES, stream, a);
#endif
    const hipError_t le = hipPeekAtLastError();
    if (le != hipSuccess) fprintf(stderr, "kernel_launch: launch failed: %s\n", hipGetErrorName(le));
}
```
